# Optimizing an MI355X kernel written in HIP

```python
import math
import jax, jax.numpy as jnp
from jax import lax
import numpy as np


D_MODEL = 2048
BATCH = 4
SEQ = 4096
DEPTH = 4
DEC_BATCH = 8
DEC_SEQ = 4096
PAST_LEN = 128

HYENA_WIDTH = 1024
HYENA_ORDER = 2
FILTER_HIDDEN = 64
N_BANDS = 16
FILTER_FEAT = 1 + 2 * N_BANDS
FAST_DECAY_PCT = 0.3
SLOW_DECAY_PCT = 1.5
DECAY_TARGET = 1e-2
ATTN_GROUPS = ((128, 1), (512, 4), (2048, 16))
N_GROUPS = len(ATTN_GROUPS)
HEADS_PER_GROUP = 8
HEAD_DIM = 64
N_ATTN_HEADS = N_GROUPS * HEADS_PER_GROUP
ATTN_WIDTH = N_ATTN_HEADS * HEAD_DIM
ATTN_OUT = HEADS_PER_GROUP * HEAD_DIM
REL_BUCKETS = 32
REL_MAX_DIST = 1024
D_FF = 5632
NORM_EPS = 1e-6
N_MOD = 6
IN_COLS = 3 * HYENA_WIDTH + 3 * ATTN_WIDTH + 2 * D_MODEL
NEG_INF = -1e30

kernel_name = 'hybrid_hyena_dilated_attn_encoder'


def rms_norm(x, g):
    xf = x.astype(jnp.float32)
    y = xf * lax.rsqrt(jnp.mean(xf * xf, axis=-1, keepdims=True) + NORM_EPS)
    return (y * g.astype(jnp.float32)).astype(x.dtype)


def dwconv3(x, w, b):
    xp = jnp.pad(x, ((0, 0), (1, 1), (0, 0)))
    return xp[:, :-2] * w[0] + xp[:, 1:-1] * w[1] + xp[:, 2:] * w[2] + b


def hyena_filters(L, w1, b1, fr1, w2, b2, fr2, w3):
    f32 = jnp.float32
    t = jnp.linspace(0.0, 1.0, L, dtype=f32)[:, None]
    pos = jnp.arange(L, dtype=f32)[:, None]
    bands = jnp.linspace(1e-4, N_BANDS - 1, N_BANDS, dtype=f32)[None, :]
    ang = (2.0 * math.pi / L) * pos * bands
    feat = jnp.concatenate([t, jnp.cos(ang), -jnp.sin(ang)], axis=-1)
    h = jnp.sin(fr1.astype(f32) * (feat @ w1.astype(f32) + b1.astype(f32)))
    h = jnp.sin(fr2.astype(f32) * (h @ w2.astype(f32) + b2.astype(f32)))
    h = (h @ w3.astype(f32)).reshape(L, 2, HYENA_ORDER, HYENA_WIDTH)
    max_decay = math.log(DECAY_TARGET) / FAST_DECAY_PCT
    min_decay = math.log(DECAY_TARGET) / SLOW_DECAY_PCT
    deltas = jnp.abs(jnp.linspace(min_decay, max_decay, HYENA_WIDTH, dtype=f32))
    h = h * jnp.exp(-t * deltas)[:, None, None, :]
    k2 = jnp.concatenate([h[:, 0], jnp.zeros((1, HYENA_ORDER, HYENA_WIDTH), f32), h[:0:-1, 1]], axis=0)
    k2 = k2 / jnp.sum(jnp.abs(k2), axis=0, keepdims=True)
    return jnp.fft.rfft(k2, axis=0)


def hyena_mix(u, conv_w, conv_b, K, hy_bias):
    L = u.shape[1]
    f32 = jnp.float32
    uc = dwconv3(u, conv_w, conv_b).astype(f32)
    v, x1, x2 = jnp.split(uc, 3, axis=-1)
    bias = hy_bias.astype(f32)
    z = v
    for o, xg in enumerate((x1, x2)):
        y = jnp.fft.irfft(jnp.fft.rfft(z, n=2 * L, axis=1) * K[None, :, o, :], n=2 * L, axis=1)[:, :L]
        z = xg * (y + bias[o] * z)
    return z.astype(u.dtype)


def t5_bucket(rel):
    nb = REL_BUCKETS // 2
    ret = (rel > 0).astype(np.int32) * nb
    n = np.abs(rel)
    max_exact = nb // 2
    large = max_exact + (np.log(np.maximum(n, 1) / max_exact) / np.log(REL_MAX_DIST / max_exact)
                         * (nb - max_exact)).astype(np.int32)
    large = np.minimum(large, nb - 1)
    return ret + np.where(n < max_exact, n, large)


def dilated_group_attn(q, k, v, rel_bias_g, dil, n_side):
    B, L, H, E = q.shape
    blk = n_side
    chunk = dil * blk
    Lp = -(-L // chunk) * chunk
    M = Lp // dil
    nb = M // blk

    def to_classes(a):
        a = jnp.pad(a, ((0, 0), (0, Lp - L), (0, 0), (0, 0)))
        return a.reshape(B, M, dil, H, E).transpose(0, 2, 3, 1, 4)

    def windows(a):
        a = jnp.pad(a, ((0, 0), (0, 0), (0, 0), (blk, blk), (0, 0))).reshape(B, dil, H, nb + 2, blk, E)
        return jnp.concatenate([a[:, :, :, :-2], a[:, :, :, 1:-1], a[:, :, :, 2:]], axis=4)

    qb = to_classes(q).reshape(B, dil, H, nb, blk, E)
    kw = windows(to_classes(k))
    vw = windows(to_classes(v)).astype(jnp.float32)

    qq = np.arange(blk)[:, None]
    kk = np.arange(3 * blk)[None, :]
    j = kk - blk - qq
    band = np.abs(j) <= n_side
    pos = np.arange(Lp).reshape(M, dil).T
    valid = np.pad(pos < L, ((0, 0), (blk, blk))).reshape(dil, nb + 2, blk)
    kvalid = np.concatenate([valid[:, :-2], valid[:, 1:-1], valid[:, 2:]], axis=2)
    mask = band[None, None] & kvalid[:, :, None, :]
    bias = jnp.transpose(rel_bias_g[t5_bucket(j * dil)], (2, 0, 1)).astype(jnp.float32)

    s = jnp.einsum('bdhnqe,bdhnke->bdhnqk', qb, kw, preferred_element_type=jnp.float32) / math.sqrt(E)
    s = jnp.where(mask[None, :, None], s + bias[None, None, :, None], NEG_INF)
    m = jnp.max(s, axis=-1, keepdims=True)
    p = jnp.exp(s - m)
    den = jnp.sum(p, axis=-1, keepdims=True)
    o = jnp.einsum('bdhnqk,bdhnke->bdhnqe', p, vw) / den
    lse = (m + jnp.log(den))[..., 0]
    o = o.reshape(B, dil, H, M, E).transpose(0, 3, 1, 2, 4).reshape(B, Lp, H, E)[:, :L]
    lse = lse.reshape(B, dil, H, M).transpose(0, 3, 1, 2).reshape(B, Lp, H)[:, :L]
    return o, lse


def dilated_attention(qkv, rel_bias):
    B, L, _ = qkv.shape
    q, k, v = [a.reshape(B, L, N_GROUPS, HEADS_PER_GROUP, HEAD_DIM) for a in jnp.split(qkv, 3, axis=-1)]
    outs, lses = [], []
    for g, (window, dil) in enumerate(ATTN_GROUPS):
        n_side = (window // 2) // dil
        o, lse = dilated_group_attn(q[:, :, g], k[:, :, g], v[:, :, g],
                                    rel_bias[:, g * HEADS_PER_GROUP:(g + 1) * HEADS_PER_GROUP], dil, n_side)
        outs.append(o)
        lses.append(lse)
    wts = jax.nn.softmax(jnp.stack(lses, axis=2), axis=2)
    o = jnp.sum(wts[..., None] * jnp.stack(outs, axis=2), axis=2)
    return o.reshape(B, L, ATTN_OUT).astype(qkv.dtype)


def encoder_trunk(x, c, p):
    L = x.shape[1]
    cs = jax.nn.silu(c)
    for l in range(DEPTH):
        mod = cs @ p['ada_w'][l] + p['ada_b'][l]
        sh1, sc1, g1, sh2, sc2, g2 = jnp.split(mod[:, None, :], N_MOD, axis=-1)
        h = rms_norm(x, p['norm1_g'][l]) * (1 + sc1) + sh1
        u = h @ p['w_in'][l]
        u_hy, u_at, u_gate = jnp.split(u, [3 * HYENA_WIDTH, 3 * HYENA_WIDTH + 3 * ATTN_WIDTH], axis=-1)
        K = hyena_filters(L, p['filt_w1'][l], p['filt_b1'][l], p['filt_freq1'][l],
                          p['filt_w2'][l], p['filt_b2'][l], p['filt_freq2'][l], p['filt_w3'][l])
        y_hy = hyena_mix(u_hy, p['hy_conv_w'][l], p['hy_conv_b'][l], K, p['hy_bias'][l])
        y_at = dilated_attention(u_at, p['rel_bias'])
        g_hy, g_at = jnp.split(jax.nn.sigmoid(u_gate + p['b_gate'][l]), 2, axis=-1)
        merged = g_hy * (y_hy @ p['w_br_hy'][l]) + g_at * (y_at @ p['w_br_attn'][l])
        x = x + g1 * (merged @ p['w_out'][l])
        h = rms_norm(x, p['norm2_g'][l]) * (1 + sc2) + sh2
        a, gt = jnp.split(h @ p['ffn_up'][l], 2, axis=-1)
        gt = dwconv3(gt, p['ffn_conv_w'][l], p['ffn_conv_b'][l])
        x = x + g2 * ((jax.nn.silu(gt) * a) @ p['ffn_down'][l])
    return rms_norm(x, p['final_g'])


def setup_inputs(seed: int = 0) -> dict:
    key = jax.random.key(seed)
    ks = jax.random.split(key, 32)
    f32 = jnp.float32

    def nrm(k, shape, scale):
        return scale * jax.random.normal(k, shape, f32)

    D, HW = D_MODEL, HYENA_WIDTH
    return {
        'x_prompt': nrm(ks[0], (BATCH, SEQ, D), 1.0),
        'x_sample': nrm(ks[1], (DEC_BATCH, DEC_SEQ, D), 1.0),
        'c_prompt': nrm(ks[2], (BATCH, D), 1.0),
        'c_sample': nrm(ks[3], (DEC_BATCH, D), 1.0),
        'ada_w': nrm(ks[4], (DEPTH, D, N_MOD * D), 0.5 * D ** -0.5),
        'ada_b': nrm(ks[5], (DEPTH, N_MOD * D), 0.02),
        'norm1_g': 1.0 + nrm(ks[6], (DEPTH, D), 0.01),
        'w_in': nrm(ks[7], (DEPTH, D, IN_COLS), D ** -0.5),
        'b_gate': nrm(ks[8], (DEPTH, 2 * D), 0.01),
        'hy_conv_w': nrm(ks[9], (DEPTH, 3, 3 * HW), 3 ** -0.5),
        'hy_conv_b': nrm(ks[10], (DEPTH, 3 * HW), 0.01),
        'filt_w1': nrm(ks[11], (DEPTH, FILTER_FEAT, FILTER_HIDDEN), FILTER_FEAT ** -0.5),
        'filt_b1': nrm(ks[12], (DEPTH, FILTER_HIDDEN), 0.01),
        'filt_freq1': 1.0 + nrm(ks[13], (DEPTH, FILTER_HIDDEN), 0.01),
        'filt_w2': nrm(ks[14], (DEPTH, FILTER_HIDDEN, FILTER_HIDDEN), FILTER_HIDDEN ** -0.5),
        'filt_b2': nrm(ks[15], (DEPTH, FILTER_HIDDEN), 0.01),
        'filt_freq2': 1.0 + nrm(ks[16], (DEPTH, FILTER_HIDDEN), 0.01),
        'filt_w3': nrm(ks[17], (DEPTH, FILTER_HIDDEN, 2 * HYENA_ORDER * HW), FILTER_HIDDEN ** -0.5),
        'hy_bias': nrm(ks[18], (DEPTH, HYENA_ORDER, HW), 0.5),
        'rel_bias': nrm(ks[19], (REL_BUCKETS, N_ATTN_HEADS), 0.5),
        'w_br_hy': nrm(ks[20], (DEPTH, HW, D), HW ** -0.5),
        'w_br_attn': nrm(ks[21], (DEPTH, ATTN_OUT, D), ATTN_OUT ** -0.5),
        'w_out': nrm(ks[22], (DEPTH, D, D), D ** -0.5),
        'norm2_g': 1.0 + nrm(ks[23], (DEPTH, D), 0.01),
        'ffn_up': nrm(ks[24], (DEPTH, D, 2 * D_FF), D ** -0.5),
        'ffn_conv_w': nrm(ks[25], (DEPTH, 3, D_FF), 3 ** -0.5),
        'ffn_conv_b': nrm(ks[26], (DEPTH, D_FF), 0.01),
        'ffn_down': nrm(ks[27], (DEPTH, D_FF, D), D_FF ** -0.5),
        'final_g': 1.0 + nrm(ks[28], (D,), 0.01),
    }


def reference(x_prompt, x_sample, c_prompt, c_sample, ada_w, ada_b, norm1_g, w_in, b_gate,
              hy_conv_w, hy_conv_b, filt_w1, filt_b1, filt_freq1, filt_w2, filt_b2, filt_freq2,
              filt_w3, hy_bias, rel_bias, w_br_hy, w_br_attn, w_out, norm2_g, ffn_up,
              ffn_conv_w, ffn_conv_b, ffn_down, final_g):
    params = {
        'ada_w': ada_w, 'ada_b': ada_b, 'norm1_g': norm1_g, 'w_in': w_in, 'b_gate': b_gate,
        'hy_conv_w': hy_conv_w, 'hy_conv_b': hy_conv_b, 'filt_w1': filt_w1, 'filt_b1': filt_b1,
        'filt_freq1': filt_freq1, 'filt_w2': filt_w2, 'filt_b2': filt_b2, 'filt_freq2': filt_freq2,
        'filt_w3': filt_w3, 'hy_bias': hy_bias, 'rel_bias': rel_bias, 'w_br_hy': w_br_hy,
        'w_br_attn': w_br_attn, 'w_out': w_out, 'norm2_g': norm2_g, 'ffn_up': ffn_up,
        'ffn_conv_w': ffn_conv_w, 'ffn_conv_b': ffn_conv_b, 'ffn_down': ffn_down, 'final_g': final_g,
    }
    y_prompt = encoder_trunk(x_prompt, c_prompt, params)
    y_sample = encoder_trunk(x_sample, c_sample, params)
    return (y_prompt, y_sample)
```

```cpp
#include <hip/hip_runtime.h>
#include <cstdio>
#include <cstdint>
#define DEV __device__ __forceinline__
#define DEVCONST __device__
#define LAS __attribute__((address_space(3)))
#define SYNC() __syncthreads()
#define F2U(x) __float_as_uint(x)
#define U2F(x) __uint_as_float(x)
#define BITCAST(T, v) __builtin_bit_cast(T, v)
#define EXP2(x) __builtin_amdgcn_exp2f(x)
#define LOG2(x) __builtin_amdgcn_logf(x)
#define SINCOSPI(x, s, c) do { const float hx_ = 0.5f * (x); *(s) = __builtin_amdgcn_sinf(hx_); *(c) = __builtin_amdgcn_cosf(hx_); } while (0)
__device__ __forceinline__ float shfl_from(float v, int src_lane) { return __builtin_bit_cast(float, __builtin_amdgcn_ds_bpermute(src_lane << 2, __builtin_bit_cast(int, v))); }
#define SHFL_XOR3(v, m, lane) shfl_from((v), (lane) ^ (m))
#define MFMA32(a, b, c) __builtin_amdgcn_mfma_f32_32x32x16_bf16((a), (b), (c), 0, 0, 0)
#define OPAQUE_I(x) asm volatile("" : "+v"(x))

typedef _Float16 h16x2_t __attribute__((ext_vector_type(2)));
__device__ __forceinline__ unsigned pkh2(float a, float b) { h16x2_t h; h.x = (_Float16)a; h.y = (_Float16)b; return __builtin_bit_cast(unsigned, h); }
__device__ __forceinline__ float hlo(unsigned w) { return (float)__builtin_bit_cast(h16x2_t, w).x; }
__device__ __forceinline__ float hhi(unsigned w) { return (float)__builtin_bit_cast(h16x2_t, w).y; }
constexpr int D_ = 2048, SEQ = 4096, NSEQ = 12, DEPTH_ = 4, CHS = 4  , NCHUNK = 3, MROWS = CHS * SEQ  ;
constexpr int HW_ = 1024, AW_ = 1536, AO_ = 512, DFF_ = 5632, INC_ = 11776, NMOD_ = 6;
constexpr int NA_ = 4608  , NB_ = 7168  ;
constexpr int FFTN = 8192, FPAD = FFTN + FFTN / 16  ;
constexpr int NTHR = 512;

typedef unsigned short bf16_t;
typedef short bf16x8 __attribute__((ext_vector_type(8)));
typedef float f32x4 __attribute__((ext_vector_type(4)));
typedef float f32x16 __attribute__((ext_vector_type(16)));
typedef float cf __attribute__((ext_vector_type(2)));
typedef unsigned u32x4 __attribute__((ext_vector_type(4)));
typedef unsigned u32x2 __attribute__((ext_vector_type(2)));
typedef unsigned short u16x4 __attribute__((ext_vector_type(4)));

DEV unsigned short f2bf(float f) { unsigned u = F2U(f); u += 0x7fffu + ((u >> 16) & 1u); return (unsigned short)(u >> 16); }
DEV float bf2f(unsigned short b) { return U2F(((unsigned)b) << 16); }
DEV unsigned pk2(float lo, float hi) { return (unsigned)f2bf(lo) | ((unsigned)f2bf(hi) << 16); }

DEVCONST constexpr float C8T[9] = {1.0f, 0.980785280403230449f, 0.923879532511286756f, 0.831469612302545237f, 0.707106781186547524f, 0.555570233019602225f, 0.382683432365089772f, 0.195090322016128268f, 0.0f};
DEV constexpr float tw_cos(int m) { m &= 31; return m <= 8 ? C8T[m] : (m <= 16 ? -C8T[16 - m] : (m <= 24 ? -C8T[m - 16] : C8T[32 - m])); }
DEV constexpr float tw_sin(int m) { return tw_cos(m - 8); }
DEVCONST constexpr int BR16[16] = {0, 8, 4, 12, 2, 10, 6, 14, 1, 9, 5, 13, 3, 11, 7, 15};
DEVCONST constexpr int BR32[32] = {0, 16, 8, 24, 4, 20, 12, 28, 2, 18, 10, 26, 6, 22, 14, 30, 1, 17, 9, 25, 5, 21, 13, 29, 3, 19, 11, 27, 7, 23, 15, 31};
#ifdef EMU
DEV cf cmul(cf a, cf b) { return cf{a.x * b.x - a.y * b.y, a.x * b.y + a.y * b.x}; }
DEV cf cmulc(cf a, cf b) { return cf{a.x * b.x + a.y * b.y, a.y * b.x - a.x * b.y}; }
#else
DEV cf cmul(cf a, cf b) { cf r, t;
    asm("v_pk_mul_f32 %1, %2, %3 op_sel:[1,1] op_sel_hi:[1,0] neg_lo:[1,0]\n\tv_pk_fma_f32 %0, %2, %3, %1 op_sel_hi:[0,1,1]" : "=v"(r), "=&v"(t) : "v"(a), "v"(b));
    return r; }
DEV cf cmulc(cf a, cf b) { cf r, t;
    asm("v_pk_mul_f32 %1, %2, %3 op_sel:[1,1] op_sel_hi:[1,0]\n\tv_pk_fma_f32 %0, %2, %3, %1 op_sel_hi:[0,1,1] neg_hi:[1,0,0]" : "=v"(r), "=&v"(t) : "v"(a), "v"(b));
    return r; }
#endif
template <int R, bool INV> DEV void dft_regs(cf (&v)[R]) {
#pragma unroll
    for (int s = R; s >= 2; s >>= 1) {
        const int h = s >> 1;
#pragma unroll
        for (int b = 0; b < R; b += s) {
#pragma unroll
            for (int k = 0; k < h; ++k) {
                const cf a = v[b + k], c = v[b + k + h];
                v[b + k] = a + c;
                const cf d = a - c;
                const int m = k * (32 / s);
                const float wr = tw_cos(m), wi = INV ? tw_sin(m) : -tw_sin(m);
                v[b + k + h] = cf{d.x * wr - d.y * wi, d.x * wi + d.y * wr};
            }
        }
    }
}
DEV int PADI(int i) { return i + (i >> 4); }
DEV int fpos(int k) { return ((k & 15) << 9) | (((k >> 4) & 31) << 4) | (k >> 9); }
DEV int fnat(int p) { return (p >> 9) | (((p >> 4) & 31) << 4) | ((p & 15) << 9); }

DEV void fft_f1(LAS cf* buf, const cf (&z)[8], int tid) {
    OPAQUE_I(tid);
    cf v[16];
#pragma unroll
    for (int q = 0; q < 8; ++q) { v[q] = z[q]; v[q + 8] = cf{0.f, 0.f}; }
    dft_regs<16, false>(v);
    float sn, cs; SINCOSPI(-(float)tid * (2.0f / 8192.0f), &sn, &cs);
    const cf w = cf{cs, sn}; cf wp = cf{1.f, 0.f};
#pragma unroll
    for (int p = 0; p < 16; ++p) { buf[PADI(tid + 512 * p)] = cmul(v[BR16[p]], wp); wp = cmul(wp, w); }
}
DEV void fft_f1x2(LAS cf* buf0, LAS cf* buf1, const cf (&z0)[8], const cf (&z1)[8], int tid) {
    OPAQUE_I(tid);
    cf v[16], u[16];
#pragma unroll
    for (int q = 0; q < 8; ++q) { v[q] = z0[q]; v[q + 8] = cf{0.f, 0.f}; u[q] = z1[q]; u[q + 8] = cf{0.f, 0.f}; }
    dft_regs<16, false>(v); dft_regs<16, false>(u);
    float sn, cs; SINCOSPI(-(float)tid * (2.0f / 8192.0f), &sn, &cs);
    const cf w = cf{cs, sn}; cf wp = cf{1.f, 0.f};
    LAS cf* p0 = buf0 + PADI(tid); LAS cf* p1 = buf1 + PADI(tid);
#pragma unroll
    for (int p = 0; p < 16; ++p) { p0[544 * p] = cmul(v[BR16[p]], wp); p1[544 * p] = cmul(u[BR16[p]], wp); wp = cmul(wp, w); }
}
DEV void fft_i1x2(LAS cf* buf0, LAS cf* buf1, cf (&y0)[8], cf (&y1)[8], int tid) {
    OPAQUE_I(tid);
    float sn, cs; SINCOSPI(-(float)tid * (2.0f / 8192.0f), &sn, &cs);
    const cf w = cf{cs, sn}; cf wp = cf{1.f, 0.f};
    cf v[16], u[16];
    const LAS cf* p0 = buf0 + PADI(tid); const LAS cf* p1 = buf1 + PADI(tid);
#pragma unroll
    for (int p = 0; p < 16; ++p) { v[p] = cmulc(p0[544 * p], wp); u[p] = cmulc(p1[544 * p], wp); wp = cmul(wp, w); }
    dft_regs<16, true>(v); dft_regs<16, true>(u);
#pragma unroll
    for (int q = 0; q < 8; ++q) { y0[q] = v[BR16[q]]; y1[q] = u[BR16[q]]; }
}
DEV void fft_f2(LAS cf* buf, int t8) {
    OPAQUE_I(t8);
    LAS cf* pb = buf + (t8 >> 4) * 544 + (t8 & 15);
    cf v[32];
#pragma unroll
    for (int q = 0; q < 32; ++q) v[q] = pb[17 * q];
    dft_regs<32, false>(v);
    float sn, cs; SINCOSPI(-(float)(t8 & 15) * (2.0f / 512.0f), &sn, &cs);
    const cf w = cf{cs, sn}; cf wp = cf{1.f, 0.f};
#pragma unroll
    for (int p = 0; p < 32; ++p) { pb[17 * p] = cmul(v[BR32[p]], wp); wp = cmul(wp, w); }
}
DEV cf kunpack(unsigned w) { return cf{U2F(w << 16), U2F(w & 0xffff0000u)}; }
template <bool MULK> DEV void fft_mid(LAS cf* buf, const unsigned* Kp, int blk) {
    const int base = 16 * blk;
    cf v[16];
#pragma unroll
    for (int q = 0; q < 16; ++q) v[q] = buf[PADI(base + q)];
    dft_regs<16, false>(v);
    if (MULK) {
        cf w[16];
#pragma unroll
        for (int p = 0; p < 16; ++p) w[p] = cmul(v[BR16[p]], kunpack(Kp[base + p]));
        dft_regs<16, true>(w);
#pragma unroll
        for (int q = 0; q < 16; ++q) buf[PADI(base + q)] = w[BR16[q]];
    } else {
#pragma unroll
        for (int p = 0; p < 16; ++p) buf[PADI(base + p)] = v[BR16[p]];
    }
}
DEV void fft_midx2(LAS cf* buf0, LAS cf* buf1, const unsigned* Kp, int blk) {
    const int base = 16 * blk;
    LAS cf* p0 = buf0 + 17 * blk; LAS cf* p1 = buf1 + 17 * blk;
    cf v[16], u[16];
#pragma unroll
    for (int q = 0; q < 16; ++q) { v[q] = p0[q]; u[q] = p1[q]; }
    dft_regs<16, false>(v); dft_regs<16, false>(u);
    cf w[16], x[16];
    u32x4 kw[4];
#pragma unroll
    for (int j = 0; j < 4; ++j) kw[j] = *(const u32x4*)(Kp + base + 4 * j);
#pragma unroll
    for (int p = 0; p < 16; ++p) { const cf k = kunpack(kw[p >> 2][p & 3]); w[p] = cmul(v[BR16[p]], k); x[p] = cmul(u[BR16[p]], k); }
    dft_regs<16, true>(w); dft_regs<16, true>(x);
#pragma unroll
    for (int q = 0; q < 16; ++q) { p0[q] = w[BR16[q]]; p1[q] = x[BR16[q]]; }
}
DEV void fft_i2(LAS cf* buf, int t8) {
    OPAQUE_I(t8);
    LAS cf* pb = buf + (t8 >> 4) * 544 + (t8 & 15);
    float sn, cs; SINCOSPI(-(float)(t8 & 15) * (2.0f / 512.0f), &sn, &cs);
    const cf w = cf{cs, sn}; cf wp = cf{1.f, 0.f};
    cf v[32];
#pragma unroll
    for (int p = 0; p < 32; ++p) { v[p] = cmulc(pb[17 * p], wp); wp = cmul(wp, w); }
    dft_regs<32, true>(v);
#pragma unroll
    for (int q = 0; q < 32; ++q) pb[17 * q] = v[BR32[q]];
}
DEV void fft_i1(LAS cf* buf, cf (&y)[8], int tid) {
    OPAQUE_I(tid);
    float sn, cs; SINCOSPI(-(float)tid * (2.0f / 8192.0f), &sn, &cs);
    const cf w = cf{cs, sn}; cf wp = cf{1.f, 0.f};
    cf v[16];
#pragma unroll
    for (int p = 0; p < 16; ++p) { v[p] = cmulc(buf[PADI(tid + 512 * p)], wp); wp = cmul(wp, w); }
    dft_regs<16, true>(v);
#pragma unroll
    for (int q = 0; q < 8; ++q) y[q] = v[BR16[q]];
}

DEV void filt_hidden_unit(int unit, const float* w1, const float* b1, const float* fr1, const float* w2, const float* b2, const float* fr2, float* h2out, LAS float* sm, int tid) {
    LAS float* feat = sm;
    LAS float* h1 = sm + 8 * 33;
    const int tl = tid >> 6, j = tid & 63, t = unit * 8 + tl;
    if (tid < 8 * 33) {
        const int tt = tid / 33, f = tid % 33, tp = unit * 8 + tt;
        float val;
        if (f == 0) val = (float)tp * (1.0f / 4095.0f);
        else { const int k = (f - 1) & 15; const float band = 1e-4f + (float)k * ((15.0f - 1e-4f) / 15.0f);
               const float xr = (float)tp * band * (1.0f / 4096.0f), fr = xr - floorf(xr);
               float sn, cs; SINCOSPI(2.0f * fr, &sn, &cs);
               val = (f <= 16) ? cs : -sn; }
        feat[tt * 33 + f] = val;
    }
    SYNC();
    { float a = b1[j];
#pragma unroll 11
      for (int f = 0; f < 33; ++f) a += feat[tl * 33 + f] * w1[f * 64 + j];
      h1[tl * 64 + j] = sinf(fr1[j] * a); }
    SYNC();
    { float a = b2[j];
#pragma unroll 16
      for (int i = 0; i < 64; ++i) a += h1[tl * 64 + i] * w2[i * 64 + j];
      h2out[j * 4096 + t] = sinf(fr2[j] * a); }
    SYNC();
}
DEV void filt_channel_unit(int c, const float* h2, const float* w3, unsigned* KF, LAS unsigned char* lds, int tid) {
    LAS cf* buf = (LAS cf*)lds;
    LAS float* sw = (LAS float*)(lds + FPAD * 8);
    LAS float* red = sw + 256;
    if (tid < 256) { const int i = tid >> 2, q = tid & 3; sw[tid] = w3[i * 4096 + q * 1024 + c]; }
    SYNC();
    const float dmin = -3.0701134573253947f, dmax = -15.350567286626973f;
    const float delta = fabsf(dmin + (float)c * ((dmax - dmin) / 1023.0f));
    float s0 = 0.f, s1 = 0.f;
#pragma unroll 1
    for (int i = 0; i < 8; ++i) {
        const int t = tid + 512 * i;
        const float* hc = h2 + t;
        float a0 = 0.f, a1 = 0.f, a2 = 0.f, a3 = 0.f;
        float xv[64];
#pragma unroll
        for (int k = 0; k < 64; ++k) xv[k] = hc[k * 4096];
#pragma unroll
        for (int k = 0; k < 64; ++k) { const f32x4 w = *(const LAS f32x4*)(sw + k * 4); a0 += xv[k] * w.x; a1 += xv[k] * w.y; a2 += xv[k] * w.z; a3 += xv[k] * w.w; }
        const float dec = expf(-((float)t * (1.0f / 4095.0f)) * delta);
        a0 *= dec; a1 *= dec; a2 *= dec; a3 *= dec;
        s0 += fabsf(a0); s1 += fabsf(a1);
        buf[PADI(t)] = cf{a0, a1};
        if (t > 0) { s0 += fabsf(a2); s1 += fabsf(a3); buf[PADI(8192 - t)] = cf{a2, a3}; }
        else buf[PADI(4096)] = cf{a2 * 0.f, a3 * 0.f};
    }
#pragma unroll
    for (int o = 1; o < 64; o <<= 1) { s0 += SHFL_XOR3(s0, o, tid & 63); s1 += SHFL_XOR3(s1, o, tid & 63); }
    if ((tid & 63) == 0) { red[(tid >> 6) * 2] = s0; red[(tid >> 6) * 2 + 1] = s1; }
    SYNC();
    float t0 = 0.f, t1 = 0.f;
#pragma unroll
    for (int w = 0; w < 8; ++w) { t0 += red[w * 2]; t1 += red[w * 2 + 1]; }
    const cf inrm = cf{1.0f / t0, 1.0f / t1};
    {
        OPAQUE_I(tid);
        cf v[16];
#pragma unroll
        for (int q = 0; q < 16; ++q) v[q] = buf[PADI(tid + 512 * q)] * inrm;
        dft_regs<16, false>(v);
        float sn, cs; SINCOSPI(-(float)tid * (2.0f / 8192.0f), &sn, &cs);
        const cf w = cf{cs, sn}; cf wp = cf{1.f, 0.f};
#pragma unroll
        for (int p = 0; p < 16; ++p) { buf[PADI(tid + 512 * p)] = cmul(v[BR16[p]], wp); wp = cmul(wp, w); }
    }
    SYNC();
    if (tid < 256) fft_f2(buf, tid);
    SYNC();
    fft_mid<false>(buf, nullptr, tid);
    SYNC();
    const float sc = 0.5f / 8192.0f;
#pragma unroll
    for (int i = 0; i < 16; ++i) {
        const int p = tid + 512 * i, k = fnat(p), p2 = fpos((8192 - k) & 8191);
        const cf a = buf[PADI(p)], b = buf[PADI(p2)];
        KF[((size_t)c * 2 + 0) * 8192 + p] = pk2((a.x + b.x) * sc, (a.y - b.y) * sc);
        KF[((size_t)c * 2 + 1) * 8192 + p] = pk2((a.y + b.y) * sc, (b.x - a.x) * sc);
    }
    SYNC();
}

DEV void filt_channel_unit2(int c, const float* h2, const float* w3, unsigned* KF, LAS unsigned char* lds, int tid) {
    LAS cf* buf0 = (LAS cf*)lds; LAS cf* buf1 = buf0 + FPAD;
    int swo = 2 * FPAD * 8 + 1024; OPAQUE_I(swo);
    LAS float* sw = (LAS float*)(lds + swo);
    LAS float* red = sw + 512;
    { const int i = tid >> 3, q = tid & 7; sw[tid] = w3[i * 4096 + (q & 3) * 1024 + c + (q >> 2)]; }
    SYNC();
    const float dmin = -3.0701134573253947f, dmax = -15.350567286626973f;
    const float delta0 = fabsf(dmin + (float)c * ((dmax - dmin) / 1023.0f)), delta1 = fabsf(dmin + (float)(c + 1) * ((dmax - dmin) / 1023.0f));
    float s[4] = {0.f, 0.f, 0.f, 0.f};
#pragma unroll 1
    for (int i = 0; i < 8; ++i) {
        const int t = tid + 512 * i;
        const float* hc = h2 + t;
        float a[8] = {0.f, 0.f, 0.f, 0.f, 0.f, 0.f, 0.f, 0.f};
        float xv[64];
#pragma unroll
        for (int k = 0; k < 64; ++k) xv[k] = hc[k * 4096];
#pragma unroll
        for (int k = 0; k < 64; ++k) { const f32x4 w0 = *(const LAS f32x4*)(sw + k * 8), w1 = *(const LAS f32x4*)(sw + k * 8 + 4);
            a[0] += xv[k] * w0.x; a[1] += xv[k] * w0.y; a[2] += xv[k] * w0.z; a[3] += xv[k] * w0.w; a[4] += xv[k] * w1.x; a[5] += xv[k] * w1.y; a[6] += xv[k] * w1.z; a[7] += xv[k] * w1.w; }
        const float tn = (float)t * (1.0f / 4095.0f), dec0 = expf(-tn * delta0), dec1 = expf(-tn * delta1);
#pragma unroll
        for (int q = 0; q < 4; ++q) { a[q] *= dec0; a[4 + q] *= dec1; }
        s[0] += fabsf(a[0]); s[1] += fabsf(a[1]); s[2] += fabsf(a[4]); s[3] += fabsf(a[5]);
        buf0[PADI(t)] = cf{a[0], a[1]}; buf1[PADI(t)] = cf{a[4], a[5]};
        if (t > 0) { s[0] += fabsf(a[2]); s[1] += fabsf(a[3]); s[2] += fabsf(a[6]); s[3] += fabsf(a[7]); buf0[PADI(8192 - t)] = cf{a[2], a[3]}; buf1[PADI(8192 - t)] = cf{a[6], a[7]}; }
        else { buf0[PADI(4096)] = cf{a[2] * 0.f, a[3] * 0.f}; buf1[PADI(4096)] = cf{a[6] * 0.f, a[7] * 0.f}; }
    }
#pragma unroll
    for (int o = 1; o < 64; o <<= 1) {
#pragma unroll
        for (int q = 0; q < 4; ++q) s[q] += SHFL_XOR3(s[q], o, tid & 63); }
    if ((tid & 63) == 0) {
#pragma unroll
        for (int q = 0; q < 4; ++q) red[(tid >> 6) * 4 + q] = s[q]; }
    SYNC();
    float tt[4] = {0.f, 0.f, 0.f, 0.f};
#pragma unroll
    for (int w = 0; w < 8; ++w)
#pragma unroll
        for (int q = 0; q < 4; ++q) tt[q] += red[w * 4 + q];
    const cf in0 = cf{1.0f / tt[0], 1.0f / tt[1]}, in1 = cf{1.0f / tt[2], 1.0f / tt[3]};
    {
        OPAQUE_I(tid);
        cf v[16], u[16];
#pragma unroll
        for (int q = 0; q < 16; ++q) { v[q] = buf0[PADI(tid + 512 * q)] * in0; u[q] = buf1[PADI(tid + 512 * q)] * in1; }
        dft_regs<16, false>(v); dft_regs<16, false>(u);
        float sn, cs; SINCOSPI(-(float)tid * (2.0f / 8192.0f), &sn, &cs);
        const cf w = cf{cs, sn}; cf wp = cf{1.f, 0.f};
#pragma unroll
        for (int p = 0; p < 16; ++p) { buf0[PADI(tid + 512 * p)] = cmul(v[BR16[p]], wp); buf1[PADI(tid + 512 * p)] = cmul(u[BR16[p]], wp); wp = cmul(wp, w); }
    }
    SYNC();
    fft_f2((tid >> 8) ? buf1 : buf0, tid & 255);
    SYNC();
    fft_mid<false>(buf0, nullptr, tid); fft_mid<false>(buf1, nullptr, tid);
    SYNC();
    const float sc = 0.5f / 8192.0f;
#pragma unroll
    for (int i = 0; i < 16; ++i) {
        const int p = tid + 512 * i, k = fnat(p), p2 = fpos((8192 - k) & 8191);
        const cf a0 = buf0[PADI(p)], b0 = buf0[PADI(p2)], a1 = buf1[PADI(p)], b1 = buf1[PADI(p2)];
        KF[((size_t)c * 2 + 0) * 8192 + p] = pk2((a0.x + b0.x) * sc, (a0.y - b0.y) * sc);
        KF[((size_t)c * 2 + 1) * 8192 + p] = pk2((a0.y + b0.y) * sc, (b0.x - a0.x) * sc);
        KF[((size_t)c * 2 + 2) * 8192 + p] = pk2((a1.x + b1.x) * sc, (a1.y - b1.y) * sc);
        KF[((size_t)c * 2 + 3) * 8192 + p] = pk2((a1.y + b1.y) * sc, (b1.x - a1.x) * sc);
    }
    SYNC();
}

DEV float ldsbf(const LAS bf16_t* p) { return bf2f(*p); }
DEV void hyena_issue_rows(const bf16_t* UT, int s, int c, u32x4 (&r)[4], int tid) {
#pragma unroll
    for (int b = 0; b < 4; ++b) r[b] = *(const u32x4*)(UT + ((size_t)(b * 3072 + s * 1024 + c)) * 4096 + tid * 8);
}
DEV void hyena_commit_rows(LAS unsigned char* lds, const u32x4 (&r)[4], int tid) {
#pragma unroll
    for (int b = 0; b < 4; ++b) *(LAS u32x4*)(lds + b * 8192 + tid * 16) = r[b];
}
template <int MODE> DEV void hyena_conv_rows(const LAS unsigned char* lds, int slot0, float w0, float w1, float w2, float bs, cf (&z)[2][8], const cf (&y)[2][8], float hb, int tid) {
#pragma unroll
    for (int b = 0; b < 4; ++b) {
        const LAS bf16_t* row = (const LAS bf16_t*)(lds + (slot0 + b) * 8192);
#pragma unroll
        for (int i = 0; i < 8; ++i) {
            const int t = tid + 512 * i, par = tid & 1, d0 = (tid >> 1) + par;
            const LAS unsigned* rw = (const LAS unsigned*)row + d0;
            const unsigned dw0 = (i == 0) ? rw[d0 > 0 ? -1 : 0] : rw[256 * i - 1], dw1 = rw[256 * i];
            float um = par ? U2F(dw0 << 16) : U2F(dw0 & 0xffff0000u);
            const float u0 = par ? U2F(dw0 & 0xffff0000u) : U2F(dw1 << 16);
            float up = par ? U2F(dw1 << 16) : U2F(dw1 & 0xffff0000u);
            um = (t > 0) ? um : 0.f; up = (t < 4095) ? up : 0.f;
            const float r = um * w0 + u0 * w1 + up * w2 + bs;
            if (MODE == 0) { if (b & 1) z[b >> 1][i].y = r; else z[b >> 1][i].x = r; }
            else { if (b & 1) z[b >> 1][i].y = r * (y[b >> 1][i].y + hb * z[b >> 1][i].y); else z[b >> 1][i].x = r * (y[b >> 1][i].x + hb * z[b >> 1][i].x); }
        }
    }
}
#ifndef HY_ABL
#define HY_ABL 0
#endif
DEV void hyena_conv_head(LAS cf* buf0, LAS cf* buf1, const unsigned* Kp, const cf (&z)[2][8], int tid, bool abl) {
    const bool skip_all = abl && HY_ABL == 1, nosync = abl && HY_ABL == 2, nok = abl && HY_ABL == 3, skip1 = (abl && HY_ABL == 4) || skip_all, skip2 = (abl && HY_ABL == 5) || skip_all, skipm = (abl && HY_ABL == 6) || skip_all;
    if (!skip1) fft_f1x2(buf0, buf1, z[0], z[1], tid);
    if (!nosync && !skip_all) SYNC();
    if (!skip2) fft_f2((tid >> 8) ? buf1 : buf0, tid & 255);
    if (!nosync && !skip_all) SYNC();
    if (!skipm) { if (nok) { fft_mid<false>(buf0, Kp, tid); fft_mid<false>(buf1, Kp, tid); } else fft_midx2(buf0, buf1, Kp, tid); }
    if (!nosync && !skip_all) SYNC();
    if (!skip2) fft_i2((tid >> 8) ? buf1 : buf0, tid & 255);
    if (!nosync && !skip_all) SYNC();
}
DEV void hyena_units(int c0, int cstride, const bf16_t* UT, bf16_t* YHT, const unsigned* KF, const float* convw  , const float* convb  , const float* hyb  , LAS unsigned char* lds, int tid, bool abl = false) {
    if (c0 >= 1024) return;
    LAS cf* buf0 = (LAS cf*)lds; LAS cf* buf1 = buf0 + FPAD;
    u32x4 r[4];
    hyena_issue_rows(UT, 0, c0, r, tid);
#pragma unroll 1
    for (int c = c0; c < 1024; c += cstride) {
        OPAQUE_I(tid);
        cf z[2][8], y[2][8];
        hyena_commit_rows(lds, r, tid);
        SYNC();
        hyena_conv_rows<0>(lds, 0, convw[c], convw[3072 + c], convw[6144 + c], convb[c], z, y, 0.f, tid);
        SYNC();
#pragma unroll 1
        for (int o = 0; o < 2; ++o) {
            hyena_conv_head(buf0, buf1, KF + ((size_t)c * 2 + o) * 8192, z, tid, abl);
            hyena_issue_rows(UT, 1 + o, c, r, tid);
            if (abl && (HY_ABL == 1 || HY_ABL == 4)) {
#pragma unroll
                for (int i = 0; i < 8; ++i) { y[0][i] = z[0][i]; y[1][i] = z[1][i]; }
            } else fft_i1x2(buf0, buf1, y[0], y[1], tid);
            SYNC();
            hyena_commit_rows(lds, r, tid);
            if (o == 1 && c + cstride < 1024) hyena_issue_rows(UT, 0, c + cstride, r, tid);
            SYNC();
            const int col = (1 + o) * 1024 + c;
            hyena_conv_rows<1>(lds, 0, convw[col], convw[3072 + col], convw[6144 + col], convb[col], z, y, hyb[o * 1024 + c], tid);
            SYNC();
        }
#pragma unroll
        for (int p = 0; p < 2; ++p)
#pragma unroll
            for (int i = 0; i < 8; ++i) {
                const int t = tid + 512 * i;
                YHT[((size_t)((2 * p) * 1024 + c)) * 4096 + t] = f2bf(z[p][i].x);
                YHT[((size_t)((2 * p + 1) * 1024 + c)) * 4096 + t] = f2bf(z[p][i].y);
            }
    }
}
DEV void hyena_unit(int c, const bf16_t* UT, bf16_t* YHT, const unsigned* KF, const float* convw, const float* convb, const float* hyb, LAS unsigned char* lds, int tid) {
    hyena_units(c, 1024, UT, YHT, KF, convw, convb, hyb, lds, tid);
}

DEV void attn_bias_table(LAS float* tab, const float* rel_bias, int tid) {
    for (int idx = tid; idx < 24 * 129; idx += NTHR) {
        const int gh = idx / 129, jj = idx % 129, g = gh >> 3, dil = 1 << (2 * g);
        const int rel = (jj - 64) * dil, n = rel < 0 ? -rel : rel;
        int bk = (rel > 0) ? 16 : 0;
        if (n < 8) bk += n;
        else bk += 8 + (n >= 15) + (n >= 27) + (n >= 50) + (n >= 91) + (n >= 166) + (n >= 305) + (n >= 559);
        tab[idx] = rel_bias[bk * 24 + gh] * 1.4426950408889634f;
    }
}
DEV void attn_tile(int tile, const bf16_t* QKG, const bf16_t* VT, bf16_t* OG, float* LSE, const LAS float* tab, int lane) {
    const int b = tile / (24 * 64), rem = tile % (24 * 64), gh = rem >> 6, tau = rem & 63, g = gh >> 3, h = gh & 7;
    const int dsh = 2 * g, Mg = 4096 >> dsh, ntm = Mg >> 6, r = tau / ntm, m0 = (tau % ntm) * 64;
    const int n = lane & 31, hl = lane >> 5;
    const size_t rowbase = (size_t)b * 4096;
    const int colq = g * 512 + h * 64;
    const float SC = 0.125f * 1.4426950408889634f;
    bf16x8 qf[2][4];
#pragma unroll
    for (int qb = 0; qb < 2; ++qb) {
        const int t = ((m0 + 32 * qb + n) << dsh) + r;
        const bf16_t* p = QKG + (rowbase + t) * 7168 + colq + 8 * hl;
#pragma unroll
        for (int ks = 0; ks < 4; ++ks) qf[qb][ks] = *(const bf16x8*)(p + 16 * ks);
    }
    f32x16 oacc[2][2];
#pragma unroll
    for (int a = 0; a < 2; ++a)
#pragma unroll
        for (int c2 = 0; c2 < 2; ++c2)
#pragma unroll
            for (int i = 0; i < 16; ++i) oacc[a][c2][i] = 0.f;
    float mrun[2] = {-1e30f, -1e30f}, lrun[2] = {0.f, 0.f};
    for (int kbi = 0; kbi < 3; ++kbi) {
        const int kb = (kbi == 0) ? 1 : (kbi == 1 ? 0 : 2);
        const int mk0 = m0 - 64 + 64 * kb;
        if (mk0 < 0 || mk0 >= Mg) continue;
        f32x16 s[2][2];
#pragma unroll
        for (int sb = 0; sb < 2; ++sb) {
            const int t = ((mk0 + 32 * sb + n) << dsh) + r;
            const bf16_t* p = QKG + (rowbase + t) * 7168 + 1536 + colq + 8 * hl;
            bf16x8 kf[4];
#pragma unroll
            for (int ks = 0; ks < 4; ++ks) kf[ks] = *(const bf16x8*)(p + 16 * ks);
#pragma unroll
            for (int qb = 0; qb < 2; ++qb) {
                f32x16 a;
#pragma unroll
                for (int i = 0; i < 16; ++i) a[i] = 0.f;
#pragma unroll
                for (int ks = 0; ks < 4; ++ks) a = MFMA32(kf[ks], qf[qb][ks], a);
                s[sb][qb] = a;
            }
        }
#pragma unroll
        for (int qb = 0; qb < 2; ++qb) {
            const int qq = 32 * qb + n;
            float mx = -1e30f;
#pragma unroll
            for (int sb = 0; sb < 2; ++sb)
#pragma unroll
                for (int rg = 0; rg < 16; ++rg) {
                    const int kk = 32 * sb + (rg & 3) + 8 * (rg >> 2) + 4 * hl;
                    const int jj = 64 * kb + kk - qq;
                    const bool ok = (unsigned)jj <= 128u;
                    const float bia = tab[gh * 129 + (ok ? jj : 0)];
                    const float v = ok ? s[sb][qb][rg] * SC + bia : -1e30f;
                    s[sb][qb][rg] = v; mx = fmaxf(mx, v);
                }
            mx = fmaxf(mx, SHFL_XOR3(mx, 32, lane));
            const float mnew = fmaxf(mrun[qb], mx);
            const float alpha = EXP2(mrun[qb] - mnew);
            float rs = 0.f;
#pragma unroll
            for (int sb = 0; sb < 2; ++sb)
#pragma unroll
                for (int rg = 0; rg < 16; ++rg) { const float p = EXP2(s[sb][qb][rg] - mnew); s[sb][qb][rg] = p; rs += p; }
            rs += SHFL_XOR3(rs, 32, lane);
            lrun[qb] = lrun[qb] * alpha + rs; mrun[qb] = mnew;
#pragma unroll
            for (int eb = 0; eb < 2; ++eb)
#pragma unroll
                for (int i = 0; i < 16; ++i) oacc[eb][qb][i] *= alpha;
        }
#pragma unroll
        for (int sb = 0; sb < 2; ++sb)
#pragma unroll
            for (int s2 = 0; s2 < 2; ++s2) {
                bf16x8 pf[2];
#pragma unroll
                for (int qb = 0; qb < 2; ++qb) {
                    u32x4 w;
                    w.x = pk2(s[sb][qb][8 * s2 + 0], s[sb][qb][8 * s2 + 1]); w.y = pk2(s[sb][qb][8 * s2 + 2], s[sb][qb][8 * s2 + 3]);
                    w.z = pk2(s[sb][qb][8 * s2 + 4], s[sb][qb][8 * s2 + 5]); w.w = pk2(s[sb][qb][8 * s2 + 6], s[sb][qb][8 * s2 + 7]);
                    pf[qb] = BITCAST(bf16x8, w);
                }
#pragma unroll
                for (int eb = 0; eb < 2; ++eb) {
                    const int e = 32 * eb + n;
                    const bf16_t* vp = VT + ((size_t)(b * 1536 + colq + e)) * 4096 + r * Mg + mk0 + 32 * sb + 16 * s2 + 4 * hl;
                    const u32x2 lo = *(const u32x2*)vp, hi = *(const u32x2*)(vp + 8);
                    u32x4 w; w.x = lo.x; w.y = lo.y; w.z = hi.x; w.w = hi.y;
                    const bf16x8 vf = BITCAST(bf16x8, w);
#pragma unroll
                    for (int qb = 0; qb < 2; ++qb) oacc[eb][qb] = MFMA32(vf, pf[qb], oacc[eb][qb]);
                }
            }
    }
#pragma unroll
    for (int qb = 0; qb < 2; ++qb) {
        const float inv = 1.0f / lrun[qb];
        const int t = ((m0 + 32 * qb + n) << dsh) + r;
        bf16_t* op = OG + (rowbase + t) * 1536 + colq;
#pragma unroll
        for (int eb = 0; eb < 2; ++eb)
#pragma unroll
            for (int gq = 0; gq < 4; ++gq) {
                u32x2 w; w.x = pk2(oacc[eb][qb][4 * gq] * inv, oacc[eb][qb][4 * gq + 1] * inv); w.y = pk2(oacc[eb][qb][4 * gq + 2] * inv, oacc[eb][qb][4 * gq + 3] * inv);
                *(u32x2*)(op + 32 * eb + 8 * gq + 4 * hl) = w;
            }
        if (hl == 0) LSE[(rowbase + t) * 24 + gh] = mrun[qb] + LOG2(lrun[qb]);
    }
}
constexpr int AT_KP = 144, AT_VP = 776;
constexpr int AT_K_OFF = 0, AT_V_OFF = 384 * AT_KP, AT_TAB_OFF = AT_V_OFF + 64 * AT_VP;
struct AttnU { int b, gh, g, dsh, Mg, r, mu0, colq; };
DEV AttnU attn_decode(int unit) {
    AttnU a; a.b = unit / 384; const int rem = unit % 384; a.gh = rem >> 4; const int uu = rem & 15; a.g = a.gh >> 3;
    a.dsh = 2 * a.g; a.Mg = 4096 >> a.dsh; const int upc = a.Mg >> 8; a.r = uu / upc; a.mu0 = (uu % upc) * 256; a.colq = a.g * 512 + (a.gh & 7) * 64;
    return a;
}
DEV void attn_issue(const AttnU& a, const bf16_t* QKG, const bf16_t* VT, u32x4 (&kr)[6], u32x4 (&vr)[6], int tid) {
    const size_t rowbase = (size_t)a.b * 4096;
#pragma unroll
    for (int i = 0; i < 6; ++i) {
        const int idx = tid + 512 * i, row = idx >> 3, ch = idx & 7, m = a.mu0 - 64 + row;
        kr[i] = (u32x4){0u, 0u, 0u, 0u};
        if (m >= 0 && m < a.Mg) kr[i] = *(const u32x4*)(QKG + (rowbase + (size_t)((m << a.dsh) + a.r)) * 7168 + 1536 + a.colq + 8 * ch);
    }
#pragma unroll
    for (int i = 0; i < 6; ++i) {
        const int idx = tid + 512 * i, e = idx / 48, ch = idx % 48, m = a.mu0 - 64 + 8 * ch;
        vr[i] = (u32x4){0u, 0u, 0u, 0u};
        if (m >= 0 && m < a.Mg) vr[i] = *(const u32x4*)(VT + ((size_t)(a.b * 1536 + a.colq + e)) * 4096 + a.r * a.Mg + m);
    }
}
DEV void attn_commit(LAS unsigned char* lds, const u32x4 (&kr)[6], const u32x4 (&vr)[6], int tid) {
#pragma unroll
    for (int i = 0; i < 6; ++i) { const int idx = tid + 512 * i, row = idx >> 3, ch = idx & 7; *(LAS u32x4*)(lds + AT_K_OFF + row * AT_KP + ch * 16) = kr[i]; }
#pragma unroll
    for (int i = 0; i < 6; ++i) { const int idx = tid + 512 * i, e = idx / 48, ch = idx % 48;
        LAS u32x2* d = (LAS u32x2*)(lds + AT_V_OFF + e * AT_VP + ch * 16);
        d[0] = (u32x2){vr[i].x, vr[i].y}; d[1] = (u32x2){vr[i].z, vr[i].w}; }
}
DEV void attn_compute(const AttnU& a, const bf16x8 (&qf)[4], int tq, bf16_t* OG, float* LSE, LAS unsigned char* lds, int tid) {
    const int lane = tid & 63, wave = tid >> 6, n = lane & 31, hl = lane >> 5;
    const size_t rowbase = (size_t)a.b * 4096;
    const LAS float* tab = (const LAS float*)(lds + AT_TAB_OFF) + a.gh * 129;
    const float SC = 0.125f * 1.4426950408889634f;
    f32x16 s[5];
    bool vb[5];
    float mx = -1e30f;
#pragma unroll
    for (int sb = 0; sb < 5; ++sb) {
        const int sbk = wave + sb, mb = a.mu0 - 64 + 32 * sbk;
        vb[sb] = (mb >= 0) && (mb < a.Mg);
        f32x16 acc;
#pragma unroll
        for (int i = 0; i < 16; ++i) acc[i] = 0.f;
        if (vb[sb]) {
            const LAS unsigned char* kp = lds + AT_K_OFF + (32 * sbk + n) * AT_KP + 16 * hl;
#pragma unroll
            for (int ks = 0; ks < 4; ++ks) { const bf16x8 kf = *(const LAS bf16x8*)(kp + 32 * ks); acc = MFMA32(kf, qf[ks], acc); }
        }
#pragma unroll
        for (int rg = 0; rg < 16; ++rg) {
            const int jj = 32 * sb + (rg & 3) + 8 * (rg >> 2) + 4 * hl - n;
            const bool ok = vb[sb] && ((unsigned)jj <= 128u);
            const float bia = tab[ok ? jj : 0];
            const float v = ok ? acc[rg] * SC + bia : -1e30f;
            acc[rg] = v; mx = fmaxf(mx, v);
        }
        s[sb] = acc;
    }
    mx = fmaxf(mx, SHFL_XOR3(mx, 32, lane));
    float rs = 0.f;
#pragma unroll
    for (int sb = 0; sb < 5; ++sb)
#pragma unroll
        for (int rg = 0; rg < 16; ++rg) { const float p = EXP2(s[sb][rg] - mx); s[sb][rg] = p; rs += p; }
    rs += SHFL_XOR3(rs, 32, lane);
    f32x16 oacc[2];
#pragma unroll
    for (int eb = 0; eb < 2; ++eb)
#pragma unroll
        for (int i = 0; i < 16; ++i) oacc[eb][i] = 0.f;
#pragma unroll
    for (int sb = 0; sb < 5; ++sb) {
        if (!vb[sb]) continue;
#pragma unroll
        for (int s2 = 0; s2 < 2; ++s2) {
            u32x4 w;
            w.x = pk2(s[sb][8 * s2 + 0], s[sb][8 * s2 + 1]); w.y = pk2(s[sb][8 * s2 + 2], s[sb][8 * s2 + 3]);
            w.z = pk2(s[sb][8 * s2 + 4], s[sb][8 * s2 + 5]); w.w = pk2(s[sb][8 * s2 + 6], s[sb][8 * s2 + 7]);
            const bf16x8 pf = BITCAST(bf16x8, w);
#pragma unroll
            for (int eb = 0; eb < 2; ++eb) {
                const LAS unsigned char* vp = lds + AT_V_OFF + (32 * eb + n) * AT_VP + (32 * (wave + sb) + 16 * s2 + 4 * hl) * 2;
                const u32x2 lo = *(const LAS u32x2*)vp, hi = *(const LAS u32x2*)(vp + 16);
                u32x4 wv; wv.x = lo.x; wv.y = lo.y; wv.z = hi.x; wv.w = hi.y;
                oacc[eb] = MFMA32(BITCAST(bf16x8, wv), pf, oacc[eb]);
            }
        }
    }
    const float inv = 1.0f / rs;
    bf16_t* op = OG + (rowbase + tq) * 1536 + a.colq;
#pragma unroll
    for (int eb = 0; eb < 2; ++eb)
#pragma unroll
        for (int gq = 0; gq < 4; ++gq) {
            u32x2 w; w.x = pk2(oacc[eb][4 * gq] * inv, oacc[eb][4 * gq + 1] * inv); w.y = pk2(oacc[eb][4 * gq + 2] * inv, oacc[eb][4 * gq + 3] * inv);
            *(u32x2*)(op + 32 * eb + 8 * gq + 4 * hl) = w;
        }
    if (hl == 0) LSE[(rowbase + tq) * 24 + a.gh] = mx + LOG2(rs);
}
DEV void attn_units(int u0, int ustride, int nunits, const bf16_t* QKG, const bf16_t* VT, bf16_t* OG, float* LSE, LAS unsigned char* lds, int tid) {
    if (u0 >= nunits) return;
    u32x4 kr[6], vr[6];
    { const AttnU a0 = attn_decode(u0); attn_issue(a0, QKG, VT, kr, vr, tid); }
#pragma unroll 1
    for (int u = u0; u < nunits; u += ustride) {
        OPAQUE_I(tid);
        const AttnU a = attn_decode(u);
        const int lane = tid & 63, wave = tid >> 6, n = lane & 31, hl = lane >> 5;
        SYNC();
        attn_commit(lds, kr, vr, tid);
        bf16x8 qf[4];
        const int tq = ((a.mu0 + 32 * wave + n) << a.dsh) + a.r;
        {
            const bf16_t* p = QKG + ((size_t)a.b * 4096 + tq) * 7168 + a.colq + 8 * hl;
#pragma unroll
            for (int ks = 0; ks < 4; ++ks) qf[ks] = *(const bf16x8*)(p + 16 * ks);
        }
        SYNC();
        if (u + ustride < nunits) { const AttnU an = attn_decode(u + ustride); attn_issue(an, QKG, VT, kr, vr, tid); }
        attn_compute(a, qf, tq, OG, LSE, lds, tid);
    }
}
DEV void attn_unit(int unit, const bf16_t* QKG, const bf16_t* VT, bf16_t* OG, float* LSE, LAS unsigned char* lds, int tid) {
    attn_units(unit, 1 << 20, unit + 1, QKG, VT, OG, LSE, lds, tid);
}
DEV void attn_combine_item(int item, const bf16_t* OG, const float* LSE, bf16_t* YA, int pitch = 512, int coloff = 0) {
    const int row = item >> 6, h = (item >> 3) & 7, e8 = item & 7;
    const float l0 = LSE[row * 24 + h], l1 = LSE[row * 24 + 8 + h], l2 = LSE[row * 24 + 16 + h];
    const float mx = fmaxf(l0, fmaxf(l1, l2));
    float w0 = EXP2(l0 - mx), w1 = EXP2(l1 - mx), w2 = EXP2(l2 - mx);
    const float inv = 1.0f / (w0 + w1 + w2); w0 *= inv; w1 *= inv; w2 *= inv;
    const bf16_t* p = OG + (size_t)row * 1536 + h * 64 + e8 * 8;
    const u32x4 a = *(const u32x4*)p, b = *(const u32x4*)(p + 512), c = *(const u32x4*)(p + 1024);
    u32x4 o;
#pragma unroll
    for (int i = 0; i < 4; ++i) {
        const float lo = w0 * U2F(a[i] << 16) + w1 * U2F(b[i] << 16) + w2 * U2F(c[i] << 16);
        const float hi = w0 * U2F(a[i] & 0xffff0000u) + w1 * U2F(b[i] & 0xffff0000u) + w2 * U2F(c[i] & 0xffff0000u);
        o[i] = pk2(lo, hi);
    }
    *(u32x4*)(YA + (size_t)row * pitch + coloff + h * 64 + e8 * 8) = o;
}

namespace pg8 {
#define PG8_LAS __attribute__((address_space(3)))
typedef unsigned short bf16_t;
typedef short bf16x8 __attribute__((ext_vector_type(8)));
typedef float f32x4 __attribute__((ext_vector_type(4)));
typedef unsigned u32x4 __attribute__((ext_vector_type(4)));
constexpr int BM = 256, BK = 64, HALF = 128, HTB = HALF * BK * 2  , STAGE_BYTES = 8 * HTB, NXCD = 8, WGM = 8;

__host__ __device__ __forceinline__ int lds_byte(int r, int c) { const int st = (r >> 4) * 2 + (c >> 5), rr = r & 15, cc = c & 31, ob = rr * 64 + cc * 2; return st * 1024 + (ob ^ (((ob >> 9) & 1) << 5)); }
__host__ __device__ __forceinline__ void stage_rc(int b, int& R, int& C) { const int st = b / 1024, sb = b % 1024, swz = sb ^ (((sb >> 9) & 1) << 5); R = (st >> 1) * 16 + swz / 64; C = (st & 1) * 32 + (swz % 64) / 2; }
__host__ __device__ __forceinline__ int perm32(int rho) { const int n = rho >> 4, i = rho & 15; return 8 * (i >> 2) + 4 * n + (i & 3); }

struct Unit { int pm, pn; };
struct Gemm { const bf16_t* A; const bf16_t* Bt; int M, N, K; };

struct StaticOrder {
    int nM, nN, nwg, G, c;
    __host__ __device__ void init(int M, int N, int G_, int c_) { nM = M / BM; nN = N / BM; nwg = nM * nN; G = G_; c = c_; }
    __host__ __device__ bool next(int i, Unit& u) const {
        const long L = (long)i * G + c; if (L >= nwg) return false;
        int wgid = (int)L; { const int q = nwg / NXCD, r = nwg % NXCD, xcd = wgid % NXCD, off = wgid / NXCD; wgid = (xcd < r ? xcd * (q + 1) : r * (q + 1) + (xcd - r) * q) + off; }
        const int nig = WGM * nN, gid = wgid / nig, fm = gid * WGM, gsz = (nM - fm) < WGM ? (nM - fm) : WGM;
        u.pm = fm + ((wgid % nig) % gsz); u.pn = (wgid % nig) / gsz; return true;
    }
    __device__ __forceinline__ void a_ready(const Unit&) const {}
    __device__ __forceinline__ void done(const Unit&) const {}
};

__device__ __forceinline__ unsigned cvt_pk_bf16(float lo, float hi) { unsigned r; asm volatile("v_cvt_pk_bf16_f32 %0, %1, %2" : "=v"(r) : "v"(lo), "v"(hi)); return r; }
constexpr int EPI_LDS_OFF = 139264 + 1024;
template <int MODE> __device__ __forceinline__ int perm_row(int R) {
    if (MODE == 0) return R;
    if (MODE == 1) return (R & ~31) + perm32(R & 31);
    const int wcp = R >> 5, n = (R >> 4) & 1, fq = (R >> 2) & 3, e = R & 3;
    if (MODE == 2) return fq + 4 * (8 * wcp + 4 * n + e);
    return (4 * wcp + fq) + 16 * (4 * n + e);
}
__device__ __forceinline__ float sigmoid_f(float x) { return __builtin_amdgcn_rcpf(1.0f + __builtin_amdgcn_exp2f(-1.4426950408889634f * x)); }
__device__ __forceinline__ float bflo(unsigned w) { return __uint_as_float(w << 16); }
__device__ __forceinline__ float bfhi(unsigned w) { return __uint_as_float(w & 0xffff0000u); }
template <int VM> struct EpiG1a {
    static constexpr bool PERM = true, AFTER_DRAIN = false; static constexpr int PMODE = 1 + VM, KSPLIT = 0; static constexpr bool PREF = false;
    bf16_t* UT; bf16_t* VT;
    __device__ __forceinline__ void operator()(const f32x4 (&acc)[2][2][4][2], const Unit& u, int wr, int wc, int fr, int fq) const {
        const int row0 = u.pm * BM + wr * 64 + fr;
        const int T0 = u.pn * BM, bseq = T0 >> 12, t0 = T0 & 4095;
#pragma unroll
        for (int ai = 0; ai < 2; ++ai)
#pragma unroll
            for (int m = 0; m < 4; ++m) {
                const int nn = row0 + ai * HALF + m * 16;
#pragma unroll
                for (int bj = 0; bj < 2; ++bj) {
                    const f32x4 v0 = acc[ai][bj][m][0], v1 = acc[ai][bj][m][1];
                    u32x4 w; w.x = cvt_pk_bf16(v0[0], v0[1]); w.y = cvt_pk_bf16(v0[2], v0[3]); w.z = cvt_pk_bf16(v1[0], v1[1]); w.w = cvt_pk_bf16(v1[2], v1[3]);
                    const int th = t0 + bj * HALF;
                    if (VM == 0) {
                        const int t = th + wc * 32 + 8 * fq;
                        if (u.pm < 12) *(u32x4*)(UT + ((size_t)(bseq * 3072 + nn)) * 4096 + t) = w;
                        else *(u32x4*)(VT + ((size_t)(bseq * 1536 + (nn - 3072))) * 4096 + t) = w;
                    } else if (VM == 1) {
                        *(u32x4*)(VT + ((size_t)(bseq * 1536 + 512 + nn)) * 4096 + fq * 1024 + (th >> 2) + 8 * wc) = w;
                    } else {
                        *(u32x4*)(VT + ((size_t)(bseq * 1536 + 1024 + nn)) * 4096 + (4 * wc + fq) * 256 + (th >> 4)) = w;
                    }
                }
            }
    }
};
struct EpiG1b {
    static constexpr bool PERM = true, AFTER_DRAIN = false; static constexpr int PMODE = 1, KSPLIT = 0; static constexpr bool PREF = true;
    bf16_t* O; const float* bgate;
    __device__ __forceinline__ void prefetch(const Unit& u, int buf, PG8_LAS unsigned char* lds, int wid, int lane) const {
        if (u.pn >= 12 && wid == 0) __builtin_amdgcn_global_load_lds((const unsigned*)(bgate + (u.pn * BM - 3072) + lane * 4), (PG8_LAS unsigned*)(lds + EPI_LDS_OFF + buf * 2048), 16, 0, 0);
    }
    __device__ __forceinline__ void run(const f32x4 (&acc)[2][2][4][2], const Unit& u, int wr, int wc, int fr, int fq, PG8_LAS unsigned char* lds, int buf) const {
        const int row0 = u.pm * BM + wr * 64 + fr, col0 = u.pn * BM + wc * 32 + 8 * fq; const bool gate = u.pn >= 12;
        const PG8_LAS float* bl = (const PG8_LAS float*)(lds + EPI_LDS_OFF + buf * 2048) + wc * 32 + 8 * fq;
        f32x4 bv[2][2];
#pragma unroll
        for (int bj = 0; bj < 2; ++bj)
#pragma unroll
            for (int n = 0; n < 2; ++n) bv[bj][n] = gate ? *(const PG8_LAS f32x4*)(bl + bj * HALF + 4 * n) : (f32x4){0.f, 0.f, 0.f, 0.f};
#pragma unroll
        for (int ai = 0; ai < 2; ++ai)
#pragma unroll
            for (int m = 0; m < 4; ++m) { bf16_t* rowp = O + (size_t)(row0 + ai * HALF + m * 16) * 7168 + col0;
#pragma unroll
                for (int bj = 0; bj < 2; ++bj) { f32x4 v0 = acc[ai][bj][m][0] + bv[bj][0], v1 = acc[ai][bj][m][1] + bv[bj][1];
                    if (gate) {
#pragma unroll
                        for (int j = 0; j < 4; ++j) { v0[j] = sigmoid_f(v0[j]); v1[j] = sigmoid_f(v1[j]); } }
                    u32x4 w; w.x = cvt_pk_bf16(v0[0], v0[1]); w.y = cvt_pk_bf16(v0[2], v0[3]); w.z = cvt_pk_bf16(v1[0], v1[1]); w.w = cvt_pk_bf16(v1[2], v1[3]);
                    *(u32x4*)(rowp + bj * HALF) = w; } }
    }
};
template <bool ADD> struct EpiG2 {
    static constexpr bool PERM = true, AFTER_DRAIN = false; static constexpr int PMODE = 1, KSPLIT = 0; static constexpr bool PREF = false;
    const bf16_t* QKG; bf16_t* MB; int goff;
    __device__ __forceinline__ void operator()(const f32x4 (&acc)[2][2][4][2], const Unit& u, int wr, int wc, int fr, int fq) const {
        const int row0 = u.pm * BM + wr * 64 + fr, col0 = u.pn * BM + wc * 32 + 8 * fq;
#pragma unroll
        for (int ai = 0; ai < 2; ++ai) {
            u32x4 gtv[4][2], mbv[4][2];
#pragma unroll
            for (int m = 0; m < 4; ++m) { const size_t row = (size_t)(row0 + ai * HALF + m * 16);
#pragma unroll
                for (int bj = 0; bj < 2; ++bj) { const int col = col0 + bj * HALF;
                    gtv[m][bj] = *(const u32x4*)(QKG + row * 7168 + goff + col);
                    if (ADD) mbv[m][bj] = *(const u32x4*)(MB + row * 2048 + col); } }
#pragma unroll
            for (int m = 0; m < 4; ++m) { const size_t row = (size_t)(row0 + ai * HALF + m * 16);
#pragma unroll
                for (int bj = 0; bj < 2; ++bj) { const int col = col0 + bj * HALF;
                    const u32x4 gt = gtv[m][bj];
                    f32x4 v0 = acc[ai][bj][m][0], v1 = acc[ai][bj][m][1];
                    v0[0] *= bflo(gt.x); v0[1] *= bfhi(gt.x); v0[2] *= bflo(gt.y); v0[3] *= bfhi(gt.y); v1[0] *= bflo(gt.z); v1[1] *= bfhi(gt.z); v1[2] *= bflo(gt.w); v1[3] *= bfhi(gt.w);
                    if (ADD) { const u32x4 mb = mbv[m][bj];
                        v0[0] += bflo(mb.x); v0[1] += bfhi(mb.x); v0[2] += bflo(mb.y); v0[3] += bfhi(mb.y); v1[0] += bflo(mb.z); v1[1] += bfhi(mb.z); v1[2] += bflo(mb.w); v1[3] += bfhi(mb.w); }
                    u32x4 w; w.x = cvt_pk_bf16(v0[0], v0[1]); w.y = cvt_pk_bf16(v0[2], v0[3]); w.z = cvt_pk_bf16(v1[0], v1[1]); w.w = cvt_pk_bf16(v1[2], v1[3]);
                    *(u32x4*)(MB + row * 2048 + col) = w; } }
        }
    }
};
struct EpiRes {
    static constexpr bool PERM = false, AFTER_DRAIN = false; static constexpr int PMODE = 0, KSPLIT = 0; static constexpr bool PREF = false;
    const float* xold; float* xnew; const float* gate;
    __device__ __forceinline__ void operator()(const f32x4 (&acc)[2][2][4][2], const Unit& u, int wr, int wc, int fr, int fq) const {
        const int row0 = u.pm * BM + wr * 64 + fr, col0 = u.pn * BM + wc * 32 + 4 * fq;
        const float* gp = gate + (size_t)(u.pm >> 4) * 12288 + col0;
        f32x4 gv[2][2];
#pragma unroll
        for (int bj = 0; bj < 2; ++bj)
#pragma unroll
            for (int n = 0; n < 2; ++n) gv[bj][n] = *(const f32x4*)(gp + bj * HALF + n * 16);
#pragma unroll
        for (int ai = 0; ai < 2; ++ai) {
            f32x4 xo[4][2][2];
#pragma unroll
            for (int m = 0; m < 4; ++m) { const size_t off = (size_t)(row0 + ai * HALF + m * 16) * 2048 + col0;
#pragma unroll
                for (int bj = 0; bj < 2; ++bj)
#pragma unroll
                    for (int n = 0; n < 2; ++n) xo[m][bj][n] = *(const f32x4*)(xold + off + bj * HALF + n * 16); }
#pragma unroll
            for (int m = 0; m < 4; ++m) { const size_t off = (size_t)(row0 + ai * HALF + m * 16) * 2048 + col0;
#pragma unroll
                for (int bj = 0; bj < 2; ++bj)
#pragma unroll
                    for (int n = 0; n < 2; ++n) *(f32x4*)(xnew + off + bj * HALF + n * 16) = xo[m][bj][n] + gv[bj][n] * acc[ai][bj][m][n]; }
        }
    }
};
template <bool F32IN> struct EpiResB {
    static constexpr bool PERM = true, AFTER_DRAIN = false; static constexpr int PMODE = 1, KSPLIT = 0; static constexpr bool PREF = false;
    const float* xin; const bf16_t* xold; bf16_t* xnew; const float* gate;
    __device__ __forceinline__ void operator()(const f32x4 (&acc)[2][2][4][2], const Unit& u, int wr, int wc, int fr, int fq) const {
        const int row0 = u.pm * BM + wr * 64 + fr, col0 = u.pn * BM + wc * 32 + 8 * fq;
        const float* gp = gate + (size_t)(u.pm >> 4) * 12288 + col0;
        f32x4 gv[2][2];
#pragma unroll
        for (int bj = 0; bj < 2; ++bj)
#pragma unroll
            for (int n = 0; n < 2; ++n) gv[bj][n] = *(const f32x4*)(gp + bj * HALF + n * 4);
        if constexpr (F32IN) {
#pragma unroll
            for (int ai = 0; ai < 2; ++ai) {
                f32x4 xo[4][2][2];
#pragma unroll
                for (int m = 0; m < 4; ++m) { const size_t off = (size_t)(row0 + ai * HALF + m * 16) * 2048 + col0;
#pragma unroll
                    for (int bj = 0; bj < 2; ++bj)
#pragma unroll
                        for (int n = 0; n < 2; ++n) xo[m][bj][n] = *(const f32x4*)(xin + off + bj * HALF + n * 4); }
#pragma unroll
                for (int m = 0; m < 4; ++m) { const size_t off = (size_t)(row0 + ai * HALF + m * 16) * 2048 + col0;
#pragma unroll
                    for (int bj = 0; bj < 2; ++bj) { const f32x4 v0 = xo[m][bj][0] + gv[bj][0] * acc[ai][bj][m][0], v1 = xo[m][bj][1] + gv[bj][1] * acc[ai][bj][m][1];
                        u32x4 w; w.x = pkh2(v0[0], v0[1]); w.y = pkh2(v0[2], v0[3]); w.z = pkh2(v1[0], v1[1]); w.w = pkh2(v1[2], v1[3]);
                        *(u32x4*)(xnew + off + bj * HALF) = w; } }
            }
        } else {
            u32x4 xo[2][4][2];
#pragma unroll
            for (int ai = 0; ai < 2; ++ai)
#pragma unroll
                for (int m = 0; m < 4; ++m) { const size_t off = (size_t)(row0 + ai * HALF + m * 16) * 2048 + col0;
#pragma unroll
                    for (int bj = 0; bj < 2; ++bj) xo[ai][m][bj] = *(const u32x4*)(xold + off + bj * HALF); }
#pragma unroll
            for (int ai = 0; ai < 2; ++ai)
#pragma unroll
                for (int m = 0; m < 4; ++m) { const size_t off = (size_t)(row0 + ai * HALF + m * 16) * 2048 + col0;
#pragma unroll
                    for (int bj = 0; bj < 2; ++bj) { const u32x4 o = xo[ai][m][bj]; const f32x4 a0 = acc[ai][bj][m][0], a1 = acc[ai][bj][m][1], g0 = gv[bj][0], g1 = gv[bj][1];
                        u32x4 w;
                        w.x = pkh2(hlo(o.x) + g0[0] * a0[0], hhi(o.x) + g0[1] * a0[1]); w.y = pkh2(hlo(o.y) + g0[2] * a0[2], hhi(o.y) + g0[3] * a0[3]);
                        w.z = pkh2(hlo(o.z) + g1[0] * a1[0], hhi(o.z) + g1[1] * a1[1]); w.w = pkh2(hlo(o.w) + g1[2] * a1[2], hhi(o.w) + g1[3] * a1[3]);
                        *(u32x4*)(xnew + off + bj * HALF) = w; } }
        }
    }
};
struct EpiPlain {
    static constexpr bool PERM = true, AFTER_DRAIN = false; static constexpr int PMODE = 1, KSPLIT = 0; static constexpr bool PREF = false;
    bf16_t* O; int ldc;
    __device__ __forceinline__ void operator()(const f32x4 (&acc)[2][2][4][2], const Unit& u, int wr, int wc, int fr, int fq) const {
        const int row0 = u.pm * BM + wr * 64 + fr, col0 = u.pn * BM + wc * 32 + 8 * fq;
#pragma unroll
        for (int ai = 0; ai < 2; ++ai)
#pragma unroll
            for (int m = 0; m < 4; ++m) { bf16_t* rowp = O + (size_t)(row0 + ai * HALF + m * 16) * ldc + col0;
#pragma unroll
                for (int bj = 0; bj < 2; ++bj) { const f32x4 v0 = acc[ai][bj][m][0], v1 = acc[ai][bj][m][1];
                    u32x4 w; w.x = cvt_pk_bf16(v0[0], v0[1]); w.y = cvt_pk_bf16(v0[2], v0[3]); w.z = cvt_pk_bf16(v1[0], v1[1]); w.w = cvt_pk_bf16(v1[2], v1[3]);
                    *(u32x4*)(rowp + bj * HALF) = w; } }
    }
};

struct EpiUpCG {
    static constexpr bool PERM = true, AFTER_DRAIN = false; static constexpr int PMODE = 1, KSPLIT = 0; static constexpr bool PREF = true;
    bf16_t* ACT; bf16_t* GB; const float* cw; const float* cb;
    __device__ __forceinline__ void prefetch(const Unit& u, int buf, PG8_LAS unsigned char* lds, int wid, int lane) const {
        if (wid < 2) { const int v = 2 * wid + (lane >> 5);
            const float* src = (v < 3 ? cw + v * 5632 : cb) + u.pn * 128 + (lane & 31) * 4;
            __builtin_amdgcn_global_load_lds((const unsigned*)src, (PG8_LAS unsigned*)(lds + EPI_LDS_OFF + buf * 2048 + wid * 1024), 16, 0, 0); }
    }
    __device__ __forceinline__ void run(const f32x4 (&acc)[2][2][4][2], const Unit& u, int wr, int wc, int fr, int fq, PG8_LAS unsigned char* lds, int buf) const {
        const int row0 = u.pm * BM + wr * 64 + fr, ch0 = u.pn * 128 + wc * 32 + 8 * fq;
        const PG8_LAS float* vl = (const PG8_LAS float*)(lds + EPI_LDS_OFF + buf * 2048) + wc * 32 + 8 * fq;
        const int lane = fq * 16 + fr, lup = (lane & 48) | ((lane - 1) & 15), ldn = (lane & 48) | ((lane + 1) & 15);
        f32x4 w0[2], w1[2], w2[2], bb[2];
#pragma unroll
        for (int n = 0; n < 2; ++n) { w0[n] = *(const PG8_LAS f32x4*)(vl + 4 * n); w1[n] = *(const PG8_LAS f32x4*)(vl + 128 + 4 * n); w2[n] = *(const PG8_LAS f32x4*)(vl + 256 + 4 * n); bb[n] = *(const PG8_LAS f32x4*)(vl + 384 + 4 * n); }
#pragma unroll
        for (int ai = 0; ai < 2; ++ai) {
            unsigned op[4][2][2];
#pragma unroll
            for (int n = 0; n < 2; ++n)
#pragma unroll
                for (int ep = 0; ep < 2; ++ep) {
                    float ov[4][2];
#pragma unroll
                    for (int eh = 0; eh < 2; ++eh) { const int e = 2 * ep + eh;
                        float R[4], L[4];
#pragma unroll
                        for (int m = 0; m < 4; ++m) { R[m] = shfl_from(acc[ai][1][m][n][e], lup); L[m] = shfl_from(acc[ai][1][m][n][e], ldn); }
#pragma unroll
                        for (int m = 0; m < 4; ++m) {
                            const float up = (fr == 0) ? R[m > 0 ? m - 1 : 0] : R[m];
                            const float dn = (fr == 15) ? L[m < 3 ? m + 1 : 3] : L[m];
                            const float x = up * w0[n][e] + acc[ai][1][m][n][e] * w1[n][e] + dn * w2[n][e] + bb[n][e];
                            const float s = x * sigmoid_f(x);
                            const bool edge = (m == 0 && fr == 0) || (m == 3 && fr == 15);
                            ov[m][eh] = edge ? acc[ai][0][m][n][e] : s * acc[ai][0][m][n][e];
                        } }
#pragma unroll
                    for (int m = 0; m < 4; ++m) op[m][n][ep] = cvt_pk_bf16(ov[m][0], ov[m][1]);
                    __builtin_amdgcn_sched_barrier(0);
                }
#pragma unroll
            for (int m = 0; m < 4; ++m) {
                u32x4 w; w.x = op[m][0][0]; w.y = op[m][0][1]; w.z = op[m][1][0]; w.w = op[m][1][1];
                *(u32x4*)(ACT + (size_t)(row0 + ai * HALF + m * 16) * 5632 + ch0) = w;
            }
            const int grp = u.pm * 4 + ai * 2 + wr;
            if (fr <= 1) { const f32x4 g0 = acc[ai][1][0][0], g1 = acc[ai][1][0][1];
                u32x4 w; w.x = cvt_pk_bf16(g0[0], g0[1]); w.y = cvt_pk_bf16(g0[2], g0[3]); w.z = cvt_pk_bf16(g1[0], g1[1]); w.w = cvt_pk_bf16(g1[2], g1[3]);
                *(u32x4*)(GB + ((size_t)(grp * 4 + fr)) * 5632 + ch0) = w; }
            if (fr >= 14) { const f32x4 g0 = acc[ai][1][3][0], g1 = acc[ai][1][3][1];
                u32x4 w; w.x = cvt_pk_bf16(g0[0], g0[1]); w.y = cvt_pk_bf16(g0[2], g0[3]); w.z = cvt_pk_bf16(g1[0], g1[1]); w.w = cvt_pk_bf16(g1[2], g1[3]);
                *(u32x4*)(GB + ((size_t)(grp * 4 + fr - 12)) * 5632 + ch0) = w; }
        }
    }
};

struct EpiG2M {
    static constexpr bool PERM = true, AFTER_DRAIN = false; static constexpr int PMODE = 1, KSPLIT = 1024; static constexpr bool PREF = false;
    const bf16_t* QKG; bf16_t* MB;
    __device__ __forceinline__ void midk(f32x4 (&acc)[2][2][4][2], const Unit& u, int wr, int wc, int fr, int fq) const {
        asm volatile("" : "+v"(fr), "+v"(fq));
        const int row0 = u.pm * BM + wr * 64 + fr, col0 = u.pn * BM + wc * 32 + 8 * fq;
        u32x4 gh[4][2][2], ga[4][2][2];
#define G2M_LOAD(b) do { _Pragma("unroll") for (int mm = 0; mm < 2; ++mm) { const bf16_t* gp = QKG + (size_t)(row0 + ((b) >> 1) * HALF + (2 * ((b) & 1) + mm) * 16) * 7168 + 3072 + col0; \
            _Pragma("unroll") for (int bj = 0; bj < 2; ++bj) { gh[b][mm][bj] = *(const u32x4*)(gp + bj * HALF); ga[b][mm][bj] = *(const u32x4*)(gp + 2048 + bj * HALF); } } } while (0)
#define G2M_APPLY(b) do { _Pragma("unroll") for (int mm = 0; mm < 2; ++mm) _Pragma("unroll") for (int bj = 0; bj < 2; ++bj) { const int ai = (b) >> 1, m = 2 * ((b) & 1) + mm; \
            const unsigned hw[4] = {gh[b][mm][bj].x, gh[b][mm][bj].y, gh[b][mm][bj].z, gh[b][mm][bj].w}, aw[4] = {ga[b][mm][bj].x, ga[b][mm][bj].y, ga[b][mm][bj].z, ga[b][mm][bj].w}; \
            _Pragma("unroll") for (int j = 0; j < 4; ++j) { \
                const float rl = bflo(hw[j]) * __builtin_amdgcn_rcpf(fmaxf(bflo(aw[j]), 1e-30f)), rh = bfhi(hw[j]) * __builtin_amdgcn_rcpf(fmaxf(bfhi(aw[j]), 1e-30f)); \
                acc[ai][bj][m][j >> 1][(2 * j) & 3] *= rl; acc[ai][bj][m][j >> 1][(2 * j + 1) & 3] *= rh; } } } while (0)
        G2M_LOAD(0); G2M_LOAD(1); __builtin_amdgcn_sched_barrier(0);
        G2M_APPLY(0); G2M_LOAD(2); __builtin_amdgcn_sched_barrier(0);
        G2M_APPLY(1); G2M_LOAD(3); __builtin_amdgcn_sched_barrier(0);
        G2M_APPLY(2); __builtin_amdgcn_sched_barrier(0);
        G2M_APPLY(3); __builtin_amdgcn_sched_barrier(0);
#undef G2M_LOAD
#undef G2M_APPLY
    }
    __device__ __forceinline__ void operator()(const f32x4 (&acc)[2][2][4][2], const Unit& u, int wr, int wc, int fr, int fq) const {
        const int row0 = u.pm * BM + wr * 64 + fr, col0 = u.pn * BM + wc * 32 + 8 * fq;
        u32x4 ga[2][4][2];
#pragma unroll
        for (int ai = 0; ai < 2; ++ai)
#pragma unroll
            for (int m = 0; m < 4; ++m)
#pragma unroll
                for (int bj = 0; bj < 2; ++bj) ga[ai][m][bj] = *(const u32x4*)(QKG + (size_t)(row0 + ai * HALF + m * 16) * 7168 + 5120 + col0 + bj * HALF);
#pragma unroll
        for (int ai = 0; ai < 2; ++ai)
#pragma unroll
            for (int m = 0; m < 4; ++m)
#pragma unroll
                for (int bj = 0; bj < 2; ++bj) {
                    const unsigned aw[4] = {ga[ai][m][bj].x, ga[ai][m][bj].y, ga[ai][m][bj].z, ga[ai][m][bj].w};
                    float o[8];
#pragma unroll
                    for (int j = 0; j < 4; ++j) { o[2 * j] = acc[ai][bj][m][j >> 1][(2 * j) & 3] * fmaxf(bflo(aw[j]), 1e-30f); o[2 * j + 1] = acc[ai][bj][m][j >> 1][(2 * j + 1) & 3] * fmaxf(bfhi(aw[j]), 1e-30f); }
                    u32x4 w; w.x = cvt_pk_bf16(o[0], o[1]); w.y = cvt_pk_bf16(o[2], o[3]); w.z = cvt_pk_bf16(o[4], o[5]); w.w = cvt_pk_bf16(o[6], o[7]);
                    *(u32x4*)(MB + (size_t)(row0 + ai * HALF + m * 16) * 2048 + col0 + bj * HALF) = w;
                }
    }
};
template <class Epi, class Sched, bool ALIGN_EPI = false, bool SP2 = false>
__device__ __forceinline__ void gemm_phase(PG8_LAS unsigned char* lds, const Gemm g, const Sched& S, const Epi& E, const int tid_in) {
    int tid_l = tid_in; asm volatile("" : "+v"(tid_l));
    const int tid = tid_l, wid = __builtin_amdgcn_readfirstlane(tid >> 6), lane = tid & 63, wr = wid >> 2, wc = wid & 3, fr = lane & 15, fq = lane >> 4;
    const int K = g.K, nt = K / BK;
    unsigned voffA[2], voffB[2];
#pragma unroll
    for (int i = 0; i < 2; ++i) { int R, C; stage_rc(tid * 16 + i * 8192, R, C); const int Rb = perm_row<Epi::PMODE>(R);
        voffA[i] = (unsigned)(R * K + C) * 2u; voffB[i] = (unsigned)(Rb * K + C) * 2u; }
    const size_t kstep = (size_t)(BK * 2);
    const size_t hstep = (size_t)HALF * K * 2;
    const size_t tstep = 2 * hstep;
    const unsigned ldsw = (unsigned)wid * 1024u;
    const int aoff = lds_byte(wr * 64 + fr, fq * 8), boff = lds_byte(wc * 32 + fr, fq * 8);
#define PG8_SA(b, h) (((b) * 2 + (h)) * HTB)
#define PG8_SB(b, h) ((4 + (b) * 2 + (h)) * HTB)
#define PG8_STAGE(bufoff, gbase, voff) do { _Pragma("unroll") for (int _i = 0; _i < 2; ++_i) \
        __builtin_amdgcn_global_load_lds((const unsigned*)((const char*)(gbase) + (voff)[_i]), (PG8_LAS unsigned*)(lds + (bufoff) + ldsw + _i * 8192), 16, 0, 0); } while (0)
#define PG8_LDA(dst, b, h) do { _Pragma("unroll") for (int m = 0; m < 4; ++m) _Pragma("unroll") for (int k = 0; k < 2; ++k) dst[m][k] = *(const PG8_LAS bf16x8*)(lds + PG8_SA(b, h) + aoff + m * 2048 + k * 1024); } while (0)
#define PG8_LDB(dst, b, h) do { _Pragma("unroll") for (int n = 0; n < 2; ++n) _Pragma("unroll") for (int k = 0; k < 2; ++k) dst[n][k] = *(const PG8_LAS bf16x8*)(lds + PG8_SB(b, h) + boff + n * 2048 + k * 1024); } while (0)
#define PG8_MMA(ai, bj, At, Bt) do { __builtin_amdgcn_s_setprio(1); _Pragma("unroll") for (int m = 0; m < 4; ++m) _Pragma("unroll") for (int n = 0; n < 2; ++n) _Pragma("unroll") for (int k = 0; k < 2; ++k) \
        acc[ai][bj][m][n] = __builtin_amdgcn_mfma_f32_16x16x32_bf16(Bt[n][k], At[m][k], acc[ai][bj][m][n], 0, 0, 0); __builtin_amdgcn_s_setprio(0); } while (0)
#define PG8_WAIT_V(n) asm volatile("s_waitcnt vmcnt(" #n ")" ::: "memory")
#define PG8_WAIT_L(n) asm volatile("s_waitcnt lgkmcnt(" #n ")" ::: "memory")
#define PG8_BAR __builtin_amdgcn_s_barrier()
#define PG8_SCHED __builtin_amdgcn_sched_barrier(0)
    Unit cur, nxt; int ui = 0;
    if (!S.next(0, cur)) return;
    f32x4 acc[2][2][4][2];
#pragma unroll
    for (int a = 0; a < 2; ++a)
#pragma unroll
        for (int b = 0; b < 2; ++b)
#pragma unroll
            for (int m = 0; m < 4; ++m)
#pragma unroll
                for (int n = 0; n < 2; ++n) acc[a][b][m][n] = (f32x4){0.f, 0.f, 0.f, 0.f};
    bf16x8 At[4][2], B0[2][2], B1[2][2];
    const char* cA = (const char*)g.A + (size_t)cur.pm * tstep; const char* cB = (const char*)g.Bt + (size_t)cur.pn * tstep;
    S.a_ready(cur);
    if constexpr (Epi::PREF) E.prefetch(cur, 0, lds, wid, lane);
    if constexpr (SP2) {
        PG8_STAGE(PG8_SB(0, 0), cB, voffB); PG8_STAGE(PG8_SB(0, 1), cB + hstep, voffB); PG8_STAGE(PG8_SA(0, 0), cA, voffA); PG8_STAGE(PG8_SA(0, 1), cA + hstep, voffA);
        if (wr == 1) PG8_BAR;
        PG8_WAIT_V(2); PG8_BAR;
        PG8_STAGE(PG8_SB(1, 0), cB + kstep, voffB); PG8_STAGE(PG8_SA(1, 0), cA + kstep, voffA); PG8_STAGE(PG8_SB(1, 1), cB + hstep + kstep, voffB);
        PG8_WAIT_V(6); PG8_BAR;
    } else {
        PG8_STAGE(PG8_SB(0, 0), cB, voffB); PG8_STAGE(PG8_SA(0, 0), cA, voffA); PG8_STAGE(PG8_SB(0, 1), cB + hstep, voffB); PG8_STAGE(PG8_SA(0, 1), cA + hstep, voffA);
        if (wr == 1) PG8_BAR;
        PG8_WAIT_V(4); PG8_BAR;
        PG8_STAGE(PG8_SB(1, 0), cB + kstep, voffB); PG8_STAGE(PG8_SA(1, 0), cA + kstep, voffA); PG8_STAGE(PG8_SB(1, 1), cB + hstep + kstep, voffB);
        PG8_WAIT_V(6); PG8_BAR;
    }
    for (;;) {
        const bool has_next = S.next(ui + 1, nxt);
        const char* nA = has_next ? (const char*)g.A + (size_t)nxt.pm * tstep : cA; const char* nB = has_next ? (const char*)g.Bt + (size_t)nxt.pn * tstep : cB;
        for (int t = 0; t < nt; t += 2) {
            if constexpr (Epi::KSPLIT > 0) { if (t == Epi::KSPLIT / BK) E.midk(acc, cur, wr, wc, fr, fq); }
            const bool last = (t == nt - 2);
            const char* a1 = cA + (size_t)(t + 1) * kstep;
            const char* a2 = last ? nA : cA + (size_t)(t + 2) * kstep; const char* b2 = last ? nB : cB + (size_t)(t + 2) * kstep;
            const char* a3 = a2 + kstep; const char* b3 = b2 + kstep;
            if (last && has_next) S.a_ready(nxt);
            if constexpr (SP2) {
            PG8_LDB(B0, 0, 0); PG8_LDB(B1, 0, 1); PG8_SCHED; PG8_LDA(At, 0, 0); PG8_STAGE(PG8_SA(1, 1), a1 + hstep, voffA);
            PG8_WAIT_V(8); PG8_WAIT_L(0); PG8_BAR; PG8_MMA(0, 0, At, B0); PG8_MMA(0, 1, At, B1); PG8_BAR; PG8_SCHED;
            PG8_LDA(At, 0, 1); PG8_STAGE(PG8_SB(0, 0), b2, voffB); PG8_STAGE(PG8_SB(0, 1), b2 + hstep, voffB); PG8_STAGE(PG8_SA(0, 0), a2, voffA);
            PG8_WAIT_V(8); PG8_WAIT_L(0); PG8_BAR; PG8_MMA(1, 0, At, B0); PG8_MMA(1, 1, At, B1); PG8_BAR; PG8_SCHED;
            PG8_LDB(B0, 1, 0); PG8_LDB(B1, 1, 1); PG8_SCHED; PG8_LDA(At, 1, 0); PG8_STAGE(PG8_SA(0, 1), a2 + hstep, voffA);
            PG8_WAIT_V(8); PG8_WAIT_L(0); PG8_BAR; PG8_MMA(0, 0, At, B0); PG8_MMA(0, 1, At, B1); PG8_BAR; PG8_SCHED;
            PG8_LDA(At, 1, 1); PG8_STAGE(PG8_SB(1, 0), b3, voffB); PG8_STAGE(PG8_SB(1, 1), b3 + hstep, voffB); PG8_STAGE(PG8_SA(1, 0), a3, voffA);
            PG8_WAIT_V(8); PG8_WAIT_L(0); PG8_BAR; PG8_MMA(1, 0, At, B0); PG8_MMA(1, 1, At, B1); PG8_BAR; PG8_SCHED;
            } else {
            PG8_LDB(B0, 0, 0); PG8_SCHED; PG8_LDA(At, 0, 0); PG8_STAGE(PG8_SA(1, 1), a1 + hstep, voffA);
            PG8_WAIT_L(8); PG8_BAR; PG8_WAIT_L(0); PG8_MMA(0, 0, At, B0); PG8_BAR; PG8_SCHED;
            PG8_LDB(B1, 0, 1); PG8_STAGE(PG8_SB(0, 0), b2, voffB);
            PG8_BAR; PG8_WAIT_L(0); PG8_MMA(0, 1, At, B1); PG8_BAR;
            PG8_LDA(At, 0, 1); PG8_STAGE(PG8_SA(0, 0), a2, voffA);
            PG8_BAR; PG8_WAIT_L(0); PG8_MMA(1, 0, At, B0); PG8_BAR; PG8_SCHED;
            PG8_STAGE(PG8_SB(0, 1), b2 + hstep, voffB);
            PG8_WAIT_V(6); PG8_BAR; PG8_MMA(1, 1, At, B1); PG8_BAR;
            PG8_LDB(B0, 1, 0); PG8_SCHED; PG8_LDA(At, 1, 0); PG8_STAGE(PG8_SA(0, 1), a2 + hstep, voffA);
            PG8_WAIT_L(8); PG8_BAR; PG8_WAIT_L(0); PG8_MMA(0, 0, At, B0); PG8_BAR; PG8_SCHED;
            PG8_LDB(B1, 1, 1); PG8_STAGE(PG8_SB(1, 0), b3, voffB);
            PG8_BAR; PG8_WAIT_L(0); PG8_MMA(0, 1, At, B1); PG8_BAR;
            PG8_LDA(At, 1, 1); PG8_STAGE(PG8_SA(1, 0), a3, voffA);
            PG8_BAR; PG8_WAIT_L(0); PG8_MMA(1, 0, At, B0); PG8_BAR; PG8_SCHED;
            PG8_STAGE(PG8_SB(1, 1), b3 + hstep, voffB);
            PG8_WAIT_V(6); PG8_BAR; PG8_MMA(1, 1, At, B1); PG8_BAR;
            }
        }
        if constexpr (ALIGN_EPI) { if (wr == 0) PG8_BAR; }
        if constexpr (Epi::PREF) { if (has_next) E.prefetch(nxt, (ui + 1) & 1, lds, wid, lane); E.run(acc, cur, wr, wc, fr, fq, lds, ui & 1); S.done(cur); }
        else if constexpr (!Epi::AFTER_DRAIN) { E(acc, cur, wr, wc, fr, fq); S.done(cur); }
        if (!has_next) break;
#pragma unroll
        for (int a = 0; a < 2; ++a)
#pragma unroll
            for (int b = 0; b < 2; ++b)
#pragma unroll
                for (int m = 0; m < 4; ++m)
#pragma unroll
                    for (int n = 0; n < 2; ++n) acc[a][b][m][n] = (f32x4){0.f, 0.f, 0.f, 0.f};
        cur = nxt; cA = nA; cB = nB; ++ui;
        if constexpr (ALIGN_EPI) { if (wr == 1) PG8_BAR; }
    }
    PG8_WAIT_V(0);
    if constexpr (!ALIGN_EPI) { if (wr == 0) PG8_BAR; }
    PG8_BAR;
    if constexpr (Epi::AFTER_DRAIN) { E.fused(acc, cur, wr, wc, fr, fq, lds, wid, lane); S.done(cur); }
#undef PG8_SA
#undef PG8_SB
#undef PG8_STAGE
#undef PG8_LDA
#undef PG8_LDB
#undef PG8_MMA
#undef PG8_WAIT_V
#undef PG8_WAIT_L
#undef PG8_BAR
#undef PG8_SCHED
}
}

#define XB_TMO      128
#define XB_XCNT(j)  (256  + 64 * (j))
#define XB_XSUB(j)  (1280 + 64 * (j))
#define XB_XGEN(j)  (2304 + 64 * (j))
#define XB_TOP      3328
#define XB_TOPGEN   3392
#define XCD_BAR_WORDS 3456
#define XB_SPIN_CAP (1u << 18)

__device__ __forceinline__ unsigned xb_ld(unsigned* p)              { return __hip_atomic_load(p, __ATOMIC_RELAXED, __HIP_MEMORY_SCOPE_AGENT); }
__device__ __forceinline__ unsigned xb_add(unsigned* p, unsigned v) { return __hip_atomic_fetch_add(p, v, __ATOMIC_RELAXED, __HIP_MEMORY_SCOPE_AGENT); }
__device__ __forceinline__ unsigned xb_xcc_id() { return (unsigned)__builtin_amdgcn_s_getreg((3 << 11) | 20) & 0xFu; }
#define XB_SPIN(cond, bar) do { unsigned _sp = 0; while (cond) { __builtin_amdgcn_s_sleep(1); \
    if ((++_sp & 255u) == 0u) { if (xb_ld(&(bar)[XB_TMO])) break; if (_sp > XB_SPIN_CAP) { atomicAdd(&(bar)[XB_TMO], 1u); break; } } } } while (0)

struct XcdBarrier {
    unsigned* bar; unsigned x;
    volatile LAS unsigned* st;
};

__device__ __forceinline__ XcdBarrier xcd_barrier_post(unsigned* bar, volatile LAS unsigned* st) {
    XcdBarrier b; b.bar = bar; b.x = xb_xcc_id(); b.st = st;
    if (threadIdx.x == 0) (void)xb_add(&bar[XB_XCNT(b.x)], 1u);
    return b;
}
__device__ __forceinline__ void xcd_barrier_complete(unsigned* bar, unsigned x, unsigned& nloc, unsigned& nx) {
    const unsigned G = gridDim.x * gridDim.y * gridDim.z;
    unsigned sum, cnt, mine, sp = 0u;
    for (;;) {
        sum = 0u; cnt = 0u; mine = 0u;
#pragma unroll
        for (unsigned j = 0; j < 16; ++j) { const unsigned c = xb_ld(&bar[XB_XCNT(j)]); sum += c; cnt += (c > 0u) ? 1u : 0u; mine = (j == x) ? c : mine; }
        if (sum == G) break;
        __builtin_amdgcn_s_sleep(1);
        if ((++sp & 255u) == 0u) { if (xb_ld(&bar[XB_TMO])) break; if (sp > XB_SPIN_CAP) { atomicAdd(&bar[XB_TMO], 1u); break; } }
    }
    nloc = mine > 0u ? mine : 1u; nx = cnt > 0u ? cnt : 1u;
}

__device__ __forceinline__ void xcd_barrier(const XcdBarrier& b, const bool leader) {
    asm volatile("s_waitcnt vmcnt(0)" ::: "memory");
    __syncthreads();
    if (leader) {
        unsigned* bar = b.bar;
        __builtin_amdgcn_s_waitcnt(0);
        unsigned nloc = b.st[0], nx = b.st[1];
        if (nloc == 0u) { xcd_barrier_complete(bar, b.x, nloc, nx); b.st[0] = nloc; b.st[1] = nx; }
        const unsigned old = xb_add(&bar[XB_XSUB(b.x)], 1u);
        const unsigned gen = old / nloc;
        if (old + 1u == (gen + 1u) * nloc) {
            __builtin_amdgcn_fence(__ATOMIC_RELEASE, "agent");
            asm volatile("s_waitcnt vmcnt(0)" ::: "memory");
            const unsigned og = xb_add(&bar[XB_TOP], 1u);
            const unsigned tg = og / nx;
            if (og + 1u == (tg + 1u) * nx) xb_add(&bar[XB_TOPGEN], 1u);
            else XB_SPIN(xb_ld(&bar[XB_TOPGEN]) == tg, bar);
            __builtin_amdgcn_fence(__ATOMIC_ACQUIRE, "agent");
            xb_add(&bar[XB_XGEN(b.x)], 1u);
            asm volatile("s_waitcnt vmcnt(0)" ::: "memory");
        } else {
            XB_SPIN(xb_ld(&bar[XB_XGEN(b.x)]) == gen, bar);
            __builtin_amdgcn_fence(__ATOMIC_ACQUIRE, "agent");
            asm volatile("s_waitcnt vmcnt(0)" ::: "memory");
        }
    }
    __syncthreads();
}


constexpr size_t MiB = 1u << 20;
constexpr size_t WS_CTL = 0, CTL_ZERO_BYTES = 1 * MiB;
constexpr size_t WS_MOD = 1 * MiB;
constexpr size_t WS_H2F = 4 * MiB;
constexpr size_t WS_KF = 8 * MiB;
constexpr size_t WS_WIN = 136 * MiB;
constexpr size_t WS_WUP = 320 * MiB;
constexpr size_t WS_WDN = 496 * MiB;
constexpr size_t WS_WOUT = 584 * MiB;
constexpr size_t WS_WBH = 616 * MiB;
constexpr size_t WS_HB = 640 * MiB;
constexpr size_t WS_YHT = 704 * MiB;
constexpr size_t WS_YH = 736 * MiB;
constexpr size_t WS_MB = 784 * MiB;
constexpr size_t WS_ACT = 1522 * MiB;
constexpr size_t WS_UT = 848 * MiB;
constexpr size_t WS_VT = 944 * MiB;
constexpr size_t WS_QKG = 992 * MiB;
constexpr size_t WS_OG = 1216 * MiB;
constexpr size_t WS_LSE = 1264 * MiB;
constexpr size_t WS_GB = 848 * MiB;
constexpr size_t WS_HB2 = 1266 * MiB;
constexpr size_t WS_XB = 1330 * MiB;
constexpr size_t WS_END = 1698 * MiB;
constexpr int CW_BAR = 4096;
constexpr int LDS_BYTES = 147456, MISC_OFF = 139264; static_assert(pg8::EPI_LDS_OFF == MISC_OFF + 1024 && pg8::EPI_LDS_OFF + 4096 <= LDS_BYTES, "epilogue vector buffers");
constexpr int N_PHASES = 1 + DEPTH_ * 2 + 1 + DEPTH_ * NCHUNK * 8 + 1 + 1;

#ifndef PG8_ALIGN
#define PG8_ALIGN true
#endif
struct Args { const float* in[29]; float* out; unsigned char* ws; int ph_lo, ph_hi; };

using pg8::bflo; using pg8::bfhi;
__device__ __forceinline__ float wave_sum(float v, int lane) {
#pragma unroll
    for (int o = 1; o < 64; o <<= 1) v += shfl_from(v, lane ^ o);
    return v;
}
__device__ __forceinline__ void transpose_item(const float* W, int K, int N, bf16_t* WT, int k0, int n0, int drow0, LAS float* scr, int lane) {
#pragma unroll 8
    for (int i = 0; i < 32; ++i) { const int kk = 2 * i + (lane >> 5); scr[kk * 33 + (lane & 31)] = W[(size_t)(k0 + kk) * N + n0 + (lane & 31)]; }
    asm volatile("s_waitcnt lgkmcnt(0)" ::: "memory");
    const int c = lane & 7;
#pragma unroll
    for (int j = 0; j < 4; ++j) { const int n = (lane >> 3) + 8 * j; const LAS float* s = scr + (8 * c) * 33 + n;
        u32x4 o; o.x = pk2(s[0 * 33], s[1 * 33]); o.y = pk2(s[2 * 33], s[3 * 33]); o.z = pk2(s[4 * 33], s[5 * 33]); o.w = pk2(s[6 * 33], s[7 * 33]);
        *(u32x4*)(WT + (size_t)(drow0 + n) * K + k0 + 8 * c) = o; }
    asm volatile("s_waitcnt lgkmcnt(0)" ::: "memory");
}
__device__ __forceinline__ int win_dest_row(int n0) {
    if (n0 < 3072) return n0;
    if (n0 < 4608) return n0 + 1536;
    if (n0 < 6144) return n0 + 1536;
    if (n0 < 7680) return n0 - 3072;
    return n0;
}
__device__ __forceinline__ int wup_dest_row(int n0) {
    const int j = (n0 < 5632) ? n0 : n0 - 5632; return (j >> 7) * 256 + ((n0 < 5632) ? 0 : 128) + (j & 127);
}
__device__ __forceinline__ void prologue_phase(const __attribute__((address_space(4))) Args* Ap, LAS unsigned char* lds, int vcu, int G, int tid) {
    const int lane = tid & 63, wave = tid >> 6;
    unsigned char* ws = Ap->ws;
    {
        LAS float* scr = (LAS float*)(lds + wave * 16384);
        const int gw = vcu * 8 + wave, NGW = G * 8;
        constexpr int I_IN = 32 * 368, I_UP = 32 * 352, I_DN = 88 * 64, I_OUT = 32 * 64, I_BH = 16 * 64, I_BA = 8 * 64, I_L = I_IN + I_UP + I_DN + I_OUT + I_BH + I_BA;
        for (int it = gw; it < DEPTH_ * I_L; it += NGW) {
            const int l = it / I_L; int r = it % I_L;
            if (r < I_IN) { const int kb = r / 368, nb = r % 368; transpose_item(Ap->in[7] + (size_t)l * 2048 * 11776, 2048, 11776, (bf16_t*)(ws + WS_WIN) + (size_t)l * 11776 * 2048, 64 * kb, 32 * nb, win_dest_row(32 * nb), scr, lane); continue; } r -= I_IN;
            if (r < I_UP) { const int kb = r / 352, nb = r % 352; transpose_item(Ap->in[24] + (size_t)l * 2048 * 11264, 2048, 11264, (bf16_t*)(ws + WS_WUP) + (size_t)l * 11264 * 2048, 64 * kb, 32 * nb, wup_dest_row(32 * nb), scr, lane); continue; } r -= I_UP;
            if (r < I_DN) { const int kb = r / 64, nb = r % 64; transpose_item(Ap->in[27] + (size_t)l * 5632 * 2048, 5632, 2048, (bf16_t*)(ws + WS_WDN) + (size_t)l * 2048 * 5632, 64 * kb, 32 * nb, 32 * nb, scr, lane); continue; } r -= I_DN;
            if (r < I_OUT) { const int kb = r / 64, nb = r % 64; transpose_item(Ap->in[22] + (size_t)l * 2048 * 2048, 2048, 2048, (bf16_t*)(ws + WS_WOUT) + (size_t)l * 2048 * 2048, 64 * kb, 32 * nb, 32 * nb, scr, lane); continue; } r -= I_OUT;
            if (r < I_BH) { const int kb = r / 64, nb = r % 64; transpose_item(Ap->in[20] + (size_t)l * 1024 * 2048, 1536, 2048, (bf16_t*)(ws + WS_WBH) + (size_t)l * 2048 * 1536, 64 * kb, 32 * nb, 32 * nb, scr, lane); continue; } r -= I_BH;
            { const int kb = r / 64, nb = r % 64; transpose_item(Ap->in[21] + (size_t)l * 512 * 2048, 1536, 2048, (bf16_t*)(ws + WS_WBH) + (size_t)l * 2048 * 1536 + 1024, 64 * kb, 32 * nb, 32 * nb, scr, lane); }
        }
    }
    __syncthreads();
    {
        LAS float* cs = (LAS float*)lds;
        LAS float* red = (LAS float*)(lds + 98304);
        bool loaded = false;
        for (int unit = vcu; unit < DEPTH_ * 192; unit += G) {
            if (!loaded) {
                for (int i = tid; i < 12 * 2048; i += NTHR) { const int b = i >> 11, k = i & 2047; const float c = (b < 4) ? Ap->in[2][b * 2048 + k] : Ap->in[3][(b - 4) * 2048 + k]; cs[i] = c / (1.0f + __expf(-c)); }
                loaded = true; __syncthreads();
            }
            const int l = unit / 192, j = (unit % 192) * 64 + lane;
            const float* wp = Ap->in[4] + ((size_t)l * 2048 + wave * 256) * 12288 + j;
            float acc[12];
#pragma unroll
            for (int b = 0; b < 12; ++b) acc[b] = 0.f;
#pragma unroll 4
            for (int k = 0; k < 256; ++k) { const float w = wp[(size_t)k * 12288];
#pragma unroll
                for (int b = 0; b < 12; ++b) acc[b] += w * cs[b * 2048 + wave * 256 + k]; }
#pragma unroll
            for (int b = 0; b < 12; ++b) red[(wave * 12 + b) * 64 + lane] = acc[b];
            __syncthreads();
            for (int i = tid; i < 12 * 64; i += NTHR) { const int b = i >> 6, jj = i & 63; float s = 0.f;
#pragma unroll
                for (int w = 0; w < 8; ++w) s += red[(w * 12 + b) * 64 + jj];
                const int col = (unit % 192) * 64 + jj;
                ((float*)(ws + WS_MOD))[((size_t)l * 12 + b) * 12288 + col] = s + Ap->in[5][l * 12288 + col]; }
            __syncthreads();
        }
    }
}
template <bool XBF> __device__ __forceinline__ void norm_phase(const void* xv, bf16_t* hout, const float* gn, const float* modb  , int sh_off, int sc_off, int gw, int NGW, int lane) {
    int curb = -1; f32x4 gs[8], sh[8];
    for (int row = gw; row < MROWS; row += NGW) {
        const int b = row >> 12;
        if (b != curb) { curb = b;
#pragma unroll
            for (int j = 0; j < 8; ++j) { const int col = 4 * lane + 256 * j; const f32x4 g = *(const f32x4*)(gn + col), sc = *(const f32x4*)(modb + (size_t)b * 12288 + sc_off + col);
                gs[j] = g * (sc + 1.0f); sh[j] = *(const f32x4*)(modb + (size_t)b * 12288 + sh_off + col); } }
        f32x4 v[8]; float ss = 0.f;
        if constexpr (XBF) {
            const u32x2* xr = (const u32x2*)((const bf16_t*)xv + (size_t)row * 2048) + lane; u32x2 r[8];
#pragma unroll
            for (int j = 0; j < 8; ++j) r[j] = xr[64 * j];
#pragma unroll
            for (int j = 0; j < 8; ++j) { v[j].x = hlo(r[j].x); v[j].y = hhi(r[j].x); v[j].z = hlo(r[j].y); v[j].w = hhi(r[j].y); }
        } else {
            const f32x4* xr = (const f32x4*)((const float*)xv + (size_t)row * 2048) + lane;
#pragma unroll
            for (int j = 0; j < 8; ++j) v[j] = xr[64 * j];
        }
#pragma unroll
        for (int j = 0; j < 8; ++j) ss += (v[j].x * v[j].x + v[j].y * v[j].y) + (v[j].z * v[j].z + v[j].w * v[j].w);
        const float rstd = 1.0f / sqrtf(wave_sum(ss, lane) * (1.0f / 2048.0f) + 1e-6f);
        u32x2* o8 = (u32x2*)(hout + (size_t)row * 2048) + lane;
#pragma unroll
        for (int j = 0; j < 8; ++j) { const f32x4 y = v[j] * rstd * gs[j] + sh[j]; u32x2 w; w.x = pk2(y.x, y.y); w.y = pk2(y.z, y.w); o8[64 * j] = w; }
    }
}
__device__ __forceinline__ void final_norm_phase(const bf16_t* xb, float* out, const float* gn, int gw, int NGW, int lane) {
    f32x4 gs[8];
#pragma unroll
    for (int j = 0; j < 8; ++j) gs[j] = *(const f32x4*)(gn + 4 * lane + 256 * j);
    for (int row = gw; row < NSEQ * SEQ; row += NGW) {
        const u32x2* xr = (const u32x2*)(xb + (size_t)row * 2048) + lane; u32x2 r[8];
#pragma unroll
        for (int j = 0; j < 8; ++j) r[j] = xr[64 * j];
        f32x4 v[8]; float ss = 0.f;
#pragma unroll
        for (int j = 0; j < 8; ++j) { v[j].x = hlo(r[j].x); v[j].y = hhi(r[j].x); v[j].z = hlo(r[j].y); v[j].w = hhi(r[j].y);
            ss += (v[j].x * v[j].x + v[j].y * v[j].y) + (v[j].z * v[j].z + v[j].w * v[j].w); }
        const float rstd = 1.0f / sqrtf(wave_sum(ss, lane) * (1.0f / 2048.0f) + 1e-6f);
        f32x4* o = (f32x4*)(out + (size_t)row * 2048) + lane;
#pragma unroll
        for (int j = 0; j < 8; ++j) o[64 * j] = v[j] * rstd * gs[j];
    }
}
__device__ __forceinline__ void transpose_yh_tile(int tile, const bf16_t* YHT, bf16_t* YH, LAS bf16_t* scr, int lane) {
    const int b = tile >> 10, ct = (tile >> 6) & 15, tt = tile & 63, c0 = ct * 64, t0 = tt * 64;
#pragma unroll
    for (int i = 0; i < 8; ++i) { const int row = (lane >> 3) + 8 * i, ch = lane & 7;
        const u32x4 v = *(const u32x4*)(YHT + ((size_t)(b * 1024 + c0 + row)) * 4096 + t0 + 8 * ch);
        LAS bf16_t* d = scr + row * 66 + 8 * ch;
        d[0] = (bf16_t)(v.x & 0xffffu); d[1] = (bf16_t)(v.x >> 16); d[2] = (bf16_t)(v.y & 0xffffu); d[3] = (bf16_t)(v.y >> 16);
        d[4] = (bf16_t)(v.z & 0xffffu); d[5] = (bf16_t)(v.z >> 16); d[6] = (bf16_t)(v.w & 0xffffu); d[7] = (bf16_t)(v.w >> 16); }
    asm volatile("s_waitcnt lgkmcnt(0)" ::: "memory");
    bf16_t* orow = YH + ((size_t)(b * 4096 + t0 + lane)) * 1536 + c0;
#pragma unroll
    for (int j = 0; j < 8; ++j) { u32x4 w; unsigned q[4];
#pragma unroll
        for (int e = 0; e < 4; ++e) q[e] = (unsigned)scr[(8 * j + 2 * e) * 66 + lane] | ((unsigned)scr[(8 * j + 2 * e + 1) * 66 + lane] << 16);
        w.x = q[0]; w.y = q[1]; w.z = q[2]; w.w = q[3]; *(u32x4*)(orow + 8 * j) = w; }
    asm volatile("s_waitcnt lgkmcnt(0)" ::: "memory");
}
__device__ __forceinline__ void cg_fix_item(int idx, bf16_t* ACT, const bf16_t* GB, const float* cw, const float* cb) {
    const int col = (idx % 704) * 8, rs = idx / 704, side = rs & 1, grp = rs >> 1, row = grp * 64 + (side ? 63 : 0), t = row & 4095;
    const bf16_t* gb = GB + (size_t)grp * 4 * 5632 + col;
    u32x4 gm = (u32x4){0u, 0u, 0u, 0u}, gp = (u32x4){0u, 0u, 0u, 0u}, g0;
    if (side == 0) { g0 = *(const u32x4*)gb; gp = *(const u32x4*)(gb + 5632); if (t > 0) gm = *(const u32x4*)(gb - 5632); }
    else { gm = *(const u32x4*)(gb + 2 * 5632); g0 = *(const u32x4*)(gb + 3 * 5632); if (t < 4095) gp = *(const u32x4*)(gb + 4 * 5632); }
    bf16_t* ap = ACT + (size_t)row * 5632 + col;
    const u32x4 a = *(const u32x4*)ap;
    const f32x4 w0a = *(const f32x4*)(cw + col), w0b = *(const f32x4*)(cw + col + 4), w1a = *(const f32x4*)(cw + 5632 + col), w1b = *(const f32x4*)(cw + 5632 + col + 4);
    const f32x4 w2a = *(const f32x4*)(cw + 11264 + col), w2b = *(const f32x4*)(cw + 11264 + col + 4), ba = *(const f32x4*)(cb + col), bb = *(const f32x4*)(cb + col + 4);
    float w0[8] = {w0a.x, w0a.y, w0a.z, w0a.w, w0b.x, w0b.y, w0b.z, w0b.w}, w1[8] = {w1a.x, w1a.y, w1a.z, w1a.w, w1b.x, w1b.y, w1b.z, w1b.w};
    float w2[8] = {w2a.x, w2a.y, w2a.z, w2a.w, w2b.x, w2b.y, w2b.z, w2b.w}, bs[8] = {ba.x, ba.y, ba.z, ba.w, bb.x, bb.y, bb.z, bb.w};
    u32x4 o;
#pragma unroll
    for (int i = 0; i < 4; ++i) {
        const float xl = bflo(gm[i]) * w0[2 * i] + bflo(g0[i]) * w1[2 * i] + bflo(gp[i]) * w2[2 * i] + bs[2 * i];
        const float xh = bfhi(gm[i]) * w0[2 * i + 1] + bfhi(g0[i]) * w1[2 * i + 1] + bfhi(gp[i]) * w2[2 * i + 1] + bs[2 * i + 1];
        const float sl = xl / (1.0f + __expf(-xl)), shh = xh / (1.0f + __expf(-xh));
        o[i] = pk2(sl * bflo(a[i]), shh * bfhi(a[i]));
    }
    *(u32x4*)ap = o;
}

typedef const __attribute__((address_space(4))) Args* kargs_t;
__global__ void __launch_bounds__(512, 2) mega_fwd(Args args) {
    extern __shared__ __attribute__((aligned(16))) unsigned char lds_raw[];
    LAS unsigned char* lds = (LAS unsigned char*)lds_raw;
    const int G = gridDim.x, bx = blockIdx.x, vcu = (G % 8 == 0) ? (bx % 8) * (G / 8) + bx / 8 : bx, NGW = G * 8;
    const int lo = args.ph_lo, hi = args.ph_hi;
    const int wave_s = __builtin_amdgcn_readfirstlane(threadIdx.x >> 6);
    {
        volatile LAS unsigned* MISC = (volatile LAS unsigned*)(lds + MISC_OFF);
        for (int u = threadIdx.x; u < (LDS_BYTES - MISC_OFF) / 4; u += NTHR) MISC[u] = 0u;
        __syncthreads();
    }
    XcdBarrier bar; bar.bar = (unsigned*)(args.ws + WS_CTL) + CW_BAR; bar.x = 0; bar.st = nullptr;
    if (hi - lo > 1) bar = xcd_barrier_post((unsigned*)(args.ws + WS_CTL) + CW_BAR, (volatile LAS unsigned*)(lds + MISC_OFF) + 8);
#ifndef NOBAR_PASSES
#define NOBAR_PASSES 0
#endif
    int pc = 0;
#define IS_T0() ({ int t0_; asm volatile("v_mbcnt_lo_u32_b32 %0, -1, 0\n\tv_mbcnt_hi_u32_b32 %0, -1, %0" : "=v"(t0_)); (t0_ | wave_s) == 0; })
#define PH_IN (pc >= lo && pc < hi)
#define PH_CTX int ptid; asm volatile("v_mbcnt_lo_u32_b32 %0, -1, 0\n\tv_mbcnt_hi_u32_b32 %0, -1, %0" : "=v"(ptid)); ptid |= (wave_s << 6); const int plane = ptid & 63, pwave = __builtin_amdgcn_readfirstlane(ptid >> 6), pgw = vcu * 8 + pwave; (void)plane; (void)pgw; \
    kargs_t ap = (kargs_t)__builtin_amdgcn_kernarg_segment_ptr(); asm volatile("" : "+s"(ap)); unsigned char* const pws = ap->ws; (void)pws; int pl = l, pch = ch; asm volatile("" : "+s"(pl), "+s"(pch)); (void)pl; (void)pch;
#ifndef DUP_MASK
#define DUP_MASK 0
#endif
#ifndef DUP_REP
#define DUP_REP 2
#endif
#ifndef DUP_BAR
#define DUP_BAR 0
#endif
#define DUP(bit) for (int rep_ = 0; rep_ < (((DUP_MASK) & (bit)) ? (DUP_REP) : 1); (void)(((DUP_BAR) && ((DUP_MASK) & (bit)) && rep_ + 1 < (DUP_REP)) ? (xcd_barrier(bar, IS_T0()), 0) : 0), ++rep_)
#ifndef BAR_REP
#define BAR_REP 1
#endif
#define PH_END do { if (pc >= lo && pc + 1 < hi && pass_ == (NOBAR_PASSES)) { for (int br_ = 0; br_ < (BAR_REP); ++br_) xcd_barrier(bar, IS_T0()); } ++pc; } while (0)
#define WSP(T, off) ((T*)(pws + (off)))
#define XO_PTR (WSP(bf16_t, WS_XB) + (size_t)pch * MROWS * 2048)
#define XIN0_PTR ((pch == 0) ? ap->in[0] : ap->in[1] + (size_t)(pch - 1) * MROWS * 2048)
#define MODB_PTR (WSP(const float, WS_MOD) + ((size_t)pl * 12 + pch * 4) * 12288)
#define HB_CUR (((pl * NCHUNK + pch) & 1) ? WSP(bf16_t, WS_HB2) : WSP(bf16_t, WS_HB))

    for (int pass_ = 0; pass_ <= (NOBAR_PASSES); ++pass_) {
    pc = 0;
    if (pass_ > 0 && pass_ == (NOBAR_PASSES)) xcd_barrier(bar, IS_T0());
    { const int l = 0, ch = 0; if (PH_IN) DUP(512) { PH_CTX prologue_phase(ap, lds, vcu, G, ptid); __syncthreads(); } }
    PH_END;
    for (int l = 0; l < DEPTH_; ++l) {
        { const int ch = 0;
          if (PH_IN) DUP(1024) { PH_CTX int pvcu = vcu; asm volatile("" : "+s"(pvcu)); for (int u = pvcu; u < 512; u += G) filt_hidden_unit(u, ap->in[11] + pl * 33 * 64, ap->in[12] + pl * 64, ap->in[13] + pl * 64, ap->in[14] + pl * 64 * 64, ap->in[15] + pl * 64, ap->in[16] + pl * 64, WSP(float, WS_H2F), (LAS float*)lds, ptid); }
          PH_END;
          if (PH_IN) DUP(2048) { PH_CTX int pvcu = vcu; asm volatile("" : "+s"(pvcu)); for (int c2 = pvcu; c2 < 512; c2 += G) filt_channel_unit2(2 * c2, WSP(const float, WS_H2F), ap->in[17] + (size_t)pl * 64 * 4096, WSP(unsigned, WS_KF), lds, ptid); }
          PH_END; }
        for (int ch = 0; ch < NCHUNK; ++ch) {
            if (l == 0 && ch == 0) {
                if (PH_IN) { PH_CTX norm_phase<false>(XIN0_PTR, WSP(bf16_t, WS_HB), ap->in[6], MODB_PTR, 0, 2048, pgw, NGW, plane); }
                PH_END;
            }
            if (PH_IN) DUP(2) {
                { PH_CTX const bf16_t* Win = WSP(const bf16_t, WS_WIN) + (size_t)pl * 11776 * 2048;
                  pg8::Gemm g{Win, HB_CUR, 3584, MROWS, 2048}; pg8::StaticOrder S; S.init(3584, MROWS, G, bx); pg8::EpiG1a<0> E{WSP(bf16_t, WS_UT), WSP(bf16_t, WS_VT)};
                  pg8::gemm_phase<pg8::EpiG1a<0>, pg8::StaticOrder, PG8_ALIGN, true>(lds, g, S, E, ptid); }
                { PH_CTX const bf16_t* Win = WSP(const bf16_t, WS_WIN) + (size_t)pl * 11776 * 2048 + (size_t)3584 * 2048;
                  pg8::Gemm g{Win, HB_CUR, 512, MROWS, 2048}; pg8::StaticOrder S; S.init(512, MROWS, G, (bx + G / 2) % G); pg8::EpiG1a<1> E{WSP(bf16_t, WS_UT), WSP(bf16_t, WS_VT)};
                  pg8::gemm_phase<pg8::EpiG1a<1>, pg8::StaticOrder, PG8_ALIGN, true>(lds, g, S, E, ptid); }
                { PH_CTX const bf16_t* Win = WSP(const bf16_t, WS_WIN) + (size_t)pl * 11776 * 2048 + (size_t)4096 * 2048;
                  pg8::Gemm g{Win, HB_CUR, 512, MROWS, 2048}; pg8::StaticOrder S; S.init(512, MROWS, G, bx); pg8::EpiG1a<2> E{WSP(bf16_t, WS_UT), WSP(bf16_t, WS_VT)};
                  pg8::gemm_phase<pg8::EpiG1a<2>, pg8::StaticOrder, PG8_ALIGN, true>(lds, g, S, E, ptid); }
                { PH_CTX const bf16_t* Win = WSP(const bf16_t, WS_WIN) + (size_t)pl * 11776 * 2048;
                  pg8::Gemm g{HB_CUR, Win + (size_t)NA_ * 2048, MROWS, NB_, 2048}; pg8::StaticOrder S; S.init(MROWS, NB_, G, bx); pg8::EpiG1b E{WSP(bf16_t, WS_QKG), ap->in[8] + pl * 4096};
                  pg8::gemm_phase<pg8::EpiG1b, pg8::StaticOrder, PG8_ALIGN, true>(lds, g, S, E, ptid); }
                if (l * NCHUNK + ch + 1 < DEPTH_ * NCHUNK) {
                    PH_CTX
                    const int itn = pl * NCHUNK + pch + 1, ln = itn / NCHUNK, chn = itn % NCHUNK;
                    const bool split = (G == 256);
                    if (!split || bx >= 128) {
                        const int lw = (split ? bx - 128 : bx) * 8 + pwave, nlw = (split ? 128 : G) * 8;
                        bf16_t* hn = (itn & 1) ? WSP(bf16_t, WS_HB2) : WSP(bf16_t, WS_HB); const float* mb = WSP(const float, WS_MOD) + ((size_t)ln * 12 + chn * 4) * 12288;
                        if (ln == 0) norm_phase<false>((chn == 0) ? ap->in[0] : ap->in[1] + (size_t)(chn - 1) * MROWS * 2048, hn, ap->in[6] + ln * 2048, mb, 0, 2048, lw, nlw, plane);
                        else norm_phase<true>(WSP(bf16_t, WS_XB) + (size_t)chn * MROWS * 2048, hn, ap->in[6] + ln * 2048, mb, 0, 2048, lw, nlw, plane);
                    }
                }
            }
            PH_END;
            if (PH_IN) {
                DUP(4) { PH_CTX
                  hyena_units(vcu, G, WSP(const bf16_t, WS_UT), WSP(bf16_t, WS_YHT), WSP(const unsigned, WS_KF), ap->in[9] + pl * 3 * 3072, ap->in[10] + pl * 3072, ap->in[18] + pl * 2048, lds, ptid, rep_ < (DUP_REP) - 1 && ((DUP_MASK) & 4));
                  __syncthreads(); }
                DUP(8) { PH_CTX
                  attn_bias_table((LAS float*)(lds + AT_TAB_OFF), ap->in[19], ptid);
                  attn_units(vcu, G, 4 * 24 * 16, WSP(const bf16_t, WS_QKG), WSP(const bf16_t, WS_VT), WSP(bf16_t, WS_OG), WSP(float, WS_LSE), lds, ptid);
                  __syncthreads(); }
            }
            PH_END;
            if (PH_IN) DUP(16) {
                PH_CTX
                for (int tile = pgw; tile < 4096; tile += NGW) transpose_yh_tile(tile, WSP(const bf16_t, WS_YHT), WSP(bf16_t, WS_YH), (LAS bf16_t*)(lds + pwave * 8448), plane);
                for (int it = bx * NTHR + ptid; it < MROWS * 64; it += G * NTHR) attn_combine_item(it, WSP(const bf16_t, WS_OG), WSP(const float, WS_LSE), WSP(bf16_t, WS_YH), 1536, 1024);
                __syncthreads();
            }
            PH_END;
            if (PH_IN) DUP(32) { PH_CTX pg8::Gemm g{WSP(const bf16_t, WS_YH), WSP(const bf16_t, WS_WBH) + (size_t)pl * 2048 * 1536, MROWS, 2048, 1536}; pg8::StaticOrder S; S.init(MROWS, 2048, G, bx);
                pg8::EpiG2M E{WSP(const bf16_t, WS_QKG), WSP(bf16_t, WS_MB)};
                pg8::gemm_phase<pg8::EpiG2M, pg8::StaticOrder, PG8_ALIGN, true>(lds, g, S, E, ptid); }
            PH_END;
            if (PH_IN) DUP(4096) { PH_CTX pg8::Gemm g{WSP(const bf16_t, WS_MB), WSP(const bf16_t, WS_WOUT) + (size_t)pl * 2048 * 2048, MROWS, 2048, 2048}; pg8::StaticOrder S; S.init(MROWS, 2048, G, bx);
                bf16_t* xn = (((DUP_MASK) & 4096) && rep_ < (DUP_REP) - 1) ? WSP(bf16_t, WS_ACT) : XO_PTR;
                if (pl == 0) { pg8::EpiResB<true> E{XIN0_PTR, nullptr, xn, MODB_PTR + 2 * 2048}; pg8::gemm_phase<pg8::EpiResB<true>, pg8::StaticOrder, PG8_ALIGN, true>(lds, g, S, E, ptid); }
                else { pg8::EpiResB<false> E{nullptr, XO_PTR, xn, MODB_PTR + 2 * 2048}; pg8::gemm_phase<pg8::EpiResB<false>, pg8::StaticOrder, PG8_ALIGN, true>(lds, g, S, E, ptid); } }
            PH_END;
            if (PH_IN) DUP(64) { PH_CTX norm_phase<true>(XO_PTR, HB_CUR, ap->in[23] + pl * 2048, MODB_PTR, 3 * 2048, 4 * 2048, pgw, NGW, plane); }
            PH_END;
            if (PH_IN) DUP(128) { PH_CTX pg8::Gemm g{HB_CUR, WSP(const bf16_t, WS_WUP) + (size_t)pl * 11264 * 2048, MROWS, 11264, 2048}; pg8::StaticOrder S; S.init(MROWS, 11264, G, bx); pg8::EpiUpCG E{WSP(bf16_t, WS_ACT), WSP(bf16_t, WS_GB), ap->in[25] + (size_t)pl * 3 * 5632, ap->in[26] + pl * 5632};
                pg8::gemm_phase<pg8::EpiUpCG, pg8::StaticOrder, PG8_ALIGN, true>(lds, g, S, E, ptid); }
            PH_END;
            if (PH_IN) { PH_CTX for (int it = bx * NTHR + ptid; it < 256 * 2 * 704; it += G * NTHR) cg_fix_item(it, WSP(bf16_t, WS_ACT), WSP(const bf16_t, WS_GB), ap->in[25] + (size_t)pl * 3 * 5632, ap->in[26] + pl * 5632); }
            PH_END;
            if (PH_IN) DUP(8192) { PH_CTX pg8::Gemm g{WSP(const bf16_t, WS_ACT), WSP(const bf16_t, WS_WDN) + (size_t)pl * 2048 * 5632, MROWS, 2048, 5632}; pg8::StaticOrder S; S.init(MROWS, 2048, G, bx);
                pg8::EpiResB<false> E{nullptr, XO_PTR, (((DUP_MASK) & 8192) && rep_ < (DUP_REP) - 1) ? WSP(bf16_t, WS_YHT) : XO_PTR, MODB_PTR + 5 * 2048};
                pg8::gemm_phase<pg8::EpiResB<false>, pg8::StaticOrder, PG8_ALIGN, true>(lds, g, S, E, ptid); }
            if (l == DEPTH_ - 1 && ch == NCHUNK - 1) PH_END;
        }
    }
    { const int l = 0, ch = 0; if (PH_IN) { PH_CTX final_norm_phase(WSP(const bf16_t, WS_XB), ap->out, ap->in[28], pgw, NGW, plane); } }
    PH_END;
    }
#undef PH_IN
#undef PH_CTX
#undef PH_END
#undef DUP
}

#ifndef MK_LAUNCH_PER_PHASE
#define MK_LAUNCH_PER_PHASE 0
#endif
extern "C" void kernel_launch(void* const* d_in, const int* in_sizes, int n_in, void* d_out, int out_size, void* d_ws, size_t ws_size, hipStream_t stream) {
    static int grid = 0;
    if (grid == 0) {
        if (n_in != 29 || out_size != NSEQ * SEQ * 2048 || ws_size < WS_END) { fprintf(stderr, "kernel_launch: unexpected sizes n_in %d out %d ws %zu\n", n_in, out_size, ws_size); grid = -1; return; }
        int dev = 0, cus = 0, per_cu = 0;
        if (hipGetDevice(&dev) != hipSuccess || hipDeviceGetAttribute(&cus, hipDeviceAttributeMultiprocessorCount, dev) != hipSuccess) { grid = -1; return; }
        if (hipFuncSetAttribute((const void*)mega_fwd, hipFuncAttributeMaxDynamicSharedMemorySize, LDS_BYTES) != hipSuccess) { fprintf(stderr, "kernel_launch: hipFuncSetAttribute failed\n"); grid = -1; return; }
        if (hipOccupancyMaxActiveBlocksPerMultiprocessor(&per_cu, (const void*)mega_fwd, 512, LDS_BYTES) != hipSuccess || per_cu < 1) fprintf(stderr, "kernel_launch: occupancy query says %d\n", per_cu);
        (void)hipGetLastError();
        grid = cus;
    }
    if (grid < 0) return;
    (void)hipMemsetAsync((char*)d_ws + WS_CTL, 0, CTL_ZERO_BYTES, stream);
    Args a{};
    for (int i = 0; i < 29; ++i) a.in[i] = (const float*)d_in[i];
    a.out = (float*)d_out; a.ws = (unsigned char*)d_ws;
#if MK_LAUNCH_PER_PHASE
    for (int p = 0; p < N_PHASES; ++p) { a.ph_lo = p; a.ph_hi = p + 1; hipLaunchKernelGGL(mega_fwd, dim3(grid), dim3(512), LDS_BYTES, stream, a); }
#else
    a.ph_lo = 0; a.ph_hi = N_PHASES; hipLaunchKernelGGL(mega_fwd, dim3(grid), dim3(512), LDS_BYTES, stream, a);
#endif
}
```

```cpp
#include <hip/hip_runtime.h>
#include <cstdio>
#include <cstdint>
#define DEV __device__ __forceinline__
#define DEVCONST __device__
#define LAS __attribute__((address_space(3)))
#define SYNC() __syncthreads()
#define F2U(x) __float_as_uint(x)
#define U2F(x) __uint_as_float(x)
#define BITCAST(T, v) __builtin_bit_cast(T, v)
#define EXP2(x) __builtin_amdgcn_exp2f(x)
#define LOG2(x) __builtin_amdgcn_logf(x)
#define SINCOSPI(x, s, c) do { const float hx_ = 0.5f * (x); *(s) = __builtin_amdgcn_sinf(hx_); *(c) = __builtin_amdgcn_cosf(hx_); } while (0)
__device__ __forceinline__ float shfl_from(float v, int src_lane) { return __builtin_bit_cast(float, __builtin_amdgcn_ds_bpermute(src_lane << 2, __builtin_bit_cast(int, v))); }
#define SHFL_XOR3(v, m, lane) shfl_from((v), (lane) ^ (m))
#define MFMA32(a, b, c) __builtin_amdgcn_mfma_f32_32x32x16_bf16((a), (b), (c), 0, 0, 0)
#define OPAQUE_I(x) asm volatile("" : "+v"(x))

typedef _Float16 h16x2_t __attribute__((ext_vector_type(2)));
__device__ __forceinline__ unsigned pkh2(float a, float b) { h16x2_t h; h.x = (_Float16)a; h.y = (_Float16)b; return __builtin_bit_cast(unsigned, h); }
__device__ __forceinline__ float hlo(unsigned w) { return (float)__builtin_bit_cast(h16x2_t, w).x; }
__device__ __forceinline__ float hhi(unsigned w) { return (float)__builtin_bit_cast(h16x2_t, w).y; }
constexpr int D_ = 2048, SEQ = 4096, NSEQ = 12, DEPTH_ = 4, CHS = 4  , NCHUNK = 3, MROWS = CHS * SEQ  ;
constexpr int HW_ = 1024, AW_ = 1536, AO_ = 512, DFF_ = 5632, INC_ = 11776, NMOD_ = 6;
constexpr int NA_ = 4608  , NB_ = 7168  ;
constexpr int FFTN = 8192, FPAD = FFTN + FFTN / 16  ;
constexpr int NTHR = 512;

typedef unsigned short bf16_t;
typedef short bf16x8 __attribute__((ext_vector_type(8)));
typedef float f32x4 __attribute__((ext_vector_type(4)));
typedef float f32x16 __attribute__((ext_vector_type(16)));
typedef float cf __attribute__((ext_vector_type(2)));
typedef unsigned u32x4 __attribute__((ext_vector_type(4)));
typedef unsigned u32x2 __attribute__((ext_vector_type(2)));
typedef unsigned short u16x4 __attribute__((ext_vector_type(4)));

DEV unsigned short f2bf(float f) { unsigned u = F2U(f); u += 0x7fffu + ((u >> 16) & 1u); return (unsigned short)(u >> 16); }
DEV float bf2f(unsigned short b) { return U2F(((unsigned)b) << 16); }
DEV unsigned pk2(float lo, float hi) { return (unsigned)f2bf(lo) | ((unsigned)f2bf(hi) << 16); }

DEVCONST constexpr float C8T[9] = {1.0f, 0.980785280403230449f, 0.923879532511286756f, 0.831469612302545237f, 0.707106781186547524f, 0.555570233019602225f, 0.382683432365089772f, 0.195090322016128268f, 0.0f};
DEV constexpr float tw_cos(int m) { m &= 31; return m <= 8 ? C8T[m] : (m <= 16 ? -C8T[16 - m] : (m <= 24 ? -C8T[m - 16] : C8T[32 - m])); }
DEV constexpr float tw_sin(int m) { return tw_cos(m - 8); }
DEVCONST constexpr int BR16[16] = {0, 8, 4, 12, 2, 10, 6, 14, 1, 9, 5, 13, 3, 11, 7, 15};
DEVCONST constexpr int BR32[32] = {0, 16, 8, 24, 4, 20, 12, 28, 2, 18, 10, 26, 6, 22, 14, 30, 1, 17, 9, 25, 5, 21, 13, 29, 3, 19, 11, 27, 7, 23, 15, 31};
#ifdef EMU
DEV cf cmul(cf a, cf b) { return cf{a.x * b.x - a.y * b.y, a.x * b.y + a.y * b.x}; }
DEV cf cmulc(cf a, cf b) { return cf{a.x * b.x + a.y * b.y, a.y * b.x - a.x * b.y}; }
#else
DEV cf cmul(cf a, cf b) { cf r, t;
    asm("v_pk_mul_f32 %1, %2, %3 op_sel:[1,1] op_sel_hi:[1,0] neg_lo:[1,0]\n\tv_pk_fma_f32 %0, %2, %3, %1 op_sel_hi:[0,1,1]" : "=v"(r), "=&v"(t) : "v"(a), "v"(b));
    return r; }
DEV cf cmulc(cf a, cf b) { cf r, t;
    asm("v_pk_mul_f32 %1, %2, %3 op_sel:[1,1] op_sel_hi:[1,0]\n\tv_pk_fma_f32 %0, %2, %3, %1 op_sel_hi:[0,1,1] neg_hi:[1,0,0]" : "=v"(r), "=&v"(t) : "v"(a), "v"(b));
    return r; }
#endif
template <int R, bool INV> DEV void dft_regs(cf (&v)[R]) {
#pragma unroll
    for (int s = R; s >= 2; s >>= 1) {
        const int h = s >> 1;
#pragma unroll
        for (int b = 0; b < R; b += s) {
#pragma unroll
            for (int k = 0; k < h; ++k) {
                const cf a = v[b + k], c = v[b + k + h];
                v[b + k] = a + c;
                const cf d = a - c;
                const int m = k * (32 / s);
                const float wr = tw_cos(m), wi = INV ? tw_sin(m) : -tw_sin(m);
                v[b + k + h] = cf{d.x * wr - d.y * wi, d.x * wi + d.y * wr};
            }
        }
    }
}
DEV int PADI(int i) { return i + (i >> 4); }
DEV int fpos(int k) { return ((k & 15) << 9) | (((k >> 4) & 31) << 4) | (k >> 9); }
DEV int fnat(int p) { return (p >> 9) | (((p >> 4) & 31) << 4) | ((p & 15) << 9); }

DEV void fft_f1(LAS cf* buf, const cf (&z)[8], int tid) {
    OPAQUE_I(tid);
    cf v[16];
#pragma unroll
    for (int q = 0; q < 8; ++q) { v[q] = z[q]; v[q + 8] = cf{0.f, 0.f}; }
    dft_regs<16, false>(v);
    float sn, cs; SINCOSPI(-(float)tid * (2.0f / 8192.0f), &sn, &cs);
    const cf w = cf{cs, sn}; cf wp = cf{1.f, 0.f};
#pragma unroll
    for (int p = 0; p < 16; ++p) { buf[PADI(tid + 512 * p)] = cmul(v[BR16[p]], wp); wp = cmul(wp, w); }
}
DEV void fft_f1x2(LAS cf* buf0, LAS cf* buf1, const cf (&z0)[8], const cf (&z1)[8], int tid) {
    OPAQUE_I(tid);
    cf v[16], u[16];
#pragma unroll
    for (int q = 0; q < 8; ++q) { v[q] = z0[q]; v[q + 8] = cf{0.f, 0.f}; u[q] = z1[q]; u[q + 8] = cf{0.f, 0.f}; }
    dft_regs<16, false>(v); dft_regs<16, false>(u);
    float sn, cs; SINCOSPI(-(float)tid * (2.0f / 8192.0f), &sn, &cs);
    const cf w = cf{cs, sn}; cf wp = cf{1.f, 0.f};
    LAS cf* p0 = buf0 + PADI(tid); LAS cf* p1 = buf1 + PADI(tid);
#pragma unroll
    for (int p = 0; p < 16; ++p) { p0[544 * p] = cmul(v[BR16[p]], wp); p1[544 * p] = cmul(u[BR16[p]], wp); wp = cmul(wp, w); }
}
DEV void fft_i1x2(LAS cf* buf0, LAS cf* buf1, cf (&y0)[8], cf (&y1)[8], int tid) {
    OPAQUE_I(tid);
    float sn, cs; SINCOSPI(-(float)tid * (2.0f / 8192.0f), &sn, &cs);
    const cf w = cf{cs, sn}; cf wp = cf{1.f, 0.f};
    cf v[16], u[16];
    const LAS cf* p0 = buf0 + PADI(tid); const LAS cf* p1 = buf1 + PADI(tid);
#pragma unroll
    for (int p = 0; p < 16; ++p) { v[p] = cmulc(p0[544 * p], wp); u[p] = cmulc(p1[544 * p], wp); wp = cmul(wp, w); }
    dft_regs<16, true>(v); dft_regs<16, true>(u);
#pragma unroll
    for (int q = 0; q < 8; ++q) { y0[q] = v[BR16[q]]; y1[q] = u[BR16[q]]; }
}
DEV void fft_f2(LAS cf* buf, int t8) {
    OPAQUE_I(t8);
    LAS cf* pb = buf + (t8 >> 4) * 544 + (t8 & 15);
    cf v[32];
#pragma unroll
    for (int q = 0; q < 32; ++q) v[q] = pb[17 * q];
    dft_regs<32, false>(v);
    float sn, cs; SINCOSPI(-(float)(t8 & 15) * (2.0f / 512.0f), &sn, &cs);
    const cf w = cf{cs, sn}; cf wp = cf{1.f, 0.f};
#pragma unroll
    for (int p = 0; p < 32; ++p) { pb[17 * p] = cmul(v[BR32[p]], wp); wp = cmul(wp, w); }
}
DEV cf kunpack(unsigned w) { return cf{U2F(w << 16), U2F(w & 0xffff0000u)}; }
template <bool MULK> DEV void fft_mid(LAS cf* buf, const unsigned* Kp, int blk) {
    const int base = 16 * blk;
    cf v[16];
#pragma unroll
    for (int q = 0; q < 16; ++q) v[q] = buf[PADI(base + q)];
    dft_regs<16, false>(v);
    if (MULK) {
        cf w[16];
#pragma unroll
        for (int p = 0; p < 16; ++p) w[p] = cmul(v[BR16[p]], kunpack(Kp[base + p]));
        dft_regs<16, true>(w);
#pragma unroll
        for (int q = 0; q < 16; ++q) buf[PADI(base + q)] = w[BR16[q]];
    } else {
#pragma unroll
        for (int p = 0; p < 16; ++p) buf[PADI(base + p)] = v[BR16[p]];
    }
}
DEV void fft_midx2(LAS cf* buf0, LAS cf* buf1, const unsigned* Kp, int blk) {
    const int base = 16 * blk;
    LAS cf* p0 = buf0 + 17 * blk; LAS cf* p1 = buf1 + 17 * blk;
    cf v[16], u[16];
#pragma unroll
    for (int q = 0; q < 16; ++q) { v[q] = p0[q]; u[q] = p1[q]; }
    dft_regs<16, false>(v); dft_regs<16, false>(u);
    cf w[16], x[16];
    u32x4 kw[4];
#pragma unroll
    for (int j = 0; j < 4; ++j) kw[j] = *(const u32x4*)(Kp + base + 4 * j);
#pragma unroll
    for (int p = 0; p < 16; ++p) { const cf k = kunpack(kw[p >> 2][p & 3]); w[p] = cmul(v[BR16[p]], k); x[p] = cmul(u[BR16[p]], k); }
    dft_regs<16, true>(w); dft_regs<16, true>(x);
#pragma unroll
    for (int q = 0; q < 16; ++q) { p0[q] = w[BR16[q]]; p1[q] = x[BR16[q]]; }
}
DEV void fft_i2(LAS cf* buf, int t8) {
    OPAQUE_I(t8);
    LAS cf* pb = buf + (t8 >> 4) * 544 + (t8 & 15);
    float sn, cs; SINCOSPI(-(float)(t8 & 15) * (2.0f / 512.0f), &sn, &cs);
    const cf w = cf{cs, sn}; cf wp = cf{1.f, 0.f};
    cf v[32];
#pragma unroll
    for (int p = 0; p < 32; ++p) { v[p] = cmulc(pb[17 * p], wp); wp = cmul(wp, w); }
    dft_regs<32, true>(v);
#pragma unroll
    for (int q = 0; q < 32; ++q) pb[17 * q] = v[BR32[q]];
}
DEV void fft_i1(LAS cf* buf, cf (&y)[8], int tid) {
    OPAQUE_I(tid);
    float sn, cs; SINCOSPI(-(float)tid * (2.0f / 8192.0f), &sn, &cs);
    const cf w = cf{cs, sn}; cf wp = cf{1.f, 0.f};
    cf v[16];
#pragma unroll
    for (int p = 0; p < 16; ++p) { v[p] = cmulc(buf[PADI(tid + 512 * p)], wp); wp = cmul(wp, w); }
    dft_regs<16, true>(v);
#pragma unroll
    for (int q = 0; q < 8; ++q) y[q] = v[BR16[q]];
}

DEV void filt_hidden_unit(int unit, const float* w1, const float* b1, const float* fr1, const float* w2, const float* b2, const float* fr2, float* h2out, LAS float* sm, int tid) {
    LAS float* feat = sm;
    LAS float* h1 = sm + 8 * 33;
    const int tl = tid >> 6, j = tid & 63, t = unit * 8 + tl;
    if (tid < 8 * 33) {
        const int tt = tid / 33, f = tid % 33, tp = unit * 8 + tt;
        float val;
        if (f == 0) val = (float)tp * (1.0f / 4095.0f);
        else { const int k = (f - 1) & 15; const float band = 1e-4f + (float)k * ((15.0f - 1e-4f) / 15.0f);
               const float xr = (float)tp * band * (1.0f / 4096.0f), fr = xr - floorf(xr);
               float sn, cs; SINCOSPI(2.0f * fr, &sn, &cs);
               val = (f <= 16) ? cs : -sn; }
        feat[tt * 33 + f] = val;
    }
    SYNC();
    { float a = b1[j];
#pragma unroll 11
      for (int f = 0; f < 33; ++f) a += feat[tl * 33 + f] * w1[f * 64 + j];
      h1[tl * 64 + j] = sinf(fr1[j] * a); }
    SYNC();
    { float a = b2[j];
#pragma unroll 16
      for (int i = 0; i < 64; ++i) a += h1[tl * 64 + i] * w2[i * 64 + j];
      h2out[j * 4096 + t] = sinf(fr2[j] * a); }
    SYNC();
}
DEV void filt_channel_unit(int c, const float* h2, const float* w3, unsigned* KF, LAS unsigned char* lds, int tid) {
    LAS cf* buf = (LAS cf*)lds;
    LAS float* sw = (LAS float*)(lds + FPAD * 8);
    LAS float* red = sw + 256;
    if (tid < 256) { const int i = tid >> 2, q = tid & 3; sw[tid] = w3[i * 4096 + q * 1024 + c]; }
    SYNC();
    const float dmin = -3.0701134573253947f, dmax = -15.350567286626973f;
    const float delta = fabsf(dmin + (float)c * ((dmax - dmin) / 1023.0f));
    float s0 = 0.f, s1 = 0.f;
#pragma unroll 1
    for (int i = 0; i < 8; ++i) {
        const int t = tid + 512 * i;
        const float* hc = h2 + t;
        float a0 = 0.f, a1 = 0.f, a2 = 0.f, a3 = 0.f;
        float xv[64];
#pragma unroll
        for (int k = 0; k < 64; ++k) xv[k] = hc[k * 4096];
#pragma unroll
        for (int k = 0; k < 64; ++k) { const f32x4 w = *(const LAS f32x4*)(sw + k * 4); a0 += xv[k] * w.x; a1 += xv[k] * w.y; a2 += xv[k] * w.z; a3 += xv[k] * w.w; }
        const float dec = expf(-((float)t * (1.0f / 4095.0f)) * delta);
        a0 *= dec; a1 *= dec; a2 *= dec; a3 *= dec;
        s0 += fabsf(a0); s1 += fabsf(a1);
        buf[PADI(t)] = cf{a0, a1};
        if (t > 0) { s0 += fabsf(a2); s1 += fabsf(a3); buf[PADI(8192 - t)] = cf{a2, a3}; }
        else buf[PADI(4096)] = cf{a2 * 0.f, a3 * 0.f};
    }
#pragma unroll
    for (int o = 1; o < 64; o <<= 1) { s0 += SHFL_XOR3(s0, o, tid & 63); s1 += SHFL_XOR3(s1, o, tid & 63); }
    if ((tid & 63) == 0) { red[(tid >> 6) * 2] = s0; red[(tid >> 6) * 2 + 1] = s1; }
    SYNC();
    float t0 = 0.f, t1 = 0.f;
#pragma unroll
    for (int w = 0; w < 8; ++w) { t0 += red[w * 2]; t1 += red[w * 2 + 1]; }
    const cf inrm = cf{1.0f / t0, 1.0f / t1};
    {
        OPAQUE_I(tid);
        cf v[16];
#pragma unroll
        for (int q = 0; q < 16; ++q) v[q] = buf[PADI(tid + 512 * q)] * inrm;
        dft_regs<16, false>(v);
        float sn, cs; SINCOSPI(-(float)tid * (2.0f / 8192.0f), &sn, &cs);
        const cf w = cf{cs, sn}; cf wp = cf{1.f, 0.f};
#pragma unroll
        for (int p = 0; p < 16; ++p) { buf[PADI(tid + 512 * p)] = cmul(v[BR16[p]], wp); wp = cmul(wp, w); }
    }
    SYNC();
    if (tid < 256) fft_f2(buf, tid);
    SYNC();
    fft_mid<false>(buf, nullptr, tid);
    SYNC();
    const float sc = 0.5f / 8192.0f;
#pragma unroll
    for (int i = 0; i < 16; ++i) {
        const int p = tid + 512 * i, k = fnat(p), p2 = fpos((8192 - k) & 8191);
        const cf a = buf[PADI(p)], b = buf[PADI(p2)];
        KF[((size_t)c * 2 + 0) * 8192 + p] = pk2((a.x + b.x) * sc, (a.y - b.y) * sc);
        KF[((size_t)c * 2 + 1) * 8192 + p] = pk2((a.y + b.y) * sc, (b.x - a.x) * sc);
    }
    SYNC();
}

DEV void filt_channel_unit2(int c, const float* h2, const float* w3, unsigned* KF, LAS unsigned char* lds, int tid) {
    LAS cf* buf0 = (LAS cf*)lds; LAS cf* buf1 = buf0 + FPAD;
    int swo = 2 * FPAD * 8 + 1024; OPAQUE_I(swo);
    LAS float* sw = (LAS float*)(lds + swo);
    LAS float* red = sw + 512;
    { const int i = tid >> 3, q = tid & 7; sw[tid] = w3[i * 4096 + (q & 3) * 1024 + c + (q >> 2)]; }
    SYNC();
    const float dmin = -3.0701134573253947f, dmax = -15.350567286626973f;
    const float delta0 = fabsf(dmin + (float)c * ((dmax - dmin) / 1023.0f)), delta1 = fabsf(dmin + (float)(c + 1) * ((dmax - dmin) / 1023.0f));
    float s[4] = {0.f, 0.f, 0.f, 0.f};
#pragma unroll 1
    for (int i = 0; i < 8; ++i) {
        const int t = tid + 512 * i;
        const float* hc = h2 + t;
        float a[8] = {0.f, 0.f, 0.f, 0.f, 0.f, 0.f, 0.f, 0.f};
        float xv[64];
#pragma unroll
        for (int k = 0; k < 64; ++k) xv[k] = hc[k * 4096];
#pragma unroll
        for (int k = 0; k < 64; ++k) { const f32x4 w0 = *(const LAS f32x4*)(sw + k * 8), w1 = *(const LAS f32x4*)(sw + k * 8 + 4);
            a[0] += xv[k] * w0.x; a[1] += xv[k] * w0.y; a[2] += xv[k] * w0.z; a[3] += xv[k] * w0.w; a[4] += xv[k] * w1.x; a[5] += xv[k] * w1.y; a[6] += xv[k] * w1.z; a[7] += xv[k] * w1.w; }
        const float tn = (float)t * (1.0f / 4095.0f), dec0 = expf(-tn * delta0), dec1 = expf(-tn * delta1);
#pragma unroll
        for (int q = 0; q < 4; ++q) { a[q] *= dec0; a[4 + q] *= dec1; }
        s[0] += fabsf(a[0]); s[1] += fabsf(a[1]); s[2] += fabsf(a[4]); s[3] += fabsf(a[5]);
        buf0[PADI(t)] = cf{a[0], a[1]}; buf1[PADI(t)] = cf{a[4], a[5]};
        if (t > 0) { s[0] += fabsf(a[2]); s[1] += fabsf(a[3]); s[2] += fabsf(a[6]); s[3] += fabsf(a[7]); buf0[PADI(8192 - t)] = cf{a[2], a[3]}; buf1[PADI(8192 - t)] = cf{a[6], a[7]}; }
        else { buf0[PADI(4096)] = cf{a[2] * 0.f, a[3] * 0.f}; buf1[PADI(4096)] = cf{a[6] * 0.f, a[7] * 0.f}; }
    }
#pragma unroll
    for (int o = 1; o < 64; o <<= 1) {
#pragma unroll
        for (int q = 0; q < 4; ++q) s[q] += SHFL_XOR3(s[q], o, tid & 63); }
    if ((tid & 63) == 0) {
#pragma unroll
        for (int q = 0; q < 4; ++q) red[(tid >> 6) * 4 + q] = s[q]; }
    SYNC();
    float tt[4] = {0.f, 0.f, 0.f, 0.f};
#pragma unroll
    for (int w = 0; w < 8; ++w)
#pragma unroll
        for (int q = 0; q < 4; ++q) tt[q] += red[w * 4 + q];
    const cf in0 = cf{1.0f / tt[0], 1.0f / tt[1]}, in1 = cf{1.0f / tt[2], 1.0f / tt[3]};
    {
        OPAQUE_I(tid);
        cf v[16], u[16];
#pragma unroll
        for (int q = 0; q < 16; ++q) { v[q] = buf0[PADI(tid + 512 * q)] * in0; u[q] = buf1[PADI(tid + 512 * q)] * in1; }
        dft_regs<16, false>(v); dft_regs<16, false>(u);
        float sn, cs; SINCOSPI(-(float)tid * (2.0f / 8192.0f), &sn, &cs);
        const cf w = cf{cs, sn}; cf wp = cf{1.f, 0.f};
#pragma unroll
        for (int p = 0; p < 16; ++p) { buf0[PADI(tid + 512 * p)] = cmul(v[BR16[p]], wp); buf1[PADI(tid + 512 * p)] = cmul(u[BR16[p]], wp); wp = cmul(wp, w); }
    }
    SYNC();
    fft_f2((tid >> 8) ? buf1 : buf0, tid & 255);
    SYNC();
    fft_mid<false>(buf0, nullptr, tid); fft_mid<false>(buf1, nullptr, tid);
    SYNC();
    const float sc = 0.5f / 8192.0f;
#pragma unroll
    for (int i = 0; i < 16; ++i) {
        const int p = tid + 512 * i, k = fnat(p), p2 = fpos((8192 - k) & 8191);
        const cf a0 = buf0[PADI(p)], b0 = buf0[PADI(p2)], a1 = buf1[PADI(p)], b1 = buf1[PADI(p2)];
        KF[((size_t)c * 2 + 0) * 8192 + p] = pk2((a0.x + b0.x) * sc, (a0.y - b0.y) * sc);
        KF[((size_t)c * 2 + 1) * 8192 + p] = pk2((a0.y + b0.y) * sc, (b0.x - a0.x) * sc);
        KF[((size_t)c * 2 + 2) * 8192 + p] = pk2((a1.x + b1.x) * sc, (a1.y - b1.y) * sc);
        KF[((size_t)c * 2 + 3) * 8192 + p] = pk2((a1.y + b1.y) * sc, (b1.x - a1.x) * sc);
    }
    SYNC();
}

DEV float ldsbf(const LAS bf16_t* p) { return bf2f(*p); }
DEV void hyena_issue_rows(const bf16_t* UT, int s, int c, u32x4 (&r)[4], int tid) {
#pragma unroll
    for (int b = 0; b < 4; ++b) r[b] = *(const u32x4*)(UT + ((size_t)(b * 3072 + s * 1024 + c)) * 4096 + tid * 8);
}
DEV void hyena_commit_rows(LAS unsigned char* lds, const u32x4 (&r)[4], int tid) {
#pragma unroll
    for (int b = 0; b < 4; ++b) *(LAS u32x4*)(lds + b * 8192 + tid * 16) = r[b];
}
template <int MODE> DEV void hyena_conv_rows(const LAS unsigned char* lds, int slot0, float w0, float w1, float w2, float bs, cf (&z)[2][8], const cf (&y)[2][8], float hb, int tid) {
#pragma unroll
    for (int b = 0; b < 4; ++b) {
        const LAS bf16_t* row = (const LAS bf16_t*)(lds + (slot0 + b) * 8192);
#pragma unroll
        for (int i = 0; i < 8; ++i) {
            const int t = tid + 512 * i, par = tid & 1, d0 = (tid >> 1) + par;
            const LAS unsigned* rw = (const LAS unsigned*)row + d0;
            const unsigned dw0 = (i == 0) ? rw[d0 > 0 ? -1 : 0] : rw[256 * i - 1], dw1 = rw[256 * i];
            float um = par ? U2F(dw0 << 16) : U2F(dw0 & 0xffff0000u);
            const float u0 = par ? U2F(dw0 & 0xffff0000u) : U2F(dw1 << 16);
            float up = par ? U2F(dw1 << 16) : U2F(dw1 & 0xffff0000u);
            um = (t > 0) ? um : 0.f; up = (t < 4095) ? up : 0.f;
            const float r = um * w0 + u0 * w1 + up * w2 + bs;
            if (MODE == 0) { if (b & 1) z[b >> 1][i].y = r; else z[b >> 1][i].x = r; }
            else { if (b & 1) z[b >> 1][i].y = r * (y[b >> 1][i].y + hb * z[b >> 1][i].y); else z[b >> 1][i].x = r * (y[b >> 1][i].x + hb * z[b >> 1][i].x); }
        }
    }
}
#ifndef HY_ABL
#define HY_ABL 0
#endif
DEV void hyena_conv_head(LAS cf* buf0, LAS cf* buf1, const unsigned* Kp, const cf (&z)[2][8], int tid, bool abl) {
    const bool skip_all = abl && HY_ABL == 1, nosync = abl && HY_ABL == 2, nok = abl && HY_ABL == 3, skip1 = (abl && HY_ABL == 4) || skip_all, skip2 = (abl && HY_ABL == 5) || skip_all, skipm = (abl && HY_ABL == 6) || skip_all;
    if (!skip1) fft_f1x2(buf0, buf1, z[0], z[1], tid);
    if (!nosync && !skip_all) SYNC();
    if (!skip2) fft_f2((tid >> 8) ? buf1 : buf0, tid & 255);
    if (!nosync && !skip_all) SYNC();
    if (!skipm) { if (nok) { fft_mid<false>(buf0, Kp, tid); fft_mid<false>(buf1, Kp, tid); } else fft_midx2(buf0, buf1, Kp, tid); }
    if (!nosync && !skip_all) SYNC();
    if (!skip2) fft_i2((tid >> 8) ? buf1 : buf0, tid & 255);
    if (!nosync && !skip_all) SYNC();
}
DEV void hyena_units(int c0, int cstride, const bf16_t* UT, bf16_t* YHT, const unsigned* KF, const float* convw  , const float* convb  , const float* hyb  , LAS unsigned char* lds, int tid, bool abl = false) {
    if (c0 >= 1024) return;
    LAS cf* buf0 = (LAS cf*)lds; LAS cf* buf1 = buf0 + FPAD;
    u32x4 r[4];
    hyena_issue_rows(UT, 0, c0, r, tid);
#pragma unroll 1
    for (int c = c0; c < 1024; c += cstride) {
        OPAQUE_I(tid);
        cf z[2][8], y[2][8];
        hyena_commit_rows(lds, r, tid);
        SYNC();
        hyena_conv_rows<0>(lds, 0, convw[c], convw[3072 + c], convw[6144 + c], convb[c], z, y, 0.f, tid);
        SYNC();
#pragma unroll 1
        for (int o = 0; o < 2; ++o) {
            hyena_conv_head(buf0, buf1, KF + ((size_t)c * 2 + o) * 8192, z, tid, abl);
            hyena_issue_rows(UT, 1 + o, c, r, tid);
            if (abl && (HY_ABL == 1 || HY_ABL == 4)) {
#pragma unroll
                for (int i = 0; i < 8; ++i) { y[0][i] = z[0][i]; y[1][i] = z[1][i]; }
            } else fft_i1x2(buf0, buf1, y[0], y[1], tid);
            SYNC();
            hyena_commit_rows(lds, r, tid);
            if (o == 1 && c + cstride < 1024) hyena_issue_rows(UT, 0, c + cstride, r, tid);
            SYNC();
            const int col = (1 + o) * 1024 + c;
            hyena_conv_rows<1>(lds, 0, convw[col], convw[3072 + col], convw[6144 + col], convb[col], z, y, hyb[o * 1024 + c], tid);
            SYNC();
        }
#pragma unroll
        for (int p = 0; p < 2; ++p)
#pragma unroll
            for (int i = 0; i < 8; ++i) {
                const int t = tid + 512 * i;
                YHT[((size_t)((2 * p) * 1024 + c)) * 4096 + t] = f2bf(z[p][i].x);
                YHT[((size_t)((2 * p + 1) * 1024 + c)) * 4096 + t] = f2bf(z[p][i].y);
            }
    }
}
DEV void hyena_unit(int c, const bf16_t* UT, bf16_t* YHT, const unsigned* KF, const float* convw, const float* convb, const float* hyb, LAS unsigned char* lds, int tid) {
    hyena_units(c, 1024, UT, YHT, KF, convw, convb, hyb, lds, tid);
}

DEV void attn_bias_table(LAS float* tab, const float* rel_bias, int tid) {
    for (int idx = tid; idx < 24 * 129; idx += NTHR) {
        const int gh = idx / 129, jj = idx % 129, g = gh >> 3, dil = 1 << (2 * g);
        const int rel = (jj - 64) * dil, n = rel < 0 ? -rel : rel;
        int bk = (rel > 0) ? 16 : 0;
        if (n < 8) bk += n;
        else bk += 8 + (n >= 15) + (n >= 27) + (n >= 50) + (n >= 91) + (n >= 166) + (n >= 305) + (n >= 559);
        tab[idx] = rel_bias[bk * 24 + gh] * 1.4426950408889634f;
    }
}
DEV void attn_tile(int tile, const bf16_t* QKG, const bf16_t* VT, bf16_t* OG, float* LSE, const LAS float* tab, int lane) {
    const int b = tile / (24 * 64), rem = tile % (24 * 64), gh = rem >> 6, tau = rem & 63, g = gh >> 3, h = gh & 7;
    const int dsh = 2 * g, Mg = 4096 >> dsh, ntm = Mg >> 6, r = tau / ntm, m0 = (tau % ntm) * 64;
    const int n = lane & 31, hl = lane >> 5;
    const size_t rowbase = (size_t)b * 4096;
    const int colq = g * 512 + h * 64;
    const float SC = 0.125f * 1.4426950408889634f;
    bf16x8 qf[2][4];
#pragma unroll
    for (int qb = 0; qb < 2; ++qb) {
        const int t = ((m0 + 32 * qb + n) << dsh) + r;
        const bf16_t* p = QKG + (rowbase + t) * 7168 + colq + 8 * hl;
#pragma unroll
        for (int ks = 0; ks < 4; ++ks) qf[qb][ks] = *(const bf16x8*)(p + 16 * ks);
    }
    f32x16 oacc[2][2];
#pragma unroll
    for (int a = 0; a < 2; ++a)
#pragma unroll
        for (int c2 = 0; c2 < 2; ++c2)
#pragma unroll
            for (int i = 0; i < 16; ++i) oacc[a][c2][i] = 0.f;
    float mrun[2] = {-1e30f, -1e30f}, lrun[2] = {0.f, 0.f};
    for (int kbi = 0; kbi < 3; ++kbi) {
        const int kb = (kbi == 0) ? 1 : (kbi == 1 ? 0 : 2);
        const int mk0 = m0 - 64 + 64 * kb;
        if (mk0 < 0 || mk0 >= Mg) continue;
        f32x16 s[2][2];
#pragma unroll
        for (int sb = 0; sb < 2; ++sb) {
            const int t = ((mk0 + 32 * sb + n) << dsh) + r;
            const bf16_t* p = QKG + (rowbase + t) * 7168 + 1536 + colq + 8 * hl;
            bf16x8 kf[4];
#pragma unroll
            for (int ks = 0; ks < 4; ++ks) kf[ks] = *(const bf16x8*)(p + 16 * ks);
#pragma unroll
            for (int qb = 0; qb < 2; ++qb) {
                f32x16 a;
#pragma unroll
                for (int i = 0; i < 16; ++i) a[i] = 0.f;
#pragma unroll
                for (int ks = 0; ks < 4; ++ks) a = MFMA32(kf[ks], qf[qb][ks], a);
                s[sb][qb] = a;
            }
        }
#pragma unroll
        for (int qb = 0; qb < 2; ++qb) {
            const int qq = 32 * qb + n;
            float mx = -1e30f;
#pragma unroll
            for (int sb = 0; sb < 2; ++sb)
#pragma unroll
                for (int rg = 0; rg < 16; ++rg) {
                    const int kk = 32 * sb + (rg & 3) + 8 * (rg >> 2) + 4 * hl;
                    const int jj = 64 * kb + kk - qq;
                    const bool ok = (unsigned)jj <= 128u;
                    const float bia = tab[gh * 129 + (ok ? jj : 0)];
                    const float v = ok ? s[sb][qb][rg] * SC + bia : -1e30f;
                    s[sb][qb][rg] = v; mx = fmaxf(mx, v);
                }
            mx = fmaxf(mx, SHFL_XOR3(mx, 32, lane));
            const float mnew = fmaxf(mrun[qb], mx);
            const float alpha = EXP2(mrun[qb] - mnew);
            float rs = 0.f;
#pragma unroll
            for (int sb = 0; sb < 2; ++sb)
#pragma unroll
                for (int rg = 0; rg < 16; ++rg) { const float p = EXP2(s[sb][qb][rg] - mnew); s[sb][qb][rg] = p; rs += p; }
            rs += SHFL_XOR3(rs, 32, lane);
            lrun[qb] = lrun[qb] * alpha + rs; mrun[qb] = mnew;
#pragma unroll
            for (int eb = 0; eb < 2; ++eb)
#pragma unroll
                for (int i = 0; i < 16; ++i) oacc[eb][qb][i] *= alpha;
        }
#pragma unroll
        for (int sb = 0; sb < 2; ++sb)
#pragma unroll
            for (int s2 = 0; s2 < 2; ++s2) {
                bf16x8 pf[2];
#pragma unroll
                for (int qb = 0; qb < 2; ++qb) {
                    u32x4 w;
                    w.x = pk2(s[sb][qb][8 * s2 + 0], s[sb][qb][8 * s2 + 1]); w.y = pk2(s[sb][qb][8 * s2 + 2], s[sb][qb][8 * s2 + 3]);
                    w.z = pk2(s[sb][qb][8 * s2 + 4], s[sb][qb][8 * s2 + 5]); w.w = pk2(s[sb][qb][8 * s2 + 6], s[sb][qb][8 * s2 + 7]);
                    pf[qb] = BITCAST(bf16x8, w);
                }
#pragma unroll
                for (int eb = 0; eb < 2; ++eb) {
                    const int e = 32 * eb + n;
                    const bf16_t* vp = VT + ((size_t)(b * 1536 + colq + e)) * 4096 + r * Mg + mk0 + 32 * sb + 16 * s2 + 4 * hl;
                    const u32x2 lo = *(const u32x2*)vp, hi = *(const u32x2*)(vp + 8);
                    u32x4 w; w.x = lo.x; w.y = lo.y; w.z = hi.x; w.w = hi.y;
                    const bf16x8 vf = BITCAST(bf16x8, w);
#pragma unroll
                    for (int qb = 0; qb < 2; ++qb) oacc[eb][qb] = MFMA32(vf, pf[qb], oacc[eb][qb]);
                }
            }
    }
#pragma unroll
    for (int qb = 0; qb < 2; ++qb) {
        const float inv = 1.0f / lrun[qb];
        const int t = ((m0 + 32 * qb + n) << dsh) + r;
        bf16_t* op = OG + (rowbase + t) * 1536 + colq;
#pragma unroll
        for (int eb = 0; eb < 2; ++eb)
#pragma unroll
            for (int gq = 0; gq < 4; ++gq) {
                u32x2 w; w.x = pk2(oacc[eb][qb][4 * gq] * inv, oacc[eb][qb][4 * gq + 1] * inv); w.y = pk2(oacc[eb][qb][4 * gq + 2] * inv, oacc[eb][qb][4 * gq + 3] * inv);
                *(u32x2*)(op + 32 * eb + 8 * gq + 4 * hl) = w;
            }
        if (hl == 0) LSE[(rowbase + t) * 24 + gh] = mrun[qb] + LOG2(lrun[qb]);
    }
}
constexpr int AT_KP = 144, AT_VP = 776;
constexpr int AT_K_OFF = 0, AT_V_OFF = 384 * AT_KP, AT_TAB_OFF = AT_V_OFF + 64 * AT_VP;
struct AttnU { int b, gh, g, dsh, Mg, r, mu0, colq; };
DEV AttnU attn_decode(int unit) {
    AttnU a; a.b = unit / 384; const int rem = unit % 384; a.gh = rem >> 4; const int uu = rem & 15; a.g = a.gh >> 3;
    a.dsh = 2 * a.g; a.Mg = 4096 >> a.dsh; const int upc = a.Mg >> 8; a.r = uu / upc; a.mu0 = (uu % upc) * 256; a.colq = a.g * 512 + (a.gh & 7) * 64;
    return a;
}
DEV void attn_issue(const AttnU& a, const bf16_t* QKG, const bf16_t* VT, u32x4 (&kr)[6], u32x4 (&vr)[6], int tid) {
    const size_t rowbase = (size_t)a.b * 4096;
#pragma unroll
    for (int i = 0; i < 6; ++i) {
        const int idx = tid + 512 * i, row = idx >> 3, ch = idx & 7, m = a.mu0 - 64 + row;
        kr[i] = (u32x4){0u, 0u, 0u, 0u};
        if (m >= 0 && m < a.Mg) kr[i] = *(const u32x4*)(QKG + (rowbase + (size_t)((m << a.dsh) + a.r)) * 7168 + 1536 + a.colq + 8 * ch);
    }
#pragma unroll
    for (int i = 0; i < 6; ++i) {
        const int idx = tid + 512 * i, e = idx / 48, ch = idx % 48, m = a.mu0 - 64 + 8 * ch;
        vr[i] = (u32x4){0u, 0u, 0u, 0u};
        if (m >= 0 && m < a.Mg) vr[i] = *(const u32x4*)(VT + ((size_t)(a.b * 1536 + a.colq + e)) * 4096 + a.r * a.Mg + m);
    }
}
DEV void attn_commit(LAS unsigned char* lds, const u32x4 (&kr)[6], const u32x4 (&vr)[6], int tid) {
#pragma unroll
    for (int i = 0; i < 6; ++i) { const int idx = tid + 512 * i, row = idx >> 3, ch = idx & 7; *(LAS u32x4*)(lds + AT_K_OFF + row * AT_KP + ch * 16) = kr[i]; }
#pragma unroll
    for (int i = 0; i < 6; ++i) { const int idx = tid + 512 * i, e = idx / 48, ch = idx % 48;
        LAS u32x2* d = (LAS u32x2*)(lds + AT_V_OFF + e * AT_VP + ch * 16);
        d[0] = (u32x2){vr[i].x, vr[i].y}; d[1] = (u32x2){vr[i].z, vr[i].w}; }
}
DEV void attn_compute(const AttnU& a, const bf16x8 (&qf)[4], int tq, bf16_t* OG, float* LSE, LAS unsigned char* lds, int tid) {
    const int lane = tid & 63, wave = tid >> 6, n = lane & 31, hl = lane >> 5;
    const size_t rowbase = (size_t)a.b * 4096;
    const LAS float* tab = (const LAS float*)(lds + AT_TAB_OFF) + a.gh * 129;
    const float SC = 0.125f * 1.4426950408889634f;
    f32x16 s[5];
    bool vb[5];
    float mx = -1e30f;
#pragma unroll
    for (int sb = 0; sb < 5; ++sb) {
        const int sbk = wave + sb, mb = a.mu0 - 64 + 32 * sbk;
        vb[sb] = (mb >= 0) && (mb < a.Mg);
        f32x16 acc;
#pragma unroll
        for (int i = 0; i < 16; ++i) acc[i] = 0.f;
        if (vb[sb]) {
            const LAS unsigned char* kp = lds + AT_K_OFF + (32 * sbk + n) * AT_KP + 16 * hl;
#pragma unroll
            for (int ks = 0; ks < 4; ++ks) { const bf16x8 kf = *(const LAS bf16x8*)(kp + 32 * ks); acc = MFMA32(kf, qf[ks], acc); }
        }
#pragma unroll
        for (int rg = 0; rg < 16; ++rg) {
            const int jj = 32 * sb + (rg & 3) + 8 * (rg >> 2) + 4 * hl - n;
            const bool ok = vb[sb] && ((unsigned)jj <= 128u);
            const float bia = tab[ok ? jj : 0];
            const float v = ok ? acc[rg] * SC + bia : -1e30f;
            acc[rg] = v; mx = fmaxf(mx, v);
        }
        s[sb] = acc;
    }
    mx = fmaxf(mx, SHFL_XOR3(mx, 32, lane));
    float rs = 0.f;
#pragma unroll
    for (int sb = 0; sb < 5; ++sb)
#pragma unroll
        for (int rg = 0; rg < 16; ++rg) { const float p = EXP2(s[sb][rg] - mx); s[sb][rg] = p; rs += p; }
    rs += SHFL_XOR3(rs, 32, lane);
    f32x16 oacc[2];
#pragma unroll
    for (int eb = 0; eb < 2; ++eb)
#pragma unroll
        for (int i = 0; i < 16; ++i) oacc[eb][i] = 0.f;
#pragma unroll
    for (int sb = 0; sb < 5; ++sb) {
        if (!vb[sb]) continue;
#pragma unroll
        for (int s2 = 0; s2 < 2; ++s2) {
            u32x4 w;
            w.x = pk2(s[sb][8 * s2 + 0], s[sb][8 * s2 + 1]); w.y = pk2(s[sb][8 * s2 + 2], s[sb][8 * s2 + 3]);
            w.z = pk2(s[sb][8 * s2 + 4], s[sb][8 * s2 + 5]); w.w = pk2(s[sb][8 * s2 + 6], s[sb][8 * s2 + 7]);
            const bf16x8 pf = BITCAST(bf16x8, w);
#pragma unroll
            for (int eb = 0; eb < 2; ++eb) {
                const LAS unsigned char* vp = lds + AT_V_OFF + (32 * eb + n) * AT_VP + (32 * (wave + sb) + 16 * s2 + 4 * hl) * 2;
                const u32x2 lo = *(const LAS u32x2*)vp, hi = *(const LAS u32x2*)(vp + 16);
                u32x4 wv; wv.x = lo.x; wv.y = lo.y; wv.z = hi.x; wv.w = hi.y;
                oacc[eb] = MFMA32(BITCAST(bf16x8, wv), pf, oacc[eb]);
            }
        }
    }
    const float inv = 1.0f / rs;
    bf16_t* op = OG + (rowbase + tq) * 1536 + a.colq;
#pragma unroll
    for (int eb = 0; eb < 2; ++eb)
#pragma unroll
        for (int gq = 0; gq < 4; ++gq) {
            u32x2 w; w.x = pk2(oacc[eb][4 * gq] * inv, oacc[eb][4 * gq + 1] * inv); w.y = pk2(oacc[eb][4 * gq + 2] * inv, oacc[eb][4 * gq + 3] * inv);
            *(u32x2*)(op + 32 * eb + 8 * gq + 4 * hl) = w;
        }
    if (hl == 0) LSE[(rowbase + tq) * 24 + a.gh] = mx + LOG2(rs);
}
DEV void attn_units(int u0, int ustride, int nunits, const bf16_t* QKG, const bf16_t* VT, bf16_t* OG, float* LSE, LAS unsigned char* lds, int tid) {
    if (u0 >= nunits) return;
    u32x4 kr[6], vr[6];
    { const AttnU a0 = attn_decode(u0); attn_issue(a0, QKG, VT, kr, vr, tid); }
#pragma unroll 1
    for (int u = u0; u < nunits; u += ustride) {
        OPAQUE_I(tid);
        const AttnU a = attn_decode(u);
        const int lane = tid & 63, wave = tid >> 6, n = lane & 31, hl = lane >> 5;
        SYNC();
        attn_commit(lds, kr, vr, tid);
        bf16x8 qf[4];
        const int tq = ((a.mu0 + 32 * wave + n) << a.dsh) + a.r;
        {
            const bf16_t* p = QKG + ((size_t)a.b * 4096 + tq) * 7168 + a.colq + 8 * hl;
#pragma unroll
            for (int ks = 0; ks < 4; ++ks) qf[ks] = *(const bf16x8*)(p + 16 * ks);
        }
        SYNC();
        if (u + ustride < nunits) { const AttnU an = attn_decode(u + ustride); attn_issue(an, QKG, VT, kr, vr, tid); }
        attn_compute(a, qf, tq, OG, LSE, lds, tid);
    }
}
DEV void attn_unit(int unit, const bf16_t* QKG, const bf16_t* VT, bf16_t* OG, float* LSE, LAS unsigned char* lds, int tid) {
    attn_units(unit, 1 << 20, unit + 1, QKG, VT, OG, LSE, lds, tid);
}
DEV void attn_combine_item(int item, const bf16_t* OG, const float* LSE, bf16_t* YA, int pitch = 512, int coloff = 0) {
    const int row = item >> 6, h = (item >> 3) & 7, e8 = item & 7;
    const float l0 = LSE[row * 24 + h], l1 = LSE[row * 24 + 8 + h], l2 = LSE[row * 24 + 16 + h];
    const float mx = fmaxf(l0, fmaxf(l1, l2));
    float w0 = EXP2(l0 - mx), w1 = EXP2(l1 - mx), w2 = EXP2(l2 - mx);
    const float inv = 1.0f / (w0 + w1 + w2); w0 *= inv; w1 *= inv; w2 *= inv;
    const bf16_t* p = OG + (size_t)row * 1536 + h * 64 + e8 * 8;
    const u32x4 a = *(const u32x4*)p, b = *(const u32x4*)(p + 512), c = *(const u32x4*)(p + 1024);
    u32x4 o;
#pragma unroll
    for (int i = 0; i < 4; ++i) {
        const float lo = w0 * U2F(a[i] << 16) + w1 * U2F(b[i] << 16) + w2 * U2F(c[i] << 16);
        const float hi = w0 * U2F(a[i] & 0xffff0000u) + w1 * U2F(b[i] & 0xffff0000u) + w2 * U2F(c[i] & 0xffff0000u);
        o[i] = pk2(lo, hi);
    }
    *(u32x4*)(YA + (size_t)row * pitch + coloff + h * 64 + e8 * 8) = o;
}

namespace pg8 {
#define PG8_LAS __attribute__((address_space(3)))
typedef unsigned short bf16_t;
typedef short bf16x8 __attribute__((ext_vector_type(8)));
typedef float f32x4 __attribute__((ext_vector_type(4)));
typedef unsigned u32x4 __attribute__((ext_vector_type(4)));
constexpr int BM = 256, BK = 64, HALF = 128, HTB = HALF * BK * 2  , STAGE_BYTES = 8 * HTB, NXCD = 8, WGM = 8;

__host__ __device__ __forceinline__ int lds_byte(int r, int c) { const int st = (r >> 4) * 2 + (c >> 5), rr = r & 15, cc = c & 31, ob = rr * 64 + cc * 2; return st * 1024 + (ob ^ (((ob >> 9) & 1) << 5)); }
__host__ __device__ __forceinline__ void stage_rc(int b, int& R, int& C) { const int st = b / 1024, sb = b % 1024, swz = sb ^ (((sb >> 9) & 1) << 5); R = (st >> 1) * 16 + swz / 64; C = (st & 1) * 32 + (swz % 64) / 2; }
__host__ __device__ __forceinline__ int perm32(int rho) { const int n = rho >> 4, i = rho & 15; return 8 * (i >> 2) + 4 * n + (i & 3); }

struct Unit { int pm, pn; };
struct Gemm { const bf16_t* A; const bf16_t* Bt; int M, N, K; };

struct StaticOrder {
    int nM, nN, nwg, G, c;
    __host__ __device__ void init(int M, int N, int G_, int c_) { nM = M / BM; nN = N / BM; nwg = nM * nN; G = G_; c = c_; }
    __host__ __device__ bool next(int i, Unit& u) const {
        const long L = (long)i * G + c; if (L >= nwg) return false;
        int wgid = (int)L; { const int q = nwg / NXCD, r = nwg % NXCD, xcd = wgid % NXCD, off = wgid / NXCD; wgid = (xcd < r ? xcd * (q + 1) : r * (q + 1) + (xcd - r) * q) + off; }
        const int nig = WGM * nN, gid = wgid / nig, fm = gid * WGM, gsz = (nM - fm) < WGM ? (nM - fm) : WGM;
        u.pm = fm + ((wgid % nig) % gsz); u.pn = (wgid % nig) / gsz; return true;
    }
    __device__ __forceinline__ void a_ready(const Unit&) const {}
    __device__ __forceinline__ void done(const Unit&) const {}
};

__device__ __forceinline__ unsigned cvt_pk_bf16(float lo, float hi) { unsigned r; asm volatile("v_cvt_pk_bf16_f32 %0, %1, %2" : "=v"(r) : "v"(lo), "v"(hi)); return r; }
constexpr int EPI_LDS_OFF = 139264 + 1024;
template <int MODE> __device__ __forceinline__ int perm_row(int R) {
    if (MODE == 0) return R;
    if (MODE == 1) return (R & ~31) + perm32(R & 31);
    const int wcp = R >> 5, n = (R >> 4) & 1, fq = (R >> 2) & 3, e = R & 3;
    if (MODE == 2) return fq + 4 * (8 * wcp + 4 * n + e);
    return (4 * wcp + fq) + 16 * (4 * n + e);
}
__device__ __forceinline__ float sigmoid_f(float x) { return __builtin_amdgcn_rcpf(1.0f + __builtin_amdgcn_exp2f(-1.4426950408889634f * x)); }
__device__ __forceinline__ float bflo(unsigned w) { return __uint_as_float(w << 16); }
__device__ __forceinline__ float bfhi(unsigned w) { return __uint_as_float(w & 0xffff0000u); }
template <int VM> struct EpiG1a {
    static constexpr bool PERM = true, AFTER_DRAIN = false; static constexpr int PMODE = 1 + VM, KSPLIT = 0; static constexpr bool PREF = false;
    bf16_t* UT; bf16_t* VT;
    __device__ __forceinline__ void operator()(const f32x4 (&acc)[2][2][4][2], const Unit& u, int wr, int wc, int fr, int fq) const {
        const int row0 = u.pm * BM + wr * 64 + fr;
        const int T0 = u.pn * BM, bseq = T0 >> 12, t0 = T0 & 4095;
#pragma unroll
        for (int ai = 0; ai < 2; ++ai)
#pragma unroll
            for (int m = 0; m < 4; ++m) {
                const int nn = row0 + ai * HALF + m * 16;
#pragma unroll
                for (int bj = 0; bj < 2; ++bj) {
                    const f32x4 v0 = acc[ai][bj][m][0], v1 = acc[ai][bj][m][1];
                    u32x4 w; w.x = cvt_pk_bf16(v0[0], v0[1]); w.y = cvt_pk_bf16(v0[2], v0[3]); w.z = cvt_pk_bf16(v1[0], v1[1]); w.w = cvt_pk_bf16(v1[2], v1[3]);
                    const int th = t0 + bj * HALF;
                    if (VM == 0) {
                        const int t = th + wc * 32 + 8 * fq;
                        if (u.pm < 12) *(u32x4*)(UT + ((size_t)(bseq * 3072 + nn)) * 4096 + t) = w;
                        else *(u32x4*)(VT + ((size_t)(bseq * 1536 + (nn - 3072))) * 4096 + t) = w;
                    } else if (VM == 1) {
                        *(u32x4*)(VT + ((size_t)(bseq * 1536 + 512 + nn)) * 4096 + fq * 1024 + (th >> 2) + 8 * wc) = w;
                    } else {
                        *(u32x4*)(VT + ((size_t)(bseq * 1536 + 1024 + nn)) * 4096 + (4 * wc + fq) * 256 + (th >> 4)) = w;
                    }
                }
            }
    }
};
struct EpiG1b {
    static constexpr bool PERM = true, AFTER_DRAIN = false; static constexpr int PMODE = 1, KSPLIT = 0; static constexpr bool PREF = true;
    bf16_t* O; const float* bgate;
    __device__ __forceinline__ void prefetch(const Unit& u, int buf, PG8_LAS unsigned char* lds, int wid, int lane) const {
        if (u.pn >= 12 && wid == 0) __builtin_amdgcn_global_load_lds((const unsigned*)(bgate + (lane >> 5) * 2048 + (u.pn - 12) * 128 + (lane & 31) * 4), (PG8_LAS unsigned*)(lds + EPI_LDS_OFF + buf * 2048), 16, 0, 0);
    }
    __device__ __forceinline__ void run(const f32x4 (&acc)[2][2][4][2], const Unit& u, int wr, int wc, int fr, int fq, PG8_LAS unsigned char* lds, int buf) const {
        const int row0 = u.pm * BM + wr * 64 + fr, col0 = u.pn * BM + wc * 32 + 8 * fq; const bool gate = u.pn >= 12;
        const PG8_LAS float* bl = (const PG8_LAS float*)(lds + EPI_LDS_OFF + buf * 2048) + wc * 32 + 8 * fq;
        f32x4 bv[2][2];
#pragma unroll
        for (int bj = 0; bj < 2; ++bj)
#pragma unroll
            for (int n = 0; n < 2; ++n) bv[bj][n] = gate ? *(const PG8_LAS f32x4*)(bl + bj * HALF + 4 * n) : (f32x4){0.f, 0.f, 0.f, 0.f};
#pragma unroll
        for (int ai = 0; ai < 2; ++ai)
#pragma unroll
            for (int m = 0; m < 4; ++m) { bf16_t* rowp = O + (size_t)(row0 + ai * HALF + m * 16) * 7168 + col0;
                {
                    f32x4 h0 = acc[ai][0][m][0] + bv[0][0], h1 = acc[ai][0][m][1] + bv[0][1], a0 = acc[ai][1][m][0] + bv[1][0], a1 = acc[ai][1][m][1] + bv[1][1];
                    if (gate) {
#pragma unroll
                        for (int j = 0; j < 4; ++j) { a0[j] = sigmoid_f(a0[j]); a1[j] = sigmoid_f(a1[j]);
                            h0[j] = sigmoid_f(h0[j]) * __builtin_amdgcn_rcpf(fmaxf(a0[j], 1e-30f)); h1[j] = sigmoid_f(h1[j]) * __builtin_amdgcn_rcpf(fmaxf(a1[j], 1e-30f)); } }
                    u32x4 w; w.x = cvt_pk_bf16(h0[0], h0[1]); w.y = cvt_pk_bf16(h0[2], h0[3]); w.z = cvt_pk_bf16(h1[0], h1[1]); w.w = cvt_pk_bf16(h1[2], h1[3]);
                    *(u32x4*)(rowp) = w;
                    w.x = cvt_pk_bf16(a0[0], a0[1]); w.y = cvt_pk_bf16(a0[2], a0[3]); w.z = cvt_pk_bf16(a1[0], a1[1]); w.w = cvt_pk_bf16(a1[2], a1[3]);
                    *(u32x4*)(rowp + HALF) = w; } }
    }
};
template <bool ADD> struct EpiG2 {
    static constexpr bool PERM = true, AFTER_DRAIN = false; static constexpr int PMODE = 1, KSPLIT = 0; static constexpr bool PREF = false;
    const bf16_t* QKG; bf16_t* MB; int goff;
    __device__ __forceinline__ void operator()(const f32x4 (&acc)[2][2][4][2], const Unit& u, int wr, int wc, int fr, int fq) const {
        const int row0 = u.pm * BM + wr * 64 + fr, col0 = u.pn * BM + wc * 32 + 8 * fq;
#pragma unroll
        for (int ai = 0; ai < 2; ++ai) {
            u32x4 gtv[4][2], mbv[4][2];
#pragma unroll
            for (int m = 0; m < 4; ++m) { const size_t row = (size_t)(row0 + ai * HALF + m * 16);
#pragma unroll
                for (int bj = 0; bj < 2; ++bj) { const int col = col0 + bj * HALF;
                    gtv[m][bj] = *(const u32x4*)(QKG + row * 7168 + goff + col);
                    if (ADD) mbv[m][bj] = *(const u32x4*)(MB + row * 2048 + col); } }
#pragma unroll
            for (int m = 0; m < 4; ++m) { const size_t row = (size_t)(row0 + ai * HALF + m * 16);
#pragma unroll
                for (int bj = 0; bj < 2; ++bj) { const int col = col0 + bj * HALF;
                    const u32x4 gt = gtv[m][bj];
                    f32x4 v0 = acc[ai][bj][m][0], v1 = acc[ai][bj][m][1];
                    v0[0] *= bflo(gt.x); v0[1] *= bfhi(gt.x); v0[2] *= bflo(gt.y); v0[3] *= bfhi(gt.y); v1[0] *= bflo(gt.z); v1[1] *= bfhi(gt.z); v1[2] *= bflo(gt.w); v1[3] *= bfhi(gt.w);
                    if (ADD) { const u32x4 mb = mbv[m][bj];
                        v0[0] += bflo(mb.x); v0[1] += bfhi(mb.x); v0[2] += bflo(mb.y); v0[3] += bfhi(mb.y); v1[0] += bflo(mb.z); v1[1] += bfhi(mb.z); v1[2] += bflo(mb.w); v1[3] += bfhi(mb.w); }
                    u32x4 w; w.x = cvt_pk_bf16(v0[0], v0[1]); w.y = cvt_pk_bf16(v0[2], v0[3]); w.z = cvt_pk_bf16(v1[0], v1[1]); w.w = cvt_pk_bf16(v1[2], v1[3]);
                    *(u32x4*)(MB + row * 2048 + col) = w; } }
        }
    }
};
struct EpiRes {
    static constexpr bool PERM = false, AFTER_DRAIN = false; static constexpr int PMODE = 0, KSPLIT = 0; static constexpr bool PREF = false;
    const float* xold; float* xnew; const float* gate;
    __device__ __forceinline__ void operator()(const f32x4 (&acc)[2][2][4][2], const Unit& u, int wr, int wc, int fr, int fq) const {
        const int row0 = u.pm * BM + wr * 64 + fr, col0 = u.pn * BM + wc * 32 + 4 * fq;
        const float* gp = gate + (size_t)(u.pm >> 4) * 12288 + col0;
        f32x4 gv[2][2];
#pragma unroll
        for (int bj = 0; bj < 2; ++bj)
#pragma unroll
            for (int n = 0; n < 2; ++n) gv[bj][n] = *(const f32x4*)(gp + bj * HALF + n * 16);
#pragma unroll
        for (int ai = 0; ai < 2; ++ai) {
            f32x4 xo[4][2][2];
#pragma unroll
            for (int m = 0; m < 4; ++m) { const size_t off = (size_t)(row0 + ai * HALF + m * 16) * 2048 + col0;
#pragma unroll
                for (int bj = 0; bj < 2; ++bj)
#pragma unroll
                    for (int n = 0; n < 2; ++n) xo[m][bj][n] = *(const f32x4*)(xold + off + bj * HALF + n * 16); }
#pragma unroll
            for (int m = 0; m < 4; ++m) { const size_t off = (size_t)(row0 + ai * HALF + m * 16) * 2048 + col0;
#pragma unroll
                for (int bj = 0; bj < 2; ++bj)
#pragma unroll
                    for (int n = 0; n < 2; ++n) *(f32x4*)(xnew + off + bj * HALF + n * 16) = xo[m][bj][n] + gv[bj][n] * acc[ai][bj][m][n]; }
        }
    }
};
template <bool F32IN> struct EpiResB {
    static constexpr bool PERM = true, AFTER_DRAIN = false; static constexpr int PMODE = 1, KSPLIT = 0; static constexpr bool PREF = false;
    const float* xin; const bf16_t* xold; bf16_t* xnew; const float* gate;
    __device__ __forceinline__ void operator()(const f32x4 (&acc)[2][2][4][2], const Unit& u, int wr, int wc, int fr, int fq) const {
        const int row0 = u.pm * BM + wr * 64 + fr, col0 = u.pn * BM + wc * 32 + 8 * fq;
        const float* gp = gate + (size_t)(u.pm >> 4) * 12288 + col0;
        f32x4 gv[2][2];
#pragma unroll
        for (int bj = 0; bj < 2; ++bj)
#pragma unroll
            for (int n = 0; n < 2; ++n) gv[bj][n] = *(const f32x4*)(gp + bj * HALF + n * 4);
        if constexpr (F32IN) {
#pragma unroll
            for (int ai = 0; ai < 2; ++ai) {
                f32x4 xo[4][2][2];
#pragma unroll
                for (int m = 0; m < 4; ++m) { const size_t off = (size_t)(row0 + ai * HALF + m * 16) * 2048 + col0;
#pragma unroll
                    for (int bj = 0; bj < 2; ++bj)
#pragma unroll
                        for (int n = 0; n < 2; ++n) xo[m][bj][n] = *(const f32x4*)(xin + off + bj * HALF + n * 4); }
#pragma unroll
                for (int m = 0; m < 4; ++m) { const size_t off = (size_t)(row0 + ai * HALF + m * 16) * 2048 + col0;
#pragma unroll
                    for (int bj = 0; bj < 2; ++bj) { const f32x4 v0 = xo[m][bj][0] + gv[bj][0] * acc[ai][bj][m][0], v1 = xo[m][bj][1] + gv[bj][1] * acc[ai][bj][m][1];
                        u32x4 w; w.x = pkh2(v0[0], v0[1]); w.y = pkh2(v0[2], v0[3]); w.z = pkh2(v1[0], v1[1]); w.w = pkh2(v1[2], v1[3]);
                        *(u32x4*)(xnew + off + bj * HALF) = w; } }
            }
        } else {
            u32x4 xo[2][4][2];
#pragma unroll
            for (int ai = 0; ai < 2; ++ai)
#pragma unroll
                for (int m = 0; m < 4; ++m) { const size_t off = (size_t)(row0 + ai * HALF + m * 16) * 2048 + col0;
#pragma unroll
                    for (int bj = 0; bj < 2; ++bj) xo[ai][m][bj] = *(const u32x4*)(xold + off + bj * HALF); }
#pragma unroll
            for (int ai = 0; ai < 2; ++ai)
#pragma unroll
                for (int m = 0; m < 4; ++m) { const size_t off = (size_t)(row0 + ai * HALF + m * 16) * 2048 + col0;
#pragma unroll
                    for (int bj = 0; bj < 2; ++bj) { const u32x4 o = xo[ai][m][bj]; const f32x4 a0 = acc[ai][bj][m][0], a1 = acc[ai][bj][m][1], g0 = gv[bj][0], g1 = gv[bj][1];
                        u32x4 w;
                        w.x = pkh2(hlo(o.x) + g0[0] * a0[0], hhi(o.x) + g0[1] * a0[1]); w.y = pkh2(hlo(o.y) + g0[2] * a0[2], hhi(o.y) + g0[3] * a0[3]);
                        w.z = pkh2(hlo(o.z) + g1[0] * a1[0], hhi(o.z) + g1[1] * a1[1]); w.w = pkh2(hlo(o.w) + g1[2] * a1[2], hhi(o.w) + g1[3] * a1[3]);
                        *(u32x4*)(xnew + off + bj * HALF) = w; } }
        }
    }
};
struct EpiPlain {
    static constexpr bool PERM = true, AFTER_DRAIN = false; static constexpr int PMODE = 1, KSPLIT = 0; static constexpr bool PREF = false;
    bf16_t* O; int ldc;
    __device__ __forceinline__ void operator()(const f32x4 (&acc)[2][2][4][2], const Unit& u, int wr, int wc, int fr, int fq) const {
        const int row0 = u.pm * BM + wr * 64 + fr, col0 = u.pn * BM + wc * 32 + 8 * fq;
#pragma unroll
        for (int ai = 0; ai < 2; ++ai)
#pragma unroll
            for (int m = 0; m < 4; ++m) { bf16_t* rowp = O + (size_t)(row0 + ai * HALF + m * 16) * ldc + col0;
#pragma unroll
                for (int bj = 0; bj < 2; ++bj) { const f32x4 v0 = acc[ai][bj][m][0], v1 = acc[ai][bj][m][1];
                    u32x4 w; w.x = cvt_pk_bf16(v0[0], v0[1]); w.y = cvt_pk_bf16(v0[2], v0[3]); w.z = cvt_pk_bf16(v1[0], v1[1]); w.w = cvt_pk_bf16(v1[2], v1[3]);
                    *(u32x4*)(rowp + bj * HALF) = w; } }
    }
};

struct EpiUpCG {
    static constexpr bool PERM = true, AFTER_DRAIN = false; static constexpr int PMODE = 1, KSPLIT = 0; static constexpr bool PREF = true;
    bf16_t* ACT; bf16_t* GB; const float* cw; const float* cb;
    __device__ __forceinline__ void prefetch(const Unit& u, int buf, PG8_LAS unsigned char* lds, int wid, int lane) const {
        if (wid < 2) { const int v = 2 * wid + (lane >> 5);
            const float* src = (v < 3 ? cw + v * 5632 : cb) + u.pn * 128 + (lane & 31) * 4;
            __builtin_amdgcn_global_load_lds((const unsigned*)src, (PG8_LAS unsigned*)(lds + EPI_LDS_OFF + buf * 2048 + wid * 1024), 16, 0, 0); }
    }
    __device__ __forceinline__ void run(const f32x4 (&acc)[2][2][4][2], const Unit& u, int wr, int wc, int fr, int fq, PG8_LAS unsigned char* lds, int buf) const {
        const int row0 = u.pm * BM + wr * 64 + fr, ch0 = u.pn * 128 + wc * 32 + 8 * fq;
        const PG8_LAS float* vl = (const PG8_LAS float*)(lds + EPI_LDS_OFF + buf * 2048) + wc * 32 + 8 * fq;
        const int lane = fq * 16 + fr, lup = (lane & 48) | ((lane - 1) & 15), ldn = (lane & 48) | ((lane + 1) & 15);
        f32x4 w0[2], w1[2], w2[2], bb[2];
#pragma unroll
        for (int n = 0; n < 2; ++n) { w0[n] = *(const PG8_LAS f32x4*)(vl + 4 * n); w1[n] = *(const PG8_LAS f32x4*)(vl + 128 + 4 * n); w2[n] = *(const PG8_LAS f32x4*)(vl + 256 + 4 * n); bb[n] = *(const PG8_LAS f32x4*)(vl + 384 + 4 * n); }
#pragma unroll
        for (int ai = 0; ai < 2; ++ai) {
            unsigned op[4][2][2];
#pragma unroll
            for (int n = 0; n < 2; ++n)
#pragma unroll
                for (int ep = 0; ep < 2; ++ep) {
                    float ov[4][2];
#pragma unroll
                    for (int eh = 0; eh < 2; ++eh) { const int e = 2 * ep + eh;
                        float R[4], L[4];
#pragma unroll
                        for (int m = 0; m < 4; ++m) { R[m] = shfl_from(acc[ai][1][m][n][e], lup); L[m] = shfl_from(acc[ai][1][m][n][e], ldn); }
#pragma unroll
                        for (int m = 0; m < 4; ++m) {
                            const float up = (fr == 0) ? R[m > 0 ? m - 1 : 0] : R[m];
                            const float dn = (fr == 15) ? L[m < 3 ? m + 1 : 3] : L[m];
                            const float x = up * w0[n][e] + acc[ai][1][m][n][e] * w1[n][e] + dn * w2[n][e] + bb[n][e];
                            const float s = x * sigmoid_f(x);
                            const bool edge = (m == 0 && fr == 0) || (m == 3 && fr == 15);
                            ov[m][eh] = edge ? acc[ai][0][m][n][e] : s * acc[ai][0][m][n][e];
                        } }
#pragma unroll
                    for (int m = 0; m < 4; ++m) op[m][n][ep] = cvt_pk_bf16(ov[m][0], ov[m][1]);
                    __builtin_amdgcn_sched_barrier(0);
                }
#pragma unroll
            for (int m = 0; m < 4; ++m) {
                u32x4 w; w.x = op[m][0][0]; w.y = op[m][0][1]; w.z = op[m][1][0]; w.w = op[m][1][1];
                *(u32x4*)(ACT + (size_t)(row0 + ai * HALF + m * 16) * 5632 + ch0) = w;
            }
            const int grp = u.pm * 4 + ai * 2 + wr;
            if (fr <= 1) { const f32x4 g0 = acc[ai][1][0][0], g1 = acc[ai][1][0][1];
                u32x4 w; w.x = cvt_pk_bf16(g0[0], g0[1]); w.y = cvt_pk_bf16(g0[2], g0[3]); w.z = cvt_pk_bf16(g1[0], g1[1]); w.w = cvt_pk_bf16(g1[2], g1[3]);
                *(u32x4*)(GB + ((size_t)(grp * 4 + fr)) * 5632 + ch0) = w; }
            if (fr >= 14) { const f32x4 g0 = acc[ai][1][3][0], g1 = acc[ai][1][3][1];
                u32x4 w; w.x = cvt_pk_bf16(g0[0], g0[1]); w.y = cvt_pk_bf16(g0[2], g0[3]); w.z = cvt_pk_bf16(g1[0], g1[1]); w.w = cvt_pk_bf16(g1[2], g1[3]);
                *(u32x4*)(GB + ((size_t)(grp * 4 + fr - 12)) * 5632 + ch0) = w; }
        }
    }
};

struct EpiG2M {
    static constexpr bool PERM = true, AFTER_DRAIN = false; static constexpr int PMODE = 1, KSPLIT = 1024; static constexpr bool PREF = false;
    const bf16_t* QKG; bf16_t* MB;
    __device__ __forceinline__ void midk(f32x4 (&acc)[2][2][4][2], const Unit& u, int wr, int wc, int fr, int fq) const {
        asm volatile("" : "+v"(fr), "+v"(fq));
        scale<0>(acc, u, wr, wc, fr, fq);
    }
    template <int WHICH> __device__ __forceinline__ void scale(f32x4 (&acc)[2][2][4][2], const Unit& u, int wr, int wc, int fr, int fq) const {
        const int row0 = u.pm * BM + wr * 64 + fr, gcol = 3072 + u.pn * 512 + WHICH * 128 + wc * 32 + 8 * fq;
        u32x4 g[2][4][2];
#pragma unroll
        for (int ai = 0; ai < 2; ++ai)
#pragma unroll
            for (int m = 0; m < 4; ++m)
#pragma unroll
                for (int bj = 0; bj < 2; ++bj) g[ai][m][bj] = *(const u32x4*)(QKG + (size_t)(row0 + ai * HALF + m * 16) * 7168 + gcol + bj * 256);
#pragma unroll
        for (int ai = 0; ai < 2; ++ai)
#pragma unroll
            for (int m = 0; m < 4; ++m)
#pragma unroll
                for (int bj = 0; bj < 2; ++bj) {
                    const unsigned gw[4] = {g[ai][m][bj].x, g[ai][m][bj].y, g[ai][m][bj].z, g[ai][m][bj].w};
#pragma unroll
                    for (int j = 0; j < 4; ++j) { acc[ai][bj][m][j >> 1][(2 * j) & 3] *= bflo(gw[j]); acc[ai][bj][m][j >> 1][(2 * j + 1) & 3] *= bfhi(gw[j]); }
                }
    }
    __device__ __forceinline__ void operator()(f32x4 (&acc)[2][2][4][2], const Unit& u, int wr, int wc, int fr, int fq) const {
        scale<1>(acc, u, wr, wc, fr, fq);
        const int row0 = u.pm * BM + wr * 64 + fr, col0 = u.pn * BM + wc * 32 + 8 * fq;
#pragma unroll
        for (int ai = 0; ai < 2; ++ai)
#pragma unroll
            for (int m = 0; m < 4; ++m)
#pragma unroll
                for (int bj = 0; bj < 2; ++bj) { const f32x4 v0 = acc[ai][bj][m][0], v1 = acc[ai][bj][m][1];
                    u32x4 w; w.x = cvt_pk_bf16(v0[0], v0[1]); w.y = cvt_pk_bf16(v0[2], v0[3]); w.z = cvt_pk_bf16(v1[0], v1[1]); w.w = cvt_pk_bf16(v1[2], v1[3]);
                    *(u32x4*)(MB + (size_t)(row0 + ai * HALF + m * 16) * 2048 + col0 + bj * HALF) = w; }
    }
};
template <class Epi, class Sched, bool ALIGN_EPI = false, bool SP2 = false>
__device__ __forceinline__ void gemm_phase(PG8_LAS unsigned char* lds, const Gemm g, const Sched& S, const Epi& E, const int tid_in) {
    int tid_l = tid_in; asm volatile("" : "+v"(tid_l));
    const int tid = tid_l, wid = __builtin_amdgcn_readfirstlane(tid >> 6), lane = tid & 63, wr = wid >> 2, wc = wid & 3, fr = lane & 15, fq = lane >> 4;
    const int K = g.K, nt = K / BK;
    unsigned voffA[2], voffB[2];
#pragma unroll
    for (int i = 0; i < 2; ++i) { int R, C; stage_rc(tid * 16 + i * 8192, R, C); const int Rb = perm_row<Epi::PMODE>(R);
        voffA[i] = (unsigned)(R * K + C) * 2u; voffB[i] = (unsigned)(Rb * K + C) * 2u; }
    const size_t kstep = (size_t)(BK * 2);
    const size_t hstep = (size_t)HALF * K * 2;
    const size_t tstep = 2 * hstep;
    const unsigned ldsw = (unsigned)wid * 1024u;
    const int aoff = lds_byte(wr * 64 + fr, fq * 8), boff = lds_byte(wc * 32 + fr, fq * 8);
#define PG8_SA(b, h) (((b) * 2 + (h)) * HTB)
#define PG8_SB(b, h) ((4 + (b) * 2 + (h)) * HTB)
#define PG8_STAGE(bufoff, gbase, voff) do { _Pragma("unroll") for (int _i = 0; _i < 2; ++_i) \
        __builtin_amdgcn_global_load_lds((const unsigned*)((const char*)(gbase) + (voff)[_i]), (PG8_LAS unsigned*)(lds + (bufoff) + ldsw + _i * 8192), 16, 0, 0); } while (0)
#define PG8_LDA(dst, b, h) do { _Pragma("unroll") for (int m = 0; m < 4; ++m) _Pragma("unroll") for (int k = 0; k < 2; ++k) dst[m][k] = *(const PG8_LAS bf16x8*)(lds + PG8_SA(b, h) + aoff + m * 2048 + k * 1024); } while (0)
#define PG8_LDB(dst, b, h) do { _Pragma("unroll") for (int n = 0; n < 2; ++n) _Pragma("unroll") for (int k = 0; k < 2; ++k) dst[n][k] = *(const PG8_LAS bf16x8*)(lds + PG8_SB(b, h) + boff + n * 2048 + k * 1024); } while (0)
#define PG8_MMA(ai, bj, At, Bt) do { __builtin_amdgcn_s_setprio(1); _Pragma("unroll") for (int m = 0; m < 4; ++m) _Pragma("unroll") for (int n = 0; n < 2; ++n) _Pragma("unroll") for (int k = 0; k < 2; ++k) \
        acc[ai][bj][m][n] = __builtin_amdgcn_mfma_f32_16x16x32_bf16(Bt[n][k], At[m][k], acc[ai][bj][m][n], 0, 0, 0); __builtin_amdgcn_s_setprio(0); } while (0)
#define PG8_WAIT_V(n) asm volatile("s_waitcnt vmcnt(" #n ")" ::: "memory")
#define PG8_WAIT_L(n) asm volatile("s_waitcnt lgkmcnt(" #n ")" ::: "memory")
#define PG8_BAR __builtin_amdgcn_s_barrier()
#define PG8_SCHED __builtin_amdgcn_sched_barrier(0)
    Unit cur, nxt; int ui = 0;
    if (!S.next(0, cur)) return;
    f32x4 acc[2][2][4][2];
#pragma unroll
    for (int a = 0; a < 2; ++a)
#pragma unroll
        for (int b = 0; b < 2; ++b)
#pragma unroll
            for (int m = 0; m < 4; ++m)
#pragma unroll
                for (int n = 0; n < 2; ++n) acc[a][b][m][n] = (f32x4){0.f, 0.f, 0.f, 0.f};
    bf16x8 At[4][2], B0[2][2], B1[2][2];
    const char* cA = (const char*)g.A + (size_t)cur.pm * tstep; const char* cB = (const char*)g.Bt + (size_t)cur.pn * tstep;
    S.a_ready(cur);
    if constexpr (Epi::PREF) E.prefetch(cur, 0, lds, wid, lane);
    if constexpr (SP2) {
        PG8_STAGE(PG8_SB(0, 0), cB, voffB); PG8_STAGE(PG8_SB(0, 1), cB + hstep, voffB); PG8_STAGE(PG8_SA(0, 0), cA, voffA); PG8_STAGE(PG8_SA(0, 1), cA + hstep, voffA);
        if (wr == 1) PG8_BAR;
        PG8_WAIT_V(2); PG8_BAR;
        PG8_STAGE(PG8_SB(1, 0), cB + kstep, voffB); PG8_STAGE(PG8_SA(1, 0), cA + kstep, voffA); PG8_STAGE(PG8_SB(1, 1), cB + hstep + kstep, voffB);
        PG8_WAIT_V(6); PG8_BAR;
    } else {
        PG8_STAGE(PG8_SB(0, 0), cB, voffB); PG8_STAGE(PG8_SA(0, 0), cA, voffA); PG8_STAGE(PG8_SB(0, 1), cB + hstep, voffB); PG8_STAGE(PG8_SA(0, 1), cA + hstep, voffA);
        if (wr == 1) PG8_BAR;
        PG8_WAIT_V(4); PG8_BAR;
        PG8_STAGE(PG8_SB(1, 0), cB + kstep, voffB); PG8_STAGE(PG8_SA(1, 0), cA + kstep, voffA); PG8_STAGE(PG8_SB(1, 1), cB + hstep + kstep, voffB);
        PG8_WAIT_V(6); PG8_BAR;
    }
    for (;;) {
        const bool has_next = S.next(ui + 1, nxt);
        const char* nA = has_next ? (const char*)g.A + (size_t)nxt.pm * tstep : cA; const char* nB = has_next ? (const char*)g.Bt + (size_t)nxt.pn * tstep : cB;
        for (int t = 0; t < nt; t += 2) {
            if constexpr (Epi::KSPLIT > 0) { if (t == Epi::KSPLIT / BK) E.midk(acc, cur, wr, wc, fr, fq); }
            const bool last = (t == nt - 2);
            const char* a1 = cA + (size_t)(t + 1) * kstep;
            const char* a2 = last ? nA : cA + (size_t)(t + 2) * kstep; const char* b2 = last ? nB : cB + (size_t)(t + 2) * kstep;
            const char* a3 = a2 + kstep; const char* b3 = b2 + kstep;
            if (last && has_next) S.a_ready(nxt);
            if constexpr (SP2) {
            PG8_LDB(B0, 0, 0); PG8_LDB(B1, 0, 1); PG8_SCHED; PG8_LDA(At, 0, 0); PG8_STAGE(PG8_SA(1, 1), a1 + hstep, voffA);
            PG8_WAIT_V(8); PG8_WAIT_L(0); PG8_BAR; PG8_MMA(0, 0, At, B0); PG8_MMA(0, 1, At, B1); PG8_BAR; PG8_SCHED;
            PG8_LDA(At, 0, 1); PG8_STAGE(PG8_SB(0, 0), b2, voffB); PG8_STAGE(PG8_SB(0, 1), b2 + hstep, voffB); PG8_STAGE(PG8_SA(0, 0), a2, voffA);
            PG8_WAIT_V(8); PG8_WAIT_L(0); PG8_BAR; PG8_MMA(1, 0, At, B0); PG8_MMA(1, 1, At, B1); PG8_BAR; PG8_SCHED;
            PG8_LDB(B0, 1, 0); PG8_LDB(B1, 1, 1); PG8_SCHED; PG8_LDA(At, 1, 0); PG8_STAGE(PG8_SA(0, 1), a2 + hstep, voffA);
            PG8_WAIT_V(8); PG8_WAIT_L(0); PG8_BAR; PG8_MMA(0, 0, At, B0); PG8_MMA(0, 1, At, B1); PG8_BAR; PG8_SCHED;
            PG8_LDA(At, 1, 1); PG8_STAGE(PG8_SB(1, 0), b3, voffB); PG8_STAGE(PG8_SB(1, 1), b3 + hstep, voffB); PG8_STAGE(PG8_SA(1, 0), a3, voffA);
            PG8_WAIT_V(8); PG8_WAIT_L(0); PG8_BAR; PG8_MMA(1, 0, At, B0); PG8_MMA(1, 1, At, B1); PG8_BAR; PG8_SCHED;
            } else {
            PG8_LDB(B0, 0, 0); PG8_SCHED; PG8_LDA(At, 0, 0); PG8_STAGE(PG8_SA(1, 1), a1 + hstep, voffA);
            PG8_WAIT_L(8); PG8_BAR; PG8_WAIT_L(0); PG8_MMA(0, 0, At, B0); PG8_BAR; PG8_SCHED;
            PG8_LDB(B1, 0, 1); PG8_STAGE(PG8_SB(0, 0), b2, voffB);
            PG8_BAR; PG8_WAIT_L(0); PG8_MMA(0, 1, At, B1); PG8_BAR;
            PG8_LDA(At, 0, 1); PG8_STAGE(PG8_SA(0, 0), a2, voffA);
            PG8_BAR; PG8_WAIT_L(0); PG8_MMA(1, 0, At, B0); PG8_BAR; PG8_SCHED;
            PG8_STAGE(PG8_SB(0, 1), b2 + hstep, voffB);
            PG8_WAIT_V(6); PG8_BAR; PG8_MMA(1, 1, At, B1); PG8_BAR;
            PG8_LDB(B0, 1, 0); PG8_SCHED; PG8_LDA(At, 1, 0); PG8_STAGE(PG8_SA(0, 1), a2 + hstep, voffA);
            PG8_WAIT_L(8); PG8_BAR; PG8_WAIT_L(0); PG8_MMA(0, 0, At, B0); PG8_BAR; PG8_SCHED;
            PG8_LDB(B1, 1, 1); PG8_STAGE(PG8_SB(1, 0), b3, voffB);
            PG8_BAR; PG8_WAIT_L(0); PG8_MMA(0, 1, At, B1); PG8_BAR;
            PG8_LDA(At, 1, 1); PG8_STAGE(PG8_SA(1, 0), a3, voffA);
            PG8_BAR; PG8_WAIT_L(0); PG8_MMA(1, 0, At, B0); PG8_BAR; PG8_SCHED;
            PG8_STAGE(PG8_SB(1, 1), b3 + hstep, voffB);
            PG8_WAIT_V(6); PG8_BAR; PG8_MMA(1, 1, At, B1); PG8_BAR;
            }
        }
        if constexpr (ALIGN_EPI) { if (wr == 0) PG8_BAR; }
        if constexpr (Epi::PREF) { if (has_next) E.prefetch(nxt, (ui + 1) & 1, lds, wid, lane); E.run(acc, cur, wr, wc, fr, fq, lds, ui & 1); S.done(cur); }
        else if constexpr (!Epi::AFTER_DRAIN) { E(acc, cur, wr, wc, fr, fq); S.done(cur); }
        if (!has_next) break;
#pragma unroll
        for (int a = 0; a < 2; ++a)
#pragma unroll
            for (int b = 0; b < 2; ++b)
#pragma unroll
                for (int m = 0; m < 4; ++m)
#pragma unroll
                    for (int n = 0; n < 2; ++n) acc[a][b][m][n] = (f32x4){0.f, 0.f, 0.f, 0.f};
        cur = nxt; cA = nA; cB = nB; ++ui;
        if constexpr (ALIGN_EPI) { if (wr == 1) PG8_BAR; }
    }
    PG8_WAIT_V(0);
    if constexpr (!ALIGN_EPI) { if (wr == 0) PG8_BAR; }
    PG8_BAR;
    if constexpr (Epi::AFTER_DRAIN) { E.fused(acc, cur, wr, wc, fr, fq, lds, wid, lane); S.done(cur); }
#undef PG8_SA
#undef PG8_SB
#undef PG8_STAGE
#undef PG8_LDA
#undef PG8_LDB
#undef PG8_MMA
#undef PG8_WAIT_V
#undef PG8_WAIT_L
#undef PG8_BAR
#undef PG8_SCHED
}
}

#define XB_TMO      128
#define XB_XCNT(j)  (256  + 64 * (j))
#define XB_XSUB(j)  (1280 + 64 * (j))
#define XB_XGEN(j)  (2304 + 64 * (j))
#define XB_TOP      3328
#define XB_TOPGEN   3392
#define XCD_BAR_WORDS 3456
#define XB_SPIN_CAP (1u << 18)

__device__ __forceinline__ unsigned xb_ld(unsigned* p)              { return __hip_atomic_load(p, __ATOMIC_RELAXED, __HIP_MEMORY_SCOPE_AGENT); }
__device__ __forceinline__ unsigned xb_add(unsigned* p, unsigned v) { return __hip_atomic_fetch_add(p, v, __ATOMIC_RELAXED, __HIP_MEMORY_SCOPE_AGENT); }
__device__ __forceinline__ unsigned xb_xcc_id() { return (unsigned)__builtin_amdgcn_s_getreg((3 << 11) | 20) & 0xFu; }
#define XB_SPIN(cond, bar) do { unsigned _sp = 0; while (cond) { __builtin_amdgcn_s_sleep(1); \
    if ((++_sp & 255u) == 0u) { if (xb_ld(&(bar)[XB_TMO])) break; if (_sp > XB_SPIN_CAP) { atomicAdd(&(bar)[XB_TMO], 1u); break; } } } } while (0)

struct XcdBarrier {
    unsigned* bar; unsigned x;
    volatile LAS unsigned* st;
};

__device__ __forceinline__ XcdBarrier xcd_barrier_post(unsigned* bar, volatile LAS unsigned* st) {
    XcdBarrier b; b.bar = bar; b.x = xb_xcc_id(); b.st = st;
    if (threadIdx.x == 0) (void)xb_add(&bar[XB_XCNT(b.x)], 1u);
    return b;
}
__device__ __forceinline__ void xcd_barrier_complete(unsigned* bar, unsigned x, unsigned& nloc, unsigned& nx) {
    const unsigned G = gridDim.x * gridDim.y * gridDim.z;
    unsigned sum, cnt, mine, sp = 0u;
    for (;;) {
        sum = 0u; cnt = 0u; mine = 0u;
#pragma unroll
        for (unsigned j = 0; j < 16; ++j) { const unsigned c = xb_ld(&bar[XB_XCNT(j)]); sum += c; cnt += (c > 0u) ? 1u : 0u; mine = (j == x) ? c : mine; }
        if (sum == G) break;
        __builtin_amdgcn_s_sleep(1);
        if ((++sp & 255u) == 0u) { if (xb_ld(&bar[XB_TMO])) break; if (sp > XB_SPIN_CAP) { atomicAdd(&bar[XB_TMO], 1u); break; } }
    }
    nloc = mine > 0u ? mine : 1u; nx = cnt > 0u ? cnt : 1u;
}

__device__ __forceinline__ void xcd_barrier(const XcdBarrier& b, const bool leader) {
    asm volatile("s_waitcnt vmcnt(0)" ::: "memory");
    __syncthreads();
    if (leader) {
        unsigned* bar = b.bar;
        __builtin_amdgcn_s_waitcnt(0);
        unsigned nloc = b.st[0], nx = b.st[1];
        if (nloc == 0u) { xcd_barrier_complete(bar, b.x, nloc, nx); b.st[0] = nloc; b.st[1] = nx; }
        const unsigned old = xb_add(&bar[XB_XSUB(b.x)], 1u);
        const unsigned gen = old / nloc;
        if (old + 1u == (gen + 1u) * nloc) {
            __builtin_amdgcn_fence(__ATOMIC_RELEASE, "agent");
            asm volatile("s_waitcnt vmcnt(0)" ::: "memory");
            const unsigned og = xb_add(&bar[XB_TOP], 1u);
            const unsigned tg = og / nx;
            if (og + 1u == (tg + 1u) * nx) xb_add(&bar[XB_TOPGEN], 1u);
            else XB_SPIN(xb_ld(&bar[XB_TOPGEN]) == tg, bar);
            __builtin_amdgcn_fence(__ATOMIC_ACQUIRE, "agent");
            xb_add(&bar[XB_XGEN(b.x)], 1u);
            asm volatile("s_waitcnt vmcnt(0)" ::: "memory");
        } else {
            XB_SPIN(xb_ld(&bar[XB_XGEN(b.x)]) == gen, bar);
            __builtin_amdgcn_fence(__ATOMIC_ACQUIRE, "agent");
            asm volatile("s_waitcnt vmcnt(0)" ::: "memory");
        }
    }
    __syncthreads();
}


constexpr size_t MiB = 1u << 20;
constexpr size_t WS_CTL = 0, CTL_ZERO_BYTES = 1 * MiB;
constexpr size_t WS_MOD = 1 * MiB;
constexpr size_t WS_H2F = 4 * MiB;
constexpr size_t WS_KF = 8 * MiB;
constexpr size_t WS_WIN = 136 * MiB;
constexpr size_t WS_WUP = 320 * MiB;
constexpr size_t WS_WDN = 496 * MiB;
constexpr size_t WS_WOUT = 584 * MiB;
constexpr size_t WS_WBH = 616 * MiB;
constexpr size_t WS_HB = 640 * MiB;
constexpr size_t WS_YHT = 704 * MiB;
constexpr size_t WS_YH = 736 * MiB;
constexpr size_t WS_MB = 784 * MiB;
constexpr size_t WS_ACT = 1522 * MiB;
constexpr size_t WS_UT = 848 * MiB;
constexpr size_t WS_VT = 944 * MiB;
constexpr size_t WS_QKG = 992 * MiB;
constexpr size_t WS_OG = 1216 * MiB;
constexpr size_t WS_LSE = 1264 * MiB;
constexpr size_t WS_GB = 848 * MiB;
constexpr size_t WS_HB2 = 1266 * MiB;
constexpr size_t WS_XB = 1330 * MiB;
constexpr size_t WS_END = 1698 * MiB;
constexpr int CW_BAR = 4096;
constexpr int LDS_BYTES = 147456, MISC_OFF = 139264; static_assert(pg8::EPI_LDS_OFF == MISC_OFF + 1024 && pg8::EPI_LDS_OFF + 4096 <= LDS_BYTES, "epilogue vector buffers");
constexpr int N_PHASES = 1 + DEPTH_ * 2 + 1 + DEPTH_ * NCHUNK * 8 + 1 + 1;

#ifndef PG8_ALIGN
#define PG8_ALIGN true
#endif
struct Args { const float* in[29]; float* out; unsigned char* ws; int ph_lo, ph_hi; };

using pg8::bflo; using pg8::bfhi;
__device__ __forceinline__ float wave_sum(float v, int lane) {
#pragma unroll
    for (int o = 1; o < 64; o <<= 1) v += shfl_from(v, lane ^ o);
    return v;
}
__device__ __forceinline__ void transpose_item(const float* W, int K, int N, bf16_t* WT, int k0, int n0, int drow0, LAS float* scr, int lane) {
#pragma unroll 8
    for (int i = 0; i < 32; ++i) { const int kk = 2 * i + (lane >> 5); scr[kk * 33 + (lane & 31)] = W[(size_t)(k0 + kk) * N + n0 + (lane & 31)]; }
    asm volatile("s_waitcnt lgkmcnt(0)" ::: "memory");
    const int c = lane & 7;
#pragma unroll
    for (int j = 0; j < 4; ++j) { const int n = (lane >> 3) + 8 * j; const LAS float* s = scr + (8 * c) * 33 + n;
        u32x4 o; o.x = pk2(s[0 * 33], s[1 * 33]); o.y = pk2(s[2 * 33], s[3 * 33]); o.z = pk2(s[4 * 33], s[5 * 33]); o.w = pk2(s[6 * 33], s[7 * 33]);
        *(u32x4*)(WT + (size_t)(drow0 + n) * K + k0 + 8 * c) = o; }
    asm volatile("s_waitcnt lgkmcnt(0)" ::: "memory");
}
__device__ __forceinline__ int win_dest_row(int n0) {
    if (n0 < 3072) return n0;
    if (n0 < 4608) return n0 + 1536;
    if (n0 < 6144) return n0 + 1536;
    if (n0 < 7680) return n0 - 3072;
    const int g = n0 - 7680, c = g & 2047;
    return 7680 + (c >> 7) * 256 + (g >> 11) * 128 + (c & 127);
}
__device__ __forceinline__ int wup_dest_row(int n0) {
    const int j = (n0 < 5632) ? n0 : n0 - 5632; return (j >> 7) * 256 + ((n0 < 5632) ? 0 : 128) + (j & 127);
}
__device__ __forceinline__ void prologue_phase(const __attribute__((address_space(4))) Args* Ap, LAS unsigned char* lds, int vcu, int G, int tid) {
    const int lane = tid & 63, wave = tid >> 6;
    unsigned char* ws = Ap->ws;
    {
        LAS float* scr = (LAS float*)(lds + wave * 16384);
        const int gw = vcu * 8 + wave, NGW = G * 8;
        constexpr int I_IN = 32 * 368, I_UP = 32 * 352, I_DN = 88 * 64, I_OUT = 32 * 64, I_BH = 16 * 64, I_BA = 8 * 64, I_L = I_IN + I_UP + I_DN + I_OUT + I_BH + I_BA;
        for (int it = gw; it < DEPTH_ * I_L; it += NGW) {
            const int l = it / I_L; int r = it % I_L;
            if (r < I_IN) { const int kb = r / 368, nb = r % 368; transpose_item(Ap->in[7] + (size_t)l * 2048 * 11776, 2048, 11776, (bf16_t*)(ws + WS_WIN) + (size_t)l * 11776 * 2048, 64 * kb, 32 * nb, win_dest_row(32 * nb), scr, lane); continue; } r -= I_IN;
            if (r < I_UP) { const int kb = r / 352, nb = r % 352; transpose_item(Ap->in[24] + (size_t)l * 2048 * 11264, 2048, 11264, (bf16_t*)(ws + WS_WUP) + (size_t)l * 11264 * 2048, 64 * kb, 32 * nb, wup_dest_row(32 * nb), scr, lane); continue; } r -= I_UP;
            if (r < I_DN) { const int kb = r / 64, nb = r % 64; transpose_item(Ap->in[27] + (size_t)l * 5632 * 2048, 5632, 2048, (bf16_t*)(ws + WS_WDN) + (size_t)l * 2048 * 5632, 64 * kb, 32 * nb, 32 * nb, scr, lane); continue; } r -= I_DN;
            if (r < I_OUT) { const int kb = r / 64, nb = r % 64; transpose_item(Ap->in[22] + (size_t)l * 2048 * 2048, 2048, 2048, (bf16_t*)(ws + WS_WOUT) + (size_t)l * 2048 * 2048, 64 * kb, 32 * nb, 32 * nb, scr, lane); continue; } r -= I_OUT;
            if (r < I_BH) { const int kb = r / 64, nb = r % 64; transpose_item(Ap->in[20] + (size_t)l * 1024 * 2048, 1536, 2048, (bf16_t*)(ws + WS_WBH) + (size_t)l * 2048 * 1536, 64 * kb, 32 * nb, 32 * nb, scr, lane); continue; } r -= I_BH;
            { const int kb = r / 64, nb = r % 64; transpose_item(Ap->in[21] + (size_t)l * 512 * 2048, 1536, 2048, (bf16_t*)(ws + WS_WBH) + (size_t)l * 2048 * 1536 + 1024, 64 * kb, 32 * nb, 32 * nb, scr, lane); }
        }
    }
    __syncthreads();
    {
        LAS float* cs = (LAS float*)lds;
        LAS float* red = (LAS float*)(lds + 98304);
        bool loaded = false;
        for (int unit = vcu; unit < DEPTH_ * 192; unit += G) {
            if (!loaded) {
                for (int i = tid; i < 12 * 2048; i += NTHR) { const int b = i >> 11, k = i & 2047; const float c = (b < 4) ? Ap->in[2][b * 2048 + k] : Ap->in[3][(b - 4) * 2048 + k]; cs[i] = c / (1.0f + __expf(-c)); }
                loaded = true; __syncthreads();
            }
            const int l = unit / 192, j = (unit % 192) * 64 + lane;
            const float* wp = Ap->in[4] + ((size_t)l * 2048 + wave * 256) * 12288 + j;
            float acc[12];
#pragma unroll
            for (int b = 0; b < 12; ++b) acc[b] = 0.f;
#pragma unroll 4
            for (int k = 0; k < 256; ++k) { const float w = wp[(size_t)k * 12288];
#pragma unroll
                for (int b = 0; b < 12; ++b) acc[b] += w * cs[b * 2048 + wave * 256 + k]; }
#pragma unroll
            for (int b = 0; b < 12; ++b) red[(wave * 12 + b) * 64 + lane] = acc[b];
            __syncthreads();
            for (int i = tid; i < 12 * 64; i += NTHR) { const int b = i >> 6, jj = i & 63; float s = 0.f;
#pragma unroll
                for (int w = 0; w < 8; ++w) s += red[(w * 12 + b) * 64 + jj];
                const int col = (unit % 192) * 64 + jj;
                ((float*)(ws + WS_MOD))[((size_t)l * 12 + b) * 12288 + col] = s + Ap->in[5][l * 12288 + col]; }
            __syncthreads();
        }
    }
}
template <bool XBF> __device__ __forceinline__ void norm_phase(const void* xv, bf16_t* hout, const float* gn, const float* modb  , int sh_off, int sc_off, int gw, int NGW, int lane) {
    int curb = -1; f32x4 gs[8], sh[8];
    for (int row = gw; row < MROWS; row += NGW) {
        const int b = row >> 12;
        if (b != curb) { curb = b;
#pragma unroll
            for (int j = 0; j < 8; ++j) { const int col = 4 * lane + 256 * j; const f32x4 g = *(const f32x4*)(gn + col), sc = *(const f32x4*)(modb + (size_t)b * 12288 + sc_off + col);
                gs[j] = g * (sc + 1.0f); sh[j] = *(const f32x4*)(modb + (size_t)b * 12288 + sh_off + col); } }
        f32x4 v[8]; float ss = 0.f;
        if constexpr (XBF) {
            const u32x2* xr = (const u32x2*)((const bf16_t*)xv + (size_t)row * 2048) + lane; u32x2 r[8];
#pragma unroll
            for (int j = 0; j < 8; ++j) r[j] = xr[64 * j];
#pragma unroll
            for (int j = 0; j < 8; ++j) { v[j].x = hlo(r[j].x); v[j].y = hhi(r[j].x); v[j].z = hlo(r[j].y); v[j].w = hhi(r[j].y); }
        } else {
            const f32x4* xr = (const f32x4*)((const float*)xv + (size_t)row * 2048) + lane;
#pragma unroll
            for (int j = 0; j < 8; ++j) v[j] = xr[64 * j];
        }
#pragma unroll
        for (int j = 0; j < 8; ++j) ss += (v[j].x * v[j].x + v[j].y * v[j].y) + (v[j].z * v[j].z + v[j].w * v[j].w);
        const float rstd = 1.0f / sqrtf(wave_sum(ss, lane) * (1.0f / 2048.0f) + 1e-6f);
        u32x2* o8 = (u32x2*)(hout + (size_t)row * 2048) + lane;
#pragma unroll
        for (int j = 0; j < 8; ++j) { const f32x4 y = v[j] * rstd * gs[j] + sh[j]; u32x2 w; w.x = pk2(y.x, y.y); w.y = pk2(y.z, y.w); o8[64 * j] = w; }
    }
}
__device__ __forceinline__ void final_norm_phase(const bf16_t* xb, float* out, const float* gn, int gw, int NGW, int lane) {
    f32x4 gs[8];
#pragma unroll
    for (int j = 0; j < 8; ++j) gs[j] = *(const f32x4*)(gn + 4 * lane + 256 * j);
    for (int row = gw; row < NSEQ * SEQ; row += NGW) {
        const u32x2* xr = (const u32x2*)(xb + (size_t)row * 2048) + lane; u32x2 r[8];
#pragma unroll
        for (int j = 0; j < 8; ++j) r[j] = xr[64 * j];
        f32x4 v[8]; float ss = 0.f;
#pragma unroll
        for (int j = 0; j < 8; ++j) { v[j].x = hlo(r[j].x); v[j].y = hhi(r[j].x); v[j].z = hlo(r[j].y); v[j].w = hhi(r[j].y);
            ss += (v[j].x * v[j].x + v[j].y * v[j].y) + (v[j].z * v[j].z + v[j].w * v[j].w); }
        const float rstd = 1.0f / sqrtf(wave_sum(ss, lane) * (1.0f / 2048.0f) + 1e-6f);
        f32x4* o = (f32x4*)(out + (size_t)row * 2048) + lane;
#pragma unroll
        for (int j = 0; j < 8; ++j) o[64 * j] = v[j] * rstd * gs[j];
    }
}
__device__ __forceinline__ void transpose_yh_tile(int tile, const bf16_t* YHT, bf16_t* YH, LAS bf16_t* scr, int lane) {
    const int b = tile >> 10, ct = (tile >> 6) & 15, tt = tile & 63, c0 = ct * 64, t0 = tt * 64;
#pragma unroll
    for (int i = 0; i < 8; ++i) { const int row = (lane >> 3) + 8 * i, ch = lane & 7;
        const u32x4 v = *(const u32x4*)(YHT + ((size_t)(b * 1024 + c0 + row)) * 4096 + t0 + 8 * ch);
        LAS bf16_t* d = scr + row * 66 + 8 * ch;
        d[0] = (bf16_t)(v.x & 0xffffu); d[1] = (bf16_t)(v.x >> 16); d[2] = (bf16_t)(v.y & 0xffffu); d[3] = (bf16_t)(v.y >> 16);
        d[4] = (bf16_t)(v.z & 0xffffu); d[5] = (bf16_t)(v.z >> 16); d[6] = (bf16_t)(v.w & 0xffffu); d[7] = (bf16_t)(v.w >> 16); }
    asm volatile("s_waitcnt lgkmcnt(0)" ::: "memory");
    bf16_t* orow = YH + ((size_t)(b * 4096 + t0 + lane)) * 1536 + c0;
#pragma unroll
    for (int j = 0; j < 8; ++j) { u32x4 w; unsigned q[4];
#pragma unroll
        for (int e = 0; e < 4; ++e) q[e] = (unsigned)scr[(8 * j + 2 * e) * 66 + lane] | ((unsigned)scr[(8 * j + 2 * e + 1) * 66 + lane] << 16);
        w.x = q[0]; w.y = q[1]; w.z = q[2]; w.w = q[3]; *(u32x4*)(orow + 8 * j) = w; }
    asm volatile("s_waitcnt lgkmcnt(0)" ::: "memory");
}
__device__ __forceinline__ void cg_fix_item(int idx, bf16_t* ACT, const bf16_t* GB, const float* cw, const float* cb) {
    const int col = (idx % 704) * 8, rs = idx / 704, side = rs & 1, grp = rs >> 1, row = grp * 64 + (side ? 63 : 0), t = row & 4095;
    const bf16_t* gb = GB + (size_t)grp * 4 * 5632 + col;
    u32x4 gm = (u32x4){0u, 0u, 0u, 0u}, gp = (u32x4){0u, 0u, 0u, 0u}, g0;
    if (side == 0) { g0 = *(const u32x4*)gb; gp = *(const u32x4*)(gb + 5632); if (t > 0) gm = *(const u32x4*)(gb - 5632); }
    else { gm = *(const u32x4*)(gb + 2 * 5632); g0 = *(const u32x4*)(gb + 3 * 5632); if (t < 4095) gp = *(const u32x4*)(gb + 4 * 5632); }
    bf16_t* ap = ACT + (size_t)row * 5632 + col;
    const u32x4 a = *(const u32x4*)ap;
    const f32x4 w0a = *(const f32x4*)(cw + col), w0b = *(const f32x4*)(cw + col + 4), w1a = *(const f32x4*)(cw + 5632 + col), w1b = *(const f32x4*)(cw + 5632 + col + 4);
    const f32x4 w2a = *(const f32x4*)(cw + 11264 + col), w2b = *(const f32x4*)(cw + 11264 + col + 4), ba = *(const f32x4*)(cb + col), bb = *(const f32x4*)(cb + col + 4);
    float w0[8] = {w0a.x, w0a.y, w0a.z, w0a.w, w0b.x, w0b.y, w0b.z, w0b.w}, w1[8] = {w1a.x, w1a.y, w1a.z, w1a.w, w1b.x, w1b.y, w1b.z, w1b.w};
    float w2[8] = {w2a.x, w2a.y, w2a.z, w2a.w, w2b.x, w2b.y, w2b.z, w2b.w}, bs[8] = {ba.x, ba.y, ba.z, ba.w, bb.x, bb.y, bb.z, bb.w};
    u32x4 o;
#pragma unroll
    for (int i = 0; i < 4; ++i) {
        const float xl = bflo(gm[i]) * w0[2 * i] + bflo(g0[i]) * w1[2 * i] + bflo(gp[i]) * w2[2 * i] + bs[2 * i];
        const float xh = bfhi(gm[i]) * w0[2 * i + 1] + bfhi(g0[i]) * w1[2 * i + 1] + bfhi(gp[i]) * w2[2 * i + 1] + bs[2 * i + 1];
        const float sl = xl / (1.0f + __expf(-xl)), shh = xh / (1.0f + __expf(-xh));
        o[i] = pk2(sl * bflo(a[i]), shh * bfhi(a[i]));
    }
    *(u32x4*)ap = o;
}

typedef const __attribute__((address_space(4))) Args* kargs_t;
__global__ void __launch_bounds__(512, 2) mega_fwd(Args args) {
    extern __shared__ __attribute__((aligned(16))) unsigned char lds_raw[];
    LAS unsigned char* lds = (LAS unsigned char*)lds_raw;
    const int G = gridDim.x, bx = blockIdx.x, vcu = (G % 8 == 0) ? (bx % 8) * (G / 8) + bx / 8 : bx, NGW = G * 8;
    const int lo = args.ph_lo, hi = args.ph_hi;
    const int wave_s = __builtin_amdgcn_readfirstlane(threadIdx.x >> 6);
    {
        volatile LAS unsigned* MISC = (volatile LAS unsigned*)(lds + MISC_OFF);
        for (int u = threadIdx.x; u < (LDS_BYTES - MISC_OFF) / 4; u += NTHR) MISC[u] = 0u;
        __syncthreads();
    }
    XcdBarrier bar; bar.bar = (unsigned*)(args.ws + WS_CTL) + CW_BAR; bar.x = 0; bar.st = nullptr;
    if (hi - lo > 1) bar = xcd_barrier_post((unsigned*)(args.ws + WS_CTL) + CW_BAR, (volatile LAS unsigned*)(lds + MISC_OFF) + 8);
#ifndef NOBAR_PASSES
#define NOBAR_PASSES 0
#endif
    int pc = 0;
#define IS_T0() ({ int t0_; asm volatile("v_mbcnt_lo_u32_b32 %0, -1, 0\n\tv_mbcnt_hi_u32_b32 %0, -1, %0" : "=v"(t0_)); (t0_ | wave_s) == 0; })
#define PH_IN (pc >= lo && pc < hi)
#define PH_CTX int ptid; asm volatile("v_mbcnt_lo_u32_b32 %0, -1, 0\n\tv_mbcnt_hi_u32_b32 %0, -1, %0" : "=v"(ptid)); ptid |= (wave_s << 6); const int plane = ptid & 63, pwave = __builtin_amdgcn_readfirstlane(ptid >> 6), pgw = vcu * 8 + pwave; (void)plane; (void)pgw; \
    kargs_t ap = (kargs_t)__builtin_amdgcn_kernarg_segment_ptr(); asm volatile("" : "+s"(ap)); unsigned char* const pws = ap->ws; (void)pws; int pl = l, pch = ch; asm volatile("" : "+s"(pl), "+s"(pch)); (void)pl; (void)pch;
#ifndef DUP_MASK
#define DUP_MASK 0
#endif
#ifndef DUP_REP
#define DUP_REP 2
#endif
#ifndef DUP_BAR
#define DUP_BAR 0
#endif
#define DUP(bit) for (int rep_ = 0; rep_ < (((DUP_MASK) & (bit)) ? (DUP_REP) : 1); (void)(((DUP_BAR) && ((DUP_MASK) & (bit)) && rep_ + 1 < (DUP_REP)) ? (xcd_barrier(bar, IS_T0()), 0) : 0), ++rep_)
#ifndef BAR_REP
#define BAR_REP 1
#endif
#define PH_END do { if (pc >= lo && pc + 1 < hi && pass_ == (NOBAR_PASSES)) { for (int br_ = 0; br_ < (BAR_REP); ++br_) xcd_barrier(bar, IS_T0()); } ++pc; } while (0)
#define WSP(T, off) ((T*)(pws + (off)))
#define XO_PTR (WSP(bf16_t, WS_XB) + (size_t)pch * MROWS * 2048)
#define XIN0_PTR ((pch == 0) ? ap->in[0] : ap->in[1] + (size_t)(pch - 1) * MROWS * 2048)
#define MODB_PTR (WSP(const float, WS_MOD) + ((size_t)pl * 12 + pch * 4) * 12288)
#define HB_CUR (((pl * NCHUNK + pch) & 1) ? WSP(bf16_t, WS_HB2) : WSP(bf16_t, WS_HB))

    for (int pass_ = 0; pass_ <= (NOBAR_PASSES); ++pass_) {
    pc = 0;
    if (pass_ > 0 && pass_ == (NOBAR_PASSES)) xcd_barrier(bar, IS_T0());
    { const int l = 0, ch = 0; if (PH_IN) DUP(512) { PH_CTX prologue_phase(ap, lds, vcu, G, ptid); __syncthreads(); } }
    PH_END;
    for (int l = 0; l < DEPTH_; ++l) {
        { const int ch = 0;
          if (PH_IN) DUP(1024) { PH_CTX int pvcu = vcu; asm volatile("" : "+s"(pvcu)); for (int u = pvcu; u < 512; u += G) filt_hidden_unit(u, ap->in[11] + pl * 33 * 64, ap->in[12] + pl * 64, ap->in[13] + pl * 64, ap->in[14] + pl * 64 * 64, ap->in[15] + pl * 64, ap->in[16] + pl * 64, WSP(float, WS_H2F), (LAS float*)lds, ptid); }
          PH_END;
          if (PH_IN) DUP(2048) { PH_CTX int pvcu = vcu; asm volatile("" : "+s"(pvcu)); for (int c2 = pvcu; c2 < 512; c2 += G) filt_channel_unit2(2 * c2, WSP(const float, WS_H2F), ap->in[17] + (size_t)pl * 64 * 4096, WSP(unsigned, WS_KF), lds, ptid); }
          PH_END; }
        for (int ch = 0; ch < NCHUNK; ++ch) {
            if (l == 0 && ch == 0) {
                if (PH_IN) { PH_CTX norm_phase<false>(XIN0_PTR, WSP(bf16_t, WS_HB), ap->in[6], MODB_PTR, 0, 2048, pgw, NGW, plane); }
                PH_END;
            }
            if (PH_IN) DUP(2) {
                { PH_CTX const bf16_t* Win = WSP(const bf16_t, WS_WIN) + (size_t)pl * 11776 * 2048;
                  pg8::Gemm g{Win, HB_CUR, 3584, MROWS, 2048}; pg8::StaticOrder S; S.init(3584, MROWS, G, bx); pg8::EpiG1a<0> E{WSP(bf16_t, WS_UT), WSP(bf16_t, WS_VT)};
                  pg8::gemm_phase<pg8::EpiG1a<0>, pg8::StaticOrder, PG8_ALIGN, true>(lds, g, S, E, ptid); }
                { PH_CTX const bf16_t* Win = WSP(const bf16_t, WS_WIN) + (size_t)pl * 11776 * 2048 + (size_t)3584 * 2048;
                  pg8::Gemm g{Win, HB_CUR, 512, MROWS, 2048}; pg8::StaticOrder S; S.init(512, MROWS, G, (bx + G / 2) % G); pg8::EpiG1a<1> E{WSP(bf16_t, WS_UT), WSP(bf16_t, WS_VT)};
                  pg8::gemm_phase<pg8::EpiG1a<1>, pg8::StaticOrder, PG8_ALIGN, true>(lds, g, S, E, ptid); }
                { PH_CTX const bf16_t* Win = WSP(const bf16_t, WS_WIN) + (size_t)pl * 11776 * 2048 + (size_t)4096 * 2048;
                  pg8::Gemm g{Win, HB_CUR, 512, MROWS, 2048}; pg8::StaticOrder S; S.init(512, MROWS, G, bx); pg8::EpiG1a<2> E{WSP(bf16_t, WS_UT), WSP(bf16_t, WS_VT)};
                  pg8::gemm_phase<pg8::EpiG1a<2>, pg8::StaticOrder, PG8_ALIGN, true>(lds, g, S, E, ptid); }
                { PH_CTX const bf16_t* Win = WSP(const bf16_t, WS_WIN) + (size_t)pl * 11776 * 2048;
                  pg8::Gemm g{HB_CUR, Win + (size_t)NA_ * 2048, MROWS, NB_, 2048}; pg8::StaticOrder S; S.init(MROWS, NB_, G, bx); pg8::EpiG1b E{WSP(bf16_t, WS_QKG), ap->in[8] + pl * 4096};
                  pg8::gemm_phase<pg8::EpiG1b, pg8::StaticOrder, PG8_ALIGN, true>(lds, g, S, E, ptid); }
                if (l * NCHUNK + ch + 1 < DEPTH_ * NCHUNK) {
                    PH_CTX
                    const int itn = pl * NCHUNK + pch + 1, ln = itn / NCHUNK, chn = itn % NCHUNK;
                    const bool split = (G == 256);
                    if (!split || bx >= 128) {
                        const int lw = (split ? bx - 128 : bx) * 8 + pwave, nlw = (split ? 128 : G) * 8;
                        bf16_t* hn = (itn & 1) ? WSP(bf16_t, WS_HB2) : WSP(bf16_t, WS_HB); const float* mb = WSP(const float, WS_MOD) + ((size_t)ln * 12 + chn * 4) * 12288;
                        if (ln == 0) norm_phase<false>((chn == 0) ? ap->in[0] : ap->in[1] + (size_t)(chn - 1) * MROWS * 2048, hn, ap->in[6] + ln * 2048, mb, 0, 2048, lw, nlw, plane);
                        else norm_phase<true>(WSP(bf16_t, WS_XB) + (size_t)chn * MROWS * 2048, hn, ap->in[6] + ln * 2048, mb, 0, 2048, lw, nlw, plane);
                    }
                }
            }
            PH_END;
            if (PH_IN) {
                DUP(4) { PH_CTX
                  hyena_units(vcu, G, WSP(const bf16_t, WS_UT), WSP(bf16_t, WS_YHT), WSP(const unsigned, WS_KF), ap->in[9] + pl * 3 * 3072, ap->in[10] + pl * 3072, ap->in[18] + pl * 2048, lds, ptid, rep_ < (DUP_REP) - 1 && ((DUP_MASK) & 4));
                  __syncthreads(); }
                DUP(8) { PH_CTX
                  attn_bias_table((LAS float*)(lds + AT_TAB_OFF), ap->in[19], ptid);
                  attn_units(vcu, G, 4 * 24 * 16, WSP(const bf16_t, WS_QKG), WSP(const bf16_t, WS_VT), WSP(bf16_t, WS_OG), WSP(float, WS_LSE), lds, ptid);
                  __syncthreads(); }
            }
            PH_END;
            if (PH_IN) DUP(16) {
                PH_CTX
                for (int tile = pgw; tile < 4096; tile += NGW) transpose_yh_tile(tile, WSP(const bf16_t, WS_YHT), WSP(bf16_t, WS_YH), (LAS bf16_t*)(lds + pwave * 8448), plane);
                for (int it = bx * NTHR + ptid; it < MROWS * 64; it += G * NTHR) attn_combine_item(it, WSP(const bf16_t, WS_OG), WSP(const float, WS_LSE), WSP(bf16_t, WS_YH), 1536, 1024);
                __syncthreads();
            }
            PH_END;
            if (PH_IN) DUP(32) { PH_CTX pg8::Gemm g{WSP(const bf16_t, WS_YH), WSP(const bf16_t, WS_WBH) + (size_t)pl * 2048 * 1536, MROWS, 2048, 1536}; pg8::StaticOrder S; S.init(MROWS, 2048, G, bx);
                pg8::EpiG2M E{WSP(const bf16_t, WS_QKG), WSP(bf16_t, WS_MB)};
                pg8::gemm_phase<pg8::EpiG2M, pg8::StaticOrder, PG8_ALIGN, true>(lds, g, S, E, ptid); }
            PH_END;
            if (PH_IN) DUP(4096) { PH_CTX pg8::Gemm g{WSP(const bf16_t, WS_MB), WSP(const bf16_t, WS_WOUT) + (size_t)pl * 2048 * 2048, MROWS, 2048, 2048}; pg8::StaticOrder S; S.init(MROWS, 2048, G, bx);
                bf16_t* xn = (((DUP_MASK) & 4096) && rep_ < (DUP_REP) - 1) ? WSP(bf16_t, WS_ACT) : XO_PTR;
                if (pl == 0) { pg8::EpiResB<true> E{XIN0_PTR, nullptr, xn, MODB_PTR + 2 * 2048}; pg8::gemm_phase<pg8::EpiResB<true>, pg8::StaticOrder, PG8_ALIGN, true>(lds, g, S, E, ptid); }
                else { pg8::EpiResB<false> E{nullptr, XO_PTR, xn, MODB_PTR + 2 * 2048}; pg8::gemm_phase<pg8::EpiResB<false>, pg8::StaticOrder, PG8_ALIGN, true>(lds, g, S, E, ptid); } }
            PH_END;
            if (PH_IN) DUP(64) { PH_CTX norm_phase<true>(XO_PTR, HB_CUR, ap->in[23] + pl * 2048, MODB_PTR, 3 * 2048, 4 * 2048, pgw, NGW, plane); }
            PH_END;
            if (PH_IN) DUP(128) { PH_CTX pg8::Gemm g{HB_CUR, WSP(const bf16_t, WS_WUP) + (size_t)pl * 11264 * 2048, MROWS, 11264, 2048}; pg8::StaticOrder S; S.init(MROWS, 11264, G, bx); pg8::EpiUpCG E{WSP(bf16_t, WS_ACT), WSP(bf16_t, WS_GB), ap->in[25] + (size_t)pl * 3 * 5632, ap->in[26] + pl * 5632};
                pg8::gemm_phase<pg8::EpiUpCG, pg8::StaticOrder, PG8_ALIGN, true>(lds, g, S, E, ptid); }
            PH_END;
            if (PH_IN) { PH_CTX for (int it = bx * NTHR + ptid; it < 256 * 2 * 704; it += G * NTHR) cg_fix_item(it, WSP(bf16_t, WS_ACT), WSP(const bf16_t, WS_GB), ap->in[25] + (size_t)pl * 3 * 5632, ap->in[26] + pl * 5632); }
            PH_END;
            if (PH_IN) DUP(8192) { PH_CTX pg8::Gemm g{WSP(const bf16_t, WS_ACT), WSP(const bf16_t, WS_WDN) + (size_t)pl * 2048 * 5632, MROWS, 2048, 5632}; pg8::StaticOrder S; S.init(MROWS, 2048, G, bx);
                pg8::EpiResB<false> E{nullptr, XO_PTR, (((DUP_MASK) & 8192) && rep_ < (DUP_REP) - 1) ? WSP(bf16_t, WS_YHT) : XO_PTR, MODB_PTR + 5 * 2048};
                pg8::gemm_phase<pg8::EpiResB<false>, pg8::StaticOrder, PG8_ALIGN, true>(lds, g, S, E, ptid); }
            if (l == DEPTH_ - 1 && ch == NCHUNK - 1) PH_END;
        }
    }
    { const int l = 0, ch = 0; if (PH_IN) { PH_CTX final_norm_phase(WSP(const bf16_t, WS_XB), ap->out, ap->in[28], pgw, NGW, plane); } }
    PH_END;
    }
#undef PH_IN
#undef PH_CTX
#undef PH_END
#undef DUP
}

#ifndef MK_LAUNCH_PER_PHASE
#define MK_LAUNCH_PER_PHASE 0
#endif
extern "C" void kernel_launch(void* const* d_in, const int* in_sizes, int n_in, void* d_out, int out_size, void* d_ws, size_t ws_size, hipStream_t stream) {
    static int grid = 0;
    if (grid == 0) {
        if (n_in != 29 || out_size != NSEQ * SEQ * 2048 || ws_size < WS_END) { fprintf(stderr, "kernel_launch: unexpected sizes n_in %d out %d ws %zu\n", n_in, out_size, ws_size); grid = -1; return; }
        int dev = 0, cus = 0, per_cu = 0;
        if (hipGetDevice(&dev) != hipSuccess || hipDeviceGetAttribute(&cus, hipDeviceAttributeMultiprocessorCount, dev) != hipSuccess) { grid = -1; return; }
        if (hipFuncSetAttribute((const void*)mega_fwd, hipFuncAttributeMaxDynamicSharedMemorySize, LDS_BYTES) != hipSuccess) { fprintf(stderr, "kernel_launch: hipFuncSetAttribute failed\n"); grid = -1; return; }
        if (hipOccupancyMaxActiveBlocksPerMultiprocessor(&per_cu, (const void*)mega_fwd, 512, LDS_BYTES) != hipSuccess || per_cu < 1) fprintf(stderr, "kernel_launch: occupancy query says %d\n", per_cu);
        (void)hipGetLastError();
        grid = cus;
    }
    if (grid < 0) return;
    (void)hipMemsetAsync((char*)d_ws + WS_CTL, 0, CTL_ZERO_BYTES, stream);
    Args a{};
    for (int i = 0; i < 29; ++i) a.in[i] = (const float*)d_in[i];
    a.out = (float*)d_out; a.ws = (unsigned char*)d_ws;
#if MK_LAUNCH_PER_PHASE
    for (int p = 0; p < N_PHASES; ++p) { a.ph_lo = p; a.ph_hi = p + 1; hipLaunchKernelGGL(mega_fwd, dim3(grid), dim3(512), LDS_BYTES, stream, a); }
#else
    a.ph_lo = 0; a.ph_hi = N_PHASES; hipLaunchKernelGGL(mega_fwd, dim3(grid), dim3(512), LDS_BYTES, stream, a);
#endif
}
```

```cpp
#include <hip/hip_runtime.h>
#include <cstdio>
#include <cstdint>
#define DEV __device__ __forceinline__
#define DEVCONST __device__
#define LAS __attribute__((address_space(3)))
#define SYNC() __syncthreads()
#define F2U(x) __float_as_uint(x)
#define U2F(x) __uint_as_float(x)
#define BITCAST(T, v) __builtin_bit_cast(T, v)
#define EXP2(x) __builtin_amdgcn_exp2f(x)
#define LOG2(x) __builtin_amdgcn_logf(x)
#define SINCOSPI(x, s, c) do { const float hx_ = 0.5f * (x); *(s) = __builtin_amdgcn_sinf(hx_); *(c) = __builtin_amdgcn_cosf(hx_); } while (0)
__device__ __forceinline__ float shfl_from(float v, int src_lane) { return __builtin_bit_cast(float, __builtin_amdgcn_ds_bpermute(src_lane << 2, __builtin_bit_cast(int, v))); }
#define SHFL_XOR3(v, m, lane) shfl_from((v), (lane) ^ (m))
template <int N> __device__ __forceinline__ float dpp_ror(float v) { return __builtin_bit_cast(float, __builtin_amdgcn_update_dpp(0, __builtin_bit_cast(int, v), 0x120 + N, 0xf, 0xf, false)); }
#define MFMA32(a, b, c) __builtin_amdgcn_mfma_f32_32x32x16_bf16((a), (b), (c), 0, 0, 0)
#define OPAQUE_I(x) asm volatile("" : "+v"(x))

typedef _Float16 h16x2_t __attribute__((ext_vector_type(2)));
__device__ __forceinline__ unsigned pkh2(float a, float b) { h16x2_t h; h.x = (_Float16)a; h.y = (_Float16)b; return __builtin_bit_cast(unsigned, h); }
__device__ __forceinline__ float hlo(unsigned w) { return (float)__builtin_bit_cast(h16x2_t, w).x; }
__device__ __forceinline__ float hhi(unsigned w) { return (float)__builtin_bit_cast(h16x2_t, w).y; }
constexpr int D_ = 2048, SEQ = 4096, NSEQ = 12, DEPTH_ = 4, CHS = 4  , NCHUNK = 3, MROWS = CHS * SEQ  ;
constexpr int HW_ = 1024, AW_ = 1536, AO_ = 512, DFF_ = 5632, INC_ = 11776, NMOD_ = 6;
constexpr int NA_ = 4608  , NB_ = 7168  ;
constexpr int FFTN = 8192, FPAD = FFTN + FFTN / 16 + 16 * (FFTN / 512)  ;
constexpr int NTHR = 512;

typedef unsigned short bf16_t;
typedef short bf16x8 __attribute__((ext_vector_type(8)));
typedef float f32x4 __attribute__((ext_vector_type(4)));
typedef float f32x16 __attribute__((ext_vector_type(16)));
typedef float cf __attribute__((ext_vector_type(2)));
typedef unsigned u32x4 __attribute__((ext_vector_type(4)));
typedef unsigned u32x2 __attribute__((ext_vector_type(2)));
typedef unsigned short u16x4 __attribute__((ext_vector_type(4)));

DEV unsigned short f2bf(float f) { unsigned u = F2U(f); u += 0x7fffu + ((u >> 16) & 1u); return (unsigned short)(u >> 16); }
DEV float bf2f(unsigned short b) { return U2F(((unsigned)b) << 16); }
DEV unsigned pk2(float lo, float hi) { return (unsigned)f2bf(lo) | ((unsigned)f2bf(hi) << 16); }

DEVCONST constexpr float C8T[9] = {1.0f, 0.980785280403230449f, 0.923879532511286756f, 0.831469612302545237f, 0.707106781186547524f, 0.555570233019602225f, 0.382683432365089772f, 0.195090322016128268f, 0.0f};
DEV constexpr float tw_cos(int m) { m &= 31; return m <= 8 ? C8T[m] : (m <= 16 ? -C8T[16 - m] : (m <= 24 ? -C8T[m - 16] : C8T[32 - m])); }
DEV constexpr float tw_sin(int m) { return tw_cos(m - 8); }
DEVCONST constexpr int BR16[16] = {0, 8, 4, 12, 2, 10, 6, 14, 1, 9, 5, 13, 3, 11, 7, 15};
DEVCONST constexpr int BR32[32] = {0, 16, 8, 24, 4, 20, 12, 28, 2, 18, 10, 26, 6, 22, 14, 30, 1, 17, 9, 25, 5, 21, 13, 29, 3, 19, 11, 27, 7, 23, 15, 31};
#ifdef EMU
DEV cf cmul(cf a, cf b) { return cf{a.x * b.x - a.y * b.y, a.x * b.y + a.y * b.x}; }
DEV cf cmulc(cf a, cf b) { return cf{a.x * b.x + a.y * b.y, a.y * b.x - a.x * b.y}; }
#else
DEV cf cmul(cf a, cf b) { cf r, t;
    asm("v_pk_mul_f32 %1, %2, %3 op_sel:[1,1] op_sel_hi:[1,0] neg_lo:[1,0]\n\tv_pk_fma_f32 %0, %2, %3, %1 op_sel_hi:[0,1,1]" : "=v"(r), "=&v"(t) : "v"(a), "v"(b));
    return r; }
DEV cf cmulc(cf a, cf b) { cf r, t;
    asm("v_pk_mul_f32 %1, %2, %3 op_sel:[1,1] op_sel_hi:[1,0]\n\tv_pk_fma_f32 %0, %2, %3, %1 op_sel_hi:[0,1,1] neg_hi:[1,0,0]" : "=v"(r), "=&v"(t) : "v"(a), "v"(b));
    return r; }
#endif
template <int R, bool INV> DEV void dft_regs(cf (&v)[R]) {
#pragma unroll
    for (int s = R; s >= 2; s >>= 1) {
        const int h = s >> 1;
#pragma unroll
        for (int b = 0; b < R; b += s) {
#pragma unroll
            for (int k = 0; k < h; ++k) {
                const cf a = v[b + k], c = v[b + k + h];
                v[b + k] = a + c;
                const cf d = a - c;
                const int m = k * (32 / s);
                const float wr = tw_cos(m), wi = INV ? tw_sin(m) : -tw_sin(m);
                v[b + k + h] = cf{d.x * wr - d.y * wi, d.x * wi + d.y * wr};
            }
        }
    }
}
DEV int PADI(int i) { return i + (i >> 4) + 16 * (i >> 9); }
DEV int fpos(int k) { return ((k & 15) << 9) | (((k >> 4) & 31) << 4) | (k >> 9); }
DEV int fnat(int p) { return (p >> 9) | (((p >> 4) & 31) << 4) | ((p & 15) << 9); }

DEV void fft_f1(LAS cf* buf, const cf (&z)[8], int tid) {
    OPAQUE_I(tid);
    cf v[16];
#pragma unroll
    for (int q = 0; q < 8; ++q) { v[q] = z[q]; v[q + 8] = cf{0.f, 0.f}; }
    dft_regs<16, false>(v);
    float sn, cs; SINCOSPI(-(float)tid * (2.0f / 8192.0f), &sn, &cs);
    const cf w = cf{cs, sn}; cf wp = cf{1.f, 0.f};
#pragma unroll
    for (int p = 0; p < 16; ++p) { buf[PADI(tid + 512 * p)] = cmul(v[BR16[p]], wp); wp = cmul(wp, w); }
}
DEV void fft_f1x2(LAS cf* buf0, LAS cf* buf1, const cf (&z0)[8], const cf (&z1)[8], int tid) {
    OPAQUE_I(tid);
    cf v[16], u[16];
#pragma unroll
    for (int q = 0; q < 8; ++q) { v[q] = z0[q]; v[q + 8] = cf{0.f, 0.f}; u[q] = z1[q]; u[q + 8] = cf{0.f, 0.f}; }
    dft_regs<16, false>(v); dft_regs<16, false>(u);
    float sn, cs; SINCOSPI(-(float)tid * (2.0f / 8192.0f), &sn, &cs);
    const cf w = cf{cs, sn}; cf wp = cf{1.f, 0.f};
    LAS cf* p0 = buf0 + PADI(tid); LAS cf* p1 = buf1 + PADI(tid);
#pragma unroll
    for (int p = 0; p < 16; ++p) { p0[560 * p] = cmul(v[BR16[p]], wp); p1[560 * p] = cmul(u[BR16[p]], wp); wp = cmul(wp, w); }
}
DEV void fft_i1x2(LAS cf* buf0, LAS cf* buf1, cf (&y0)[8], cf (&y1)[8], int tid) {
    OPAQUE_I(tid);
    float sn, cs; SINCOSPI(-(float)tid * (2.0f / 8192.0f), &sn, &cs);
    const cf w = cf{cs, sn}; cf wp = cf{1.f, 0.f};
    cf v[16], u[16];
    const LAS cf* p0 = buf0 + PADI(tid); const LAS cf* p1 = buf1 + PADI(tid);
#pragma unroll
    for (int p = 0; p < 16; ++p) { v[p] = cmulc(p0[560 * p], wp); u[p] = cmulc(p1[560 * p], wp); wp = cmul(wp, w); }
    dft_regs<16, true>(v); dft_regs<16, true>(u);
#pragma unroll
    for (int q = 0; q < 8; ++q) { y0[q] = v[BR16[q]]; y1[q] = u[BR16[q]]; }
}
DEV void fft_f2(LAS cf* buf, int t8) {
    OPAQUE_I(t8);
    LAS cf* pb = buf + (t8 >> 4) * 560 + (t8 & 15);
    cf v[32];
#pragma unroll
    for (int q = 0; q < 32; ++q) v[q] = pb[17 * q];
    dft_regs<32, false>(v);
    float sn, cs; SINCOSPI(-(float)(t8 & 15) * (2.0f / 512.0f), &sn, &cs);
    const cf w = cf{cs, sn}; cf wp = cf{1.f, 0.f};
#pragma unroll
    for (int p = 0; p < 32; ++p) { pb[17 * p] = cmul(v[BR32[p]], wp); wp = cmul(wp, w); }
}
DEV cf kunpack(unsigned w) { return cf{U2F(w << 16), U2F(w & 0xffff0000u)}; }
template <bool MULK> DEV void fft_mid(LAS cf* buf, const unsigned* Kp, int blk) {
    const int base = 16 * blk;
    cf v[16];
#pragma unroll
    for (int q = 0; q < 16; ++q) v[q] = buf[PADI(base + q)];
    dft_regs<16, false>(v);
    if (MULK) {
        cf w[16];
#pragma unroll
        for (int p = 0; p < 16; ++p) w[p] = cmul(v[BR16[p]], kunpack(Kp[base + p]));
        dft_regs<16, true>(w);
#pragma unroll
        for (int q = 0; q < 16; ++q) buf[PADI(base + q)] = w[BR16[q]];
    } else {
#pragma unroll
        for (int p = 0; p < 16; ++p) buf[PADI(base + p)] = v[BR16[p]];
    }
}
DEV void fft_midx2(LAS cf* buf0, LAS cf* buf1, const unsigned* Kp, int blk) {
    const int base = 16 * blk;
    LAS cf* p0 = buf0 + 17 * blk + 16 * (blk >> 5); LAS cf* p1 = buf1 + 17 * blk + 16 * (blk >> 5);
    cf v[16], u[16];
#pragma unroll
    for (int q = 0; q < 16; ++q) { v[q] = p0[q]; u[q] = p1[q]; }
    dft_regs<16, false>(v); dft_regs<16, false>(u);
    cf w[16], x[16];
    u32x4 kw[4];
#pragma unroll
    for (int j = 0; j < 4; ++j) kw[j] = *(const u32x4*)(Kp + base + 4 * j);
#pragma unroll
    for (int p = 0; p < 16; ++p) { const cf k = kunpack(kw[p >> 2][p & 3]); w[p] = cmul(v[BR16[p]], k); x[p] = cmul(u[BR16[p]], k); }
    dft_regs<16, true>(w); dft_regs<16, true>(x);
#pragma unroll
    for (int q = 0; q < 16; ++q) { p0[q] = w[BR16[q]]; p1[q] = x[BR16[q]]; }
}
DEV void fft_i2(LAS cf* buf, int t8) {
    OPAQUE_I(t8);
    LAS cf* pb = buf + (t8 >> 4) * 560 + (t8 & 15);
    float sn, cs; SINCOSPI(-(float)(t8 & 15) * (2.0f / 512.0f), &sn, &cs);
    const cf w = cf{cs, sn}; cf wp = cf{1.f, 0.f};
    cf v[32];
#pragma unroll
    for (int p = 0; p < 32; ++p) { v[p] = cmulc(pb[17 * p], wp); wp = cmul(wp, w); }
    dft_regs<32, true>(v);
#pragma unroll
    for (int q = 0; q < 32; ++q) pb[17 * q] = v[BR32[q]];
}
DEV void fft_i1(LAS cf* buf, cf (&y)[8], int tid) {
    OPAQUE_I(tid);
    float sn, cs; SINCOSPI(-(float)tid * (2.0f / 8192.0f), &sn, &cs);
    const cf w = cf{cs, sn}; cf wp = cf{1.f, 0.f};
    cf v[16];
#pragma unroll
    for (int p = 0; p < 16; ++p) { v[p] = cmulc(buf[PADI(tid + 512 * p)], wp); wp = cmul(wp, w); }
    dft_regs<16, true>(v);
#pragma unroll
    for (int q = 0; q < 8; ++q) y[q] = v[BR16[q]];
}

DEV void filt_hidden_unit(int unit, const float* w1, const float* b1, const float* fr1, const float* w2, const float* b2, const float* fr2, float* h2out  , bf16_t* h2b  , LAS float* sm, int tid) {
    LAS float* feat = sm;
    LAS float* h1 = sm + 8 * 33;
    const int tl = tid >> 6, j = tid & 63, t = unit * 8 + tl;
    if (tid < 8 * 33) {
        const int tt = tid / 33, f = tid % 33, tp = unit * 8 + tt;
        float val;
        if (f == 0) val = (float)tp * (1.0f / 4095.0f);
        else { const int k = (f - 1) & 15; const float band = 1e-4f + (float)k * ((15.0f - 1e-4f) / 15.0f);
               const float xr = (float)tp * band * (1.0f / 4096.0f), fr = xr - floorf(xr);
               float sn, cs; SINCOSPI(2.0f * fr, &sn, &cs);
               val = (f <= 16) ? cs : -sn; }
        feat[tt * 33 + f] = val;
    }
    SYNC();
    { float a = b1[j];
#pragma unroll 11
      for (int f = 0; f < 33; ++f) a += feat[tl * 33 + f] * w1[f * 64 + j];
      h1[tl * 64 + j] = sinf(fr1[j] * a); }
    SYNC();
    { float a = b2[j];
#pragma unroll 16
      for (int i = 0; i < 64; ++i) a += h1[tl * 64 + i] * w2[i * 64 + j];
      const float hv = sinf(fr2[j] * a); if (h2out) h2out[j * 4096 + t] = hv; h2b[t * 64 + j] = f2bf(hv); }
    SYNC();
}
DEV void filt_channel_unit(int c, const float* h2, const float* w3, unsigned* KF, LAS unsigned char* lds, int tid) {
    LAS cf* buf = (LAS cf*)lds;
    LAS float* sw = (LAS float*)(lds + FPAD * 8);
    LAS float* red = sw + 256;
    if (tid < 256) { const int i = tid >> 2, q = tid & 3; sw[tid] = w3[i * 4096 + q * 1024 + c]; }
    SYNC();
    const float dmin = -3.0701134573253947f, dmax = -15.350567286626973f;
    const float delta = fabsf(dmin + (float)c * ((dmax - dmin) / 1023.0f));
    float s0 = 0.f, s1 = 0.f;
#pragma unroll 1
    for (int i = 0; i < 8; ++i) {
        const int t = tid + 512 * i;
        const float* hc = h2 + t;
        float a0 = 0.f, a1 = 0.f, a2 = 0.f, a3 = 0.f;
        float xv[64];
#pragma unroll
        for (int k = 0; k < 64; ++k) xv[k] = hc[k * 4096];
#pragma unroll
        for (int k = 0; k < 64; ++k) { const f32x4 w = *(const LAS f32x4*)(sw + k * 4); a0 += xv[k] * w.x; a1 += xv[k] * w.y; a2 += xv[k] * w.z; a3 += xv[k] * w.w; }
        const float dec = expf(-((float)t * (1.0f / 4095.0f)) * delta);
        a0 *= dec; a1 *= dec; a2 *= dec; a3 *= dec;
        s0 += fabsf(a0); s1 += fabsf(a1);
        buf[PADI(t)] = cf{a0, a1};
        if (t > 0) { s0 += fabsf(a2); s1 += fabsf(a3); buf[PADI(8192 - t)] = cf{a2, a3}; }
        else buf[PADI(4096)] = cf{a2 * 0.f, a3 * 0.f};
    }
#pragma unroll
    for (int o = 1; o < 64; o <<= 1) { s0 += SHFL_XOR3(s0, o, tid & 63); s1 += SHFL_XOR3(s1, o, tid & 63); }
    if ((tid & 63) == 0) { red[(tid >> 6) * 2] = s0; red[(tid >> 6) * 2 + 1] = s1; }
    SYNC();
    float t0 = 0.f, t1 = 0.f;
#pragma unroll
    for (int w = 0; w < 8; ++w) { t0 += red[w * 2]; t1 += red[w * 2 + 1]; }
    const cf inrm = cf{1.0f / t0, 1.0f / t1};
    {
        OPAQUE_I(tid);
        cf v[16];
#pragma unroll
        for (int q = 0; q < 16; ++q) v[q] = buf[PADI(tid + 512 * q)] * inrm;
        dft_regs<16, false>(v);
        float sn, cs; SINCOSPI(-(float)tid * (2.0f / 8192.0f), &sn, &cs);
        const cf w = cf{cs, sn}; cf wp = cf{1.f, 0.f};
#pragma unroll
        for (int p = 0; p < 16; ++p) { buf[PADI(tid + 512 * p)] = cmul(v[BR16[p]], wp); wp = cmul(wp, w); }
    }
    SYNC();
    if (tid < 256) fft_f2(buf, tid);
    SYNC();
    fft_mid<false>(buf, nullptr, tid);
    SYNC();
    const float sc = 0.5f / 8192.0f;
#pragma unroll
    for (int i = 0; i < 16; ++i) {
        const int p = tid + 512 * i, k = fnat(p), p2 = fpos((8192 - k) & 8191);
        const cf a = buf[PADI(p)], b = buf[PADI(p2)];
        KF[((size_t)c * 2 + 0) * 8192 + p] = pk2((a.x + b.x) * sc, (a.y - b.y) * sc);
        KF[((size_t)c * 2 + 1) * 8192 + p] = pk2((a.y + b.y) * sc, (b.x - a.x) * sc);
    }
    SYNC();
}

DEV void filt_channel_unit2(int c, const bf16_t* h2b, const float* w3, unsigned* KF, LAS unsigned char* lds, int tid) {
    LAS cf* buf0 = (LAS cf*)lds; LAS cf* buf1 = buf0 + FPAD;
    int swo = 2 * FPAD * 8 + 1024; OPAQUE_I(swo);
    LAS float* sw = (LAS float*)(lds + swo);
    LAS float* red = sw + 512;
    { const int i = tid >> 3, q = tid & 7; sw[tid] = w3[i * 4096 + (q & 3) * 1024 + c + (q >> 2)]; }
    SYNC();
    const float dmin = -3.0701134573253947f, dmax = -15.350567286626973f;
    const int lane = tid & 63, wave = tid >> 6, n = lane & 31, hl = lane >> 5;
    const float delta = fabsf(dmin + (float)(c + hl) * ((dmax - dmin) / 1023.0f));
    bf16x8 wa[4];
#pragma unroll
    for (int ks = 0; ks < 4; ++ks) { float wv[8];
#pragma unroll
        for (int j = 0; j < 8; ++j) { const float x = sw[(16 * ks + 8 * hl + j) * 8 + (n & 7)]; wv[j] = (n < 8) ? x : 0.f; }
        u32x4 w; w.x = pk2(wv[0], wv[1]); w.y = pk2(wv[2], wv[3]); w.z = pk2(wv[4], wv[5]); w.w = pk2(wv[6], wv[7]); wa[ks] = BITCAST(bf16x8, w); }
    LAS cf* bufc = hl ? buf1 : buf0;
    float s[2] = {0.f, 0.f};
#pragma unroll 1
    for (int g = 0; g < 4; ++g) {
        bf16x8 hb[4][4];
#pragma unroll
        for (int i = 0; i < 4; ++i) { const int t = 32 * (wave * 16 + 4 * g + i) + n;
#pragma unroll
            for (int ks = 0; ks < 4; ++ks) hb[i][ks] = *(const bf16x8*)(h2b + t * 64 + 16 * ks + 8 * hl); }
#pragma unroll
        for (int i = 0; i < 4; ++i) { const int t = 32 * (wave * 16 + 4 * g + i) + n;
            f32x16 acc;
#pragma unroll
            for (int r = 0; r < 16; ++r) acc[r] = 0.f;
#pragma unroll
            for (int ks = 0; ks < 4; ++ks) acc = MFMA32(wa[ks], hb[i][ks], acc);
            const float dec = expf(-(float)t * (1.0f / 4095.0f) * delta);
            const float a0 = acc[0] * dec, a1 = acc[1] * dec, a2 = acc[2] * dec, a3 = acc[3] * dec;
            s[0] += fabsf(a0); s[1] += fabsf(a1);
            bufc[PADI(t)] = cf{a0, a1};
            if (t > 0) { s[0] += fabsf(a2); s[1] += fabsf(a3); bufc[PADI(8192 - t)] = cf{a2, a3}; }
            else bufc[PADI(4096)] = cf{a2 * 0.f, a3 * 0.f};
        }
    }
#pragma unroll
    for (int o = 1; o < 32; o <<= 1) { s[0] += SHFL_XOR3(s[0], o, lane); s[1] += SHFL_XOR3(s[1], o, lane); }
    if (n == 0) { red[wave * 4 + 2 * hl] = s[0]; red[wave * 4 + 2 * hl + 1] = s[1]; }
    SYNC();
    float tt[4] = {0.f, 0.f, 0.f, 0.f};
#pragma unroll
    for (int w = 0; w < 8; ++w)
#pragma unroll
        for (int q = 0; q < 4; ++q) tt[q] += red[w * 4 + q];
    const cf in0 = cf{1.0f / tt[0], 1.0f / tt[1]}, in1 = cf{1.0f / tt[2], 1.0f / tt[3]};
    {
        OPAQUE_I(tid);
        cf v[16], u[16];
#pragma unroll
        for (int q = 0; q < 16; ++q) { v[q] = buf0[PADI(tid + 512 * q)] * in0; u[q] = buf1[PADI(tid + 512 * q)] * in1; }
        dft_regs<16, false>(v); dft_regs<16, false>(u);
        float sn, cs; SINCOSPI(-(float)tid * (2.0f / 8192.0f), &sn, &cs);
        const cf w = cf{cs, sn}; cf wp = cf{1.f, 0.f};
#pragma unroll
        for (int p = 0; p < 16; ++p) { buf0[PADI(tid + 512 * p)] = cmul(v[BR16[p]], wp); buf1[PADI(tid + 512 * p)] = cmul(u[BR16[p]], wp); wp = cmul(wp, w); }
    }
    SYNC();
    fft_f2((tid >> 8) ? buf1 : buf0, tid & 255);
    SYNC();
    fft_mid<false>(buf0, nullptr, tid); fft_mid<false>(buf1, nullptr, tid);
    SYNC();
    const float sc = 0.5f / 8192.0f;
#pragma unroll
    for (int i = 0; i < 16; ++i) {
        const int p = tid + 512 * i, k = fnat(p), p2 = fpos((8192 - k) & 8191);
        const cf a0 = buf0[PADI(p)], b0 = buf0[PADI(p2)], a1 = buf1[PADI(p)], b1 = buf1[PADI(p2)];
        KF[((size_t)c * 2 + 0) * 8192 + p] = pk2((a0.x + b0.x) * sc, (a0.y - b0.y) * sc);
        KF[((size_t)c * 2 + 1) * 8192 + p] = pk2((a0.y + b0.y) * sc, (b0.x - a0.x) * sc);
        KF[((size_t)c * 2 + 2) * 8192 + p] = pk2((a1.x + b1.x) * sc, (a1.y - b1.y) * sc);
        KF[((size_t)c * 2 + 3) * 8192 + p] = pk2((a1.y + b1.y) * sc, (b1.x - a1.x) * sc);
    }
    SYNC();
}

DEV float ldsbf(const LAS bf16_t* p) { return bf2f(*p); }
DEV void hyena_issue_rows(const bf16_t* UT, int s, int c, u32x4 (&r)[4], int tid) {
#pragma unroll
    for (int b = 0; b < 4; ++b) r[b] = *(const u32x4*)(UT + ((size_t)(b * 3072 + s * 1024 + c)) * 4096 + tid * 8);
}
DEV void hyena_commit_rows(LAS unsigned char* lds, const u32x4 (&r)[4], int tid) {
#pragma unroll
    for (int b = 0; b < 4; ++b) *(LAS u32x4*)(lds + b * 8192 + tid * 16) = r[b];
}
template <int MODE> DEV void hyena_conv_rows(const LAS unsigned char* lds, int slot0, float w0, float w1, float w2, float bs, cf (&z)[2][8], const cf (&y)[2][8], float hb, int tid) {
#pragma unroll
    for (int b = 0; b < 4; ++b) {
        const LAS bf16_t* row = (const LAS bf16_t*)(lds + (slot0 + b) * 8192);
#pragma unroll
        for (int i = 0; i < 8; ++i) {
            const int t = tid + 512 * i, par = tid & 1, d0 = (tid >> 1) + par;
            const LAS unsigned* rw = (const LAS unsigned*)row + d0;
            const unsigned dw0 = (i == 0) ? rw[d0 > 0 ? -1 : 0] : rw[256 * i - 1], dw1 = rw[256 * i];
            float um = par ? U2F(dw0 << 16) : U2F(dw0 & 0xffff0000u);
            const float u0 = par ? U2F(dw0 & 0xffff0000u) : U2F(dw1 << 16);
            float up = par ? U2F(dw1 << 16) : U2F(dw1 & 0xffff0000u);
            um = (t > 0) ? um : 0.f; up = (t < 4095) ? up : 0.f;
            const float r = um * w0 + u0 * w1 + up * w2 + bs;
            if (MODE == 0) { if (b & 1) z[b >> 1][i].y = r; else z[b >> 1][i].x = r; }
            else { if (b & 1) z[b >> 1][i].y = r * (y[b >> 1][i].y + hb * z[b >> 1][i].y); else z[b >> 1][i].x = r * (y[b >> 1][i].x + hb * z[b >> 1][i].x); }
        }
    }
}
#ifndef HY_ABL
#define HY_ABL 0
#endif
DEV void hyena_conv_head(LAS cf* buf0, LAS cf* buf1, const unsigned* Kp, const cf (&z)[2][8], int tid, bool abl) {
    const bool skip_all = abl && HY_ABL == 1, nosync = abl && HY_ABL == 2, nok = abl && HY_ABL == 3, skip1 = (abl && HY_ABL == 4) || skip_all, skip2 = (abl && HY_ABL == 5) || skip_all, skipm = (abl && HY_ABL == 6) || skip_all;
    if (!skip1) fft_f1x2(buf0, buf1, z[0], z[1], tid);
    if (!nosync && !skip_all) SYNC();
    if (!skip2) fft_f2((tid >> 8) ? buf1 : buf0, tid & 255);
    if (!nosync && !skip_all) SYNC();
    if (!skipm) { if (nok) { fft_mid<false>(buf0, Kp, tid); fft_mid<false>(buf1, Kp, tid); } else fft_midx2(buf0, buf1, Kp, tid); }
    if (!nosync && !skip_all) SYNC();
    if (!skip2) fft_i2((tid >> 8) ? buf1 : buf0, tid & 255);
    if (!nosync && !skip_all) SYNC();
}
DEV void hyena_units(int c0, int cstride, const bf16_t* UT, bf16_t* YHT, const unsigned* KF, const float* convw  , const float* convb  , const float* hyb  , LAS unsigned char* lds, int tid, bool abl = false) {
    if (c0 >= 1024) return;
    LAS cf* buf0 = (LAS cf*)lds; LAS cf* buf1 = buf0 + FPAD;
    u32x4 r[4];
    hyena_issue_rows(UT, 0, c0, r, tid);
#pragma unroll 1
    for (int c = c0; c < 1024; c += cstride) {
        OPAQUE_I(tid);
        cf z[2][8], y[2][8];
        hyena_commit_rows(lds, r, tid);
        SYNC();
        hyena_conv_rows<0>(lds, 0, convw[c], convw[3072 + c], convw[6144 + c], convb[c], z, y, 0.f, tid);
        SYNC();
#pragma unroll 1
        for (int o = 0; o < 2; ++o) {
            hyena_conv_head(buf0, buf1, KF + ((size_t)c * 2 + o) * 8192, z, tid, abl);
            hyena_issue_rows(UT, 1 + o, c, r, tid);
            if (abl && (HY_ABL == 1 || HY_ABL == 4)) {
#pragma unroll
                for (int i = 0; i < 8; ++i) { y[0][i] = z[0][i]; y[1][i] = z[1][i]; }
            } else fft_i1x2(buf0, buf1, y[0], y[1], tid);
            SYNC();
            hyena_commit_rows(lds, r, tid);
            if (o == 1 && c + cstride < 1024) hyena_issue_rows(UT, 0, c + cstride, r, tid);
            SYNC();
            const int col = (1 + o) * 1024 + c;
            hyena_conv_rows<1>(lds, 0, convw[col], convw[3072 + col], convw[6144 + col], convb[col], z, y, hyb[o * 1024 + c], tid);
            SYNC();
        }
#pragma unroll
        for (int p = 0; p < 2; ++p)
#pragma unroll
            for (int i = 0; i < 8; ++i) {
                const int t = tid + 512 * i;
                YHT[((size_t)((2 * p) * 1024 + c)) * 4096 + t] = f2bf(z[p][i].x);
                YHT[((size_t)((2 * p + 1) * 1024 + c)) * 4096 + t] = f2bf(z[p][i].y);
            }
    }
}
DEV void hyena_unit(int c, const bf16_t* UT, bf16_t* YHT, const unsigned* KF, const float* convw, const float* convb, const float* hyb, LAS unsigned char* lds, int tid) {
    hyena_units(c, 1024, UT, YHT, KF, convw, convb, hyb, lds, tid);
}

DEV void attn_bias_table(LAS float* tab, const float* rel_bias, int tid) {
    for (int idx = tid; idx < 24 * 129; idx += NTHR) {
        const int gh = idx / 129, jj = idx % 129, g = gh >> 3, dil = 1 << (2 * g);
        const int rel = (jj - 64) * dil, n = rel < 0 ? -rel : rel;
        int bk = (rel > 0) ? 16 : 0;
        if (n < 8) bk += n;
        else bk += 8 + (n >= 15) + (n >= 27) + (n >= 50) + (n >= 91) + (n >= 166) + (n >= 305) + (n >= 559);
        tab[idx] = rel_bias[bk * 24 + gh] * 1.4426950408889634f;
    }
}
DEV void attn_tile(int tile, const bf16_t* QKG, const bf16_t* VT, bf16_t* OG, float* LSE, const LAS float* tab, int lane) {
    const int b = tile / (24 * 64), rem = tile % (24 * 64), gh = rem >> 6, tau = rem & 63, g = gh >> 3, h = gh & 7;
    const int dsh = 2 * g, Mg = 4096 >> dsh, ntm = Mg >> 6, r = tau / ntm, m0 = (tau % ntm) * 64;
    const int n = lane & 31, hl = lane >> 5;
    const size_t rowbase = (size_t)b * 4096;
    const int colq = g * 512 + h * 64;
    const float SC = 0.125f * 1.4426950408889634f;
    bf16x8 qf[2][4];
#pragma unroll
    for (int qb = 0; qb < 2; ++qb) {
        const int t = ((m0 + 32 * qb + n) << dsh) + r;
        const bf16_t* p = QKG + (rowbase + t) * 7168 + colq + 8 * hl;
#pragma unroll
        for (int ks = 0; ks < 4; ++ks) qf[qb][ks] = *(const bf16x8*)(p + 16 * ks);
    }
    f32x16 oacc[2][2];
#pragma unroll
    for (int a = 0; a < 2; ++a)
#pragma unroll
        for (int c2 = 0; c2 < 2; ++c2)
#pragma unroll
            for (int i = 0; i < 16; ++i) oacc[a][c2][i] = 0.f;
    float mrun[2] = {-1e30f, -1e30f}, lrun[2] = {0.f, 0.f};
    for (int kbi = 0; kbi < 3; ++kbi) {
        const int kb = (kbi == 0) ? 1 : (kbi == 1 ? 0 : 2);
        const int mk0 = m0 - 64 + 64 * kb;
        if (mk0 < 0 || mk0 >= Mg) continue;
        f32x16 s[2][2];
#pragma unroll
        for (int sb = 0; sb < 2; ++sb) {
            const int t = ((mk0 + 32 * sb + n) << dsh) + r;
            const bf16_t* p = QKG + (rowbase + t) * 7168 + 1536 + colq + 8 * hl;
            bf16x8 kf[4];
#pragma unroll
            for (int ks = 0; ks < 4; ++ks) kf[ks] = *(const bf16x8*)(p + 16 * ks);
#pragma unroll
            for (int qb = 0; qb < 2; ++qb) {
                f32x16 a;
#pragma unroll
                for (int i = 0; i < 16; ++i) a[i] = 0.f;
#pragma unroll
                for (int ks = 0; ks < 4; ++ks) a = MFMA32(kf[ks], qf[qb][ks], a);
                s[sb][qb] = a;
            }
        }
#pragma unroll
        for (int qb = 0; qb < 2; ++qb) {
            const int qq = 32 * qb + n;
            float mx = -1e30f;
#pragma unroll
            for (int sb = 0; sb < 2; ++sb)
#pragma unroll
                for (int rg = 0; rg < 16; ++rg) {
                    const int kk = 32 * sb + (rg & 3) + 8 * (rg >> 2) + 4 * hl;
                    const int jj = 64 * kb + kk - qq;
                    const bool ok = (unsigned)jj <= 128u;
                    const float bia = tab[gh * 129 + (ok ? jj : 0)];
                    const float v = ok ? s[sb][qb][rg] * SC + bia : -1e30f;
                    s[sb][qb][rg] = v; mx = fmaxf(mx, v);
                }
            mx = fmaxf(mx, SHFL_XOR3(mx, 32, lane));
            const float mnew = fmaxf(mrun[qb], mx);
            const float alpha = EXP2(mrun[qb] - mnew);
            float rs = 0.f;
#pragma unroll
            for (int sb = 0; sb < 2; ++sb)
#pragma unroll
                for (int rg = 0; rg < 16; ++rg) { const float p = EXP2(s[sb][qb][rg] - mnew); s[sb][qb][rg] = p; rs += p; }
            rs += SHFL_XOR3(rs, 32, lane);
            lrun[qb] = lrun[qb] * alpha + rs; mrun[qb] = mnew;
#pragma unroll
            for (int eb = 0; eb < 2; ++eb)
#pragma unroll
                for (int i = 0; i < 16; ++i) oacc[eb][qb][i] *= alpha;
        }
#pragma unroll
        for (int sb = 0; sb < 2; ++sb)
#pragma unroll
            for (int s2 = 0; s2 < 2; ++s2) {
                bf16x8 pf[2];
#pragma unroll
                for (int qb = 0; qb < 2; ++qb) {
                    u32x4 w;
                    w.x = pk2(s[sb][qb][8 * s2 + 0], s[sb][qb][8 * s2 + 1]); w.y = pk2(s[sb][qb][8 * s2 + 2], s[sb][qb][8 * s2 + 3]);
                    w.z = pk2(s[sb][qb][8 * s2 + 4], s[sb][qb][8 * s2 + 5]); w.w = pk2(s[sb][qb][8 * s2 + 6], s[sb][qb][8 * s2 + 7]);
                    pf[qb] = BITCAST(bf16x8, w);
                }
#pragma unroll
                for (int eb = 0; eb < 2; ++eb) {
                    const int e = 32 * eb + n;
                    const bf16_t* vp = VT + ((size_t)(b * 1536 + colq + e)) * 4096 + r * Mg + mk0 + 32 * sb + 16 * s2 + 4 * hl;
                    const u32x2 lo = *(const u32x2*)vp, hi = *(const u32x2*)(vp + 8);
                    u32x4 w; w.x = lo.x; w.y = lo.y; w.z = hi.x; w.w = hi.y;
                    const bf16x8 vf = BITCAST(bf16x8, w);
#pragma unroll
                    for (int qb = 0; qb < 2; ++qb) oacc[eb][qb] = MFMA32(vf, pf[qb], oacc[eb][qb]);
                }
            }
    }
#pragma unroll
    for (int qb = 0; qb < 2; ++qb) {
        const float inv = 1.0f / lrun[qb];
        const int t = ((m0 + 32 * qb + n) << dsh) + r;
        bf16_t* op = OG + (rowbase + t) * 1536 + colq;
#pragma unroll
        for (int eb = 0; eb < 2; ++eb)
#pragma unroll
            for (int gq = 0; gq < 4; ++gq) {
                u32x2 w; w.x = pk2(oacc[eb][qb][4 * gq] * inv, oacc[eb][qb][4 * gq + 1] * inv); w.y = pk2(oacc[eb][qb][4 * gq + 2] * inv, oacc[eb][qb][4 * gq + 3] * inv);
                *(u32x2*)(op + 32 * eb + 8 * gq + 4 * hl) = w;
            }
        if (hl == 0) LSE[(rowbase + t) * 24 + gh] = mrun[qb] + LOG2(lrun[qb]);
    }
}
constexpr int AT_KP = 144, AT_VP = 776;
constexpr int AT_K_OFF = 0, AT_V_OFF = 384 * AT_KP, AT_TAB_OFF = AT_V_OFF + 64 * AT_VP;
struct AttnU { int b, gh, g, dsh, Mg, r, mu0, colq; };
DEV AttnU attn_decode(int unit) {
    AttnU a; a.b = unit / 384; const int rem = unit % 384; a.gh = rem >> 4; const int uu = rem & 15; a.g = a.gh >> 3;
    a.dsh = 2 * a.g; a.Mg = 4096 >> a.dsh; const int upc = a.Mg >> 8; a.r = uu / upc; a.mu0 = (uu % upc) * 256; a.colq = a.g * 512 + (a.gh & 7) * 64;
    return a;
}
DEV void attn_issue(const AttnU& a, const bf16_t* QKG, const bf16_t* VT, u32x4 (&kr)[6], u32x4 (&vr)[6], int tid) {
    const size_t rowbase = (size_t)a.b * 4096;
#pragma unroll
    for (int i = 0; i < 6; ++i) {
        const int idx = tid + 512 * i, row = idx >> 3, ch = idx & 7, m = a.mu0 - 64 + row;
        kr[i] = (u32x4){0u, 0u, 0u, 0u};
        if (m >= 0 && m < a.Mg) kr[i] = *(const u32x4*)(QKG + (rowbase + (size_t)((m << a.dsh) + a.r)) * 7168 + 1536 + a.colq + 8 * ch);
    }
#pragma unroll
    for (int i = 0; i < 6; ++i) {
        const int idx = tid + 512 * i, e = idx / 48, ch = idx % 48, m = a.mu0 - 64 + 8 * ch;
        vr[i] = (u32x4){0u, 0u, 0u, 0u};
        if (m >= 0 && m < a.Mg) vr[i] = *(const u32x4*)(VT + ((size_t)(a.b * 1536 + a.colq + e)) * 4096 + a.r * a.Mg + m);
    }
}
DEV void attn_commit(LAS unsigned char* lds, const u32x4 (&kr)[6], const u32x4 (&vr)[6], int tid) {
#pragma unroll
    for (int i = 0; i < 6; ++i) { const int idx = tid + 512 * i, row = idx >> 3, ch = idx & 7; *(LAS u32x4*)(lds + AT_K_OFF + row * AT_KP + ch * 16) = kr[i]; }
#pragma unroll
    for (int i = 0; i < 6; ++i) { const int idx = tid + 512 * i, e = idx / 48, ch = idx % 48;
        LAS u32x2* d = (LAS u32x2*)(lds + AT_V_OFF + e * AT_VP + ch * 16);
        d[0] = (u32x2){vr[i].x, vr[i].y}; d[1] = (u32x2){vr[i].z, vr[i].w}; }
}
DEV void attn_compute(const AttnU& a, const bf16x8 (&qf)[4], int tq, bf16_t* OG, float* LSE, LAS unsigned char* lds, int tid) {
    const int lane = tid & 63, wave = tid >> 6, n = lane & 31, hl = lane >> 5;
    const size_t rowbase = (size_t)a.b * 4096;
    const LAS float* tab = (const LAS float*)(lds + AT_TAB_OFF) + a.gh * 129;
    const float SC = 0.125f * 1.4426950408889634f;
    f32x16 s[5];
    bool vb[5];
    float mx = -1e30f;
#pragma unroll
    for (int sb = 0; sb < 5; ++sb) {
        const int sbk = wave + sb, mb = a.mu0 - 64 + 32 * sbk;
        vb[sb] = (mb >= 0) && (mb < a.Mg);
        f32x16 acc;
#pragma unroll
        for (int i = 0; i < 16; ++i) acc[i] = 0.f;
        if (vb[sb]) {
            const LAS unsigned char* kp = lds + AT_K_OFF + (32 * sbk + n) * AT_KP + 16 * hl;
#pragma unroll
            for (int ks = 0; ks < 4; ++ks) { const bf16x8 kf = *(const LAS bf16x8*)(kp + 32 * ks); acc = MFMA32(kf, qf[ks], acc); }
        }
#pragma unroll
        for (int rg = 0; rg < 16; ++rg) {
            const int jj = 32 * sb + (rg & 3) + 8 * (rg >> 2) + 4 * hl - n;
            const bool ok = vb[sb] && ((unsigned)jj <= 128u);
            const float bia = tab[ok ? jj : 0];
            const float v = ok ? acc[rg] * SC + bia : -1e30f;
            acc[rg] = v; mx = fmaxf(mx, v);
        }
        s[sb] = acc;
    }
    mx = fmaxf(mx, SHFL_XOR3(mx, 32, lane));
    float rs = 0.f;
#pragma unroll
    for (int sb = 0; sb < 5; ++sb)
#pragma unroll
        for (int rg = 0; rg < 16; ++rg) { const float p = EXP2(s[sb][rg] - mx); s[sb][rg] = p; rs += p; }
    rs += SHFL_XOR3(rs, 32, lane);
    f32x16 oacc[2];
#pragma unroll
    for (int eb = 0; eb < 2; ++eb)
#pragma unroll
        for (int i = 0; i < 16; ++i) oacc[eb][i] = 0.f;
#pragma unroll
    for (int sb = 0; sb < 5; ++sb) {
        if (!vb[sb]) continue;
#pragma unroll
        for (int s2 = 0; s2 < 2; ++s2) {
            u32x4 w;
            w.x = pk2(s[sb][8 * s2 + 0], s[sb][8 * s2 + 1]); w.y = pk2(s[sb][8 * s2 + 2], s[sb][8 * s2 + 3]);
            w.z = pk2(s[sb][8 * s2 + 4], s[sb][8 * s2 + 5]); w.w = pk2(s[sb][8 * s2 + 6], s[sb][8 * s2 + 7]);
            const bf16x8 pf = BITCAST(bf16x8, w);
#pragma unroll
            for (int eb = 0; eb < 2; ++eb) {
                const LAS unsigned char* vp = lds + AT_V_OFF + (32 * eb + n) * AT_VP + (32 * (wave + sb) + 16 * s2 + 4 * hl) * 2;
                const u32x2 lo = *(const LAS u32x2*)vp, hi = *(const LAS u32x2*)(vp + 16);
                u32x4 wv; wv.x = lo.x; wv.y = lo.y; wv.z = hi.x; wv.w = hi.y;
                oacc[eb] = MFMA32(BITCAST(bf16x8, wv), pf, oacc[eb]);
            }
        }
    }
    const float inv = 1.0f / rs;
    bf16_t* op = OG + (rowbase + tq) * 1536 + a.colq;
#pragma unroll
    for (int eb = 0; eb < 2; ++eb)
#pragma unroll
        for (int gq = 0; gq < 4; ++gq) {
            u32x2 w; w.x = pk2(oacc[eb][4 * gq] * inv, oacc[eb][4 * gq + 1] * inv); w.y = pk2(oacc[eb][4 * gq + 2] * inv, oacc[eb][4 * gq + 3] * inv);
            *(u32x2*)(op + 32 * eb + 8 * gq + 4 * hl) = w;
        }
    if (hl == 0) LSE[(rowbase + tq) * 24 + a.gh] = mx + LOG2(rs);
}
DEV void attn_load_q(const AttnU& a, const bf16_t* QKG, bf16x8 (&qf)[4], int tid) {
    const int lane = tid & 63, wave = tid >> 6, n = lane & 31, hl = lane >> 5;
    const int tq = ((a.mu0 + 32 * wave + n) << a.dsh) + a.r;
    const bf16_t* p = QKG + ((size_t)a.b * 4096 + tq) * 7168 + a.colq + 8 * hl;
#pragma unroll
    for (int ks = 0; ks < 4; ++ks) qf[ks] = *(const bf16x8*)(p + 16 * ks);
}
DEV void attn_units(int u0, int ustride, int nunits, const bf16_t* QKG, const bf16_t* VT, bf16_t* OG, float* LSE, LAS unsigned char* lds, int tid) {
    if (u0 >= nunits) return;
    u32x4 kr[6], vr[6]; bf16x8 qn[4];
    { const AttnU a0 = attn_decode(u0); attn_issue(a0, QKG, VT, kr, vr, tid); attn_load_q(a0, QKG, qn, tid); }
#pragma unroll 1
    for (int u = u0; u < nunits; u += ustride) {
        OPAQUE_I(tid);
        const AttnU a = attn_decode(u);
        const int lane = tid & 63, wave = tid >> 6, n = lane & 31;
        SYNC();
        attn_commit(lds, kr, vr, tid);
        bf16x8 qf[4];
#pragma unroll
        for (int ks = 0; ks < 4; ++ks) qf[ks] = qn[ks];
        const int tq = ((a.mu0 + 32 * wave + n) << a.dsh) + a.r;
        SYNC();
        if (u + ustride < nunits) { const AttnU an = attn_decode(u + ustride); attn_issue(an, QKG, VT, kr, vr, tid); attn_load_q(an, QKG, qn, tid); }
        attn_compute(a, qf, tq, OG, LSE, lds, tid);
    }
}
DEV void attn_unit(int unit, const bf16_t* QKG, const bf16_t* VT, bf16_t* OG, float* LSE, LAS unsigned char* lds, int tid) {
    attn_units(unit, 1 << 20, unit + 1, QKG, VT, OG, LSE, lds, tid);
}
DEV void attn_combine_item(int item, const bf16_t* OG, const float* LSE, bf16_t* YA, int pitch = 512, int coloff = 0) {
    const int row = item >> 6, h = (item >> 3) & 7, e8 = item & 7;
    const float l0 = LSE[row * 24 + h], l1 = LSE[row * 24 + 8 + h], l2 = LSE[row * 24 + 16 + h];
    const float mx = fmaxf(l0, fmaxf(l1, l2));
    float w0 = EXP2(l0 - mx), w1 = EXP2(l1 - mx), w2 = EXP2(l2 - mx);
    const float inv = 1.0f / (w0 + w1 + w2); w0 *= inv; w1 *= inv; w2 *= inv;
    const bf16_t* p = OG + (size_t)row * 1536 + h * 64 + e8 * 8;
    const u32x4 a = *(const u32x4*)p, b = *(const u32x4*)(p + 512), c = *(const u32x4*)(p + 1024);
    u32x4 o;
#pragma unroll
    for (int i = 0; i < 4; ++i) {
        const float lo = w0 * U2F(a[i] << 16) + w1 * U2F(b[i] << 16) + w2 * U2F(c[i] << 16);
        const float hi = w0 * U2F(a[i] & 0xffff0000u) + w1 * U2F(b[i] & 0xffff0000u) + w2 * U2F(c[i] & 0xffff0000u);
        o[i] = pk2(lo, hi);
    }
    *(u32x4*)(YA + (size_t)row * pitch + coloff + h * 64 + e8 * 8) = o;
}

namespace pg8 {
#define PG8_LAS __attribute__((address_space(3)))
typedef unsigned short bf16_t;
typedef short bf16x8 __attribute__((ext_vector_type(8)));
typedef float f32x4 __attribute__((ext_vector_type(4)));
typedef unsigned u32x4 __attribute__((ext_vector_type(4)));
constexpr int BM = 256, BK = 64, HALF = 128, HTB = HALF * BK * 2  , STAGE_BYTES = 8 * HTB, NXCD = 8, WGM = 8;

__host__ __device__ __forceinline__ int lds_byte(int r, int c) { const int st = (r >> 4) * 2 + (c >> 5), rr = r & 15, cc = c & 31, ob = rr * 64 + cc * 2; return st * 1024 + (ob ^ (((ob >> 9) & 1) << 5)); }
__host__ __device__ __forceinline__ void stage_rc(int b, int& R, int& C) { const int st = b / 1024, sb = b % 1024, swz = sb ^ (((sb >> 9) & 1) << 5); R = (st >> 1) * 16 + swz / 64; C = (st & 1) * 32 + (swz % 64) / 2; }
__host__ __device__ __forceinline__ int perm32(int rho) { const int n = rho >> 4, i = rho & 15; return 8 * (i >> 2) + 4 * n + (i & 3); }

struct Unit { int pm, pn; };
struct Gemm { const bf16_t* A; const bf16_t* Bt; int M, N, K; };

struct StaticOrder {
    int nM, nN, nwg, G, c;
    __host__ __device__ void init(int M, int N, int G_, int c_) { nM = M / BM; nN = N / BM; nwg = nM * nN; G = G_; c = c_; }
    __host__ __device__ bool next(int i, Unit& u) const {
        const long L = (long)i * G + c; if (L >= nwg) return false;
        int wgid = (int)L; { const int q = nwg / NXCD, r = nwg % NXCD, xcd = wgid % NXCD, off = wgid / NXCD; wgid = (xcd < r ? xcd * (q + 1) : r * (q + 1) + (xcd - r) * q) + off; }
        const int nig = WGM * nN, gid = wgid / nig, fm = gid * WGM, gsz = (nM - fm) < WGM ? (nM - fm) : WGM;
        u.pm = fm + ((wgid % nig) % gsz); u.pn = (wgid % nig) / gsz; return true;
    }
    __device__ __forceinline__ void a_ready(const Unit&) const {}
    __device__ __forceinline__ void done(const Unit&) const {}
};

__device__ __forceinline__ unsigned cvt_pk_bf16(float lo, float hi) { unsigned r; asm volatile("v_cvt_pk_bf16_f32 %0, %1, %2" : "=v"(r) : "v"(lo), "v"(hi)); return r; }
constexpr int EPI_LDS_OFF = 143360 + 1024;
template <int MODE> __device__ __forceinline__ int perm_row(int R) {
    if (MODE == 0) return R;
    if (MODE == 1) return (R & ~31) + perm32(R & 31);
    const int wcp = R >> 5, n = (R >> 4) & 1, fq = (R >> 2) & 3, e = R & 3;
    if (MODE == 2) return fq + 4 * (8 * wcp + 4 * n + e);
    return (4 * wcp + fq) + 16 * (4 * n + e);
}
__device__ __forceinline__ float sigmoid_f(float x) { return __builtin_amdgcn_rcpf(1.0f + __builtin_amdgcn_exp2f(-1.4426950408889634f * x)); }
__device__ __forceinline__ f32x4 exp2_4(f32x4 t) { f32x4 r;
#pragma unroll
    for (int j = 0; j < 4; ++j) r[j] = __builtin_amdgcn_exp2f(fminf(t[j], 60.0f));
    return r; }
__device__ __forceinline__ f32x4 rcp_4(f32x4 t) { f32x4 r;
#pragma unroll
    for (int j = 0; j < 4; ++j) r[j] = __builtin_amdgcn_rcpf(t[j]);
    return r; }
__device__ __forceinline__ float bflo(unsigned w) { return __uint_as_float(w << 16); }
__device__ __forceinline__ float bfhi(unsigned w) { return __uint_as_float(w & 0xffff0000u); }
template <int VM> struct EpiG1a {
    static constexpr bool PERM = true, AFTER_DRAIN = false; static constexpr int PMODE = 1 + VM, KSPLIT = 0; static constexpr bool PREF = false;
    bf16_t* UT; bf16_t* VT;
    __device__ __forceinline__ void operator()(const f32x4 (&acc)[2][2][4][2], const Unit& u, int wr, int wc, int fr, int fq) const {
        const int row0 = u.pm * BM + wr * 64 + fr;
        const int T0 = u.pn * BM, bseq = T0 >> 12, t0 = T0 & 4095;
#pragma unroll
        for (int ai = 0; ai < 2; ++ai)
#pragma unroll
            for (int m = 0; m < 4; ++m) {
                const int nn = row0 + ai * HALF + m * 16;
#pragma unroll
                for (int bj = 0; bj < 2; ++bj) {
                    const f32x4 v0 = acc[ai][bj][m][0], v1 = acc[ai][bj][m][1];
                    u32x4 w; w.x = cvt_pk_bf16(v0[0], v0[1]); w.y = cvt_pk_bf16(v0[2], v0[3]); w.z = cvt_pk_bf16(v1[0], v1[1]); w.w = cvt_pk_bf16(v1[2], v1[3]);
                    const int th = t0 + bj * HALF;
                    if (VM == 0) {
                        const int t = th + wc * 32 + 8 * fq;
                        if (u.pm < 12) *(u32x4*)(UT + ((size_t)(bseq * 3072 + nn)) * 4096 + t) = w;
                        else *(u32x4*)(VT + ((size_t)(bseq * 1536 + (nn - 3072))) * 4096 + t) = w;
                    } else if (VM == 1) {
                        *(u32x4*)(VT + ((size_t)(bseq * 1536 + 512 + nn)) * 4096 + fq * 1024 + (th >> 2) + 8 * wc) = w;
                    } else {
                        *(u32x4*)(VT + ((size_t)(bseq * 1536 + 1024 + nn)) * 4096 + (4 * wc + fq) * 256 + (th >> 4)) = w;
                    }
                }
            }
    }
};
struct EpiG1b {
    static constexpr bool PERM = true, AFTER_DRAIN = false; static constexpr int PMODE = 1, KSPLIT = 0; static constexpr bool PREF = true;
    bf16_t* O; const float* bgate;
    __device__ __forceinline__ void prefetch(const Unit& u, int buf, PG8_LAS unsigned char* lds, int wid, int lane) const {
        if (u.pn >= 12 && wid == 0) __builtin_amdgcn_global_load_lds((const unsigned*)(bgate + (lane >> 5) * 2048 + (u.pn - 12) * 128 + (lane & 31) * 4), (PG8_LAS unsigned*)(lds + EPI_LDS_OFF + buf * 2048), 16, 0, 0);
    }
    __device__ __forceinline__ void run(const f32x4 (&acc)[2][2][4][2], const Unit& u, int wr, int wc, int fr, int fq, PG8_LAS unsigned char* lds, int buf) const {
        const int row0 = u.pm * BM + wr * 64 + fr, col0 = u.pn * BM + wc * 32 + 8 * fq; const bool gate = u.pn >= 12;
        const PG8_LAS float* bl = (const PG8_LAS float*)(lds + EPI_LDS_OFF + buf * 2048) + wc * 32 + 8 * fq;
        f32x4 bv[2][2];
#pragma unroll
        for (int bj = 0; bj < 2; ++bj)
#pragma unroll
            for (int n = 0; n < 2; ++n) bv[bj][n] = gate ? *(const PG8_LAS f32x4*)(bl + bj * HALF + 4 * n) : (f32x4){0.f, 0.f, 0.f, 0.f};
#pragma unroll
        for (int ai = 0; ai < 2; ++ai)
#pragma unroll
            for (int m = 0; m < 4; ++m) { bf16_t* rowp = O + (size_t)(row0 + ai * HALF + m * 16) * 7168 + col0;
                {
                    f32x4 h0 = acc[ai][0][m][0] + bv[0][0], h1 = acc[ai][0][m][1] + bv[0][1], a0 = acc[ai][1][m][0] + bv[1][0], a1 = acc[ai][1][m][1] + bv[1][1];
                    if (gate) {
                        const float nl2e = -1.4426950408889634f;
                        const f32x4 pa0 = exp2_4(a0 * nl2e) + 1.0f, pa1 = exp2_4(a1 * nl2e) + 1.0f, ph0 = exp2_4(h0 * nl2e) + 1.0f, ph1 = exp2_4(h1 * nl2e) + 1.0f;
                        const f32x4 r0 = rcp_4(pa0 * ph0), r1 = rcp_4(pa1 * ph1);
                        h0 = r0 * pa0 * pa0; h1 = r1 * pa1 * pa1; a0 = r0 * ph0; a1 = r1 * ph1; }
                    u32x4 w; w.x = cvt_pk_bf16(h0[0], h0[1]); w.y = cvt_pk_bf16(h0[2], h0[3]); w.z = cvt_pk_bf16(h1[0], h1[1]); w.w = cvt_pk_bf16(h1[2], h1[3]);
                    *(u32x4*)(rowp) = w;
                    w.x = cvt_pk_bf16(a0[0], a0[1]); w.y = cvt_pk_bf16(a0[2], a0[3]); w.z = cvt_pk_bf16(a1[0], a1[1]); w.w = cvt_pk_bf16(a1[2], a1[3]);
                    *(u32x4*)(rowp + HALF) = w; } }
    }
};
template <bool ADD> struct EpiG2 {
    static constexpr bool PERM = true, AFTER_DRAIN = false; static constexpr int PMODE = 1, KSPLIT = 0; static constexpr bool PREF = false;
    const bf16_t* QKG; bf16_t* MB; int goff;
    __device__ __forceinline__ void operator()(const f32x4 (&acc)[2][2][4][2], const Unit& u, int wr, int wc, int fr, int fq) const {
        const int row0 = u.pm * BM + wr * 64 + fr, col0 = u.pn * BM + wc * 32 + 8 * fq;
#pragma unroll
        for (int ai = 0; ai < 2; ++ai) {
            u32x4 gtv[4][2], mbv[4][2];
#pragma unroll
            for (int m = 0; m < 4; ++m) { const size_t row = (size_t)(row0 + ai * HALF + m * 16);
#pragma unroll
                for (int bj = 0; bj < 2; ++bj) { const int col = col0 + bj * HALF;
                    gtv[m][bj] = *(const u32x4*)(QKG + row * 7168 + goff + col);
                    if (ADD) mbv[m][bj] = *(const u32x4*)(MB + row * 2048 + col); } }
#pragma unroll
            for (int m = 0; m < 4; ++m) { const size_t row = (size_t)(row0 + ai * HALF + m * 16);
#pragma unroll
                for (int bj = 0; bj < 2; ++bj) { const int col = col0 + bj * HALF;
                    const u32x4 gt = gtv[m][bj];
                    f32x4 v0 = acc[ai][bj][m][0], v1 = acc[ai][bj][m][1];
                    v0[0] *= bflo(gt.x); v0[1] *= bfhi(gt.x); v0[2] *= bflo(gt.y); v0[3] *= bfhi(gt.y); v1[0] *= bflo(gt.z); v1[1] *= bfhi(gt.z); v1[2] *= bflo(gt.w); v1[3] *= bfhi(gt.w);
                    if (ADD) { const u32x4 mb = mbv[m][bj];
                        v0[0] += bflo(mb.x); v0[1] += bfhi(mb.x); v0[2] += bflo(mb.y); v0[3] += bfhi(mb.y); v1[0] += bflo(mb.z); v1[1] += bfhi(mb.z); v1[2] += bflo(mb.w); v1[3] += bfhi(mb.w); }
                    u32x4 w; w.x = cvt_pk_bf16(v0[0], v0[1]); w.y = cvt_pk_bf16(v0[2], v0[3]); w.z = cvt_pk_bf16(v1[0], v1[1]); w.w = cvt_pk_bf16(v1[2], v1[3]);
                    *(u32x4*)(MB + row * 2048 + col) = w; } }
        }
    }
};
struct EpiRes {
    static constexpr bool PERM = false, AFTER_DRAIN = false; static constexpr int PMODE = 0, KSPLIT = 0; static constexpr bool PREF = false;
    const float* xold; float* xnew; const float* gate;
    __device__ __forceinline__ void operator()(const f32x4 (&acc)[2][2][4][2], const Unit& u, int wr, int wc, int fr, int fq) const {
        const int row0 = u.pm * BM + wr * 64 + fr, col0 = u.pn * BM + wc * 32 + 4 * fq;
        const float* gp = gate + (size_t)(u.pm >> 4) * 12288 + col0;
        f32x4 gv[2][2];
#pragma unroll
        for (int bj = 0; bj < 2; ++bj)
#pragma unroll
            for (int n = 0; n < 2; ++n) gv[bj][n] = *(const f32x4*)(gp + bj * HALF + n * 16);
#pragma unroll
        for (int ai = 0; ai < 2; ++ai) {
            f32x4 xo[4][2][2];
#pragma unroll
            for (int m = 0; m < 4; ++m) { const size_t off = (size_t)(row0 + ai * HALF + m * 16) * 2048 + col0;
#pragma unroll
                for (int bj = 0; bj < 2; ++bj)
#pragma unroll
                    for (int n = 0; n < 2; ++n) xo[m][bj][n] = *(const f32x4*)(xold + off + bj * HALF + n * 16); }
#pragma unroll
            for (int m = 0; m < 4; ++m) { const size_t off = (size_t)(row0 + ai * HALF + m * 16) * 2048 + col0;
#pragma unroll
                for (int bj = 0; bj < 2; ++bj)
#pragma unroll
                    for (int n = 0; n < 2; ++n) *(f32x4*)(xnew + off + bj * HALF + n * 16) = xo[m][bj][n] + gv[bj][n] * acc[ai][bj][m][n]; }
        }
    }
};
template <bool F32IN> struct EpiResB {
    static constexpr bool PERM = true, AFTER_DRAIN = false; static constexpr int PMODE = 1, KSPLIT = 0; static constexpr bool PREF = false;
    const float* xin; const bf16_t* xold; bf16_t* xnew; const float* gate;
    __device__ __forceinline__ void operator()(const f32x4 (&acc)[2][2][4][2], const Unit& u, int wr, int wc, int fr, int fq) const {
        const int row0 = u.pm * BM + wr * 64 + fr, col0 = u.pn * BM + wc * 32 + 8 * fq;
        const float* gp = gate + (size_t)(u.pm >> 4) * 12288 + col0;
        f32x4 gv[2][2];
#pragma unroll
        for (int bj = 0; bj < 2; ++bj)
#pragma unroll
            for (int n = 0; n < 2; ++n) gv[bj][n] = *(const f32x4*)(gp + bj * HALF + n * 4);
        if constexpr (F32IN) {
#pragma unroll
            for (int ai = 0; ai < 2; ++ai) {
                f32x4 xo[4][2][2];
#pragma unroll
                for (int m = 0; m < 4; ++m) { const size_t off = (size_t)(row0 + ai * HALF + m * 16) * 2048 + col0;
#pragma unroll
                    for (int bj = 0; bj < 2; ++bj)
#pragma unroll
                        for (int n = 0; n < 2; ++n) xo[m][bj][n] = *(const f32x4*)(xin + off + bj * HALF + n * 4); }
#pragma unroll
                for (int m = 0; m < 4; ++m) { const size_t off = (size_t)(row0 + ai * HALF + m * 16) * 2048 + col0;
#pragma unroll
                    for (int bj = 0; bj < 2; ++bj) { const f32x4 v0 = xo[m][bj][0] + gv[bj][0] * acc[ai][bj][m][0], v1 = xo[m][bj][1] + gv[bj][1] * acc[ai][bj][m][1];
                        u32x4 w; w.x = pkh2(v0[0], v0[1]); w.y = pkh2(v0[2], v0[3]); w.z = pkh2(v1[0], v1[1]); w.w = pkh2(v1[2], v1[3]);
                        *(u32x4*)(xnew + off + bj * HALF) = w; } }
            }
        } else {
            u32x4 xo[2][4][2];
#pragma unroll
            for (int ai = 0; ai < 2; ++ai)
#pragma unroll
                for (int m = 0; m < 4; ++m) { const size_t off = (size_t)(row0 + ai * HALF + m * 16) * 2048 + col0;
#pragma unroll
                    for (int bj = 0; bj < 2; ++bj) xo[ai][m][bj] = *(const u32x4*)(xold + off + bj * HALF); }
#pragma unroll
            for (int ai = 0; ai < 2; ++ai)
#pragma unroll
                for (int m = 0; m < 4; ++m) { const size_t off = (size_t)(row0 + ai * HALF + m * 16) * 2048 + col0;
#pragma unroll
                    for (int bj = 0; bj < 2; ++bj) { const u32x4 o = xo[ai][m][bj]; const f32x4 a0 = acc[ai][bj][m][0], a1 = acc[ai][bj][m][1], g0 = gv[bj][0], g1 = gv[bj][1];
                        u32x4 w;
                        w.x = pkh2(hlo(o.x) + g0[0] * a0[0], hhi(o.x) + g0[1] * a0[1]); w.y = pkh2(hlo(o.y) + g0[2] * a0[2], hhi(o.y) + g0[3] * a0[3]);
                        w.z = pkh2(hlo(o.z) + g1[0] * a1[0], hhi(o.z) + g1[1] * a1[1]); w.w = pkh2(hlo(o.w) + g1[2] * a1[2], hhi(o.w) + g1[3] * a1[3]);
                        *(u32x4*)(xnew + off + bj * HALF) = w; } }
        }
    }
};
struct PanelOrder {
    int nwg, G, c;
    __host__ __device__ void init(int M, int N, int G_, int c_) { nwg = (M / BM) * (N / BM); G = G_; c = c_; }
    __host__ __device__ __attribute__((always_inline)) bool next(int i, Unit& u) const {
        const int L = i * G + c; if (L >= nwg) return false;
        const int x = c & 7, r = c >> 3, ppx = G >> 6;
        u.pm = ((i * G) >> 3) + x * ppx + (r % ppx); u.pn = r / ppx; return true;
    }
    __device__ __forceinline__ void a_ready(const Unit&) const {}
    __device__ __forceinline__ void done(const Unit&) const {}
};
template <bool F32IN> struct EpiResN {
    static constexpr bool PERM = true, AFTER_DRAIN = false; static constexpr int PMODE = 1, KSPLIT = 0; static constexpr bool PREF = true;
    const float* xin; const bf16_t* xold; bf16_t* xnew; bf16_t* hout; const float* modb; const float* gn; int goff; float* part; unsigned* cnt; unsigned want; unsigned* tmo;
    __device__ __forceinline__ void prefetch(const Unit& u, int buf, PG8_LAS unsigned char* lds, int wid, int lane) const {
        if (wid < 4) { asm volatile("v_mbcnt_lo_u32_b32 %0, -1, 0\n\tv_mbcnt_hi_u32_b32 %0, -1, %0" : "=v"(lane));
            const float* base = wid == 1 ? gn + u.pn * BM : modb + (size_t)(u.pm >> 4) * 12288 + u.pn * BM + (wid == 0 ? goff : wid == 2 ? 4 * 2048 : 3 * 2048);
            __builtin_amdgcn_global_load_lds((const unsigned*)(base + lane * 4), (PG8_LAS unsigned*)(lds + EPI_LDS_OFF + buf * 4096 + wid * 1024), 16, 0, 0); }
    }
    __device__ __forceinline__ void run(f32x4 (&acc)[2][2][4][2], const Unit& u, int wr, int wc, int fr, int fq, PG8_LAS unsigned char* lds, int buf) const {
        { int l_; asm volatile("v_mbcnt_lo_u32_b32 %0, -1, 0\n\tv_mbcnt_hi_u32_b32 %0, -1, %0" : "=v"(l_)); fr = l_ & 15; fq = l_ >> 4; }
        const int wid = wr * 4 + wc;
        PG8_LAS float* P = (PG8_LAS float*)(lds + EPI_LDS_OFF + 8192);
        PG8_LAS float* S = (PG8_LAS float*)(lds + EPI_LDS_OFF + 12288);
        PG8_LAS unsigned* flag = (PG8_LAS unsigned*)(lds + EPI_LDS_OFF + 13312);
        { const int row0 = u.pm * BM + wr * 64 + fr, col0 = u.pn * BM + wc * 32 + 8 * fq;
        const PG8_LAS float* vb = (const PG8_LAS float*)(lds + EPI_LDS_OFF + buf * 4096) + wc * 32 + 8 * fq;
        f32x4 gv[2][2];
#pragma unroll
        for (int bj = 0; bj < 2; ++bj)
#pragma unroll
            for (int n = 0; n < 2; ++n) gv[bj][n] = *(const PG8_LAS f32x4*)(vb + bj * HALF + 4 * n);
        if constexpr (F32IN) {
#pragma unroll
            for (int ai = 0; ai < 2; ++ai)
#pragma unroll
                for (int mh = 0; mh < 2; ++mh) {
                    f32x4 xo[2][2][2];
#pragma unroll
                    for (int mm = 0; mm < 2; ++mm) { const unsigned off = (unsigned)(row0 + ai * HALF + (2 * mh + mm) * 16) * 2048u + (unsigned)col0;
#pragma unroll
                        for (int bj = 0; bj < 2; ++bj)
#pragma unroll
                            for (int n = 0; n < 2; ++n) xo[mm][bj][n] = *(const f32x4*)(xin + off + bj * HALF + n * 4); }
#pragma unroll
                    for (int mm = 0; mm < 2; ++mm)
#pragma unroll
                        for (int bj = 0; bj < 2; ++bj)
#pragma unroll
                            for (int n = 0; n < 2; ++n) acc[ai][bj][2 * mh + mm][n] = xo[mm][bj][n] + gv[bj][n] * acc[ai][bj][2 * mh + mm][n];
                    asm volatile("" ::: "memory");
                }
        } else {
            u32x4 xo[2][4][2];
#pragma unroll
            for (int ai = 0; ai < 2; ++ai)
#pragma unroll
                for (int m = 0; m < 4; ++m) { const unsigned off = (unsigned)(row0 + ai * HALF + m * 16) * 2048u + (unsigned)col0;
#pragma unroll
                    for (int bj = 0; bj < 2; ++bj) xo[ai][m][bj] = *(const u32x4*)(xold + off + bj * HALF); }
#pragma unroll
            for (int ai = 0; ai < 2; ++ai)
#pragma unroll
                for (int m = 0; m < 4; ++m)
#pragma unroll
                    for (int bj = 0; bj < 2; ++bj) { const u32x4 o = xo[ai][m][bj];
                        const f32x4 x0 = (f32x4){hlo(o.x), hhi(o.x), hlo(o.y), hhi(o.y)}, x1 = (f32x4){hlo(o.z), hhi(o.z), hlo(o.w), hhi(o.w)};
                        acc[ai][bj][m][0] = x0 + gv[bj][0] * acc[ai][bj][m][0]; acc[ai][bj][m][1] = x1 + gv[bj][1] * acc[ai][bj][m][1]; }
        }
        }
        __builtin_amdgcn_sched_barrier(0);
        asm volatile("" : "+v"(fr), "+v"(fq));
        const int lane = fq * 16 + fr;
#pragma unroll
        for (int ai = 0; ai < 2; ++ai)
#pragma unroll
            for (int m = 0; m < 4; ++m) { float q = 0.f;
#pragma unroll
                for (int bj = 0; bj < 2; ++bj)
#pragma unroll
                    for (int n = 0; n < 2; ++n) { const f32x4 x = acc[ai][bj][m][n]; q += (x[0] * x[0] + x[1] * x[1]) + (x[2] * x[2] + x[3] * x[3]); }
                q += shfl_from(q, lane ^ 16); q += shfl_from(q, lane ^ 32);
                if (fq == 0) P[(ai * HALF + wr * 64 + m * 16 + fr) * 4 + wc] = q; }
        asm volatile("s_waitcnt lgkmcnt(0)" ::: "memory"); __builtin_amdgcn_s_barrier(); asm volatile("" ::: "memory");
        const int t = wid * 64 + lane;
        if (wid < 4) { const f32x4 p = *(const PG8_LAS f32x4*)(P + t * 4);
            __hip_atomic_store((unsigned*)part + ((size_t)u.pm * BM + t) * 8 + u.pn, __float_as_uint((p[0] + p[1]) + (p[2] + p[3])), __ATOMIC_RELAXED, __HIP_MEMORY_SCOPE_AGENT);
            asm volatile("s_waitcnt vmcnt(0)" ::: "memory");
            if (lane == 0) __hip_atomic_fetch_add(cnt + 64 * u.pm, 1u, __ATOMIC_RELAXED, __HIP_MEMORY_SCOPE_AGENT); }
        if (wid == 0) {
            unsigned got, it_; unsigned tmpv; const unsigned* cp = cnt + 64 * u.pm;
            asm volatile("s_mov_b32 %2, 0\n.Lpw%=: global_load_dword %0, %3, off sc1\n\ts_waitcnt vmcnt(0)\n\tv_readfirstlane_b32 %1, %0\n\ts_cmp_ge_u32 %1, %4\n\ts_cbranch_scc1 .Lpd%=\n\ts_sleep 2\n\ts_add_u32 %2, %2, 1\n\ts_cmp_lt_u32 %2, 0x40000\n\ts_cbranch_scc1 .Lpw%=\n.Lpd%=:"
                         : "=&v"(tmpv), "=&s"(got), "=&s"(it_) : "v"(cp), "s"(want) : "scc", "memory");
            const bool dead = got < want;
            if (dead && lane == 0) __hip_atomic_store(tmo, 1u, __ATOMIC_RELAXED, __HIP_MEMORY_SCOPE_AGENT);
            __builtin_amdgcn_fence(__ATOMIC_ACQUIRE, "agent");
            if (lane == 0) flag[0] = dead ? 1u : 0u; }
        asm volatile("s_waitcnt vmcnt(0) lgkmcnt(0)" ::: "memory"); __builtin_amdgcn_s_barrier(); asm volatile("" ::: "memory");
        const bool bad = flag[0] != 0u;
        if (wid < 4) { const unsigned long long* sl = (const unsigned long long*)((const unsigned*)part + ((size_t)u.pm * BM + t) * 8); float q = 0.f;
#pragma unroll
            for (int k = 0; k < 4; ++k) { const unsigned long long w = __hip_atomic_load(sl + k, __ATOMIC_RELAXED, __HIP_MEMORY_SCOPE_AGENT); q += __uint_as_float((unsigned)w) + __uint_as_float((unsigned)(w >> 32)); }
            S[t] = 1.0f / sqrtf(q * (1.0f / 2048.0f) + 1e-6f); }
        asm volatile("s_waitcnt vmcnt(0) lgkmcnt(0)" ::: "memory"); __builtin_amdgcn_s_barrier(); asm volatile("" ::: "memory");
        __builtin_amdgcn_sched_barrier(0);
        asm volatile("" : "+v"(fr), "+v"(fq));
        const int row0 = u.pm * BM + wr * 64 + fr, col0 = u.pn * BM + wc * 32 + 8 * fq;
        const PG8_LAS float* vb = (const PG8_LAS float*)(lds + EPI_LDS_OFF + buf * 4096) + wc * 32 + 8 * fq;
        f32x4 gs[2][2], sh[2][2];
#pragma unroll
        for (int bj = 0; bj < 2; ++bj)
#pragma unroll
            for (int n = 0; n < 2; ++n) { gs[bj][n] = *(const PG8_LAS f32x4*)(vb + 256 + bj * HALF + 4 * n) * (*(const PG8_LAS f32x4*)(vb + 512 + bj * HALF + 4 * n) + 1.0f); sh[bj][n] = *(const PG8_LAS f32x4*)(vb + 768 + bj * HALF + 4 * n); }
        const float qnan = __builtin_nanf("");
#pragma unroll
        for (int ai = 0; ai < 2; ++ai)
#pragma unroll
            for (int m = 0; m < 4; ++m) { const float rstd = bad ? qnan : S[ai * HALF + wr * 64 + m * 16 + fr]; const unsigned off = (unsigned)(row0 + ai * HALF + m * 16) * 2048u + (unsigned)col0;
#pragma unroll
                for (int bj = 0; bj < 2; ++bj) { const f32x4 x0 = acc[ai][bj][m][0], x1 = acc[ai][bj][m][1];
                    u32x4 w; w.x = pkh2(x0[0], x0[1]); w.y = pkh2(x0[2], x0[3]); w.z = pkh2(x1[0], x1[1]); w.w = pkh2(x1[2], x1[3]);
                    *(u32x4*)(xnew + off + bj * HALF) = w;
                    const f32x4 h0 = x0 * rstd * gs[bj][0] + sh[bj][0], h1 = x1 * rstd * gs[bj][1] + sh[bj][1];
                    w.x = cvt_pk_bf16(h0[0], h0[1]); w.y = cvt_pk_bf16(h0[2], h0[3]); w.z = cvt_pk_bf16(h1[0], h1[1]); w.w = cvt_pk_bf16(h1[2], h1[3]);
                    *(u32x4*)(hout + off + bj * HALF) = w; } }
    }
};
struct EpiPlain {
    static constexpr bool PERM = true, AFTER_DRAIN = false; static constexpr int PMODE = 1, KSPLIT = 0; static constexpr bool PREF = false;
    bf16_t* O; int ldc;
    __device__ __forceinline__ void operator()(const f32x4 (&acc)[2][2][4][2], const Unit& u, int wr, int wc, int fr, int fq) const {
        const int row0 = u.pm * BM + wr * 64 + fr, col0 = u.pn * BM + wc * 32 + 8 * fq;
#pragma unroll
        for (int ai = 0; ai < 2; ++ai)
#pragma unroll
            for (int m = 0; m < 4; ++m) { bf16_t* rowp = O + (size_t)(row0 + ai * HALF + m * 16) * ldc + col0;
#pragma unroll
                for (int bj = 0; bj < 2; ++bj) { const f32x4 v0 = acc[ai][bj][m][0], v1 = acc[ai][bj][m][1];
                    u32x4 w; w.x = cvt_pk_bf16(v0[0], v0[1]); w.y = cvt_pk_bf16(v0[2], v0[3]); w.z = cvt_pk_bf16(v1[0], v1[1]); w.w = cvt_pk_bf16(v1[2], v1[3]);
                    *(u32x4*)(rowp + bj * HALF) = w; } }
    }
};

struct EpiUpCG {
    static constexpr bool PERM = true, AFTER_DRAIN = false; static constexpr int PMODE = 1, KSPLIT = 0; static constexpr bool PREF = true;
    bf16_t* ACT; bf16_t* GB; const float* cw; const float* cb;
    __device__ __forceinline__ void prefetch(const Unit& u, int buf, PG8_LAS unsigned char* lds, int wid, int lane) const {
        if (wid < 2) { const int v = 2 * wid + (lane >> 5);
            const float* src = (v < 3 ? cw + v * 5632 : cb) + u.pn * 128 + (lane & 31) * 4;
            __builtin_amdgcn_global_load_lds((const unsigned*)src, (PG8_LAS unsigned*)(lds + EPI_LDS_OFF + buf * 2048 + wid * 1024), 16, 0, 0); }
    }
    __device__ __forceinline__ void run(const f32x4 (&acc)[2][2][4][2], const Unit& u, int wr, int wc, int fr, int fq, PG8_LAS unsigned char* lds, int buf) const {
        const int row0 = u.pm * BM + wr * 64 + fr, ch0 = u.pn * 128 + wc * 32 + 8 * fq;
        const PG8_LAS float* vl = (const PG8_LAS float*)(lds + EPI_LDS_OFF + buf * 2048) + wc * 32 + 8 * fq;
        const int lane = fq * 16 + fr, lup = (lane & 48) | ((lane - 1) & 15), ldn = (lane & 48) | ((lane + 1) & 15);
        f32x4 w0[2], w1[2], w2[2], bb[2];
#pragma unroll
        for (int n = 0; n < 2; ++n) { w0[n] = *(const PG8_LAS f32x4*)(vl + 4 * n); w1[n] = *(const PG8_LAS f32x4*)(vl + 128 + 4 * n); w2[n] = *(const PG8_LAS f32x4*)(vl + 256 + 4 * n); bb[n] = *(const PG8_LAS f32x4*)(vl + 384 + 4 * n); }
#pragma unroll
        for (int ai = 0; ai < 2; ++ai) {
            unsigned op[4][2][2];
#pragma unroll
            for (int n = 0; n < 2; ++n)
#pragma unroll
                for (int ep = 0; ep < 2; ++ep) {
                    float ov[4][2], xv[4][2];
#pragma unroll
                    for (int eh = 0; eh < 2; ++eh) { const int e = 2 * ep + eh;
                        float R[4], L[4];
#pragma unroll
                        for (int m = 0; m < 4; ++m) { R[m] = dpp_ror<1>(acc[ai][1][m][n][e]); L[m] = dpp_ror<15>(acc[ai][1][m][n][e]); }
#pragma unroll
                        for (int m = 0; m < 4; ++m) {
                            const float up = (fr == 0) ? R[m > 0 ? m - 1 : 0] : R[m];
                            const float dn = (fr == 15) ? L[m < 3 ? m + 1 : 3] : L[m];
                            xv[m][eh] = up * w0[n][e] + acc[ai][1][m][n][e] * w1[n][e] + dn * w2[n][e] + bb[n][e];
                        } }
#pragma unroll
                    for (int m = 0; m < 4; ++m) {
                        const float p0 = __builtin_amdgcn_exp2f(fminf(-1.4426950408889634f * xv[m][0], 60.0f)) + 1.0f, p1 = __builtin_amdgcn_exp2f(fminf(-1.4426950408889634f * xv[m][1], 60.0f)) + 1.0f;
                        const float r = __builtin_amdgcn_rcpf(p0 * p1);
                        const bool edge = (m == 0 && fr == 0) || (m == 3 && fr == 15);
                        ov[m][0] = edge ? acc[ai][0][m][n][2 * ep] : xv[m][0] * (r * p1) * acc[ai][0][m][n][2 * ep];
                        ov[m][1] = edge ? acc[ai][0][m][n][2 * ep + 1] : xv[m][1] * (r * p0) * acc[ai][0][m][n][2 * ep + 1];
                    }
#pragma unroll
                    for (int m = 0; m < 4; ++m) op[m][n][ep] = cvt_pk_bf16(ov[m][0], ov[m][1]);
                    __builtin_amdgcn_sched_barrier(0);
                }
#pragma unroll
            for (int m = 0; m < 4; ++m) {
                u32x4 w; w.x = op[m][0][0]; w.y = op[m][0][1]; w.z = op[m][1][0]; w.w = op[m][1][1];
                *(u32x4*)(ACT + (size_t)(row0 + ai * HALF + m * 16) * 5632 + ch0) = w;
            }
            const int grp = u.pm * 4 + ai * 2 + wr;
            if (fr <= 1) { const f32x4 g0 = acc[ai][1][0][0], g1 = acc[ai][1][0][1];
                u32x4 w; w.x = cvt_pk_bf16(g0[0], g0[1]); w.y = cvt_pk_bf16(g0[2], g0[3]); w.z = cvt_pk_bf16(g1[0], g1[1]); w.w = cvt_pk_bf16(g1[2], g1[3]);
                *(u32x4*)(GB + ((size_t)(grp * 4 + fr)) * 5632 + ch0) = w; }
            if (fr >= 14) { const f32x4 g0 = acc[ai][1][3][0], g1 = acc[ai][1][3][1];
                u32x4 w; w.x = cvt_pk_bf16(g0[0], g0[1]); w.y = cvt_pk_bf16(g0[2], g0[3]); w.z = cvt_pk_bf16(g1[0], g1[1]); w.w = cvt_pk_bf16(g1[2], g1[3]);
                *(u32x4*)(GB + ((size_t)(grp * 4 + fr - 12)) * 5632 + ch0) = w; }
        }
    }
};

struct EpiG2M {
    static constexpr bool PERM = true, AFTER_DRAIN = false; static constexpr int PMODE = 1, KSPLIT = 1024; static constexpr bool PREF = false;
    const bf16_t* QKG; bf16_t* MB;
    __device__ __forceinline__ void midk(f32x4 (&acc)[2][2][4][2], const Unit& u, int wr, int wc, int fr, int fq) const {
        asm volatile("" : "+v"(fr), "+v"(fq));
        scale<0>(acc, u, wr, wc, fr, fq);
    }
    template <int WHICH> __device__ __forceinline__ void scale(f32x4 (&acc)[2][2][4][2], const Unit& u, int wr, int wc, int fr, int fq) const {
        const int row0 = u.pm * BM + wr * 64 + fr, gcol = 3072 + u.pn * 512 + WHICH * 128 + wc * 32 + 8 * fq;
        u32x4 g[2][4][2];
#pragma unroll
        for (int ai = 0; ai < 2; ++ai)
#pragma unroll
            for (int m = 0; m < 4; ++m)
#pragma unroll
                for (int bj = 0; bj < 2; ++bj) g[ai][m][bj] = *(const u32x4*)(QKG + (size_t)(row0 + ai * HALF + m * 16) * 7168 + gcol + bj * 256);
#pragma unroll
        for (int ai = 0; ai < 2; ++ai)
#pragma unroll
            for (int m = 0; m < 4; ++m)
#pragma unroll
                for (int bj = 0; bj < 2; ++bj) {
                    const unsigned gw[4] = {g[ai][m][bj].x, g[ai][m][bj].y, g[ai][m][bj].z, g[ai][m][bj].w};
#pragma unroll
                    for (int j = 0; j < 4; ++j) { acc[ai][bj][m][j >> 1][(2 * j) & 3] *= bflo(gw[j]); acc[ai][bj][m][j >> 1][(2 * j + 1) & 3] *= bfhi(gw[j]); }
                }
    }
    __device__ __forceinline__ void operator()(f32x4 (&acc)[2][2][4][2], const Unit& u, int wr, int wc, int fr, int fq) const {
        scale<1>(acc, u, wr, wc, fr, fq);
        const int row0 = u.pm * BM + wr * 64 + fr, col0 = u.pn * BM + wc * 32 + 8 * fq;
#pragma unroll
        for (int ai = 0; ai < 2; ++ai)
#pragma unroll
            for (int m = 0; m < 4; ++m)
#pragma unroll
                for (int bj = 0; bj < 2; ++bj) { const f32x4 v0 = acc[ai][bj][m][0], v1 = acc[ai][bj][m][1];
                    u32x4 w; w.x = cvt_pk_bf16(v0[0], v0[1]); w.y = cvt_pk_bf16(v0[2], v0[3]); w.z = cvt_pk_bf16(v1[0], v1[1]); w.w = cvt_pk_bf16(v1[2], v1[3]);
                    *(u32x4*)(MB + (size_t)(row0 + ai * HALF + m * 16) * 2048 + col0 + bj * HALF) = w; }
    }
};
template <class Epi, class Sched, bool ALIGN_EPI = false, bool SP2 = false>
__device__ __forceinline__ void gemm_phase(PG8_LAS unsigned char* lds, const Gemm g, const Sched& S, const Epi& E, const int tid_in) {
    int tid_l = tid_in; asm volatile("" : "+v"(tid_l));
    const int tid = tid_l, wid = __builtin_amdgcn_readfirstlane(tid >> 6), lane = tid & 63, wr = wid >> 2, wc = wid & 3, fr = lane & 15, fq = lane >> 4;
    const int K = g.K, nt = K / BK;
    unsigned voffA[2], voffB[2];
#pragma unroll
    for (int i = 0; i < 2; ++i) { int R, C; stage_rc(tid * 16 + i * 8192, R, C); const int Rb = perm_row<Epi::PMODE>(R);
        voffA[i] = (unsigned)(R * K + C) * 2u; voffB[i] = (unsigned)(Rb * K + C) * 2u; }
    const size_t kstep = (size_t)(BK * 2);
    const size_t hstep = (size_t)HALF * K * 2;
    const size_t tstep = 2 * hstep;
    const unsigned ldsw = (unsigned)wid * 1024u;
    const int aoff = lds_byte(wr * 64 + fr, fq * 8), boff = lds_byte(wc * 32 + fr, fq * 8);
#define PG8_SA(b, h) (((b) * 2 + (h)) * HTB)
#define PG8_SB(b, h) ((4 + (b) * 2 + (h)) * HTB)
#define PG8_STAGE(bufoff, gbase, voff) do { _Pragma("unroll") for (int _i = 0; _i < 2; ++_i) \
        __builtin_amdgcn_global_load_lds((const unsigned*)((const char*)(gbase) + (voff)[_i]), (PG8_LAS unsigned*)(lds + (bufoff) + ldsw + _i * 8192), 16, 0, 0); } while (0)
#define PG8_LDA(dst, b, h) do { _Pragma("unroll") for (int m = 0; m < 4; ++m) _Pragma("unroll") for (int k = 0; k < 2; ++k) dst[m][k] = *(const PG8_LAS bf16x8*)(lds + PG8_SA(b, h) + aoff + m * 2048 + k * 1024); } while (0)
#define PG8_LDB(dst, b, h) do { _Pragma("unroll") for (int n = 0; n < 2; ++n) _Pragma("unroll") for (int k = 0; k < 2; ++k) dst[n][k] = *(const PG8_LAS bf16x8*)(lds + PG8_SB(b, h) + boff + n * 2048 + k * 1024); } while (0)
#define PG8_MMA(ai, bj, At, Bt) do { __builtin_amdgcn_s_setprio(1); _Pragma("unroll") for (int m = 0; m < 4; ++m) _Pragma("unroll") for (int n = 0; n < 2; ++n) _Pragma("unroll") for (int k = 0; k < 2; ++k) \
        acc[ai][bj][m][n] = __builtin_amdgcn_mfma_f32_16x16x32_bf16(Bt[n][k], At[m][k], acc[ai][bj][m][n], 0, 0, 0); __builtin_amdgcn_s_setprio(0); } while (0)
#define PG8_WAIT_V(n) asm volatile("s_waitcnt vmcnt(" #n ")" ::: "memory")
#define PG8_WAIT_L(n) asm volatile("s_waitcnt lgkmcnt(" #n ")" ::: "memory")
#define PG8_BAR __builtin_amdgcn_s_barrier()
#define PG8_SCHED __builtin_amdgcn_sched_barrier(0)
    Unit cur, nxt; int ui = 0;
    if (!S.next(0, cur)) return;
    f32x4 acc[2][2][4][2];
#pragma unroll
    for (int a = 0; a < 2; ++a)
#pragma unroll
        for (int b = 0; b < 2; ++b)
#pragma unroll
            for (int m = 0; m < 4; ++m)
#pragma unroll
                for (int n = 0; n < 2; ++n) acc[a][b][m][n] = (f32x4){0.f, 0.f, 0.f, 0.f};
    bf16x8 At[4][2], B0[2][2], B1[2][2];
    const char* cA = (const char*)g.A + (size_t)cur.pm * tstep; const char* cB = (const char*)g.Bt + (size_t)cur.pn * tstep;
    S.a_ready(cur);
    if constexpr (Epi::PREF) E.prefetch(cur, 0, lds, wid, lane);
    if constexpr (SP2) {
        PG8_STAGE(PG8_SB(0, 0), cB, voffB); PG8_STAGE(PG8_SB(0, 1), cB + hstep, voffB); PG8_STAGE(PG8_SA(0, 0), cA, voffA); PG8_STAGE(PG8_SA(0, 1), cA + hstep, voffA);
        if (wr == 1) PG8_BAR;
        PG8_WAIT_V(2); PG8_BAR;
        PG8_STAGE(PG8_SB(1, 0), cB + kstep, voffB); PG8_STAGE(PG8_SA(1, 0), cA + kstep, voffA); PG8_STAGE(PG8_SB(1, 1), cB + hstep + kstep, voffB);
        PG8_WAIT_V(6); PG8_BAR;
    } else {
        PG8_STAGE(PG8_SB(0, 0), cB, voffB); PG8_STAGE(PG8_SA(0, 0), cA, voffA); PG8_STAGE(PG8_SB(0, 1), cB + hstep, voffB); PG8_STAGE(PG8_SA(0, 1), cA + hstep, voffA);
        if (wr == 1) PG8_BAR;
        PG8_WAIT_V(4); PG8_BAR;
        PG8_STAGE(PG8_SB(1, 0), cB + kstep, voffB); PG8_STAGE(PG8_SA(1, 0), cA + kstep, voffA); PG8_STAGE(PG8_SB(1, 1), cB + hstep + kstep, voffB);
        PG8_WAIT_V(6); PG8_BAR;
    }
    for (;;) {
        const bool has_next = S.next(ui + 1, nxt);
        const char* nA = has_next ? (const char*)g.A + (size_t)nxt.pm * tstep : cA; const char* nB = has_next ? (const char*)g.Bt + (size_t)nxt.pn * tstep : cB;
        for (int t = 0; t < nt; t += 2) {
            if constexpr (Epi::KSPLIT > 0) { if (t == Epi::KSPLIT / BK) E.midk(acc, cur, wr, wc, fr, fq); }
            const bool last = (t == nt - 2);
            const char* a1 = cA + (size_t)(t + 1) * kstep;
            const char* a2 = last ? nA : cA + (size_t)(t + 2) * kstep; const char* b2 = last ? nB : cB + (size_t)(t + 2) * kstep;
            const char* a3 = a2 + kstep; const char* b3 = b2 + kstep;
            if (last && has_next) S.a_ready(nxt);
            if constexpr (SP2) {
            PG8_LDB(B0, 0, 0); PG8_LDB(B1, 0, 1); PG8_SCHED; PG8_LDA(At, 0, 0); PG8_STAGE(PG8_SA(1, 1), a1 + hstep, voffA);
            PG8_WAIT_V(8); PG8_WAIT_L(0); PG8_BAR; PG8_MMA(0, 0, At, B0); PG8_MMA(0, 1, At, B1); PG8_BAR; PG8_SCHED;
            PG8_LDA(At, 0, 1); PG8_STAGE(PG8_SB(0, 0), b2, voffB); PG8_STAGE(PG8_SB(0, 1), b2 + hstep, voffB); PG8_STAGE(PG8_SA(0, 0), a2, voffA);
            PG8_WAIT_V(8); PG8_WAIT_L(0); PG8_BAR; PG8_MMA(1, 0, At, B0); PG8_MMA(1, 1, At, B1); PG8_BAR; PG8_SCHED;
            PG8_LDB(B0, 1, 0); PG8_LDB(B1, 1, 1); PG8_SCHED; PG8_LDA(At, 1, 0); PG8_STAGE(PG8_SA(0, 1), a2 + hstep, voffA);
            PG8_WAIT_V(8); PG8_WAIT_L(0); PG8_BAR; PG8_MMA(0, 0, At, B0); PG8_MMA(0, 1, At, B1); PG8_BAR; PG8_SCHED;
            PG8_LDA(At, 1, 1); PG8_STAGE(PG8_SB(1, 0), b3, voffB); PG8_STAGE(PG8_SB(1, 1), b3 + hstep, voffB); PG8_STAGE(PG8_SA(1, 0), a3, voffA);
            PG8_WAIT_V(8); PG8_WAIT_L(0); PG8_BAR; PG8_MMA(1, 0, At, B0); PG8_MMA(1, 1, At, B1); PG8_BAR; PG8_SCHED;
            } else {
            PG8_LDB(B0, 0, 0); PG8_SCHED; PG8_LDA(At, 0, 0); PG8_STAGE(PG8_SA(1, 1), a1 + hstep, voffA);
            PG8_WAIT_L(8); PG8_BAR; PG8_WAIT_L(0); PG8_MMA(0, 0, At, B0); PG8_BAR; PG8_SCHED;
            PG8_LDB(B1, 0, 1); PG8_STAGE(PG8_SB(0, 0), b2, voffB);
            PG8_BAR; PG8_WAIT_L(0); PG8_MMA(0, 1, At, B1); PG8_BAR;
            PG8_LDA(At, 0, 1); PG8_STAGE(PG8_SA(0, 0), a2, voffA);
            PG8_BAR; PG8_WAIT_L(0); PG8_MMA(1, 0, At, B0); PG8_BAR; PG8_SCHED;
            PG8_STAGE(PG8_SB(0, 1), b2 + hstep, voffB);
            PG8_WAIT_V(6); PG8_BAR; PG8_MMA(1, 1, At, B1); PG8_BAR;
            PG8_LDB(B0, 1, 0); PG8_SCHED; PG8_LDA(At, 1, 0); PG8_STAGE(PG8_SA(0, 1), a2 + hstep, voffA);
            PG8_WAIT_L(8); PG8_BAR; PG8_WAIT_L(0); PG8_MMA(0, 0, At, B0); PG8_BAR; PG8_SCHED;
            PG8_LDB(B1, 1, 1); PG8_STAGE(PG8_SB(1, 0), b3, voffB);
            PG8_BAR; PG8_WAIT_L(0); PG8_MMA(0, 1, At, B1); PG8_BAR;
            PG8_LDA(At, 1, 1); PG8_STAGE(PG8_SA(1, 0), a3, voffA);
            PG8_BAR; PG8_WAIT_L(0); PG8_MMA(1, 0, At, B0); PG8_BAR; PG8_SCHED;
            PG8_STAGE(PG8_SB(1, 1), b3 + hstep, voffB);
            PG8_WAIT_V(6); PG8_BAR; PG8_MMA(1, 1, At, B1); PG8_BAR;
            }
        }
        if constexpr (ALIGN_EPI) { if (wr == 0) PG8_BAR; }
        if constexpr (Epi::PREF) { if (has_next) E.prefetch(nxt, (ui + 1) & 1, lds, wid, lane); E.run(acc, cur, wr, wc, fr, fq, lds, ui & 1); S.done(cur); }
        else if constexpr (!Epi::AFTER_DRAIN) { E(acc, cur, wr, wc, fr, fq); S.done(cur); }
        if (!has_next) break;
#pragma unroll
        for (int a = 0; a < 2; ++a)
#pragma unroll
            for (int b = 0; b < 2; ++b)
#pragma unroll
                for (int m = 0; m < 4; ++m)
#pragma unroll
                    for (int n = 0; n < 2; ++n) acc[a][b][m][n] = (f32x4){0.f, 0.f, 0.f, 0.f};
        cur = nxt; cA = nA; cB = nB; ++ui;
        if constexpr (ALIGN_EPI) { if (wr == 1) PG8_BAR; }
    }
    PG8_WAIT_V(0);
    if constexpr (!ALIGN_EPI) { if (wr == 0) PG8_BAR; }
    PG8_BAR;
    if constexpr (Epi::AFTER_DRAIN) { E.fused(acc, cur, wr, wc, fr, fq, lds, wid, lane); S.done(cur); }
#undef PG8_SA
#undef PG8_SB
#undef PG8_STAGE
#undef PG8_LDA
#undef PG8_LDB
#undef PG8_MMA
#undef PG8_WAIT_V
#undef PG8_WAIT_L
#undef PG8_BAR
#undef PG8_SCHED
}
}

#define XB_TMO      128
#define XB_XCNT(j)  (256  + 64 * (j))
#define XB_XSUB(j)  (1280 + 64 * (j))
#define XB_XGEN(j)  (2304 + 64 * (j))
#define XB_TOP      3328
#define XB_TOPGEN   3392
#define XCD_BAR_WORDS 3456
#define XB_SPIN_CAP (1u << 18)

__device__ __forceinline__ unsigned xb_ld(unsigned* p)              { return __hip_atomic_load(p, __ATOMIC_RELAXED, __HIP_MEMORY_SCOPE_AGENT); }
__device__ __forceinline__ unsigned xb_add(unsigned* p, unsigned v) { return __hip_atomic_fetch_add(p, v, __ATOMIC_RELAXED, __HIP_MEMORY_SCOPE_AGENT); }
__device__ __forceinline__ unsigned xb_xcc_id() { return (unsigned)__builtin_amdgcn_s_getreg((3 << 11) | 20) & 0xFu; }
#define XB_SPIN(cond, bar) do { unsigned _sp = 0; while (cond) { __builtin_amdgcn_s_sleep(1); \
    if ((++_sp & 255u) == 0u) { if (xb_ld(&(bar)[XB_TMO])) break; if (_sp > XB_SPIN_CAP) { atomicAdd(&(bar)[XB_TMO], 1u); break; } } } } while (0)

struct XcdBarrier {
    unsigned* bar; unsigned x;
    volatile LAS unsigned* st;
};

__device__ __forceinline__ XcdBarrier xcd_barrier_post(unsigned* bar, volatile LAS unsigned* st) {
    XcdBarrier b; b.bar = bar; b.x = xb_xcc_id(); b.st = st;
    if (threadIdx.x == 0) (void)xb_add(&bar[XB_XCNT(b.x)], 1u);
    return b;
}
__device__ __forceinline__ void xcd_barrier_complete(unsigned* bar, unsigned x, unsigned& nloc, unsigned& nx) {
    const unsigned G = gridDim.x * gridDim.y * gridDim.z;
    unsigned sum, cnt, mine, sp = 0u;
    for (;;) {
        sum = 0u; cnt = 0u; mine = 0u;
#pragma unroll
        for (unsigned j = 0; j < 16; ++j) { const unsigned c = xb_ld(&bar[XB_XCNT(j)]); sum += c; cnt += (c > 0u) ? 1u : 0u; mine = (j == x) ? c : mine; }
        if (sum == G) break;
        __builtin_amdgcn_s_sleep(1);
        if ((++sp & 255u) == 0u) { if (xb_ld(&bar[XB_TMO])) break; if (sp > XB_SPIN_CAP) { atomicAdd(&bar[XB_TMO], 1u); break; } }
    }
    nloc = mine > 0u ? mine : 1u; nx = cnt > 0u ? cnt : 1u;
}

__device__ __forceinline__ void xcd_barrier(const XcdBarrier& b, const bool leader) {
    asm volatile("s_waitcnt vmcnt(0)" ::: "memory");
    __syncthreads();
    if (leader) {
        unsigned* bar = b.bar;
        __builtin_amdgcn_s_waitcnt(0);
        unsigned nloc = b.st[0], nx = b.st[1];
        if (nloc == 0u) { xcd_barrier_complete(bar, b.x, nloc, nx); b.st[0] = nloc; b.st[1] = nx; }
        const unsigned old = xb_add(&bar[XB_XSUB(b.x)], 1u);
        const unsigned gen = old / nloc;
        if (old + 1u == (gen + 1u) * nloc) {
            __builtin_amdgcn_fence(__ATOMIC_RELEASE, "agent");
            asm volatile("s_waitcnt vmcnt(0)" ::: "memory");
            const unsigned og = xb_add(&bar[XB_TOP], 1u);
            const unsigned tg = og / nx;
            if (og + 1u == (tg + 1u) * nx) xb_add(&bar[XB_TOPGEN], 1u);
            else XB_SPIN(xb_ld(&bar[XB_TOPGEN]) == tg, bar);
            __builtin_amdgcn_fence(__ATOMIC_ACQUIRE, "agent");
            xb_add(&bar[XB_XGEN(b.x)], 1u);
            asm volatile("s_waitcnt vmcnt(0)" ::: "memory");
        } else {
            XB_SPIN(xb_ld(&bar[XB_XGEN(b.x)]) == gen, bar);
            __builtin_amdgcn_fence(__ATOMIC_ACQUIRE, "agent");
            asm volatile("s_waitcnt vmcnt(0)" ::: "memory");
        }
    }
    __syncthreads();
}


constexpr size_t MiB = 1u << 20;
constexpr size_t WS_CTL = 0, CTL_ZERO_BYTES = 1 * MiB;
constexpr size_t WS_MOD = 1 * MiB;
constexpr size_t WS_H2F = 4 * MiB;
constexpr size_t WS_KF = 8 * MiB;
constexpr size_t WS_WIN = 136 * MiB;
constexpr size_t WS_WUP = 320 * MiB;
constexpr size_t WS_WDN = 496 * MiB;
constexpr size_t WS_WOUT = 584 * MiB;
constexpr size_t WS_WBH = 616 * MiB;
constexpr size_t WS_HB = 640 * MiB;
constexpr size_t WS_YHT = 704 * MiB;
constexpr size_t WS_YH = 736 * MiB;
constexpr size_t WS_MB = 784 * MiB;
constexpr size_t WS_ACT = 1522 * MiB;
constexpr size_t WS_UT = 848 * MiB;
constexpr size_t WS_VT = 944 * MiB;
constexpr size_t WS_QKG = 992 * MiB;
constexpr size_t WS_OG = 1216 * MiB;
constexpr size_t WS_LSE = 1264 * MiB;
constexpr size_t WS_GB = 848 * MiB;
constexpr size_t WS_HB2 = 1266 * MiB;
constexpr size_t WS_XB = 1330 * MiB;
constexpr size_t WS_PART = 1698 * MiB;
constexpr size_t WS_END = 1699 * MiB;
constexpr int CW_BAR = 4096, CW_PANEL = 131072  , CW_TMO = CW_PANEL + 64 * 64;
constexpr int LDS_BYTES = 159744, MISC_OFF = 143360; static_assert(MISC_OFF >= 2 * FPAD * 8, "FFT buffers"); static_assert(pg8::EPI_LDS_OFF == MISC_OFF + 1024 && pg8::EPI_LDS_OFF + 13312 + 64 <= LDS_BYTES, "epilogue vector buffers + row-sum exchange tables");
constexpr int N_PHASES = 1 + DEPTH_ * 2 + 1 + DEPTH_ * NCHUNK * 7 + 1 + 1;

#ifndef PG8_ALIGN
#define PG8_ALIGN true
#endif
struct Args { const float* in[29]; float* out; unsigned char* ws; int ph_lo, ph_hi; };

using pg8::bflo; using pg8::bfhi;
__device__ __forceinline__ float wave_sum(float v, int lane) {
#pragma unroll
    for (int o = 1; o < 64; o <<= 1) v += shfl_from(v, lane ^ o);
    return v;
}
__device__ __forceinline__ void transpose_item(const float* W, int K, int N, bf16_t* WT, int k0, int n0, int drow0, LAS float* scr, int lane) {
#pragma unroll 8
    for (int i = 0; i < 32; ++i) { const int kk = 2 * i + (lane >> 5); scr[kk * 33 + (lane & 31)] = W[(size_t)(k0 + kk) * N + n0 + (lane & 31)]; }
    asm volatile("s_waitcnt lgkmcnt(0)" ::: "memory");
    const int c = lane & 7;
#pragma unroll
    for (int j = 0; j < 4; ++j) { const int n = (lane >> 3) + 8 * j; const LAS float* s = scr + (8 * c) * 33 + n;
        u32x4 o; o.x = pk2(s[0 * 33], s[1 * 33]); o.y = pk2(s[2 * 33], s[3 * 33]); o.z = pk2(s[4 * 33], s[5 * 33]); o.w = pk2(s[6 * 33], s[7 * 33]);
        *(u32x4*)(WT + (size_t)(drow0 + n) * K + k0 + 8 * c) = o; }
    asm volatile("s_waitcnt lgkmcnt(0)" ::: "memory");
}
__device__ __forceinline__ int win_dest_row(int n0) {
    if (n0 < 3072) return n0;
    if (n0 < 4608) return n0 + 1536;
    if (n0 < 6144) return n0 + 1536;
    if (n0 < 7680) return n0 - 3072;
    const int g = n0 - 7680, c = g & 2047;
    return 7680 + (c >> 7) * 256 + (g >> 11) * 128 + (c & 127);
}
__device__ __forceinline__ int wup_dest_row(int n0) {
    const int j = (n0 < 5632) ? n0 : n0 - 5632; return (j >> 7) * 256 + ((n0 < 5632) ? 0 : 128) + (j & 127);
}
__device__ __forceinline__ void prologue_phase(const __attribute__((address_space(4))) Args* Ap, LAS unsigned char* lds, int vcu, int G, int tid) {
    const int lane = tid & 63, wave = tid >> 6;
    unsigned char* ws = Ap->ws;
    {
        LAS float* scr = (LAS float*)(lds + wave * 16384);
        const int gw = vcu * 8 + wave, NGW = G * 8;
        constexpr int I_IN = 32 * 368, I_UP = 32 * 352, I_DN = 88 * 64, I_OUT = 32 * 64, I_BH = 16 * 64, I_BA = 8 * 64, I_L = I_IN + I_UP + I_DN + I_OUT + I_BH + I_BA;
        for (int it = gw; it < DEPTH_ * I_L; it += NGW) {
            const int l = it / I_L; int r = it % I_L;
            if (r < I_IN) { const int kb = r / 368, nb = r % 368; transpose_item(Ap->in[7] + (size_t)l * 2048 * 11776, 2048, 11776, (bf16_t*)(ws + WS_WIN) + (size_t)l * 11776 * 2048, 64 * kb, 32 * nb, win_dest_row(32 * nb), scr, lane); continue; } r -= I_IN;
            if (r < I_UP) { const int kb = r / 352, nb = r % 352; transpose_item(Ap->in[24] + (size_t)l * 2048 * 11264, 2048, 11264, (bf16_t*)(ws + WS_WUP) + (size_t)l * 11264 * 2048, 64 * kb, 32 * nb, wup_dest_row(32 * nb), scr, lane); continue; } r -= I_UP;
            if (r < I_DN) { const int kb = r / 64, nb = r % 64; transpose_item(Ap->in[27] + (size_t)l * 5632 * 2048, 5632, 2048, (bf16_t*)(ws + WS_WDN) + (size_t)l * 2048 * 5632, 64 * kb, 32 * nb, 32 * nb, scr, lane); continue; } r -= I_DN;
            if (r < I_OUT) { const int kb = r / 64, nb = r % 64; transpose_item(Ap->in[22] + (size_t)l * 2048 * 2048, 2048, 2048, (bf16_t*)(ws + WS_WOUT) + (size_t)l * 2048 * 2048, 64 * kb, 32 * nb, 32 * nb, scr, lane); continue; } r -= I_OUT;
            if (r < I_BH) { const int kb = r / 64, nb = r % 64; transpose_item(Ap->in[20] + (size_t)l * 1024 * 2048, 1536, 2048, (bf16_t*)(ws + WS_WBH) + (size_t)l * 2048 * 1536, 64 * kb, 32 * nb, 32 * nb, scr, lane); continue; } r -= I_BH;
            { const int kb = r / 64, nb = r % 64; transpose_item(Ap->in[21] + (size_t)l * 512 * 2048, 1536, 2048, (bf16_t*)(ws + WS_WBH) + (size_t)l * 2048 * 1536 + 1024, 64 * kb, 32 * nb, 32 * nb, scr, lane); }
        }
    }
    __syncthreads();
    {
        LAS float* cs = (LAS float*)lds;
        LAS float* red = (LAS float*)(lds + 98304);
        bool loaded = false;
        for (int unit = vcu; unit < DEPTH_ * 192; unit += G) {
            if (!loaded) {
                for (int i = tid; i < 12 * 2048; i += NTHR) { const int b = i >> 11, k = i & 2047; const float c = (b < 4) ? Ap->in[2][b * 2048 + k] : Ap->in[3][(b - 4) * 2048 + k]; cs[i] = c / (1.0f + __expf(-c)); }
                loaded = true; __syncthreads();
            }
            const int l = unit / 192, j = (unit % 192) * 64 + lane;
            const float* wp = Ap->in[4] + ((size_t)l * 2048 + wave * 256) * 12288 + j;
            float acc[12];
#pragma unroll
            for (int b = 0; b < 12; ++b) acc[b] = 0.f;
#pragma unroll 4
            for (int k = 0; k < 256; ++k) { const float w = wp[(size_t)k * 12288];
#pragma unroll
                for (int b = 0; b < 12; ++b) acc[b] += w * cs[b * 2048 + wave * 256 + k]; }
#pragma unroll
            for (int b = 0; b < 12; ++b) red[(wave * 12 + b) * 64 + lane] = acc[b];
            __syncthreads();
            for (int i = tid; i < 12 * 64; i += NTHR) { const int b = i >> 6, jj = i & 63; float s = 0.f;
#pragma unroll
                for (int w = 0; w < 8; ++w) s += red[(w * 12 + b) * 64 + jj];
                const int col = (unit % 192) * 64 + jj;
                ((float*)(ws + WS_MOD))[((size_t)l * 12 + b) * 12288 + col] = s + Ap->in[5][l * 12288 + col]; }
            __syncthreads();
        }
    }
}
template <bool XBF> __device__ __forceinline__ void norm_phase(const void* xv, bf16_t* hout, const float* gn, const float* modb  , int sh_off, int sc_off, int gw, int NGW, int lane, bf16_t* xcopy = nullptr  ) {
    int curb = -1; f32x4 gs[8], sh[8];
    for (int row = gw; row < MROWS; row += NGW) {
        const int b = row >> 12;
        if (b != curb) { curb = b;
#pragma unroll
            for (int j = 0; j < 8; ++j) { const int col = 4 * lane + 256 * j; const f32x4 g = *(const f32x4*)(gn + col), sc = *(const f32x4*)(modb + (size_t)b * 12288 + sc_off + col);
                gs[j] = g * (sc + 1.0f); sh[j] = *(const f32x4*)(modb + (size_t)b * 12288 + sh_off + col); } }
        f32x4 v[8]; float ss = 0.f;
        if constexpr (XBF) {
            const u32x2* xr = (const u32x2*)((const bf16_t*)xv + (size_t)row * 2048) + lane; u32x2 r[8];
#pragma unroll
            for (int j = 0; j < 8; ++j) r[j] = xr[64 * j];
#pragma unroll
            for (int j = 0; j < 8; ++j) { v[j].x = hlo(r[j].x); v[j].y = hhi(r[j].x); v[j].z = hlo(r[j].y); v[j].w = hhi(r[j].y); }
        } else {
            const f32x4* xr = (const f32x4*)((const float*)xv + (size_t)row * 2048) + lane;
#pragma unroll
            for (int j = 0; j < 8; ++j) v[j] = xr[64 * j];
            if (xcopy) { u32x2* c8 = (u32x2*)(xcopy + (size_t)row * 2048) + lane;
#pragma unroll
                for (int j = 0; j < 8; ++j) { u32x2 w; w.x = pkh2(v[j].x, v[j].y); w.y = pkh2(v[j].z, v[j].w); c8[64 * j] = w; } }
        }
#pragma unroll
        for (int j = 0; j < 8; ++j) ss += (v[j].x * v[j].x + v[j].y * v[j].y) + (v[j].z * v[j].z + v[j].w * v[j].w);
        const float rstd = 1.0f / sqrtf(wave_sum(ss, lane) * (1.0f / 2048.0f) + 1e-6f);
        u32x2* o8 = (u32x2*)(hout + (size_t)row * 2048) + lane;
#pragma unroll
        for (int j = 0; j < 8; ++j) { const f32x4 y = v[j] * rstd * gs[j] + sh[j]; u32x2 w; w.x = pk2(y.x, y.y); w.y = pk2(y.z, y.w); o8[64 * j] = w; }
    }
}
__device__ __forceinline__ void final_norm_phase(const bf16_t* xb, float* out, const float* gn, int gw, int NGW, int lane) {
    f32x4 gs[8];
#pragma unroll
    for (int j = 0; j < 8; ++j) gs[j] = *(const f32x4*)(gn + 4 * lane + 256 * j);
    for (int row = gw; row < NSEQ * SEQ; row += NGW) {
        const u32x2* xr = (const u32x2*)(xb + (size_t)row * 2048) + lane; u32x2 r[8];
#pragma unroll
        for (int j = 0; j < 8; ++j) r[j] = xr[64 * j];
        f32x4 v[8]; float ss = 0.f;
#pragma unroll
        for (int j = 0; j < 8; ++j) { v[j].x = hlo(r[j].x); v[j].y = hhi(r[j].x); v[j].z = hlo(r[j].y); v[j].w = hhi(r[j].y);
            ss += (v[j].x * v[j].x + v[j].y * v[j].y) + (v[j].z * v[j].z + v[j].w * v[j].w); }
        const float rstd = 1.0f / sqrtf(wave_sum(ss, lane) * (1.0f / 2048.0f) + 1e-6f);
        f32x4* o = (f32x4*)(out + (size_t)row * 2048) + lane;
#pragma unroll
        for (int j = 0; j < 8; ++j) o[64 * j] = v[j] * rstd * gs[j];
    }
}
__device__ __forceinline__ void transpose_yh_tile(int tile, const bf16_t* YHT, bf16_t* YH, LAS bf16_t* scr, int lane) {
    const int b = tile >> 10, ct = (tile >> 6) & 15, tt = tile & 63, c0 = ct * 64, t0 = tt * 64;
#pragma unroll
    for (int i = 0; i < 8; ++i) { const int row = (lane >> 3) + 8 * i, ch = lane & 7;
        const u32x4 v = *(const u32x4*)(YHT + ((size_t)(b * 1024 + c0 + row)) * 4096 + t0 + 8 * ch);
        LAS bf16_t* d = scr + row * 66 + 8 * ch;
        d[0] = (bf16_t)(v.x & 0xffffu); d[1] = (bf16_t)(v.x >> 16); d[2] = (bf16_t)(v.y & 0xffffu); d[3] = (bf16_t)(v.y >> 16);
        d[4] = (bf16_t)(v.z & 0xffffu); d[5] = (bf16_t)(v.z >> 16); d[6] = (bf16_t)(v.w & 0xffffu); d[7] = (bf16_t)(v.w >> 16); }
    asm volatile("s_waitcnt lgkmcnt(0)" ::: "memory");
    bf16_t* orow = YH + ((size_t)(b * 4096 + t0 + lane)) * 1536 + c0;
#pragma unroll
    for (int j = 0; j < 8; ++j) { u32x4 w; unsigned q[4];
#pragma unroll
        for (int e = 0; e < 4; ++e) q[e] = (unsigned)scr[(8 * j + 2 * e) * 66 + lane] | ((unsigned)scr[(8 * j + 2 * e + 1) * 66 + lane] << 16);
        w.x = q[0]; w.y = q[1]; w.z = q[2]; w.w = q[3]; *(u32x4*)(orow + 8 * j) = w; }
    asm volatile("s_waitcnt lgkmcnt(0)" ::: "memory");
}
__device__ __forceinline__ void cg_fix_item(int idx, bf16_t* ACT, const bf16_t* GB, const float* cw, const float* cb) {
    const int col = (idx % 704) * 8, rs = idx / 704, side = rs & 1, grp = rs >> 1, row = grp * 64 + (side ? 63 : 0), t = row & 4095;
    const bf16_t* gb = GB + (size_t)grp * 4 * 5632 + col;
    u32x4 gm = (u32x4){0u, 0u, 0u, 0u}, gp = (u32x4){0u, 0u, 0u, 0u}, g0;
    if (side == 0) { g0 = *(const u32x4*)gb; gp = *(const u32x4*)(gb + 5632); if (t > 0) gm = *(const u32x4*)(gb - 5632); }
    else { gm = *(const u32x4*)(gb + 2 * 5632); g0 = *(const u32x4*)(gb + 3 * 5632); if (t < 4095) gp = *(const u32x4*)(gb + 4 * 5632); }
    bf16_t* ap = ACT + (size_t)row * 5632 + col;
    const u32x4 a = *(const u32x4*)ap;
    const f32x4 w0a = *(const f32x4*)(cw + col), w0b = *(const f32x4*)(cw + col + 4), w1a = *(const f32x4*)(cw + 5632 + col), w1b = *(const f32x4*)(cw + 5632 + col + 4);
    const f32x4 w2a = *(const f32x4*)(cw + 11264 + col), w2b = *(const f32x4*)(cw + 11264 + col + 4), ba = *(const f32x4*)(cb + col), bb = *(const f32x4*)(cb + col + 4);
    float w0[8] = {w0a.x, w0a.y, w0a.z, w0a.w, w0b.x, w0b.y, w0b.z, w0b.w}, w1[8] = {w1a.x, w1a.y, w1a.z, w1a.w, w1b.x, w1b.y, w1b.z, w1b.w};
    float w2[8] = {w2a.x, w2a.y, w2a.z, w2a.w, w2b.x, w2b.y, w2b.z, w2b.w}, bs[8] = {ba.x, ba.y, ba.z, ba.w, bb.x, bb.y, bb.z, bb.w};
    u32x4 o;
#pragma unroll
    for (int i = 0; i < 4; ++i) {
        const float xl = bflo(gm[i]) * w0[2 * i] + bflo(g0[i]) * w1[2 * i] + bflo(gp[i]) * w2[2 * i] + bs[2 * i];
        const float xh = bfhi(gm[i]) * w0[2 * i + 1] + bfhi(g0[i]) * w1[2 * i + 1] + bfhi(gp[i]) * w2[2 * i + 1] + bs[2 * i + 1];
        const float sl = xl / (1.0f + __expf(-xl)), shh = xh / (1.0f + __expf(-xh));
        o[i] = pk2(sl * bflo(a[i]), shh * bfhi(a[i]));
    }
    *(u32x4*)ap = o;
}

typedef const __attribute__((address_space(4))) Args* kargs_t;
__global__ void __launch_bounds__(512, 2) mega_fwd(Args args) {
    extern __shared__ __attribute__((aligned(16))) unsigned char lds_raw[];
    LAS unsigned char* lds = (LAS unsigned char*)lds_raw;
    const int G = gridDim.x, bx = blockIdx.x, vcu = (G % 8 == 0) ? (bx % 8) * (G / 8) + bx / 8 : bx, NGW = G * 8;
    const int lo = args.ph_lo, hi = args.ph_hi;
    const int wave_s = __builtin_amdgcn_readfirstlane(threadIdx.x >> 6);
    {
        volatile LAS unsigned* MISC = (volatile LAS unsigned*)(lds + MISC_OFF);
        for (int u = threadIdx.x; u < (LDS_BYTES - MISC_OFF) / 4; u += NTHR) MISC[u] = 0u;
        __syncthreads();
    }
    XcdBarrier bar; bar.bar = (unsigned*)(args.ws + WS_CTL) + CW_BAR; bar.x = 0; bar.st = nullptr;
    if (hi - lo > 1) bar = xcd_barrier_post((unsigned*)(args.ws + WS_CTL) + CW_BAR, (volatile LAS unsigned*)(lds + MISC_OFF) + 8);
#ifndef NOBAR_PASSES
#define NOBAR_PASSES 0
#endif
    int pc = 0;
#define IS_T0() ({ int t0_; asm volatile("v_mbcnt_lo_u32_b32 %0, -1, 0\n\tv_mbcnt_hi_u32_b32 %0, -1, %0" : "=v"(t0_)); (t0_ | wave_s) == 0; })
#define PH_IN (pc >= lo && pc < hi)
#define PH_CTX int ptid; asm volatile("v_mbcnt_lo_u32_b32 %0, -1, 0\n\tv_mbcnt_hi_u32_b32 %0, -1, %0" : "=v"(ptid)); ptid |= (wave_s << 6); const int plane = ptid & 63, pwave = __builtin_amdgcn_readfirstlane(ptid >> 6), pgw = vcu * 8 + pwave; (void)plane; (void)pgw; \
    kargs_t ap = (kargs_t)__builtin_amdgcn_kernarg_segment_ptr(); asm volatile("" : "+s"(ap)); unsigned char* const pws = ap->ws; (void)pws; int pl = l, pch = ch; asm volatile("" : "+s"(pl), "+s"(pch)); (void)pl; (void)pch;
#ifndef DUP_MASK
#define DUP_MASK 0
#endif
#ifndef DUP_REP
#define DUP_REP 2
#endif
#ifndef DUP_BAR
#define DUP_BAR 0
#endif
#define DUP(bit) for (int rep_ = 0; rep_ < (((DUP_MASK) & (bit)) ? (DUP_REP) : 1); (void)(((DUP_BAR) && ((DUP_MASK) & (bit)) && rep_ + 1 < (DUP_REP)) ? (xcd_barrier(bar, IS_T0()), 0) : 0), ++rep_)
#ifndef BAR_REP
#define BAR_REP 1
#endif
#define PH_END do { if (pc >= lo && pc + 1 < hi && pass_ == (NOBAR_PASSES)) { for (int br_ = 0; br_ < (BAR_REP); ++br_) xcd_barrier(bar, IS_T0()); } ++pc; } while (0)
#define WSP(T, off) ((T*)(pws + (off)))
#define XO_PTR (WSP(bf16_t, WS_XB) + (size_t)pch * MROWS * 2048)
#define XIN0_PTR ((pch == 0) ? ap->in[0] : ap->in[1] + (size_t)(pch - 1) * MROWS * 2048)
#define MODB_PTR (WSP(const float, WS_MOD) + ((size_t)pl * 12 + pch * 4) * 12288)
#define HB_CUR (((pl * NCHUNK + pch) & 1) ? WSP(bf16_t, WS_HB2) : WSP(bf16_t, WS_HB))

    for (int pass_ = 0; pass_ <= (NOBAR_PASSES); ++pass_) {
    pc = 0;
    if (pass_ > 0 && pass_ == (NOBAR_PASSES)) xcd_barrier(bar, IS_T0());
    { const int l = 0, ch = 0; if (PH_IN) DUP(512) { PH_CTX prologue_phase(ap, lds, vcu, G, ptid); __syncthreads(); } }
    PH_END;
    for (int l = 0; l < DEPTH_; ++l) {
        { const int ch = 0;
          if (PH_IN) DUP(1024) { PH_CTX int pvcu = vcu; asm volatile("" : "+s"(pvcu)); for (int u = pvcu; u < 512; u += G) filt_hidden_unit(u, ap->in[11] + pl * 33 * 64, ap->in[12] + pl * 64, ap->in[13] + pl * 64, ap->in[14] + pl * 64 * 64, ap->in[15] + pl * 64, ap->in[16] + pl * 64, nullptr, WSP(bf16_t, WS_H2F), (LAS float*)lds, ptid); }
          PH_END;
          if (PH_IN) DUP(2048) { PH_CTX int pvcu = vcu; asm volatile("" : "+s"(pvcu)); for (int c2 = pvcu; c2 < 512; c2 += G) filt_channel_unit2(2 * c2, WSP(const bf16_t, WS_H2F), ap->in[17] + (size_t)pl * 64 * 4096, WSP(unsigned, WS_KF), lds, ptid); }
          PH_END; }
        for (int ch = 0; ch < NCHUNK; ++ch) {
            if (l == 0 && ch == 0) {
                if (PH_IN) { PH_CTX norm_phase<false>(XIN0_PTR, WSP(bf16_t, WS_HB), ap->in[6], MODB_PTR, 0, 2048, pgw, NGW, plane, XO_PTR); }
                PH_END;
            }
            if (PH_IN) DUP(2) {
                { PH_CTX const bf16_t* Win = WSP(const bf16_t, WS_WIN) + (size_t)pl * 11776 * 2048;
                  pg8::Gemm g{Win, HB_CUR, 3584, MROWS, 2048}; pg8::StaticOrder S; S.init(3584, MROWS, G, bx); pg8::EpiG1a<0> E{WSP(bf16_t, WS_UT), WSP(bf16_t, WS_VT)};
                  pg8::gemm_phase<pg8::EpiG1a<0>, pg8::StaticOrder, PG8_ALIGN, true>(lds, g, S, E, ptid); }
                { PH_CTX const bf16_t* Win = WSP(const bf16_t, WS_WIN) + (size_t)pl * 11776 * 2048 + (size_t)3584 * 2048;
                  pg8::Gemm g{Win, HB_CUR, 512, MROWS, 2048}; pg8::StaticOrder S; S.init(512, MROWS, G, (bx + G / 2) % G); pg8::EpiG1a<1> E{WSP(bf16_t, WS_UT), WSP(bf16_t, WS_VT)};
                  pg8::gemm_phase<pg8::EpiG1a<1>, pg8::StaticOrder, PG8_ALIGN, true>(lds, g, S, E, ptid); }
                { PH_CTX const bf16_t* Win = WSP(const bf16_t, WS_WIN) + (size_t)pl * 11776 * 2048 + (size_t)4096 * 2048;
                  pg8::Gemm g{Win, HB_CUR, 512, MROWS, 2048}; pg8::StaticOrder S; S.init(512, MROWS, G, bx); pg8::EpiG1a<2> E{WSP(bf16_t, WS_UT), WSP(bf16_t, WS_VT)};
                  pg8::gemm_phase<pg8::EpiG1a<2>, pg8::StaticOrder, PG8_ALIGN, true>(lds, g, S, E, ptid); }
                { PH_CTX const bf16_t* Win = WSP(const bf16_t, WS_WIN) + (size_t)pl * 11776 * 2048;
                  pg8::Gemm g{HB_CUR, Win + (size_t)NA_ * 2048, MROWS, NB_, 2048}; pg8::StaticOrder S; S.init(MROWS, NB_, G, bx); pg8::EpiG1b E{WSP(bf16_t, WS_QKG), ap->in[8] + pl * 4096};
                  pg8::gemm_phase<pg8::EpiG1b, pg8::StaticOrder, PG8_ALIGN, true>(lds, g, S, E, ptid); }
                if (l * NCHUNK + ch + 1 < DEPTH_ * NCHUNK) {
                    PH_CTX
                    const int itn = pl * NCHUNK + pch + 1, ln = itn / NCHUNK, chn = itn % NCHUNK;
                    const bool split = (G == 256);
                    if (!split || bx >= 128) {
                        const int lw = (split ? bx - 128 : bx) * 8 + pwave, nlw = (split ? 128 : G) * 8;
                        bf16_t* hn = (itn & 1) ? WSP(bf16_t, WS_HB2) : WSP(bf16_t, WS_HB); const float* mb = WSP(const float, WS_MOD) + ((size_t)ln * 12 + chn * 4) * 12288;
                        if (ln == 0) norm_phase<false>((chn == 0) ? ap->in[0] : ap->in[1] + (size_t)(chn - 1) * MROWS * 2048, hn, ap->in[6] + ln * 2048, mb, 0, 2048, lw, nlw, plane, WSP(bf16_t, WS_XB) + (size_t)chn * MROWS * 2048);
                        else norm_phase<true>(WSP(bf16_t, WS_XB) + (size_t)chn * MROWS * 2048, hn, ap->in[6] + ln * 2048, mb, 0, 2048, lw, nlw, plane);
                    }
                }
            }
            PH_END;
            if (PH_IN) {
                DUP(4) { PH_CTX
                  hyena_units(vcu, G, WSP(const bf16_t, WS_UT), WSP(bf16_t, WS_YHT), WSP(const unsigned, WS_KF), ap->in[9] + pl * 3 * 3072, ap->in[10] + pl * 3072, ap->in[18] + pl * 2048, lds, ptid, rep_ < (DUP_REP) - 1 && ((DUP_MASK) & 4));
                  __syncthreads(); }
                DUP(8) { PH_CTX
                  attn_bias_table((LAS float*)(lds + AT_TAB_OFF), ap->in[19], ptid);
                  attn_units(vcu, G, 4 * 24 * 16, WSP(const bf16_t, WS_QKG), WSP(const bf16_t, WS_VT), WSP(bf16_t, WS_OG), WSP(float, WS_LSE), lds, ptid);
                  __syncthreads(); }
            }
            PH_END;
            if (PH_IN) DUP(16) {
                PH_CTX
                for (int tile = pgw; tile < 4096; tile += NGW) transpose_yh_tile(tile, WSP(const bf16_t, WS_YHT), WSP(bf16_t, WS_YH), (LAS bf16_t*)(lds + pwave * 8448), plane);
                for (int it = bx * NTHR + ptid; it < MROWS * 64; it += G * NTHR) attn_combine_item(it, WSP(const bf16_t, WS_OG), WSP(const float, WS_LSE), WSP(bf16_t, WS_YH), 1536, 1024);
                __syncthreads();
            }
            PH_END;
            if (PH_IN) DUP(32) { PH_CTX pg8::Gemm g{WSP(const bf16_t, WS_YH), WSP(const bf16_t, WS_WBH) + (size_t)pl * 2048 * 1536, MROWS, 2048, 1536}; pg8::StaticOrder S; S.init(MROWS, 2048, G, bx);
                pg8::EpiG2M E{WSP(const bf16_t, WS_QKG), WSP(bf16_t, WS_MB)};
                pg8::gemm_phase<pg8::EpiG2M, pg8::StaticOrder, PG8_ALIGN, true>(lds, g, S, E, ptid); }
            PH_END;
            if (PH_IN) { PH_CTX pg8::Gemm g{WSP(const bf16_t, WS_MB), WSP(const bf16_t, WS_WOUT) + (size_t)pl * 2048 * 2048, MROWS, 2048, 2048};
                pg8::PanelOrder S; S.init(MROWS, 2048, G, bx);
                pg8::EpiResN<false> E{nullptr, XO_PTR, XO_PTR, HB_CUR, MODB_PTR, ap->in[23] + pl * 2048, 2 * 2048, WSP(float, WS_PART), (unsigned*)(pws + WS_CTL) + CW_PANEL, 32u * (unsigned)(pl * NCHUNK + pch + 1), (unsigned*)(pws + WS_CTL) + CW_TMO};
                pg8::gemm_phase<pg8::EpiResN<false>, pg8::PanelOrder, PG8_ALIGN, true>(lds, g, S, E, ptid); }
            PH_END;
            if (PH_IN) DUP(128) { PH_CTX pg8::Gemm g{HB_CUR, WSP(const bf16_t, WS_WUP) + (size_t)pl * 11264 * 2048, MROWS, 11264, 2048}; pg8::StaticOrder S; S.init(MROWS, 11264, G, bx); pg8::EpiUpCG E{WSP(bf16_t, WS_ACT), WSP(bf16_t, WS_GB), ap->in[25] + (size_t)pl * 3 * 5632, ap->in[26] + pl * 5632};
                pg8::gemm_phase<pg8::EpiUpCG, pg8::StaticOrder, PG8_ALIGN, true>(lds, g, S, E, ptid); }
            PH_END;
            if (PH_IN) { PH_CTX for (int it = bx * NTHR + ptid; it < 256 * 2 * 704; it += G * NTHR) cg_fix_item(it, WSP(bf16_t, WS_ACT), WSP(const bf16_t, WS_GB), ap->in[25] + (size_t)pl * 3 * 5632, ap->in[26] + pl * 5632); }
            PH_END;
            if (PH_IN) DUP(8192) { PH_CTX pg8::Gemm g{WSP(const bf16_t, WS_ACT), WSP(const bf16_t, WS_WDN) + (size_t)pl * 2048 * 5632, MROWS, 2048, 5632}; pg8::StaticOrder S; S.init(MROWS, 2048, G, bx);
                pg8::EpiResB<false> E{nullptr, XO_PTR, (((DUP_MASK) & 8192) && rep_ < (DUP_REP) - 1) ? WSP(bf16_t, WS_YHT) : XO_PTR, MODB_PTR + 5 * 2048};
                pg8::gemm_phase<pg8::EpiResB<false>, pg8::StaticOrder, PG8_ALIGN, true>(lds, g, S, E, ptid); }
            if (l == DEPTH_ - 1 && ch == NCHUNK - 1) PH_END;
        }
    }
    { const int l = 0, ch = 0; if (PH_IN) { PH_CTX final_norm_phase(WSP(const bf16_t, WS_XB), ap->out, ap->in[28], pgw, NGW, plane); } }
    PH_END;
    }
#undef PH_IN
#undef PH_CTX
#undef PH_END
#undef DUP
}

#ifndef MK_LAUNCH_PER_PHASE
#define MK_LAUNCH_PER_PHASE 0
#endif
extern "C" void kernel_launch(void* const* d_in, const int* in_sizes, int n_in, void* d_out, int out_size, void* d_ws, size_t ws_size, hipStream_t stream) {
    static int grid = 0;
    if (grid == 0) {
        if (n_in != 29 || out_size != NSEQ * SEQ * 2048 || ws_size < WS_END) { fprintf(stderr, "kernel_launch: unexpected sizes n_in %d out %d ws %zu\n", n_in, out_size, ws_size); grid = -1; return; }
        int dev = 0, cus = 0, per_cu = 0;
        if (hipGetDevice(&dev) != hipSuccess || hipDeviceGetAttribute(&cus, hipDeviceAttributeMultiprocessorCount, dev) != hipSuccess) { grid = -1; return; }
        if (hipFuncSetAttribute((const void*)mega_fwd, hipFuncAttributeMaxDynamicSharedMemorySize, LDS_BYTES) != hipSuccess) { fprintf(stderr, "kernel_launch: hipFuncSetAttribute failed\n"); grid = -1; return; }
        if (hipOccupancyMaxActiveBlocksPerMultiprocessor(&per_cu, (const void*)mega_fwd, 512, LDS_BYTES) != hipSuccess || per_cu < 1) fprintf(stderr, "kernel_launch: occupancy query says %d\n", per_cu);
        (void)hipGetLastError();
        grid = cus >= 256 ? 256 : cus >= 128 ? 128 : cus >= 64 ? 64 : -1;
        if (grid < 0) { fprintf(stderr, "kernel_launch: %d CUs\n", cus); return; }
    }
    if (grid < 0) return;
    (void)hipMemsetAsync((char*)d_ws + WS_CTL, 0, CTL_ZERO_BYTES, stream);
    Args a{};
    for (int i = 0; i < 29; ++i) a.in[i] = (const float*)d_in[i];
    a.out = (float*)d_out; a.ws = (unsigned char*)d_ws;
#if MK_LAUNCH_PER_PHASE
    for (int p = 0; p < N_PHASES; ++p) { a.ph_lo = p; a.ph_hi = p + 1; hipLaunchKernelGGL(mega_fwd, dim3(grid), dim3(512), LDS_BYTES, stream, a); }
#else
    a.ph_lo = 0; a.ph_hi = N_PHASES; hipLaunchKernelGGL(mega_fwd, dim3(grid), dim3(512), LDS_BYTES, stream, a);
#endif
}
```

```cpp
#include <hip/hip_runtime.h>
#include <cstdio>
#include <cstdint>
#define DEV __device__ __forceinline__
#define DEVCONST __device__
#define LAS __attribute__((address_space(3)))
#define SYNC() __syncthreads()
#define F2U(x) __float_as_uint(x)
#define U2F(x) __uint_as_float(x)
#define BITCAST(T, v) __builtin_bit_cast(T, v)
#define EXP2(x) __builtin_amdgcn_exp2f(x)
#define LOG2(x) __builtin_amdgcn_logf(x)
#define SINCOSPI(x, s, c) do { const float hx_ = 0.5f * (x); *(s) = __builtin_amdgcn_sinf(hx_); *(c) = __builtin_amdgcn_cosf(hx_); } while (0)
__device__ __forceinline__ float shfl_from(float v, int src_lane) { return __builtin_bit_cast(float, __builtin_amdgcn_ds_bpermute(src_lane << 2, __builtin_bit_cast(int, v))); }
#define SHFL_XOR3(v, m, lane) shfl_from((v), (lane) ^ (m))
template <int N> __device__ __forceinline__ float dpp_ror(float v) { return __builtin_bit_cast(float, __builtin_amdgcn_update_dpp(0, __builtin_bit_cast(int, v), 0x120 + N, 0xf, 0xf, false)); }
#define MFMA32(a, b, c) __builtin_amdgcn_mfma_f32_32x32x16_bf16((a), (b), (c), 0, 0, 0)
#define OPAQUE_I(x) asm volatile("" : "+v"(x))

typedef _Float16 h16x2_t __attribute__((ext_vector_type(2)));
__device__ __forceinline__ unsigned pkh2(float a, float b) { h16x2_t h; h.x = (_Float16)a; h.y = (_Float16)b; return __builtin_bit_cast(unsigned, h); }
__device__ __forceinline__ float hlo(unsigned w) { return (float)__builtin_bit_cast(h16x2_t, w).x; }
__device__ __forceinline__ float hhi(unsigned w) { return (float)__builtin_bit_cast(h16x2_t, w).y; }
constexpr int D_ = 2048, SEQ = 4096, NSEQ = 12, DEPTH_ = 4, CHS = 4  , NCHUNK = 3, MROWS = CHS * SEQ  ;
constexpr int HW_ = 1024, AW_ = 1536, AO_ = 512, DFF_ = 5632, INC_ = 11776, NMOD_ = 6;
constexpr int NA_ = 4608  , NB_ = 7168  ;
constexpr int FFTN = 8192, FPAD = FFTN + FFTN / 16  ;
constexpr int NTHR = 512;

typedef unsigned short bf16_t;
typedef short bf16x8 __attribute__((ext_vector_type(8)));
typedef float f32x4 __attribute__((ext_vector_type(4)));
typedef float f32x16 __attribute__((ext_vector_type(16)));
typedef float cf __attribute__((ext_vector_type(2)));
typedef unsigned u32x4 __attribute__((ext_vector_type(4)));
typedef unsigned u32x2 __attribute__((ext_vector_type(2)));
typedef unsigned short u16x4 __attribute__((ext_vector_type(4)));

DEV unsigned short f2bf(float f) { unsigned u = F2U(f); u += 0x7fffu + ((u >> 16) & 1u); return (unsigned short)(u >> 16); }
DEV float bf2f(unsigned short b) { return U2F(((unsigned)b) << 16); }
DEV unsigned pk2(float lo, float hi) { return (unsigned)f2bf(lo) | ((unsigned)f2bf(hi) << 16); }

DEVCONST constexpr float C8T[9] = {1.0f, 0.980785280403230449f, 0.923879532511286756f, 0.831469612302545237f, 0.707106781186547524f, 0.555570233019602225f, 0.382683432365089772f, 0.195090322016128268f, 0.0f};
DEV constexpr float tw_cos(int m) { m &= 31; return m <= 8 ? C8T[m] : (m <= 16 ? -C8T[16 - m] : (m <= 24 ? -C8T[m - 16] : C8T[32 - m])); }
DEV constexpr float tw_sin(int m) { return tw_cos(m - 8); }
DEVCONST constexpr int BR16[16] = {0, 8, 4, 12, 2, 10, 6, 14, 1, 9, 5, 13, 3, 11, 7, 15};
DEVCONST constexpr int BR32[32] = {0, 16, 8, 24, 4, 20, 12, 28, 2, 18, 10, 26, 6, 22, 14, 30, 1, 17, 9, 25, 5, 21, 13, 29, 3, 19, 11, 27, 7, 23, 15, 31};
#ifdef EMU
DEV cf cmul(cf a, cf b) { return cf{a.x * b.x - a.y * b.y, a.x * b.y + a.y * b.x}; }
DEV cf cmulc(cf a, cf b) { return cf{a.x * b.x + a.y * b.y, a.y * b.x - a.x * b.y}; }
#else
DEV cf cmul(cf a, cf b) { cf r, t;
    asm("v_pk_mul_f32 %1, %2, %3 op_sel:[1,1] op_sel_hi:[1,0] neg_lo:[1,0]\n\tv_pk_fma_f32 %0, %2, %3, %1 op_sel_hi:[0,1,1]" : "=v"(r), "=&v"(t) : "v"(a), "v"(b));
    return r; }
DEV cf cmulc(cf a, cf b) { cf r, t;
    asm("v_pk_mul_f32 %1, %2, %3 op_sel:[1,1] op_sel_hi:[1,0]\n\tv_pk_fma_f32 %0, %2, %3, %1 op_sel_hi:[0,1,1] neg_hi:[1,0,0]" : "=v"(r), "=&v"(t) : "v"(a), "v"(b));
    return r; }
#endif
template <int R, bool INV> DEV void dft_regs(cf (&v)[R]) {
#pragma unroll
    for (int s = R; s >= 2; s >>= 1) {
        const int h = s >> 1;
#pragma unroll
        for (int b = 0; b < R; b += s) {
#pragma unroll
            for (int k = 0; k < h; ++k) {
                const cf a = v[b + k], c = v[b + k + h];
                v[b + k] = a + c;
                const cf d = a - c;
                const int m = k * (32 / s);
                const float wr = tw_cos(m), wi = INV ? tw_sin(m) : -tw_sin(m);
                v[b + k + h] = cf{d.x * wr - d.y * wi, d.x * wi + d.y * wr};
            }
        }
    }
}
DEV int PADI(int i) { return i + (i >> 4); }
DEV int fpos(int k) { return ((k & 15) << 9) | (((k >> 4) & 31) << 4) | (k >> 9); }
DEV int fnat(int p) { return (p >> 9) | (((p >> 4) & 31) << 4) | ((p & 15) << 9); }

DEV void fft_f1(LAS cf* buf, const cf (&z)[8], int tid) {
    OPAQUE_I(tid);
    cf v[16];
#pragma unroll
    for (int q = 0; q < 8; ++q) { v[q] = z[q]; v[q + 8] = cf{0.f, 0.f}; }
    dft_regs<16, false>(v);
    float sn, cs; SINCOSPI(-(float)tid * (2.0f / 8192.0f), &sn, &cs);
    const cf w = cf{cs, sn}; cf wp = cf{1.f, 0.f};
#pragma unroll
    for (int p = 0; p < 16; ++p) { buf[PADI(tid + 512 * p)] = cmul(v[BR16[p]], wp); wp = cmul(wp, w); }
}
DEV void fft_f1x2(LAS cf* buf0, LAS cf* buf1, const cf (&z0)[8], const cf (&z1)[8], int tid) {
    OPAQUE_I(tid);
    cf v[16], u[16];
#pragma unroll
    for (int q = 0; q < 8; ++q) { v[q] = z0[q]; v[q + 8] = cf{0.f, 0.f}; u[q] = z1[q]; u[q + 8] = cf{0.f, 0.f}; }
    dft_regs<16, false>(v); dft_regs<16, false>(u);
    float sn, cs; SINCOSPI(-(float)tid * (2.0f / 8192.0f), &sn, &cs);
    const cf w = cf{cs, sn}; cf wp = cf{1.f, 0.f};
    LAS cf* p0 = buf0 + PADI(tid); LAS cf* p1 = buf1 + PADI(tid);
#pragma unroll
    for (int p = 0; p < 16; ++p) { p0[544 * p] = cmul(v[BR16[p]], wp); p1[544 * p] = cmul(u[BR16[p]], wp); wp = cmul(wp, w); }
}
DEV void fft_i1x2(LAS cf* buf0, LAS cf* buf1, cf (&y0)[8], cf (&y1)[8], int tid) {
    OPAQUE_I(tid);
    float sn, cs; SINCOSPI(-(float)tid * (2.0f / 8192.0f), &sn, &cs);
    const cf w = cf{cs, sn}; cf wp = cf{1.f, 0.f};
    cf v[16], u[16];
    const LAS cf* p0 = buf0 + PADI(tid); const LAS cf* p1 = buf1 + PADI(tid);
#pragma unroll
    for (int p = 0; p < 16; ++p) { v[p] = cmulc(p0[544 * p], wp); u[p] = cmulc(p1[544 * p], wp); wp = cmul(wp, w); }
    dft_regs<16, true>(v); dft_regs<16, true>(u);
#pragma unroll
    for (int q = 0; q < 8; ++q) { y0[q] = v[BR16[q]]; y1[q] = u[BR16[q]]; }
}
DEV void fft_f2(LAS cf* buf, int t8) {
    OPAQUE_I(t8);
    LAS cf* pb = buf + (t8 >> 4) * 544 + (t8 & 15);
    cf v[32];
#pragma unroll
    for (int q = 0; q < 32; ++q) v[q] = pb[17 * q];
    dft_regs<32, false>(v);
    float sn, cs; SINCOSPI(-(float)(t8 & 15) * (2.0f / 512.0f), &sn, &cs);
    const cf w = cf{cs, sn}; cf wp = cf{1.f, 0.f};
#pragma unroll
    for (int p = 0; p < 32; ++p) { pb[17 * p] = cmul(v[BR32[p]], wp); wp = cmul(wp, w); }
}
DEV cf kunpack(unsigned w) { return cf{U2F(w << 16), U2F(w & 0xffff0000u)}; }
template <bool MULK> DEV void fft_mid(LAS cf* buf, const unsigned* Kp, int blk) {
    const int base = 16 * blk;
    cf v[16];
#pragma unroll
    for (int q = 0; q < 16; ++q) v[q] = buf[PADI(base + q)];
    dft_regs<16, false>(v);
    if (MULK) {
        cf w[16];
#pragma unroll
        for (int p = 0; p < 16; ++p) w[p] = cmul(v[BR16[p]], kunpack(Kp[base + p]));
        dft_regs<16, true>(w);
#pragma unroll
        for (int q = 0; q < 16; ++q) buf[PADI(base + q)] = w[BR16[q]];
    } else {
#pragma unroll
        for (int p = 0; p < 16; ++p) buf[PADI(base + p)] = v[BR16[p]];
    }
}
DEV void fft_midx2(LAS cf* buf0, LAS cf* buf1, const unsigned* Kp, int blk) {
    const int base = 16 * blk;
    LAS cf* p0 = buf0 + 17 * blk; LAS cf* p1 = buf1 + 17 * blk;
    cf v[16], u[16];
#pragma unroll
    for (int q = 0; q < 16; ++q) { v[q] = p0[q]; u[q] = p1[q]; }
    dft_regs<16, false>(v); dft_regs<16, false>(u);
    cf w[16], x[16];
    u32x4 kw[4];
#pragma unroll
    for (int j = 0; j < 4; ++j) kw[j] = *(const u32x4*)(Kp + base + 4 * j);
#pragma unroll
    for (int p = 0; p < 16; ++p) { const cf k = kunpack(kw[p >> 2][p & 3]); w[p] = cmul(v[BR16[p]], k); x[p] = cmul(u[BR16[p]], k); }
    dft_regs<16, true>(w); dft_regs<16, true>(x);
#pragma unroll
    for (int q = 0; q < 16; ++q) { p0[q] = w[BR16[q]]; p1[q] = x[BR16[q]]; }
}
DEV void fft_i2(LAS cf* buf, int t8) {
    OPAQUE_I(t8);
    LAS cf* pb = buf + (t8 >> 4) * 544 + (t8 & 15);
    float sn, cs; SINCOSPI(-(float)(t8 & 15) * (2.0f / 512.0f), &sn, &cs);
    const cf w = cf{cs, sn}; cf wp = cf{1.f, 0.f};
    cf v[32];
#pragma unroll
    for (int p = 0; p < 32; ++p) { v[p] = cmulc(pb[17 * p], wp); wp = cmul(wp, w); }
    dft_regs<32, true>(v);
#pragma unroll
    for (int q = 0; q < 32; ++q) pb[17 * q] = v[BR32[q]];
}
DEV void fft_i1(LAS cf* buf, cf (&y)[8], int tid) {
    OPAQUE_I(tid);
    float sn, cs; SINCOSPI(-(float)tid * (2.0f / 8192.0f), &sn, &cs);
    const cf w = cf{cs, sn}; cf wp = cf{1.f, 0.f};
    cf v[16];
#pragma unroll
    for (int p = 0; p < 16; ++p) { v[p] = cmulc(buf[PADI(tid + 512 * p)], wp); wp = cmul(wp, w); }
    dft_regs<16, true>(v);
#pragma unroll
    for (int q = 0; q < 8; ++q) y[q] = v[BR16[q]];
}

DEV void filt_hidden_unit(int unit, const float* w1, const float* b1, const float* fr1, const float* w2, const float* b2, const float* fr2, float* h2out  , bf16_t* h2b  , LAS float* sm, int tid) {
    LAS float* feat = sm;
    LAS float* h1 = sm + 8 * 33;
    const int tl = tid >> 6, j = tid & 63, t = unit * 8 + tl;
    if (tid < 8 * 33) {
        const int tt = tid / 33, f = tid % 33, tp = unit * 8 + tt;
        float val;
        if (f == 0) val = (float)tp * (1.0f / 4095.0f);
        else { const int k = (f - 1) & 15; const float band = 1e-4f + (float)k * ((15.0f - 1e-4f) / 15.0f);
               const float xr = (float)tp * band * (1.0f / 4096.0f), fr = xr - floorf(xr);
               float sn, cs; SINCOSPI(2.0f * fr, &sn, &cs);
               val = (f <= 16) ? cs : -sn; }
        feat[tt * 33 + f] = val;
    }
    SYNC();
    { float a = b1[j];
#pragma unroll 11
      for (int f = 0; f < 33; ++f) a += feat[tl * 33 + f] * w1[f * 64 + j];
      h1[tl * 64 + j] = sinf(fr1[j] * a); }
    SYNC();
    { float a = b2[j];
#pragma unroll 16
      for (int i = 0; i < 64; ++i) a += h1[tl * 64 + i] * w2[i * 64 + j];
      const float hv = sinf(fr2[j] * a); if (h2out) h2out[j * 4096 + t] = hv; h2b[t * 64 + j] = f2bf(hv); }
    SYNC();
}
DEV void filt_channel_unit(int c, const float* h2, const float* w3, unsigned* KF, LAS unsigned char* lds, int tid) {
    LAS cf* buf = (LAS cf*)lds;
    LAS float* sw = (LAS float*)(lds + FPAD * 8);
    LAS float* red = sw + 256;
    if (tid < 256) { const int i = tid >> 2, q = tid & 3; sw[tid] = w3[i * 4096 + q * 1024 + c]; }
    SYNC();
    const float dmin = -3.0701134573253947f, dmax = -15.350567286626973f;
    const float delta = fabsf(dmin + (float)c * ((dmax - dmin) / 1023.0f));
    float s0 = 0.f, s1 = 0.f;
#pragma unroll 1
    for (int i = 0; i < 8; ++i) {
        const int t = tid + 512 * i;
        const float* hc = h2 + t;
        float a0 = 0.f, a1 = 0.f, a2 = 0.f, a3 = 0.f;
        float xv[64];
#pragma unroll
        for (int k = 0; k < 64; ++k) xv[k] = hc[k * 4096];
#pragma unroll
        for (int k = 0; k < 64; ++k) { const f32x4 w = *(const LAS f32x4*)(sw + k * 4); a0 += xv[k] * w.x; a1 += xv[k] * w.y; a2 += xv[k] * w.z; a3 += xv[k] * w.w; }
        const float dec = expf(-((float)t * (1.0f / 4095.0f)) * delta);
        a0 *= dec; a1 *= dec; a2 *= dec; a3 *= dec;
        s0 += fabsf(a0); s1 += fabsf(a1);
        buf[PADI(t)] = cf{a0, a1};
        if (t > 0) { s0 += fabsf(a2); s1 += fabsf(a3); buf[PADI(8192 - t)] = cf{a2, a3}; }
        else buf[PADI(4096)] = cf{a2 * 0.f, a3 * 0.f};
    }
#pragma unroll
    for (int o = 1; o < 64; o <<= 1) { s0 += SHFL_XOR3(s0, o, tid & 63); s1 += SHFL_XOR3(s1, o, tid & 63); }
    if ((tid & 63) == 0) { red[(tid >> 6) * 2] = s0; red[(tid >> 6) * 2 + 1] = s1; }
    SYNC();
    float t0 = 0.f, t1 = 0.f;
#pragma unroll
    for (int w = 0; w < 8; ++w) { t0 += red[w * 2]; t1 += red[w * 2 + 1]; }
    const cf inrm = cf{1.0f / t0, 1.0f / t1};
    {
        OPAQUE_I(tid);
        cf v[16];
#pragma unroll
        for (int q = 0; q < 16; ++q) v[q] = buf[PADI(tid + 512 * q)] * inrm;
        dft_regs<16, false>(v);
        float sn, cs; SINCOSPI(-(float)tid * (2.0f / 8192.0f), &sn, &cs);
        const cf w = cf{cs, sn}; cf wp = cf{1.f, 0.f};
#pragma unroll
        for (int p = 0; p < 16; ++p) { buf[PADI(tid + 512 * p)] = cmul(v[BR16[p]], wp); wp = cmul(wp, w); }
    }
    SYNC();
    if (tid < 256) fft_f2(buf, tid);
    SYNC();
    fft_mid<false>(buf, nullptr, tid);
    SYNC();
    const float sc = 0.5f / 8192.0f;
#pragma unroll
    for (int i = 0; i < 16; ++i) {
        const int p = tid + 512 * i, k = fnat(p), p2 = fpos((8192 - k) & 8191);
        const cf a = buf[PADI(p)], b = buf[PADI(p2)];
        KF[((size_t)c * 2 + 0) * 8192 + p] = pk2((a.x + b.x) * sc, (a.y - b.y) * sc);
        KF[((size_t)c * 2 + 1) * 8192 + p] = pk2((a.y + b.y) * sc, (b.x - a.x) * sc);
    }
    SYNC();
}

DEV void filt_channel_unit2(int c, const bf16_t* h2b, const float* w3, unsigned* KF, LAS unsigned char* lds, int tid) {
    LAS cf* buf0 = (LAS cf*)lds; LAS cf* buf1 = buf0 + FPAD;
    int swo = 2 * FPAD * 8 + 1024; OPAQUE_I(swo);
    LAS float* sw = (LAS float*)(lds + swo);
    LAS float* red = sw + 512;
    { const int i = tid >> 3, q = tid & 7; sw[tid] = w3[i * 4096 + (q & 3) * 1024 + c + (q >> 2)]; }
    SYNC();
    const float dmin = -3.0701134573253947f, dmax = -15.350567286626973f;
    const int lane = tid & 63, wave = tid >> 6, n = lane & 31, hl = lane >> 5;
    const float delta = fabsf(dmin + (float)(c + hl) * ((dmax - dmin) / 1023.0f));
    bf16x8 wa[4];
#pragma unroll
    for (int ks = 0; ks < 4; ++ks) { float wv[8];
#pragma unroll
        for (int j = 0; j < 8; ++j) { const float x = sw[(16 * ks + 8 * hl + j) * 8 + (n & 7)]; wv[j] = (n < 8) ? x : 0.f; }
        u32x4 w; w.x = pk2(wv[0], wv[1]); w.y = pk2(wv[2], wv[3]); w.z = pk2(wv[4], wv[5]); w.w = pk2(wv[6], wv[7]); wa[ks] = BITCAST(bf16x8, w); }
    LAS cf* bufc = hl ? buf1 : buf0;
    float s[2] = {0.f, 0.f};
#pragma unroll 1
    for (int g = 0; g < 4; ++g) {
        bf16x8 hb[4][4];
#pragma unroll
        for (int i = 0; i < 4; ++i) { const int t = 32 * (wave * 16 + 4 * g + i) + n;
#pragma unroll
            for (int ks = 0; ks < 4; ++ks) hb[i][ks] = *(const bf16x8*)(h2b + t * 64 + 16 * ks + 8 * hl); }
#pragma unroll
        for (int i = 0; i < 4; ++i) { const int t = 32 * (wave * 16 + 4 * g + i) + n;
            f32x16 acc;
#pragma unroll
            for (int r = 0; r < 16; ++r) acc[r] = 0.f;
#pragma unroll
            for (int ks = 0; ks < 4; ++ks) acc = MFMA32(wa[ks], hb[i][ks], acc);
            const float dec = expf(-(float)t * (1.0f / 4095.0f) * delta);
            const float a0 = acc[0] * dec, a1 = acc[1] * dec, a2 = acc[2] * dec, a3 = acc[3] * dec;
            s[0] += fabsf(a0); s[1] += fabsf(a1);
            bufc[PADI(t)] = cf{a0, a1};
            if (t > 0) { s[0] += fabsf(a2); s[1] += fabsf(a3); bufc[PADI(8192 - t)] = cf{a2, a3}; }
            else bufc[PADI(4096)] = cf{a2 * 0.f, a3 * 0.f};
        }
    }
#pragma unroll
    for (int o = 1; o < 32; o <<= 1) { s[0] += SHFL_XOR3(s[0], o, lane); s[1] += SHFL_XOR3(s[1], o, lane); }
    if (n == 0) { red[wave * 4 + 2 * hl] = s[0]; red[wave * 4 + 2 * hl + 1] = s[1]; }
    SYNC();
    float tt[4] = {0.f, 0.f, 0.f, 0.f};
#pragma unroll
    for (int w = 0; w < 8; ++w)
#pragma unroll
        for (int q = 0; q < 4; ++q) tt[q] += red[w * 4 + q];
    const cf in0 = cf{1.0f / tt[0], 1.0f / tt[1]}, in1 = cf{1.0f / tt[2], 1.0f / tt[3]};
    {
        OPAQUE_I(tid);
        cf v[16], u[16];
#pragma unroll
        for (int q = 0; q < 16; ++q) { v[q] = buf0[PADI(tid + 512 * q)] * in0; u[q] = buf1[PADI(tid + 512 * q)] * in1; }
        dft_regs<16, false>(v); dft_regs<16, false>(u);
        float sn, cs; SINCOSPI(-(float)tid * (2.0f / 8192.0f), &sn, &cs);
        const cf w = cf{cs, sn}; cf wp = cf{1.f, 0.f};
#pragma unroll
        for (int p = 0; p < 16; ++p) { buf0[PADI(tid + 512 * p)] = cmul(v[BR16[p]], wp); buf1[PADI(tid + 512 * p)] = cmul(u[BR16[p]], wp); wp = cmul(wp, w); }
    }
    SYNC();
    fft_f2((tid >> 8) ? buf1 : buf0, tid & 255);
    SYNC();
    fft_mid<false>(buf0, nullptr, tid); fft_mid<false>(buf1, nullptr, tid);
    SYNC();
    const float sc = 0.5f / 8192.0f;
#pragma unroll
    for (int i = 0; i < 16; ++i) {
        const int p = tid + 512 * i, k = fnat(p), p2 = fpos((8192 - k) & 8191);
        const cf a0 = buf0[PADI(p)], b0 = buf0[PADI(p2)], a1 = buf1[PADI(p)], b1 = buf1[PADI(p2)];
        KF[((size_t)c * 2 + 0) * 8192 + p] = pk2((a0.x + b0.x) * sc, (a0.y - b0.y) * sc);
        KF[((size_t)c * 2 + 1) * 8192 + p] = pk2((a0.y + b0.y) * sc, (b0.x - a0.x) * sc);
        KF[((size_t)c * 2 + 2) * 8192 + p] = pk2((a1.x + b1.x) * sc, (a1.y - b1.y) * sc);
        KF[((size_t)c * 2 + 3) * 8192 + p] = pk2((a1.y + b1.y) * sc, (b1.x - a1.x) * sc);
    }
    SYNC();
}

DEV float ldsbf(const LAS bf16_t* p) { return bf2f(*p); }
DEV void hyena_issue_rows(const bf16_t* UT, int s, int c, u32x4 (&r)[4], int tid) {
#pragma unroll
    for (int b = 0; b < 4; ++b) r[b] = *(const u32x4*)(UT + ((size_t)(b * 3072 + s * 1024 + c)) * 4096 + tid * 8);
}
DEV void hyena_commit_rows(LAS unsigned char* lds, const u32x4 (&r)[4], int tid) {
#pragma unroll
    for (int b = 0; b < 4; ++b) *(LAS u32x4*)(lds + b * 8192 + tid * 16) = r[b];
}
template <int MODE> DEV void hyena_conv_rows(const LAS unsigned char* lds, int slot0, float w0, float w1, float w2, float bs, cf (&z)[2][8], const cf (&y)[2][8], float hb, int tid) {
#pragma unroll
    for (int b = 0; b < 4; ++b) {
        const LAS bf16_t* row = (const LAS bf16_t*)(lds + (slot0 + b) * 8192);
#pragma unroll
        for (int i = 0; i < 8; ++i) {
            const int t = tid + 512 * i, par = tid & 1, d0 = (tid >> 1) + par;
            const LAS unsigned* rw = (const LAS unsigned*)row + d0;
            const unsigned dw0 = (i == 0) ? rw[d0 > 0 ? -1 : 0] : rw[256 * i - 1], dw1 = rw[256 * i];
            float um = par ? U2F(dw0 << 16) : U2F(dw0 & 0xffff0000u);
            const float u0 = par ? U2F(dw0 & 0xffff0000u) : U2F(dw1 << 16);
            float up = par ? U2F(dw1 << 16) : U2F(dw1 & 0xffff0000u);
            um = (t > 0) ? um : 0.f; up = (t < 4095) ? up : 0.f;
            const float r = um * w0 + u0 * w1 + up * w2 + bs;
            if (MODE == 0) { if (b & 1) z[b >> 1][i].y = r; else z[b >> 1][i].x = r; }
            else { if (b & 1) z[b >> 1][i].y = r * (y[b >> 1][i].y + hb * z[b >> 1][i].y); else z[b >> 1][i].x = r * (y[b >> 1][i].x + hb * z[b >> 1][i].x); }
        }
    }
}
#ifndef HY_ABL
#define HY_ABL 0
#endif
DEV void hyena_conv_head(LAS cf* buf0, LAS cf* buf1, const unsigned* Kp, const cf (&z)[2][8], int tid, bool abl) {
    const bool skip_all = abl && HY_ABL == 1, nosync = abl && HY_ABL == 2, nok = abl && HY_ABL == 3, skip1 = (abl && HY_ABL == 4) || skip_all, skip2 = (abl && HY_ABL == 5) || skip_all, skipm = (abl && HY_ABL == 6) || skip_all;
    if (!skip1) fft_f1x2(buf0, buf1, z[0], z[1], tid);
    if (!nosync && !skip_all) SYNC();
    if (!skip2) fft_f2((tid >> 8) ? buf1 : buf0, tid & 255);
    if (!nosync && !skip_all) SYNC();
    if (!skipm) { if (nok) { fft_mid<false>(buf0, Kp, tid); fft_mid<false>(buf1, Kp, tid); } else fft_midx2(buf0, buf1, Kp, tid); }
    if (!nosync && !skip_all) SYNC();
    if (!skip2) fft_i2((tid >> 8) ? buf1 : buf0, tid & 255);
    if (!nosync && !skip_all) SYNC();
}
DEV void hyena_units(int c0, int cstride, const bf16_t* UT, bf16_t* YHT, const unsigned* KF, const float* convw  , const float* convb  , const float* hyb  , LAS unsigned char* lds, int tid, bool abl = false) {
    if (c0 >= 1024) return;
    LAS cf* buf0 = (LAS cf*)lds; LAS cf* buf1 = buf0 + FPAD;
    u32x4 r[4];
    hyena_issue_rows(UT, 0, c0, r, tid);
#pragma unroll 1
    for (int c = c0; c < 1024; c += cstride) {
        OPAQUE_I(tid);
        cf z[2][8], y[2][8];
        hyena_commit_rows(lds, r, tid);
        SYNC();
        hyena_conv_rows<0>(lds, 0, convw[c], convw[3072 + c], convw[6144 + c], convb[c], z, y, 0.f, tid);
        SYNC();
#pragma unroll 1
        for (int o = 0; o < 2; ++o) {
            hyena_conv_head(buf0, buf1, KF + ((size_t)c * 2 + o) * 8192, z, tid, abl);
            hyena_issue_rows(UT, 1 + o, c, r, tid);
            if (abl && (HY_ABL == 1 || HY_ABL == 4)) {
#pragma unroll
                for (int i = 0; i < 8; ++i) { y[0][i] = z[0][i]; y[1][i] = z[1][i]; }
            } else fft_i1x2(buf0, buf1, y[0], y[1], tid);
            SYNC();
            hyena_commit_rows(lds, r, tid);
            if (o == 1 && c + cstride < 1024) hyena_issue_rows(UT, 0, c + cstride, r, tid);
            SYNC();
            const int col = (1 + o) * 1024 + c;
            hyena_conv_rows<1>(lds, 0, convw[col], convw[3072 + col], convw[6144 + col], convb[col], z, y, hyb[o * 1024 + c], tid);
            SYNC();
        }
#pragma unroll
        for (int p = 0; p < 2; ++p)
#pragma unroll
            for (int i = 0; i < 8; ++i) {
                const int t = tid + 512 * i;
                YHT[((size_t)((2 * p) * 1024 + c)) * 4096 + t] = f2bf(z[p][i].x);
                YHT[((size_t)((2 * p + 1) * 1024 + c)) * 4096 + t] = f2bf(z[p][i].y);
            }
    }
}
DEV void hyena_unit(int c, const bf16_t* UT, bf16_t* YHT, const unsigned* KF, const float* convw, const float* convb, const float* hyb, LAS unsigned char* lds, int tid) {
    hyena_units(c, 1024, UT, YHT, KF, convw, convb, hyb, lds, tid);
}

DEV void attn_bias_table(LAS float* tab, const float* rel_bias, int tid) {
    for (int idx = tid; idx < 24 * 129; idx += NTHR) {
        const int gh = idx / 129, jj = idx % 129, g = gh >> 3, dil = 1 << (2 * g);
        const int rel = (jj - 64) * dil, n = rel < 0 ? -rel : rel;
        int bk = (rel > 0) ? 16 : 0;
        if (n < 8) bk += n;
        else bk += 8 + (n >= 15) + (n >= 27) + (n >= 50) + (n >= 91) + (n >= 166) + (n >= 305) + (n >= 559);
        tab[idx] = rel_bias[bk * 24 + gh] * 1.4426950408889634f;
    }
}
DEV void attn_tile(int tile, const bf16_t* QKG, const bf16_t* VT, bf16_t* OG, float* LSE, const LAS float* tab, int lane) {
    const int b = tile / (24 * 64), rem = tile % (24 * 64), gh = rem >> 6, tau = rem & 63, g = gh >> 3, h = gh & 7;
    const int dsh = 2 * g, Mg = 4096 >> dsh, ntm = Mg >> 6, r = tau / ntm, m0 = (tau % ntm) * 64;
    const int n = lane & 31, hl = lane >> 5;
    const size_t rowbase = (size_t)b * 4096;
    const int colq = g * 512 + h * 64;
    const float SC = 0.125f * 1.4426950408889634f;
    bf16x8 qf[2][4];
#pragma unroll
    for (int qb = 0; qb < 2; ++qb) {
        const int t = ((m0 + 32 * qb + n) << dsh) + r;
        const bf16_t* p = QKG + (rowbase + t) * 7168 + colq + 8 * hl;
#pragma unroll
        for (int ks = 0; ks < 4; ++ks) qf[qb][ks] = *(const bf16x8*)(p + 16 * ks);
    }
    f32x16 oacc[2][2];
#pragma unroll
    for (int a = 0; a < 2; ++a)
#pragma unroll
        for (int c2 = 0; c2 < 2; ++c2)
#pragma unroll
            for (int i = 0; i < 16; ++i) oacc[a][c2][i] = 0.f;
    float mrun[2] = {-1e30f, -1e30f}, lrun[2] = {0.f, 0.f};
    for (int kbi = 0; kbi < 3; ++kbi) {
        const int kb = (kbi == 0) ? 1 : (kbi == 1 ? 0 : 2);
        const int mk0 = m0 - 64 + 64 * kb;
        if (mk0 < 0 || mk0 >= Mg) continue;
        f32x16 s[2][2];
#pragma unroll
        for (int sb = 0; sb < 2; ++sb) {
            const int t = ((mk0 + 32 * sb + n) << dsh) + r;
            const bf16_t* p = QKG + (rowbase + t) * 7168 + 1536 + colq + 8 * hl;
            bf16x8 kf[4];
#pragma unroll
            for (int ks = 0; ks < 4; ++ks) kf[ks] = *(const bf16x8*)(p + 16 * ks);
#pragma unroll
            for (int qb = 0; qb < 2; ++qb) {
                f32x16 a;
#pragma unroll
                for (int i = 0; i < 16; ++i) a[i] = 0.f;
#pragma unroll
                for (int ks = 0; ks < 4; ++ks) a = MFMA32(kf[ks], qf[qb][ks], a);
                s[sb][qb] = a;
            }
        }
#pragma unroll
        for (int qb = 0; qb < 2; ++qb) {
            const int qq = 32 * qb + n;
            float mx = -1e30f;
#pragma unroll
            for (int sb = 0; sb < 2; ++sb)
#pragma unroll
                for (int rg = 0; rg < 16; ++rg) {
                    const int kk = 32 * sb + (rg & 3) + 8 * (rg >> 2) + 4 * hl;
                    const int jj = 64 * kb + kk - qq;
                    const bool ok = (unsigned)jj <= 128u;
                    const float bia = tab[gh * 129 + (ok ? jj : 0)];
                    const float v = ok ? s[sb][qb][rg] * SC + bia : -1e30f;
                    s[sb][qb][rg] = v; mx = fmaxf(mx, v);
                }
            mx = fmaxf(mx, SHFL_XOR3(mx, 32, lane));
            const float mnew = fmaxf(mrun[qb], mx);
            const float alpha = EXP2(mrun[qb] - mnew);
            float rs = 0.f;
#pragma unroll
            for (int sb = 0; sb < 2; ++sb)
#pragma unroll
                for (int rg = 0; rg < 16; ++rg) { const float p = EXP2(s[sb][qb][rg] - mnew); s[sb][qb][rg] = p; rs += p; }
            rs += SHFL_XOR3(rs, 32, lane);
            lrun[qb] = lrun[qb] * alpha + rs; mrun[qb] = mnew;
#pragma unroll
            for (int eb = 0; eb < 2; ++eb)
#pragma unroll
                for (int i = 0; i < 16; ++i) oacc[eb][qb][i] *= alpha;
        }
#pragma unroll
        for (int sb = 0; sb < 2; ++sb)
#pragma unroll
            for (int s2 = 0; s2 < 2; ++s2) {
                bf16x8 pf[2];
#pragma unroll
                for (int qb = 0; qb < 2; ++qb) {
                    u32x4 w;
                    w.x = pk2(s[sb][qb][8 * s2 + 0], s[sb][qb][8 * s2 + 1]); w.y = pk2(s[sb][qb][8 * s2 + 2], s[sb][qb][8 * s2 + 3]);
                    w.z = pk2(s[sb][qb][8 * s2 + 4], s[sb][qb][8 * s2 + 5]); w.w = pk2(s[sb][qb][8 * s2 + 6], s[sb][qb][8 * s2 + 7]);
                    pf[qb] = BITCAST(bf16x8, w);
                }
#pragma unroll
                for (int eb = 0; eb < 2; ++eb) {
                    const int e = 32 * eb + n;
                    const bf16_t* vp = VT + ((size_t)(b * 1536 + colq + e)) * 4096 + r * Mg + mk0 + 32 * sb + 16 * s2 + 4 * hl;
                    const u32x2 lo = *(const u32x2*)vp, hi = *(const u32x2*)(vp + 8);
                    u32x4 w; w.x = lo.x; w.y = lo.y; w.z = hi.x; w.w = hi.y;
                    const bf16x8 vf = BITCAST(bf16x8, w);
#pragma unroll
                    for (int qb = 0; qb < 2; ++qb) oacc[eb][qb] = MFMA32(vf, pf[qb], oacc[eb][qb]);
                }
            }
    }
#pragma unroll
    for (int qb = 0; qb < 2; ++qb) {
        const float inv = 1.0f / lrun[qb];
        const int t = ((m0 + 32 * qb + n) << dsh) + r;
        bf16_t* op = OG + (rowbase + t) * 1536 + colq;
#pragma unroll
        for (int eb = 0; eb < 2; ++eb)
#pragma unroll
            for (int gq = 0; gq < 4; ++gq) {
                u32x2 w; w.x = pk2(oacc[eb][qb][4 * gq] * inv, oacc[eb][qb][4 * gq + 1] * inv); w.y = pk2(oacc[eb][qb][4 * gq + 2] * inv, oacc[eb][qb][4 * gq + 3] * inv);
                *(u32x2*)(op + 32 * eb + 8 * gq + 4 * hl) = w;
            }
        if (hl == 0) LSE[(rowbase + t) * 24 + gh] = mrun[qb] + LOG2(lrun[qb]);
    }
}
constexpr int AT_KP = 144, AT_VP = 776;
constexpr int AT_K_OFF = 0, AT_V_OFF = 384 * AT_KP, AT_TAB_OFF = AT_V_OFF + 64 * AT_VP;
struct AttnU { int b, gh, g, dsh, Mg, r, mu0, colq; };
DEV AttnU attn_decode(int unit) {
    AttnU a; a.b = unit / 384; const int rem = unit % 384; a.gh = rem >> 4; const int uu = rem & 15; a.g = a.gh >> 3;
    a.dsh = 2 * a.g; a.Mg = 4096 >> a.dsh; const int upc = a.Mg >> 8; a.r = uu / upc; a.mu0 = (uu % upc) * 256; a.colq = a.g * 512 + (a.gh & 7) * 64;
    return a;
}
DEV void attn_issue(const AttnU& a, const bf16_t* QKG, const bf16_t* VT, u32x4 (&kr)[6], u32x4 (&vr)[6], int tid) {
    const size_t rowbase = (size_t)a.b * 4096;
#pragma unroll
    for (int i = 0; i < 6; ++i) {
        const int idx = tid + 512 * i, row = idx >> 3, ch = idx & 7, m = a.mu0 - 64 + row;
        kr[i] = (u32x4){0u, 0u, 0u, 0u};
        if (m >= 0 && m < a.Mg) kr[i] = *(const u32x4*)(QKG + (rowbase + (size_t)((m << a.dsh) + a.r)) * 7168 + 1536 + a.colq + 8 * ch);
    }
#pragma unroll
    for (int i = 0; i < 6; ++i) {
        const int idx = tid + 512 * i, e = idx / 48, ch = idx % 48, m = a.mu0 - 64 + 8 * ch;
        vr[i] = (u32x4){0u, 0u, 0u, 0u};
        if (m >= 0 && m < a.Mg) vr[i] = *(const u32x4*)(VT + ((size_t)(a.b * 1536 + a.colq + e)) * 4096 + a.r * a.Mg + m);
    }
}
DEV void attn_commit(LAS unsigned char* lds, const u32x4 (&kr)[6], const u32x4 (&vr)[6], int tid) {
#pragma unroll
    for (int i = 0; i < 6; ++i) { const int idx = tid + 512 * i, row = idx >> 3, ch = idx & 7; *(LAS u32x4*)(lds + AT_K_OFF + row * AT_KP + ch * 16) = kr[i]; }
#pragma unroll
    for (int i = 0; i < 6; ++i) { const int idx = tid + 512 * i, e = idx / 48, ch = idx % 48;
        LAS u32x2* d = (LAS u32x2*)(lds + AT_V_OFF + e * AT_VP + ch * 16);
        d[0] = (u32x2){vr[i].x, vr[i].y}; d[1] = (u32x2){vr[i].z, vr[i].w}; }
}
DEV void attn_compute(const AttnU& a, const bf16x8 (&qf)[4], int tq, bf16_t* OG, float* LSE, LAS unsigned char* lds, int tid) {
    const int lane = tid & 63, wave = tid >> 6, n = lane & 31, hl = lane >> 5;
    const size_t rowbase = (size_t)a.b * 4096;
    const LAS float* tab = (const LAS float*)(lds + AT_TAB_OFF) + a.gh * 129;
    const float SC = 0.125f * 1.4426950408889634f;
    f32x16 s[5];
    bool vb[5];
    float mx = -1e30f;
#pragma unroll
    for (int sb = 0; sb < 5; ++sb) {
        const int sbk = wave + sb, mb = a.mu0 - 64 + 32 * sbk;
        vb[sb] = (mb >= 0) && (mb < a.Mg);
        f32x16 acc;
#pragma unroll
        for (int i = 0; i < 16; ++i) acc[i] = 0.f;
        if (vb[sb]) {
            const LAS unsigned char* kp = lds + AT_K_OFF + (32 * sbk + n) * AT_KP + 16 * hl;
#pragma unroll
            for (int ks = 0; ks < 4; ++ks) { const bf16x8 kf = *(const LAS bf16x8*)(kp + 32 * ks); acc = MFMA32(kf, qf[ks], acc); }
        }
#pragma unroll
        for (int rg = 0; rg < 16; ++rg) {
            const int jj = 32 * sb + (rg & 3) + 8 * (rg >> 2) + 4 * hl - n;
            const bool ok = vb[sb] && ((unsigned)jj <= 128u);
            const float bia = tab[ok ? jj : 0];
            const float v = ok ? acc[rg] * SC + bia : -1e30f;
            acc[rg] = v; mx = fmaxf(mx, v);
        }
        s[sb] = acc;
    }
    mx = fmaxf(mx, SHFL_XOR3(mx, 32, lane));
    float rs = 0.f;
#pragma unroll
    for (int sb = 0; sb < 5; ++sb)
#pragma unroll
        for (int rg = 0; rg < 16; ++rg) { const float p = EXP2(s[sb][rg] - mx); s[sb][rg] = p; rs += p; }
    rs += SHFL_XOR3(rs, 32, lane);
    f32x16 oacc[2];
#pragma unroll
    for (int eb = 0; eb < 2; ++eb)
#pragma unroll
        for (int i = 0; i < 16; ++i) oacc[eb][i] = 0.f;
#pragma unroll
    for (int sb = 0; sb < 5; ++sb) {
        if (!vb[sb]) continue;
#pragma unroll
        for (int s2 = 0; s2 < 2; ++s2) {
            u32x4 w;
            w.x = pk2(s[sb][8 * s2 + 0], s[sb][8 * s2 + 1]); w.y = pk2(s[sb][8 * s2 + 2], s[sb][8 * s2 + 3]);
            w.z = pk2(s[sb][8 * s2 + 4], s[sb][8 * s2 + 5]); w.w = pk2(s[sb][8 * s2 + 6], s[sb][8 * s2 + 7]);
            const bf16x8 pf = BITCAST(bf16x8, w);
#pragma unroll
            for (int eb = 0; eb < 2; ++eb) {
                const LAS unsigned char* vp = lds + AT_V_OFF + (32 * eb + n) * AT_VP + (32 * (wave + sb) + 16 * s2 + 4 * hl) * 2;
                const u32x2 lo = *(const LAS u32x2*)vp, hi = *(const LAS u32x2*)(vp + 16);
                u32x4 wv; wv.x = lo.x; wv.y = lo.y; wv.z = hi.x; wv.w = hi.y;
                oacc[eb] = MFMA32(BITCAST(bf16x8, wv), pf, oacc[eb]);
            }
        }
    }
    const float inv = 1.0f / rs;
    bf16_t* op = OG + (rowbase + tq) * 1536 + a.colq;
#pragma unroll
    for (int eb = 0; eb < 2; ++eb)
#pragma unroll
        for (int gq = 0; gq < 4; ++gq) {
            u32x2 w; w.x = pk2(oacc[eb][4 * gq] * inv, oacc[eb][4 * gq + 1] * inv); w.y = pk2(oacc[eb][4 * gq + 2] * inv, oacc[eb][4 * gq + 3] * inv);
            *(u32x2*)(op + 32 * eb + 8 * gq + 4 * hl) = w;
        }
    if (hl == 0) LSE[(rowbase + tq) * 24 + a.gh] = mx + LOG2(rs);
}
DEV void attn_load_q(const AttnU& a, const bf16_t* QKG, bf16x8 (&qf)[4], int tid) {
    const int lane = tid & 63, wave = tid >> 6, n = lane & 31, hl = lane >> 5;
    const int tq = ((a.mu0 + 32 * wave + n) << a.dsh) + a.r;
    const bf16_t* p = QKG + ((size_t)a.b * 4096 + tq) * 7168 + a.colq + 8 * hl;
#pragma unroll
    for (int ks = 0; ks < 4; ++ks) qf[ks] = *(const bf16x8*)(p + 16 * ks);
}
DEV void attn_units(int u0, int ustride, int nunits, const bf16_t* QKG, const bf16_t* VT, bf16_t* OG, float* LSE, LAS unsigned char* lds, int tid) {
    if (u0 >= nunits) return;
    u32x4 kr[6], vr[6]; bf16x8 qn[4];
    { const AttnU a0 = attn_decode(u0); attn_issue(a0, QKG, VT, kr, vr, tid); attn_load_q(a0, QKG, qn, tid); }
#pragma unroll 1
    for (int u = u0; u < nunits; u += ustride) {
        OPAQUE_I(tid);
        const AttnU a = attn_decode(u);
        const int lane = tid & 63, wave = tid >> 6, n = lane & 31;
        SYNC();
        attn_commit(lds, kr, vr, tid);
        bf16x8 qf[4];
#pragma unroll
        for (int ks = 0; ks < 4; ++ks) qf[ks] = qn[ks];
        const int tq = ((a.mu0 + 32 * wave + n) << a.dsh) + a.r;
        SYNC();
        if (u + ustride < nunits) { const AttnU an = attn_decode(u + ustride); attn_issue(an, QKG, VT, kr, vr, tid); attn_load_q(an, QKG, qn, tid); }
        attn_compute(a, qf, tq, OG, LSE, lds, tid);
    }
}
DEV void attn_unit(int unit, const bf16_t* QKG, const bf16_t* VT, bf16_t* OG, float* LSE, LAS unsigned char* lds, int tid) {
    attn_units(unit, 1 << 20, unit + 1, QKG, VT, OG, LSE, lds, tid);
}
DEV void attn_combine_item(int item, const bf16_t* OG, const float* LSE, bf16_t* YA, int pitch = 512, int coloff = 0) {
    const int row = item >> 6, h = (item >> 3) & 7, e8 = item & 7;
    const float l0 = LSE[row * 24 + h], l1 = LSE[row * 24 + 8 + h], l2 = LSE[row * 24 + 16 + h];
    const float mx = fmaxf(l0, fmaxf(l1, l2));
    float w0 = EXP2(l0 - mx), w1 = EXP2(l1 - mx), w2 = EXP2(l2 - mx);
    const float inv = 1.0f / (w0 + w1 + w2); w0 *= inv; w1 *= inv; w2 *= inv;
    const bf16_t* p = OG + (size_t)row * 1536 + h * 64 + e8 * 8;
    const u32x4 a = *(const u32x4*)p, b = *(const u32x4*)(p + 512), c = *(const u32x4*)(p + 1024);
    u32x4 o;
#pragma unroll
    for (int i = 0; i < 4; ++i) {
        const float lo = w0 * U2F(a[i] << 16) + w1 * U2F(b[i] << 16) + w2 * U2F(c[i] << 16);
        const float hi = w0 * U2F(a[i] & 0xffff0000u) + w1 * U2F(b[i] & 0xffff0000u) + w2 * U2F(c[i] & 0xffff0000u);
        o[i] = pk2(lo, hi);
    }
    *(u32x4*)(YA + (size_t)row * pitch + coloff + h * 64 + e8 * 8) = o;
}

namespace pg8 {
#define PG8_LAS __attribute__((address_space(3)))
typedef unsigned short bf16_t;
typedef short bf16x8 __attribute__((ext_vector_type(8)));
typedef float f32x4 __attribute__((ext_vector_type(4)));
typedef unsigned u32x4 __attribute__((ext_vector_type(4)));
constexpr int BM = 256, BK = 64, HALF = 128, HTB = HALF * BK * 2  , STAGE_BYTES = 8 * HTB, NXCD = 8, WGM = 8;

__host__ __device__ __forceinline__ int lds_byte(int r, int c) { const int st = (r >> 4) * 2 + (c >> 5), rr = r & 15, cc = c & 31, ob = rr * 64 + cc * 2; return st * 1024 + (ob ^ (((ob >> 9) & 1) << 5)); }
__host__ __device__ __forceinline__ void stage_rc(int b, int& R, int& C) { const int st = b / 1024, sb = b % 1024, swz = sb ^ (((sb >> 9) & 1) << 5); R = (st >> 1) * 16 + swz / 64; C = (st & 1) * 32 + (swz % 64) / 2; }
__host__ __device__ __forceinline__ int perm32(int rho) { const int n = rho >> 4, i = rho & 15; return 8 * (i >> 2) + 4 * n + (i & 3); }

struct Unit { int pm, pn; };
struct Gemm { const bf16_t* A; const bf16_t* Bt; int M, N, K; };

struct StaticOrder {
    int nM, nN, nwg, G, c;
    __host__ __device__ void init(int M, int N, int G_, int c_) { nM = M / BM; nN = N / BM; nwg = nM * nN; G = G_; c = c_; }
    __host__ __device__ bool next(int i, Unit& u) const {
        const long L = (long)i * G + c; if (L >= nwg) return false;
        int wgid = (int)L; { const int q = nwg / NXCD, r = nwg % NXCD, xcd = wgid % NXCD, off = wgid / NXCD; wgid = (xcd < r ? xcd * (q + 1) : r * (q + 1) + (xcd - r) * q) + off; }
        const int nig = WGM * nN, gid = wgid / nig, fm = gid * WGM, gsz = (nM - fm) < WGM ? (nM - fm) : WGM;
        u.pm = fm + ((wgid % nig) % gsz); u.pn = (wgid % nig) / gsz; return true;
    }
    __device__ __forceinline__ void a_ready(const Unit&) const {}
    __device__ __forceinline__ void done(const Unit&) const {}
};

__device__ __forceinline__ unsigned cvt_pk_bf16(float lo, float hi) { unsigned r; asm volatile("v_cvt_pk_bf16_f32 %0, %1, %2" : "=v"(r) : "v"(lo), "v"(hi)); return r; }
constexpr int EPI_LDS_OFF = 139264 + 1024;
template <int MODE> __device__ __forceinline__ int perm_row(int R) {
    if (MODE == 0) return R;
    if (MODE == 1) return (R & ~31) + perm32(R & 31);
    const int wcp = R >> 5, n = (R >> 4) & 1, fq = (R >> 2) & 3, e = R & 3;
    if (MODE == 2) return fq + 4 * (8 * wcp + 4 * n + e);
    return (4 * wcp + fq) + 16 * (4 * n + e);
}
__device__ __forceinline__ float sigmoid_f(float x) { return __builtin_amdgcn_rcpf(1.0f + __builtin_amdgcn_exp2f(-1.4426950408889634f * x)); }
__device__ __forceinline__ f32x4 exp2_4(f32x4 t) { f32x4 r;
#pragma unroll
    for (int j = 0; j < 4; ++j) r[j] = __builtin_amdgcn_exp2f(fminf(t[j], 60.0f));
    return r; }
__device__ __forceinline__ f32x4 rcp_4(f32x4 t) { f32x4 r;
#pragma unroll
    for (int j = 0; j < 4; ++j) r[j] = __builtin_amdgcn_rcpf(t[j]);
    return r; }
__device__ __forceinline__ float bflo(unsigned w) { return __uint_as_float(w << 16); }
__device__ __forceinline__ float bfhi(unsigned w) { return __uint_as_float(w & 0xffff0000u); }
template <int VM> struct EpiG1a {
    static constexpr bool PERM = true, AFTER_DRAIN = false; static constexpr int PMODE = 1 + VM, KSPLIT = 0; static constexpr bool PREF = false;
    bf16_t* UT; bf16_t* VT;
    __device__ __forceinline__ void operator()(const f32x4 (&acc)[2][2][4][2], const Unit& u, int wr, int wc, int fr, int fq) const {
        const int row0 = u.pm * BM + wr * 64 + fr;
        const int T0 = u.pn * BM, bseq = T0 >> 12, t0 = T0 & 4095;
#pragma unroll
        for (int ai = 0; ai < 2; ++ai)
#pragma unroll
            for (int m = 0; m < 4; ++m) {
                const int nn = row0 + ai * HALF + m * 16;
#pragma unroll
                for (int bj = 0; bj < 2; ++bj) {
                    const f32x4 v0 = acc[ai][bj][m][0], v1 = acc[ai][bj][m][1];
                    u32x4 w; w.x = cvt_pk_bf16(v0[0], v0[1]); w.y = cvt_pk_bf16(v0[2], v0[3]); w.z = cvt_pk_bf16(v1[0], v1[1]); w.w = cvt_pk_bf16(v1[2], v1[3]);
                    const int th = t0 + bj * HALF;
                    if (VM == 0) {
                        const int t = th + wc * 32 + 8 * fq;
                        if (u.pm < 12) *(u32x4*)(UT + ((size_t)(bseq * 3072 + nn)) * 4096 + t) = w;
                        else *(u32x4*)(VT + ((size_t)(bseq * 1536 + (nn - 3072))) * 4096 + t) = w;
                    } else if (VM == 1) {
                        *(u32x4*)(VT + ((size_t)(bseq * 1536 + 512 + nn)) * 4096 + fq * 1024 + (th >> 2) + 8 * wc) = w;
                    } else {
                        *(u32x4*)(VT + ((size_t)(bseq * 1536 + 1024 + nn)) * 4096 + (4 * wc + fq) * 256 + (th >> 4)) = w;
                    }
                }
            }
    }
};
struct EpiG1b {
    static constexpr bool PERM = true, AFTER_DRAIN = false; static constexpr int PMODE = 1, KSPLIT = 0; static constexpr bool PREF = true;
    bf16_t* O; const float* bgate;
    __device__ __forceinline__ void prefetch(const Unit& u, int buf, PG8_LAS unsigned char* lds, int wid, int lane) const {
        if (u.pn >= 12 && wid == 0) __builtin_amdgcn_global_load_lds((const unsigned*)(bgate + (lane >> 5) * 2048 + (u.pn - 12) * 128 + (lane & 31) * 4), (PG8_LAS unsigned*)(lds + EPI_LDS_OFF + buf * 2048), 16, 0, 0);
    }
    __device__ __forceinline__ void run(const f32x4 (&acc)[2][2][4][2], const Unit& u, int wr, int wc, int fr, int fq, PG8_LAS unsigned char* lds, int buf) const {
        const int row0 = u.pm * BM + wr * 64 + fr, col0 = u.pn * BM + wc * 32 + 8 * fq; const bool gate = u.pn >= 12;
        const PG8_LAS float* bl = (const PG8_LAS float*)(lds + EPI_LDS_OFF + buf * 2048) + wc * 32 + 8 * fq;
        f32x4 bv[2][2];
#pragma unroll
        for (int bj = 0; bj < 2; ++bj)
#pragma unroll
            for (int n = 0; n < 2; ++n) bv[bj][n] = gate ? *(const PG8_LAS f32x4*)(bl + bj * HALF + 4 * n) : (f32x4){0.f, 0.f, 0.f, 0.f};
#pragma unroll
        for (int ai = 0; ai < 2; ++ai)
#pragma unroll
            for (int m = 0; m < 4; ++m) { bf16_t* rowp = O + (size_t)(row0 + ai * HALF + m * 16) * 7168 + col0;
                {
                    f32x4 h0 = acc[ai][0][m][0] + bv[0][0], h1 = acc[ai][0][m][1] + bv[0][1], a0 = acc[ai][1][m][0] + bv[1][0], a1 = acc[ai][1][m][1] + bv[1][1];
                    if (gate) {
                        const float nl2e = -1.4426950408889634f;
                        const f32x4 pa0 = exp2_4(a0 * nl2e) + 1.0f, pa1 = exp2_4(a1 * nl2e) + 1.0f, ph0 = exp2_4(h0 * nl2e) + 1.0f, ph1 = exp2_4(h1 * nl2e) + 1.0f;
                        const f32x4 r0 = rcp_4(pa0 * ph0), r1 = rcp_4(pa1 * ph1);
                        h0 = r0 * pa0 * pa0; h1 = r1 * pa1 * pa1; a0 = r0 * ph0; a1 = r1 * ph1; }
                    u32x4 w; w.x = cvt_pk_bf16(h0[0], h0[1]); w.y = cvt_pk_bf16(h0[2], h0[3]); w.z = cvt_pk_bf16(h1[0], h1[1]); w.w = cvt_pk_bf16(h1[2], h1[3]);
                    *(u32x4*)(rowp) = w;
                    w.x = cvt_pk_bf16(a0[0], a0[1]); w.y = cvt_pk_bf16(a0[2], a0[3]); w.z = cvt_pk_bf16(a1[0], a1[1]); w.w = cvt_pk_bf16(a1[2], a1[3]);
                    *(u32x4*)(rowp + HALF) = w; } }
    }
};
template <bool ADD> struct EpiG2 {
    static constexpr bool PERM = true, AFTER_DRAIN = false; static constexpr int PMODE = 1, KSPLIT = 0; static constexpr bool PREF = false;
    const bf16_t* QKG; bf16_t* MB; int goff;
    __device__ __forceinline__ void operator()(const f32x4 (&acc)[2][2][4][2], const Unit& u, int wr, int wc, int fr, int fq) const {
        const int row0 = u.pm * BM + wr * 64 + fr, col0 = u.pn * BM + wc * 32 + 8 * fq;
#pragma unroll
        for (int ai = 0; ai < 2; ++ai) {
            u32x4 gtv[4][2], mbv[4][2];
#pragma unroll
            for (int m = 0; m < 4; ++m) { const size_t row = (size_t)(row0 + ai * HALF + m * 16);
#pragma unroll
                for (int bj = 0; bj < 2; ++bj) { const int col = col0 + bj * HALF;
                    gtv[m][bj] = *(const u32x4*)(QKG + row * 7168 + goff + col);
                    if (ADD) mbv[m][bj] = *(const u32x4*)(MB + row * 2048 + col); } }
#pragma unroll
            for (int m = 0; m < 4; ++m) { const size_t row = (size_t)(row0 + ai * HALF + m * 16);
#pragma unroll
                for (int bj = 0; bj < 2; ++bj) { const int col = col0 + bj * HALF;
                    const u32x4 gt = gtv[m][bj];
                    f32x4 v0 = acc[ai][bj][m][0], v1 = acc[ai][bj][m][1];
                    v0[0] *= bflo(gt.x); v0[1] *= bfhi(gt.x); v0[2] *= bflo(gt.y); v0[3] *= bfhi(gt.y); v1[0] *= bflo(gt.z); v1[1] *= bfhi(gt.z); v1[2] *= bflo(gt.w); v1[3] *= bfhi(gt.w);
                    if (ADD) { const u32x4 mb = mbv[m][bj];
                        v0[0] += bflo(mb.x); v0[1] += bfhi(mb.x); v0[2] += bflo(mb.y); v0[3] += bfhi(mb.y); v1[0] += bflo(mb.z); v1[1] += bfhi(mb.z); v1[2] += bflo(mb.w); v1[3] += bfhi(mb.w); }
                    u32x4 w; w.x = cvt_pk_bf16(v0[0], v0[1]); w.y = cvt_pk_bf16(v0[2], v0[3]); w.z = cvt_pk_bf16(v1[0], v1[1]); w.w = cvt_pk_bf16(v1[2], v1[3]);
                    *(u32x4*)(MB + row * 2048 + col) = w; } }
        }
    }
};
struct EpiRes {
    static constexpr bool PERM = false, AFTER_DRAIN = false; static constexpr int PMODE = 0, KSPLIT = 0; static constexpr bool PREF = false;
    const float* xold; float* xnew; const float* gate;
    __device__ __forceinline__ void operator()(const f32x4 (&acc)[2][2][4][2], const Unit& u, int wr, int wc, int fr, int fq) const {
        const int row0 = u.pm * BM + wr * 64 + fr, col0 = u.pn * BM + wc * 32 + 4 * fq;
        const float* gp = gate + (size_t)(u.pm >> 4) * 12288 + col0;
        f32x4 gv[2][2];
#pragma unroll
        for (int bj = 0; bj < 2; ++bj)
#pragma unroll
            for (int n = 0; n < 2; ++n) gv[bj][n] = *(const f32x4*)(gp + bj * HALF + n * 16);
#pragma unroll
        for (int ai = 0; ai < 2; ++ai) {
            f32x4 xo[4][2][2];
#pragma unroll
            for (int m = 0; m < 4; ++m) { const size_t off = (size_t)(row0 + ai * HALF + m * 16) * 2048 + col0;
#pragma unroll
                for (int bj = 0; bj < 2; ++bj)
#pragma unroll
                    for (int n = 0; n < 2; ++n) xo[m][bj][n] = *(const f32x4*)(xold + off + bj * HALF + n * 16); }
#pragma unroll
            for (int m = 0; m < 4; ++m) { const size_t off = (size_t)(row0 + ai * HALF + m * 16) * 2048 + col0;
#pragma unroll
                for (int bj = 0; bj < 2; ++bj)
#pragma unroll
                    for (int n = 0; n < 2; ++n) *(f32x4*)(xnew + off + bj * HALF + n * 16) = xo[m][bj][n] + gv[bj][n] * acc[ai][bj][m][n]; }
        }
    }
};
template <bool F32IN> struct EpiResB {
    static constexpr bool PERM = true, AFTER_DRAIN = false; static constexpr int PMODE = 1, KSPLIT = 0; static constexpr bool PREF = false;
    const float* xin; const bf16_t* xold; bf16_t* xnew; const float* gate;
    __device__ __forceinline__ void operator()(const f32x4 (&acc)[2][2][4][2], const Unit& u, int wr, int wc, int fr, int fq) const {
        const int row0 = u.pm * BM + wr * 64 + fr, col0 = u.pn * BM + wc * 32 + 8 * fq;
        const float* gp = gate + (size_t)(u.pm >> 4) * 12288 + col0;
        f32x4 gv[2][2];
#pragma unroll
        for (int bj = 0; bj < 2; ++bj)
#pragma unroll
            for (int n = 0; n < 2; ++n) gv[bj][n] = *(const f32x4*)(gp + bj * HALF + n * 4);
        if constexpr (F32IN) {
#pragma unroll
            for (int ai = 0; ai < 2; ++ai) {
                f32x4 xo[4][2][2];
#pragma unroll
                for (int m = 0; m < 4; ++m) { const size_t off = (size_t)(row0 + ai * HALF + m * 16) * 2048 + col0;
#pragma unroll
                    for (int bj = 0; bj < 2; ++bj)
#pragma unroll
                        for (int n = 0; n < 2; ++n) xo[m][bj][n] = *(const f32x4*)(xin + off + bj * HALF + n * 4); }
#pragma unroll
                for (int m = 0; m < 4; ++m) { const size_t off = (size_t)(row0 + ai * HALF + m * 16) * 2048 + col0;
#pragma unroll
                    for (int bj = 0; bj < 2; ++bj) { const f32x4 v0 = xo[m][bj][0] + gv[bj][0] * acc[ai][bj][m][0], v1 = xo[m][bj][1] + gv[bj][1] * acc[ai][bj][m][1];
                        u32x4 w; w.x = pkh2(v0[0], v0[1]); w.y = pkh2(v0[2], v0[3]); w.z = pkh2(v1[0], v1[1]); w.w = pkh2(v1[2], v1[3]);
                        *(u32x4*)(xnew + off + bj * HALF) = w; } }
            }
        } else {
            u32x4 xo[2][4][2];
#pragma unroll
            for (int ai = 0; ai < 2; ++ai)
#pragma unroll
                for (int m = 0; m < 4; ++m) { const size_t off = (size_t)(row0 + ai * HALF + m * 16) * 2048 + col0;
#pragma unroll
                    for (int bj = 0; bj < 2; ++bj) xo[ai][m][bj] = *(const u32x4*)(xold + off + bj * HALF); }
#pragma unroll
            for (int ai = 0; ai < 2; ++ai)
#pragma unroll
                for (int m = 0; m < 4; ++m) { const size_t off = (size_t)(row0 + ai * HALF + m * 16) * 2048 + col0;
#pragma unroll
                    for (int bj = 0; bj < 2; ++bj) { const u32x4 o = xo[ai][m][bj]; const f32x4 a0 = acc[ai][bj][m][0], a1 = acc[ai][bj][m][1], g0 = gv[bj][0], g1 = gv[bj][1];
                        u32x4 w;
                        w.x = pkh2(hlo(o.x) + g0[0] * a0[0], hhi(o.x) + g0[1] * a0[1]); w.y = pkh2(hlo(o.y) + g0[2] * a0[2], hhi(o.y) + g0[3] * a0[3]);
                        w.z = pkh2(hlo(o.z) + g1[0] * a1[0], hhi(o.z) + g1[1] * a1[1]); w.w = pkh2(hlo(o.w) + g1[2] * a1[2], hhi(o.w) + g1[3] * a1[3]);
                        *(u32x4*)(xnew + off + bj * HALF) = w; } }
        }
    }
};
struct PanelOrder {
    int nwg, G, c;
    __host__ __device__ void init(int M, int N, int G_, int c_) { nwg = (M / BM) * (N / BM); G = G_; c = c_; }
    __host__ __device__ __attribute__((always_inline)) bool next(int i, Unit& u) const {
        const int L = i * G + c; if (L >= nwg) return false;
        const int x = c & 7, r = c >> 3, ppx = G >> 6;
        u.pm = ((i * G) >> 3) + x * ppx + (r % ppx); u.pn = r / ppx; return true;
    }
    __device__ __forceinline__ void a_ready(const Unit&) const {}
    __device__ __forceinline__ void done(const Unit&) const {}
};
template <bool F32IN, bool FINAL = false> struct EpiResN {
    static constexpr bool PERM = true, AFTER_DRAIN = false; static constexpr int PMODE = 1, KSPLIT = 0; static constexpr bool PREF = true;
    const float* xin; const bf16_t* xold; bf16_t* xnew; bf16_t* hout; const float* modb; const float* gn; int goff; float* part; unsigned* cnt; unsigned want; unsigned* tmo; float* fout;
    __device__ __forceinline__ void prefetch(const Unit& u, int buf, PG8_LAS unsigned char* lds, int wid, int lane) const {
        if (wid < (FINAL ? 2 : 4)) { asm volatile("v_mbcnt_lo_u32_b32 %0, -1, 0\n\tv_mbcnt_hi_u32_b32 %0, -1, %0" : "=v"(lane));
            const float* base = wid == 1 ? gn + u.pn * BM : modb + (size_t)(u.pm >> 4) * 12288 + u.pn * BM + (wid == 0 ? goff : wid == 2 ? 4 * 2048 : 3 * 2048);
            __builtin_amdgcn_global_load_lds((const unsigned*)(base + lane * 4), (PG8_LAS unsigned*)(lds + EPI_LDS_OFF + buf * 4096 + wid * 1024), 16, 0, 0); }
    }
    __device__ __forceinline__ void run(f32x4 (&acc)[2][2][4][2], const Unit& u, int wr, int wc, int fr, int fq, PG8_LAS unsigned char* lds, int buf) const {
        { int l_; asm volatile("v_mbcnt_lo_u32_b32 %0, -1, 0\n\tv_mbcnt_hi_u32_b32 %0, -1, %0" : "=v"(l_)); fr = l_ & 15; fq = l_ >> 4; }
        const int wid = wr * 4 + wc;
        PG8_LAS float* P = (PG8_LAS float*)(lds + EPI_LDS_OFF + 8192);
        PG8_LAS float* S = (PG8_LAS float*)(lds + EPI_LDS_OFF + 12288);
        PG8_LAS unsigned* flag = (PG8_LAS unsigned*)(lds + EPI_LDS_OFF + 13312);
        { const int row0 = u.pm * BM + wr * 64 + fr, col0 = u.pn * BM + wc * 32 + 8 * fq;
        const PG8_LAS float* vb = (const PG8_LAS float*)(lds + EPI_LDS_OFF + buf * 4096) + wc * 32 + 8 * fq;
        f32x4 gv[2][2];
#pragma unroll
        for (int bj = 0; bj < 2; ++bj)
#pragma unroll
            for (int n = 0; n < 2; ++n) gv[bj][n] = *(const PG8_LAS f32x4*)(vb + bj * HALF + 4 * n);
        if constexpr (F32IN) {
#pragma unroll
            for (int ai = 0; ai < 2; ++ai)
#pragma unroll
                for (int mh = 0; mh < 2; ++mh) {
                    f32x4 xo[2][2][2];
#pragma unroll
                    for (int mm = 0; mm < 2; ++mm) { const unsigned off = (unsigned)(row0 + ai * HALF + (2 * mh + mm) * 16) * 2048u + (unsigned)col0;
#pragma unroll
                        for (int bj = 0; bj < 2; ++bj)
#pragma unroll
                            for (int n = 0; n < 2; ++n) xo[mm][bj][n] = *(const f32x4*)(xin + off + bj * HALF + n * 4); }
#pragma unroll
                    for (int mm = 0; mm < 2; ++mm)
#pragma unroll
                        for (int bj = 0; bj < 2; ++bj)
#pragma unroll
                            for (int n = 0; n < 2; ++n) acc[ai][bj][2 * mh + mm][n] = xo[mm][bj][n] + gv[bj][n] * acc[ai][bj][2 * mh + mm][n];
                    asm volatile("" ::: "memory");
                }
        } else {
            u32x4 xo[2][4][2];
#pragma unroll
            for (int ai = 0; ai < 2; ++ai)
#pragma unroll
                for (int m = 0; m < 4; ++m) { const unsigned off = (unsigned)(row0 + ai * HALF + m * 16) * 2048u + (unsigned)col0;
#pragma unroll
                    for (int bj = 0; bj < 2; ++bj) xo[ai][m][bj] = *(const u32x4*)(xold + off + bj * HALF); }
#pragma unroll
            for (int ai = 0; ai < 2; ++ai)
#pragma unroll
                for (int m = 0; m < 4; ++m)
#pragma unroll
                    for (int bj = 0; bj < 2; ++bj) { const u32x4 o = xo[ai][m][bj];
                        const f32x4 x0 = (f32x4){hlo(o.x), hhi(o.x), hlo(o.y), hhi(o.y)}, x1 = (f32x4){hlo(o.z), hhi(o.z), hlo(o.w), hhi(o.w)};
                        acc[ai][bj][m][0] = x0 + gv[bj][0] * acc[ai][bj][m][0]; acc[ai][bj][m][1] = x1 + gv[bj][1] * acc[ai][bj][m][1]; }
        }
        }
        __builtin_amdgcn_sched_barrier(0);
        asm volatile("" : "+v"(fr), "+v"(fq));
        const int lane = fq * 16 + fr;
#pragma unroll
        for (int ai = 0; ai < 2; ++ai)
#pragma unroll
            for (int m = 0; m < 4; ++m) { float q = 0.f;
#pragma unroll
                for (int bj = 0; bj < 2; ++bj)
#pragma unroll
                    for (int n = 0; n < 2; ++n) { const f32x4 x = acc[ai][bj][m][n]; q += (x[0] * x[0] + x[1] * x[1]) + (x[2] * x[2] + x[3] * x[3]); }
                q += shfl_from(q, lane ^ 16); q += shfl_from(q, lane ^ 32);
                if (fq == 0) P[(ai * HALF + wr * 64 + m * 16 + fr) * 4 + wc] = q; }
        asm volatile("s_waitcnt lgkmcnt(0)" ::: "memory"); __builtin_amdgcn_s_barrier(); asm volatile("" ::: "memory");
        const int t = wid * 64 + lane;
        if (wid < 4) { const f32x4 p = *(const PG8_LAS f32x4*)(P + t * 4);
            __hip_atomic_store((unsigned*)part + ((size_t)u.pm * BM + t) * 8 + u.pn, __float_as_uint((p[0] + p[1]) + (p[2] + p[3])), __ATOMIC_RELAXED, __HIP_MEMORY_SCOPE_AGENT);
            asm volatile("s_waitcnt vmcnt(0)" ::: "memory");
            if (lane == 0) __hip_atomic_fetch_add(cnt + 64 * u.pm, 1u, __ATOMIC_RELAXED, __HIP_MEMORY_SCOPE_AGENT); }
        if (wid == 0) {
            unsigned got, it_; unsigned tmpv; const unsigned* cp = cnt + 64 * u.pm;
            asm volatile("s_mov_b32 %2, 0\n.Lpw%=: global_load_dword %0, %3, off sc1\n\ts_waitcnt vmcnt(0)\n\tv_readfirstlane_b32 %1, %0\n\ts_cmp_ge_u32 %1, %4\n\ts_cbranch_scc1 .Lpd%=\n\ts_sleep 2\n\ts_add_u32 %2, %2, 1\n\ts_cmp_lt_u32 %2, 0x40000\n\ts_cbranch_scc1 .Lpw%=\n.Lpd%=:"
                         : "=&v"(tmpv), "=&s"(got), "=&s"(it_) : "v"(cp), "s"(want) : "scc", "memory");
            const bool dead = got < want;
            if (dead && lane == 0) __hip_atomic_store(tmo, 1u, __ATOMIC_RELAXED, __HIP_MEMORY_SCOPE_AGENT);
            __builtin_amdgcn_fence(__ATOMIC_ACQUIRE, "agent");
            if (lane == 0) flag[0] = dead ? 1u : 0u; }
        asm volatile("s_waitcnt vmcnt(0) lgkmcnt(0)" ::: "memory"); __builtin_amdgcn_s_barrier(); asm volatile("" ::: "memory");
        const bool bad = flag[0] != 0u;
        if (wid < 4) { const unsigned long long* sl = (const unsigned long long*)((const unsigned*)part + ((size_t)u.pm * BM + t) * 8); float q = 0.f;
#pragma unroll
            for (int k = 0; k < 4; ++k) { const unsigned long long w = __hip_atomic_load(sl + k, __ATOMIC_RELAXED, __HIP_MEMORY_SCOPE_AGENT); q += __uint_as_float((unsigned)w) + __uint_as_float((unsigned)(w >> 32)); }
            S[t] = 1.0f / sqrtf(q * (1.0f / 2048.0f) + 1e-6f); }
        asm volatile("s_waitcnt vmcnt(0) lgkmcnt(0)" ::: "memory"); __builtin_amdgcn_s_barrier(); asm volatile("" ::: "memory");
        __builtin_amdgcn_sched_barrier(0);
        asm volatile("" : "+v"(fr), "+v"(fq));
        const int row0 = u.pm * BM + wr * 64 + fr, col0 = u.pn * BM + wc * 32 + 8 * fq;
        const PG8_LAS float* vb = (const PG8_LAS float*)(lds + EPI_LDS_OFF + buf * 4096) + wc * 32 + 8 * fq;
        const float qnan = __builtin_nanf("");
        if constexpr (FINAL) {
            f32x4 gs[2][2];
#pragma unroll
            for (int bj = 0; bj < 2; ++bj)
#pragma unroll
                for (int n = 0; n < 2; ++n) gs[bj][n] = *(const PG8_LAS f32x4*)(vb + 256 + bj * HALF + 4 * n);
#pragma unroll
            for (int ai = 0; ai < 2; ++ai)
#pragma unroll
                for (int m = 0; m < 4; ++m) { const float rstd = bad ? qnan : S[ai * HALF + wr * 64 + m * 16 + fr]; const unsigned off = (unsigned)(row0 + ai * HALF + m * 16) * 2048u + (unsigned)col0;
#pragma unroll
                    for (int bj = 0; bj < 2; ++bj) { *(f32x4*)(fout + off + bj * HALF) = acc[ai][bj][m][0] * rstd * gs[bj][0]; *(f32x4*)(fout + off + bj * HALF + 4) = acc[ai][bj][m][1] * rstd * gs[bj][1]; } }
        } else {
        f32x4 gs[2][2], sh[2][2];
#pragma unroll
        for (int bj = 0; bj < 2; ++bj)
#pragma unroll
            for (int n = 0; n < 2; ++n) { gs[bj][n] = *(const PG8_LAS f32x4*)(vb + 256 + bj * HALF + 4 * n) * (*(const PG8_LAS f32x4*)(vb + 512 + bj * HALF + 4 * n) + 1.0f); sh[bj][n] = *(const PG8_LAS f32x4*)(vb + 768 + bj * HALF + 4 * n); }
#pragma unroll
        for (int ai = 0; ai < 2; ++ai)
#pragma unroll
            for (int m = 0; m < 4; ++m) { const float rstd = bad ? qnan : S[ai * HALF + wr * 64 + m * 16 + fr]; const unsigned off = (unsigned)(row0 + ai * HALF + m * 16) * 2048u + (unsigned)col0;
#pragma unroll
                for (int bj = 0; bj < 2; ++bj) { const f32x4 x0 = acc[ai][bj][m][0], x1 = acc[ai][bj][m][1];
                    u32x4 w; w.x = pkh2(x0[0], x0[1]); w.y = pkh2(x0[2], x0[3]); w.z = pkh2(x1[0], x1[1]); w.w = pkh2(x1[2], x1[3]);
                    *(u32x4*)(xnew + off + bj * HALF) = w;
                    const f32x4 h0 = x0 * rstd * gs[bj][0] + sh[bj][0], h1 = x1 * rstd * gs[bj][1] + sh[bj][1];
                    w.x = cvt_pk_bf16(h0[0], h0[1]); w.y = cvt_pk_bf16(h0[2], h0[3]); w.z = cvt_pk_bf16(h1[0], h1[1]); w.w = cvt_pk_bf16(h1[2], h1[3]);
                    *(u32x4*)(hout + off + bj * HALF) = w; } }
        }
    }
};
struct EpiPlain {
    static constexpr bool PERM = true, AFTER_DRAIN = false; static constexpr int PMODE = 1, KSPLIT = 0; static constexpr bool PREF = false;
    bf16_t* O; int ldc;
    __device__ __forceinline__ void operator()(const f32x4 (&acc)[2][2][4][2], const Unit& u, int wr, int wc, int fr, int fq) const {
        const int row0 = u.pm * BM + wr * 64 + fr, col0 = u.pn * BM + wc * 32 + 8 * fq;
#pragma unroll
        for (int ai = 0; ai < 2; ++ai)
#pragma unroll
            for (int m = 0; m < 4; ++m) { bf16_t* rowp = O + (size_t)(row0 + ai * HALF + m * 16) * ldc + col0;
#pragma unroll
                for (int bj = 0; bj < 2; ++bj) { const f32x4 v0 = acc[ai][bj][m][0], v1 = acc[ai][bj][m][1];
                    u32x4 w; w.x = cvt_pk_bf16(v0[0], v0[1]); w.y = cvt_pk_bf16(v0[2], v0[3]); w.z = cvt_pk_bf16(v1[0], v1[1]); w.w = cvt_pk_bf16(v1[2], v1[3]);
                    *(u32x4*)(rowp + bj * HALF) = w; } }
    }
};

struct EpiUpCG {
    static constexpr bool PERM = true, AFTER_DRAIN = false; static constexpr int PMODE = 1, KSPLIT = 0; static constexpr bool PREF = true;
    bf16_t* ACT; bf16_t* GB; const float* cw; const float* cb;
    __device__ __forceinline__ void prefetch(const Unit& u, int buf, PG8_LAS unsigned char* lds, int wid, int lane) const {
        if (wid < 2) { const int v = 2 * wid + (lane >> 5);
            const float* src = (v < 3 ? cw + v * 5632 : cb) + u.pn * 128 + (lane & 31) * 4;
            __builtin_amdgcn_global_load_lds((const unsigned*)src, (PG8_LAS unsigned*)(lds + EPI_LDS_OFF + buf * 2048 + wid * 1024), 16, 0, 0); }
    }
    __device__ __forceinline__ void run(const f32x4 (&acc)[2][2][4][2], const Unit& u, int wr, int wc, int fr, int fq, PG8_LAS unsigned char* lds, int buf) const {
        const int row0 = u.pm * BM + wr * 64 + fr, ch0 = u.pn * 128 + wc * 32 + 8 * fq;
        const PG8_LAS float* vl = (const PG8_LAS float*)(lds + EPI_LDS_OFF + buf * 2048) + wc * 32 + 8 * fq;
        const int lane = fq * 16 + fr, lup = (lane & 48) | ((lane - 1) & 15), ldn = (lane & 48) | ((lane + 1) & 15);
        f32x4 w0[2], w1[2], w2[2], bb[2];
#pragma unroll
        for (int n = 0; n < 2; ++n) { w0[n] = *(const PG8_LAS f32x4*)(vl + 4 * n); w1[n] = *(const PG8_LAS f32x4*)(vl + 128 + 4 * n); w2[n] = *(const PG8_LAS f32x4*)(vl + 256 + 4 * n); bb[n] = *(const PG8_LAS f32x4*)(vl + 384 + 4 * n); }
#pragma unroll
        for (int ai = 0; ai < 2; ++ai) {
            unsigned op[4][2][2];
#pragma unroll
            for (int n = 0; n < 2; ++n)
#pragma unroll
                for (int ep = 0; ep < 2; ++ep) {
                    float ov[4][2], xv[4][2];
#pragma unroll
                    for (int eh = 0; eh < 2; ++eh) { const int e = 2 * ep + eh;
                        float R[4], L[4];
#pragma unroll
                        for (int m = 0; m < 4; ++m) { R[m] = dpp_ror<1>(acc[ai][1][m][n][e]); L[m] = dpp_ror<15>(acc[ai][1][m][n][e]); }
#pragma unroll
                        for (int m = 0; m < 4; ++m) {
                            const float up = (fr == 0) ? R[m > 0 ? m - 1 : 0] : R[m];
                            const float dn = (fr == 15) ? L[m < 3 ? m + 1 : 3] : L[m];
                            xv[m][eh] = up * w0[n][e] + acc[ai][1][m][n][e] * w1[n][e] + dn * w2[n][e] + bb[n][e];
                        } }
#pragma unroll
                    for (int m = 0; m < 4; ++m) {
                        const float p0 = __builtin_amdgcn_exp2f(fminf(-1.4426950408889634f * xv[m][0], 60.0f)) + 1.0f, p1 = __builtin_amdgcn_exp2f(fminf(-1.4426950408889634f * xv[m][1], 60.0f)) + 1.0f;
                        const float r = __builtin_amdgcn_rcpf(p0 * p1);
                        const bool edge = (m == 0 && fr == 0) || (m == 3 && fr == 15);
                        ov[m][0] = edge ? acc[ai][0][m][n][2 * ep] : xv[m][0] * (r * p1) * acc[ai][0][m][n][2 * ep];
                        ov[m][1] = edge ? acc[ai][0][m][n][2 * ep + 1] : xv[m][1] * (r * p0) * acc[ai][0][m][n][2 * ep + 1];
                    }
#pragma unroll
                    for (int m = 0; m < 4; ++m) op[m][n][ep] = cvt_pk_bf16(ov[m][0], ov[m][1]);
                    __builtin_amdgcn_sched_barrier(0);
                }
#pragma unroll
            for (int m = 0; m < 4; ++m) {
                u32x4 w; w.x = op[m][0][0]; w.y = op[m][0][1]; w.z = op[m][1][0]; w.w = op[m][1][1];
                *(u32x4*)(ACT + (size_t)(row0 + ai * HALF + m * 16) * 5632 + ch0) = w;
            }
            const int grp = u.pm * 4 + ai * 2 + wr;
            if (fr <= 1) { const f32x4 g0 = acc[ai][1][0][0], g1 = acc[ai][1][0][1];
                u32x4 w; w.x = cvt_pk_bf16(g0[0], g0[1]); w.y = cvt_pk_bf16(g0[2], g0[3]); w.z = cvt_pk_bf16(g1[0], g1[1]); w.w = cvt_pk_bf16(g1[2], g1[3]);
                *(u32x4*)(GB + ((size_t)(grp * 4 + fr)) * 5632 + ch0) = w; }
            if (fr >= 14) { const f32x4 g0 = acc[ai][1][3][0], g1 = acc[ai][1][3][1];
                u32x4 w; w.x = cvt_pk_bf16(g0[0], g0[1]); w.y = cvt_pk_bf16(g0[2], g0[3]); w.z = cvt_pk_bf16(g1[0], g1[1]); w.w = cvt_pk_bf16(g1[2], g1[3]);
                *(u32x4*)(GB + ((size_t)(grp * 4 + fr - 12)) * 5632 + ch0) = w; }
        }
    }
};

struct EpiG2M {
    static constexpr bool PERM = true, AFTER_DRAIN = false; static constexpr int PMODE = 1, KSPLIT = 1024; static constexpr bool PREF = false;
    const bf16_t* QKG; bf16_t* MB;
    __device__ __forceinline__ void midk(f32x4 (&acc)[2][2][4][2], const Unit& u, int wr, int wc, int fr, int fq) const {
        asm volatile("" : "+v"(fr), "+v"(fq));
        scale<0>(acc, u, wr, wc, fr, fq);
    }
    template <int WHICH> __device__ __forceinline__ void scale(f32x4 (&acc)[2][2][4][2], const Unit& u, int wr, int wc, int fr, int fq) const {
        const int row0 = u.pm * BM + wr * 64 + fr, gcol = 3072 + u.pn * 512 + WHICH * 128 + wc * 32 + 8 * fq;
        u32x4 g[2][4][2];
#pragma unroll
        for (int ai = 0; ai < 2; ++ai)
#pragma unroll
            for (int m = 0; m < 4; ++m)
#pragma unroll
                for (int bj = 0; bj < 2; ++bj) g[ai][m][bj] = *(const u32x4*)(QKG + (size_t)(row0 + ai * HALF + m * 16) * 7168 + gcol + bj * 256);
#pragma unroll
        for (int ai = 0; ai < 2; ++ai)
#pragma unroll
            for (int m = 0; m < 4; ++m)
#pragma unroll
                for (int bj = 0; bj < 2; ++bj) {
                    const unsigned gw[4] = {g[ai][m][bj].x, g[ai][m][bj].y, g[ai][m][bj].z, g[ai][m][bj].w};
#pragma unroll
                    for (int j = 0; j < 4; ++j) { acc[ai][bj][m][j >> 1][(2 * j) & 3] *= bflo(gw[j]); acc[ai][bj][m][j >> 1][(2 * j + 1) & 3] *= bfhi(gw[j]); }
                }
    }
    __device__ __forceinline__ void operator()(f32x4 (&acc)[2][2][4][2], const Unit& u, int wr, int wc, int fr, int fq) const {
        scale<1>(acc, u, wr, wc, fr, fq);
        const int row0 = u.pm * BM + wr * 64 + fr, col0 = u.pn * BM + wc * 32 + 8 * fq;
#pragma unroll
        for (int ai = 0; ai < 2; ++ai)
#pragma unroll
            for (int m = 0; m < 4; ++m)
#pragma unroll
                for (int bj = 0; bj < 2; ++bj) { const f32x4 v0 = acc[ai][bj][m][0], v1 = acc[ai][bj][m][1];
                    u32x4 w; w.x = cvt_pk_bf16(v0[0], v0[1]); w.y = cvt_pk_bf16(v0[2], v0[3]); w.z = cvt_pk_bf16(v1[0], v1[1]); w.w = cvt_pk_bf16(v1[2], v1[3]);
                    *(u32x4*)(MB + (size_t)(row0 + ai * HALF + m * 16) * 2048 + col0 + bj * HALF) = w; }
    }
};
template <class Epi, class Sched, bool ALIGN_EPI = false, bool SP2 = false>
__device__ __forceinline__ void gemm_phase(PG8_LAS unsigned char* lds, const Gemm g, const Sched& S, const Epi& E, const int tid_in) {
    int tid_l = tid_in; asm volatile("" : "+v"(tid_l));
    const int tid = tid_l, wid = __builtin_amdgcn_readfirstlane(tid >> 6), lane = tid & 63, wr = wid >> 2, wc = wid & 3, fr = lane & 15, fq = lane >> 4;
    const int K = g.K, nt = K / BK;
    unsigned voffA[2], voffB[2];
#pragma unroll
    for (int i = 0; i < 2; ++i) { int R, C; stage_rc(tid * 16 + i * 8192, R, C); const int Rb = perm_row<Epi::PMODE>(R);
        voffA[i] = (unsigned)(R * K + C) * 2u; voffB[i] = (unsigned)(Rb * K + C) * 2u; }
    const size_t kstep = (size_t)(BK * 2);
    const size_t hstep = (size_t)HALF * K * 2;
    const size_t tstep = 2 * hstep;
    const unsigned ldsw = (unsigned)wid * 1024u;
    const int aoff = lds_byte(wr * 64 + fr, fq * 8), boff = lds_byte(wc * 32 + fr, fq * 8);
#define PG8_SA(b, h) (((b) * 2 + (h)) * HTB)
#define PG8_SB(b, h) ((4 + (b) * 2 + (h)) * HTB)
#define PG8_STAGE(bufoff, gbase, voff) do { _Pragma("unroll") for (int _i = 0; _i < 2; ++_i) \
        __builtin_amdgcn_global_load_lds((const unsigned*)((const char*)(gbase) + (voff)[_i]), (PG8_LAS unsigned*)(lds + (bufoff) + ldsw + _i * 8192), 16, 0, 0); } while (0)
#define PG8_LDA(dst, b, h) do { _Pragma("unroll") for (int m = 0; m < 4; ++m) _Pragma("unroll") for (int k = 0; k < 2; ++k) dst[m][k] = *(const PG8_LAS bf16x8*)(lds + PG8_SA(b, h) + aoff + m * 2048 + k * 1024); } while (0)
#define PG8_LDB(dst, b, h) do { _Pragma("unroll") for (int n = 0; n < 2; ++n) _Pragma("unroll") for (int k = 0; k < 2; ++k) dst[n][k] = *(const PG8_LAS bf16x8*)(lds + PG8_SB(b, h) + boff + n * 2048 + k * 1024); } while (0)
#define PG8_MMA(ai, bj, At, Bt) do { __builtin_amdgcn_s_setprio(1); _Pragma("unroll") for (int m = 0; m < 4; ++m) _Pragma("unroll") for (int n = 0; n < 2; ++n) _Pragma("unroll") for (int k = 0; k < 2; ++k) \
        acc[ai][bj][m][n] = __builtin_amdgcn_mfma_f32_16x16x32_bf16(Bt[n][k], At[m][k], acc[ai][bj][m][n], 0, 0, 0); __builtin_amdgcn_s_setprio(0); } while (0)
#define PG8_WAIT_V(n) asm volatile("s_waitcnt vmcnt(" #n ")" ::: "memory")
#define PG8_WAIT_L(n) asm volatile("s_waitcnt lgkmcnt(" #n ")" ::: "memory")
#define PG8_BAR __builtin_amdgcn_s_barrier()
#define PG8_SCHED __builtin_amdgcn_sched_barrier(0)
    Unit cur, nxt; int ui = 0;
    if (!S.next(0, cur)) return;
    f32x4 acc[2][2][4][2];
#pragma unroll
    for (int a = 0; a < 2; ++a)
#pragma unroll
        for (int b = 0; b < 2; ++b)
#pragma unroll
            for (int m = 0; m < 4; ++m)
#pragma unroll
                for (int n = 0; n < 2; ++n) acc[a][b][m][n] = (f32x4){0.f, 0.f, 0.f, 0.f};
    bf16x8 At[4][2], B0[2][2], B1[2][2];
    const char* cA = (const char*)g.A + (size_t)cur.pm * tstep; const char* cB = (const char*)g.Bt + (size_t)cur.pn * tstep;
    S.a_ready(cur);
    if constexpr (Epi::PREF) E.prefetch(cur, 0, lds, wid, lane);
    if constexpr (SP2) {
        PG8_STAGE(PG8_SB(0, 0), cB, voffB); PG8_STAGE(PG8_SB(0, 1), cB + hstep, voffB); PG8_STAGE(PG8_SA(0, 0), cA, voffA); PG8_STAGE(PG8_SA(0, 1), cA + hstep, voffA);
        if (wr == 1) PG8_BAR;
        PG8_WAIT_V(2); PG8_BAR;
        PG8_STAGE(PG8_SB(1, 0), cB + kstep, voffB); PG8_STAGE(PG8_SA(1, 0), cA + kstep, voffA); PG8_STAGE(PG8_SB(1, 1), cB + hstep + kstep, voffB);
        PG8_WAIT_V(6); PG8_BAR;
    } else {
        PG8_STAGE(PG8_SB(0, 0), cB, voffB); PG8_STAGE(PG8_SA(0, 0), cA, voffA); PG8_STAGE(PG8_SB(0, 1), cB + hstep, voffB); PG8_STAGE(PG8_SA(0, 1), cA + hstep, voffA);
        if (wr == 1) PG8_BAR;
        PG8_WAIT_V(4); PG8_BAR;
        PG8_STAGE(PG8_SB(1, 0), cB + kstep, voffB); PG8_STAGE(PG8_SA(1, 0), cA + kstep, voffA); PG8_STAGE(PG8_SB(1, 1), cB + hstep + kstep, voffB);
        PG8_WAIT_V(6); PG8_BAR;
    }
    for (;;) {
        const bool has_next = S.next(ui + 1, nxt);
        const char* nA = has_next ? (const char*)g.A + (size_t)nxt.pm * tstep : cA; const char* nB = has_next ? (const char*)g.Bt + (size_t)nxt.pn * tstep : cB;
        for (int t = 0; t < nt; t += 2) {
            if constexpr (Epi::KSPLIT > 0) { if (t == Epi::KSPLIT / BK) E.midk(acc, cur, wr, wc, fr, fq); }
            const bool last = (t == nt - 2);
            const char* a1 = cA + (size_t)(t + 1) * kstep;
            const char* a2 = last ? nA : cA + (size_t)(t + 2) * kstep; const char* b2 = last ? nB : cB + (size_t)(t + 2) * kstep;
            const char* a3 = a2 + kstep; const char* b3 = b2 + kstep;
            if (last && has_next) S.a_ready(nxt);
            if constexpr (SP2) {
            PG8_LDB(B0, 0, 0); PG8_LDB(B1, 0, 1); PG8_SCHED; PG8_LDA(At, 0, 0); PG8_STAGE(PG8_SA(1, 1), a1 + hstep, voffA);
            PG8_WAIT_V(8); PG8_WAIT_L(0); PG8_BAR; PG8_MMA(0, 0, At, B0); PG8_MMA(0, 1, At, B1); PG8_BAR; PG8_SCHED;
            PG8_LDA(At, 0, 1); PG8_STAGE(PG8_SB(0, 0), b2, voffB); PG8_STAGE(PG8_SB(0, 1), b2 + hstep, voffB); PG8_STAGE(PG8_SA(0, 0), a2, voffA);
            PG8_WAIT_V(8); PG8_WAIT_L(0); PG8_BAR; PG8_MMA(1, 0, At, B0); PG8_MMA(1, 1, At, B1); PG8_BAR; PG8_SCHED;
            PG8_LDB(B0, 1, 0); PG8_LDB(B1, 1, 1); PG8_SCHED; PG8_LDA(At, 1, 0); PG8_STAGE(PG8_SA(0, 1), a2 + hstep, voffA);
            PG8_WAIT_V(8); PG8_WAIT_L(0); PG8_BAR; PG8_MMA(0, 0, At, B0); PG8_MMA(0, 1, At, B1); PG8_BAR; PG8_SCHED;
            PG8_LDA(At, 1, 1); PG8_STAGE(PG8_SB(1, 0), b3, voffB); PG8_STAGE(PG8_SB(1, 1), b3 + hstep, voffB); PG8_STAGE(PG8_SA(1, 0), a3, voffA);
            PG8_WAIT_V(8); PG8_WAIT_L(0); PG8_BAR; PG8_MMA(1, 0, At, B0); PG8_MMA(1, 1, At, B1); PG8_BAR; PG8_SCHED;
            } else {
            PG8_LDB(B0, 0, 0); PG8_SCHED; PG8_LDA(At, 0, 0); PG8_STAGE(PG8_SA(1, 1), a1 + hstep, voffA);
            PG8_WAIT_L(8); PG8_BAR; PG8_WAIT_L(0); PG8_MMA(0, 0, At, B0); PG8_BAR; PG8_SCHED;
            PG8_LDB(B1, 0, 1); PG8_STAGE(PG8_SB(0, 0), b2, voffB);
            PG8_BAR; PG8_WAIT_L(0); PG8_MMA(0, 1, At, B1); PG8_BAR;
            PG8_LDA(At, 0, 1); PG8_STAGE(PG8_SA(0, 0), a2, voffA);
            PG8_BAR; PG8_WAIT_L(0); PG8_MMA(1, 0, At, B0); PG8_BAR; PG8_SCHED;
            PG8_STAGE(PG8_SB(0, 1), b2 + hstep, voffB);
            PG8_WAIT_V(6); PG8_BAR; PG8_MMA(1, 1, At, B1); PG8_BAR;
            PG8_LDB(B0, 1, 0); PG8_SCHED; PG8_LDA(At, 1, 0); PG8_STAGE(PG8_SA(0, 1), a2 + hstep, voffA);
            PG8_WAIT_L(8); PG8_BAR; PG8_WAIT_L(0); PG8_MMA(0, 0, At, B0); PG8_BAR; PG8_SCHED;
            PG8_LDB(B1, 1, 1); PG8_STAGE(PG8_SB(1, 0), b3, voffB);
            PG8_BAR; PG8_WAIT_L(0); PG8_MMA(0, 1, At, B1); PG8_BAR;
            PG8_LDA(At, 1, 1); PG8_STAGE(PG8_SA(1, 0), a3, voffA);
            PG8_BAR; PG8_WAIT_L(0); PG8_MMA(1, 0, At, B0); PG8_BAR; PG8_SCHED;
            PG8_STAGE(PG8_SB(1, 1), b3 + hstep, voffB);
            PG8_WAIT_V(6); PG8_BAR; PG8_MMA(1, 1, At, B1); PG8_BAR;
            }
        }
        if constexpr (ALIGN_EPI) { if (wr == 0) PG8_BAR; }
        if constexpr (Epi::PREF) { if (has_next) E.prefetch(nxt, (ui + 1) & 1, lds, wid, lane); E.run(acc, cur, wr, wc, fr, fq, lds, ui & 1); S.done(cur); }
        else if constexpr (!Epi::AFTER_DRAIN) { E(acc, cur, wr, wc, fr, fq); S.done(cur); }
        if (!has_next) break;
#pragma unroll
        for (int a = 0; a < 2; ++a)
#pragma unroll
            for (int b = 0; b < 2; ++b)
#pragma unroll
                for (int m = 0; m < 4; ++m)
#pragma unroll
                    for (int n = 0; n < 2; ++n) acc[a][b][m][n] = (f32x4){0.f, 0.f, 0.f, 0.f};
        cur = nxt; cA = nA; cB = nB; ++ui;
        if constexpr (ALIGN_EPI) { if (wr == 1) PG8_BAR; }
    }
    PG8_WAIT_V(0);
    if constexpr (!ALIGN_EPI) { if (wr == 0) PG8_BAR; }
    PG8_BAR;
    if constexpr (Epi::AFTER_DRAIN) { E.fused(acc, cur, wr, wc, fr, fq, lds, wid, lane); S.done(cur); }
#undef PG8_SA
#undef PG8_SB
#undef PG8_STAGE
#undef PG8_LDA
#undef PG8_LDB
#undef PG8_MMA
#undef PG8_WAIT_V
#undef PG8_WAIT_L
#undef PG8_BAR
#undef PG8_SCHED
}
}

#define XB_TMO      128
#define XB_XCNT(j)  (256  + 64 * (j))
#define XB_XSUB(j)  (1280 + 64 * (j))
#define XB_XGEN(j)  (2304 + 64 * (j))
#define XB_TOP      3328
#define XB_TOPGEN   3392
#define XCD_BAR_WORDS 3456
#define XB_SPIN_CAP (1u << 18)

__device__ __forceinline__ unsigned xb_ld(unsigned* p)              { return __hip_atomic_load(p, __ATOMIC_RELAXED, __HIP_MEMORY_SCOPE_AGENT); }
__device__ __forceinline__ unsigned xb_add(unsigned* p, unsigned v) { return __hip_atomic_fetch_add(p, v, __ATOMIC_RELAXED, __HIP_MEMORY_SCOPE_AGENT); }
__device__ __forceinline__ unsigned xb_xcc_id() { return (unsigned)__builtin_amdgcn_s_getreg((3 << 11) | 20) & 0xFu; }
#define XB_SPIN(cond, bar) do { unsigned _sp = 0; while (cond) { __builtin_amdgcn_s_sleep(1); \
    if ((++_sp & 255u) == 0u) { if (xb_ld(&(bar)[XB_TMO])) break; if (_sp > XB_SPIN_CAP) { atomicAdd(&(bar)[XB_TMO], 1u); break; } } } } while (0)

struct XcdBarrier {
    unsigned* bar; unsigned x;
    volatile LAS unsigned* st;
};

__device__ __forceinline__ XcdBarrier xcd_barrier_post(unsigned* bar, volatile LAS unsigned* st) {
    XcdBarrier b; b.bar = bar; b.x = xb_xcc_id(); b.st = st;
    if (threadIdx.x == 0) (void)xb_add(&bar[XB_XCNT(b.x)], 1u);
    return b;
}
__device__ __forceinline__ void xcd_barrier_complete(unsigned* bar, unsigned x, unsigned& nloc, unsigned& nx) {
    const unsigned G = gridDim.x * gridDim.y * gridDim.z;
    unsigned sum, cnt, mine, sp = 0u;
    for (;;) {
        sum = 0u; cnt = 0u; mine = 0u;
#pragma unroll
        for (unsigned j = 0; j < 16; ++j) { const unsigned c = xb_ld(&bar[XB_XCNT(j)]); sum += c; cnt += (c > 0u) ? 1u : 0u; mine = (j == x) ? c : mine; }
        if (sum == G) break;
        __builtin_amdgcn_s_sleep(1);
        if ((++sp & 255u) == 0u) { if (xb_ld(&bar[XB_TMO])) break; if (sp > XB_SPIN_CAP) { atomicAdd(&bar[XB_TMO], 1u); break; } }
    }
    nloc = mine > 0u ? mine : 1u; nx = cnt > 0u ? cnt : 1u;
}

__device__ __forceinline__ void xcd_barrier(const XcdBarrier& b, const bool leader) {
    asm volatile("s_waitcnt vmcnt(0)" ::: "memory");
    __syncthreads();
    if (leader) {
        unsigned* bar = b.bar;
        __builtin_amdgcn_s_waitcnt(0);
        unsigned nloc = b.st[0], nx = b.st[1];
        if (nloc == 0u) { xcd_barrier_complete(bar, b.x, nloc, nx); b.st[0] = nloc; b.st[1] = nx; }
        const unsigned old = xb_add(&bar[XB_XSUB(b.x)], 1u);
        const unsigned gen = old / nloc;
        if (old + 1u == (gen + 1u) * nloc) {
            __builtin_amdgcn_fence(__ATOMIC_RELEASE, "agent");
            asm volatile("s_waitcnt vmcnt(0)" ::: "memory");
            const unsigned og = xb_add(&bar[XB_TOP], 1u);
            const unsigned tg = og / nx;
            if (og + 1u == (tg + 1u) * nx) xb_add(&bar[XB_TOPGEN], 1u);
            else XB_SPIN(xb_ld(&bar[XB_TOPGEN]) == tg, bar);
            __builtin_amdgcn_fence(__ATOMIC_ACQUIRE, "agent");
            xb_add(&bar[XB_XGEN(b.x)], 1u);
            asm volatile("s_waitcnt vmcnt(0)" ::: "memory");
        } else {
            XB_SPIN(xb_ld(&bar[XB_XGEN(b.x)]) == gen, bar);
            __builtin_amdgcn_fence(__ATOMIC_ACQUIRE, "agent");
            asm volatile("s_waitcnt vmcnt(0)" ::: "memory");
        }
    }
    __syncthreads();
}


constexpr size_t MiB = 1u << 20;
constexpr size_t WS_CTL = 0, CTL_ZERO_BYTES = 1 * MiB;
constexpr size_t WS_MOD = 1 * MiB;
constexpr size_t WS_H2F = 4 * MiB;
constexpr size_t WS_KF = 8 * MiB;
constexpr size_t WS_WIN = 136 * MiB;
constexpr size_t WS_WUP = 320 * MiB;
constexpr size_t WS_WDN = 496 * MiB;
constexpr size_t WS_WOUT = 584 * MiB;
constexpr size_t WS_WBH = 616 * MiB;
constexpr size_t WS_HB = 640 * MiB;
constexpr size_t WS_YHT = 704 * MiB;
constexpr size_t WS_YH = 736 * MiB;
constexpr size_t WS_MB = 784 * MiB;
constexpr size_t WS_ACT = 1522 * MiB;
constexpr size_t WS_UT = 848 * MiB;
constexpr size_t WS_VT = 944 * MiB;
constexpr size_t WS_QKG = 992 * MiB;
constexpr size_t WS_OG = 1216 * MiB;
constexpr size_t WS_LSE = 1264 * MiB;
constexpr size_t WS_GB = 848 * MiB;
constexpr size_t WS_HB2 = 1266 * MiB;
constexpr size_t WS_XB = 1330 * MiB;
constexpr size_t WS_PART = 1698 * MiB;
constexpr size_t WS_END = 1699 * MiB;
constexpr int CW_BAR = 4096, CW_PANEL = 131072  , CW_TMO = CW_PANEL + 64 * 64, CW_PANEL2 = CW_PANEL + 8192  ;
constexpr int LDS_BYTES = 155648, MISC_OFF = 139264; static_assert(pg8::EPI_LDS_OFF == MISC_OFF + 1024 && pg8::EPI_LDS_OFF + 13312 + 64 <= LDS_BYTES, "epilogue vector buffers + row-sum exchange tables");
constexpr int N_PHASES = 1 + DEPTH_ * 2 + 1 + DEPTH_ * NCHUNK * 7 + 1;

#ifndef PG8_ALIGN
#define PG8_ALIGN true
#endif
struct Args { const float* in[29]; float* out; unsigned char* ws; int ph_lo, ph_hi; };

using pg8::bflo; using pg8::bfhi;
__device__ __forceinline__ float wave_sum(float v, int lane) {
#pragma unroll
    for (int o = 1; o < 64; o <<= 1) v += shfl_from(v, lane ^ o);
    return v;
}
__device__ __forceinline__ void transpose_item(const float* W, int K, int N, bf16_t* WT, int k0, int n0, int drow0, LAS float* scr, int lane) {
#pragma unroll 8
    for (int i = 0; i < 32; ++i) { const int kk = 2 * i + (lane >> 5); scr[kk * 33 + (lane & 31)] = W[(size_t)(k0 + kk) * N + n0 + (lane & 31)]; }
    asm volatile("s_waitcnt lgkmcnt(0)" ::: "memory");
    const int c = lane & 7;
#pragma unroll
    for (int j = 0; j < 4; ++j) { const int n = (lane >> 3) + 8 * j; const LAS float* s = scr + (8 * c) * 33 + n;
        u32x4 o; o.x = pk2(s[0 * 33], s[1 * 33]); o.y = pk2(s[2 * 33], s[3 * 33]); o.z = pk2(s[4 * 33], s[5 * 33]); o.w = pk2(s[6 * 33], s[7 * 33]);
        *(u32x4*)(WT + (size_t)(drow0 + n) * K + k0 + 8 * c) = o; }
    asm volatile("s_waitcnt lgkmcnt(0)" ::: "memory");
}
__device__ __forceinline__ int win_dest_row(int n0) {
    if (n0 < 3072) return n0;
    if (n0 < 4608) return n0 + 1536;
    if (n0 < 6144) return n0 + 1536;
    if (n0 < 7680) return n0 - 3072;
    const int g = n0 - 7680, c = g & 2047;
    return 7680 + (c >> 7) * 256 + (g >> 11) * 128 + (c & 127);
}
__device__ __forceinline__ int wup_dest_row(int n0) {
    const int j = (n0 < 5632) ? n0 : n0 - 5632; return (j >> 7) * 256 + ((n0 < 5632) ? 0 : 128) + (j & 127);
}
__device__ __forceinline__ void prologue_phase(const __attribute__((address_space(4))) Args* Ap, LAS unsigned char* lds, int vcu, int G, int tid) {
    const int lane = tid & 63, wave = tid >> 6;
    unsigned char* ws = Ap->ws;
    {
        LAS float* scr = (LAS float*)(lds + wave * 16384);
        const int gw = vcu * 8 + wave, NGW = G * 8;
        constexpr int I_IN = 32 * 368, I_UP = 32 * 352, I_DN = 88 * 64, I_OUT = 32 * 64, I_BH = 16 * 64, I_BA = 8 * 64, I_L = I_IN + I_UP + I_DN + I_OUT + I_BH + I_BA;
        for (int it = gw; it < DEPTH_ * I_L; it += NGW) {
            const int l = it / I_L; int r = it % I_L;
            if (r < I_IN) { const int kb = r / 368, nb = r % 368; transpose_item(Ap->in[7] + (size_t)l * 2048 * 11776, 2048, 11776, (bf16_t*)(ws + WS_WIN) + (size_t)l * 11776 * 2048, 64 * kb, 32 * nb, win_dest_row(32 * nb), scr, lane); continue; } r -= I_IN;
            if (r < I_UP) { const int kb = r / 352, nb = r % 352; transpose_item(Ap->in[24] + (size_t)l * 2048 * 11264, 2048, 11264, (bf16_t*)(ws + WS_WUP) + (size_t)l * 11264 * 2048, 64 * kb, 32 * nb, wup_dest_row(32 * nb), scr, lane); continue; } r -= I_UP;
            if (r < I_DN) { const int kb = r / 64, nb = r % 64; transpose_item(Ap->in[27] + (size_t)l * 5632 * 2048, 5632, 2048, (bf16_t*)(ws + WS_WDN) + (size_t)l * 2048 * 5632, 64 * kb, 32 * nb, 32 * nb, scr, lane); continue; } r -= I_DN;
            if (r < I_OUT) { const int kb = r / 64, nb = r % 64; transpose_item(Ap->in[22] + (size_t)l * 2048 * 2048, 2048, 2048, (bf16_t*)(ws + WS_WOUT) + (size_t)l * 2048 * 2048, 64 * kb, 32 * nb, 32 * nb, scr, lane); continue; } r -= I_OUT;
            if (r < I_BH) { const int kb = r / 64, nb = r % 64; transpose_item(Ap->in[20] + (size_t)l * 1024 * 2048, 1536, 2048, (bf16_t*)(ws + WS_WBH) + (size_t)l * 2048 * 1536, 64 * kb, 32 * nb, 32 * nb, scr, lane); continue; } r -= I_BH;
            { const int kb = r / 64, nb = r % 64; transpose_item(Ap->in[21] + (size_t)l * 512 * 2048, 1536, 2048, (bf16_t*)(ws + WS_WBH) + (size_t)l * 2048 * 1536 + 1024, 64 * kb, 32 * nb, 32 * nb, scr, lane); }
        }
    }
    __syncthreads();
    {
        LAS float* cs = (LAS float*)lds;
        LAS float* red = (LAS float*)(lds + 98304);
        bool loaded = false;
        for (int unit = vcu; unit < DEPTH_ * 192; unit += G) {
            if (!loaded) {
                for (int i = tid; i < 12 * 2048; i += NTHR) { const int b = i >> 11, k = i & 2047; const float c = (b < 4) ? Ap->in[2][b * 2048 + k] : Ap->in[3][(b - 4) * 2048 + k]; cs[i] = c / (1.0f + __expf(-c)); }
                loaded = true; __syncthreads();
            }
            const int l = unit / 192, j = (unit % 192) * 64 + lane;
            const float* wp = Ap->in[4] + ((size_t)l * 2048 + wave * 256) * 12288 + j;
            float acc[12];
#pragma unroll
            for (int b = 0; b < 12; ++b) acc[b] = 0.f;
#pragma unroll 4
            for (int k = 0; k < 256; ++k) { const float w = wp[(size_t)k * 12288];
#pragma unroll
                for (int b = 0; b < 12; ++b) acc[b] += w * cs[b * 2048 + wave * 256 + k]; }
#pragma unroll
            for (int b = 0; b < 12; ++b) red[(wave * 12 + b) * 64 + lane] = acc[b];
            __syncthreads();
            for (int i = tid; i < 12 * 64; i += NTHR) { const int b = i >> 6, jj = i & 63; float s = 0.f;
#pragma unroll
                for (int w = 0; w < 8; ++w) s += red[(w * 12 + b) * 64 + jj];
                const int col = (unit % 192) * 64 + jj;
                ((float*)(ws + WS_MOD))[((size_t)l * 12 + b) * 12288 + col] = s + Ap->in[5][l * 12288 + col]; }
            __syncthreads();
        }
    }
}
template <bool XBF> __device__ __forceinline__ void norm_phase(const void* xv, bf16_t* hout, const float* gn, const float* modb  , int sh_off, int sc_off, int gw, int NGW, int lane, bf16_t* xcopy = nullptr  ) {
    int curb = -1; f32x4 gs[8], sh[8];
    for (int row = gw; row < MROWS; row += NGW) {
        const int b = row >> 12;
        if (b != curb) { curb = b;
#pragma unroll
            for (int j = 0; j < 8; ++j) { const int col = 4 * lane + 256 * j; const f32x4 g = *(const f32x4*)(gn + col), sc = *(const f32x4*)(modb + (size_t)b * 12288 + sc_off + col);
                gs[j] = g * (sc + 1.0f); sh[j] = *(const f32x4*)(modb + (size_t)b * 12288 + sh_off + col); } }
        f32x4 v[8]; float ss = 0.f;
        if constexpr (XBF) {
            const u32x2* xr = (const u32x2*)((const bf16_t*)xv + (size_t)row * 2048) + lane; u32x2 r[8];
#pragma unroll
            for (int j = 0; j < 8; ++j) r[j] = xr[64 * j];
#pragma unroll
            for (int j = 0; j < 8; ++j) { v[j].x = hlo(r[j].x); v[j].y = hhi(r[j].x); v[j].z = hlo(r[j].y); v[j].w = hhi(r[j].y); }
        } else {
            const f32x4* xr = (const f32x4*)((const float*)xv + (size_t)row * 2048) + lane;
#pragma unroll
            for (int j = 0; j < 8; ++j) v[j] = xr[64 * j];
            if (xcopy) { u32x2* c8 = (u32x2*)(xcopy + (size_t)row * 2048) + lane;
#pragma unroll
                for (int j = 0; j < 8; ++j) { u32x2 w; w.x = pkh2(v[j].x, v[j].y); w.y = pkh2(v[j].z, v[j].w); c8[64 * j] = w; } }
        }
#pragma unroll
        for (int j = 0; j < 8; ++j) ss += (v[j].x * v[j].x + v[j].y * v[j].y) + (v[j].z * v[j].z + v[j].w * v[j].w);
        const float rstd = 1.0f / sqrtf(wave_sum(ss, lane) * (1.0f / 2048.0f) + 1e-6f);
        u32x2* o8 = (u32x2*)(hout + (size_t)row * 2048) + lane;
#pragma unroll
        for (int j = 0; j < 8; ++j) { const f32x4 y = v[j] * rstd * gs[j] + sh[j]; u32x2 w; w.x = pk2(y.x, y.y); w.y = pk2(y.z, y.w); o8[64 * j] = w; }
    }
}
__device__ __forceinline__ void final_norm_phase(const bf16_t* xb, float* out, const float* gn, int gw, int NGW, int lane) {
    f32x4 gs[8];
#pragma unroll
    for (int j = 0; j < 8; ++j) gs[j] = *(const f32x4*)(gn + 4 * lane + 256 * j);
    for (int row = gw; row < NSEQ * SEQ; row += NGW) {
        const u32x2* xr = (const u32x2*)(xb + (size_t)row * 2048) + lane; u32x2 r[8];
#pragma unroll
        for (int j = 0; j < 8; ++j) r[j] = xr[64 * j];
        f32x4 v[8]; float ss = 0.f;
#pragma unroll
        for (int j = 0; j < 8; ++j) { v[j].x = hlo(r[j].x); v[j].y = hhi(r[j].x); v[j].z = hlo(r[j].y); v[j].w = hhi(r[j].y);
            ss += (v[j].x * v[j].x + v[j].y * v[j].y) + (v[j].z * v[j].z + v[j].w * v[j].w); }
        const float rstd = 1.0f / sqrtf(wave_sum(ss, lane) * (1.0f / 2048.0f) + 1e-6f);
        f32x4* o = (f32x4*)(out + (size_t)row * 2048) + lane;
#pragma unroll
        for (int j = 0; j < 8; ++j) o[64 * j] = v[j] * rstd * gs[j];
    }
}
__device__ __forceinline__ void transpose_yh_tile(int tile, const bf16_t* YHT, bf16_t* YH, LAS bf16_t* scr, int lane) {
    const int b = tile >> 10, ct = (tile >> 6) & 15, tt = tile & 63, c0 = ct * 64, t0 = tt * 64;
#pragma unroll
    for (int i = 0; i < 8; ++i) { const int row = (lane >> 3) + 8 * i, ch = lane & 7;
        const u32x4 v = *(const u32x4*)(YHT + ((size_t)(b * 1024 + c0 + row)) * 4096 + t0 + 8 * ch);
        LAS bf16_t* d = scr + row * 66 + 8 * ch;
        d[0] = (bf16_t)(v.x & 0xffffu); d[1] = (bf16_t)(v.x >> 16); d[2] = (bf16_t)(v.y & 0xffffu); d[3] = (bf16_t)(v.y >> 16);
        d[4] = (bf16_t)(v.z & 0xffffu); d[5] = (bf16_t)(v.z >> 16); d[6] = (bf16_t)(v.w & 0xffffu); d[7] = (bf16_t)(v.w >> 16); }
    asm volatile("s_waitcnt lgkmcnt(0)" ::: "memory");
    bf16_t* orow = YH + ((size_t)(b * 4096 + t0 + lane)) * 1536 + c0;
#pragma unroll
    for (int j = 0; j < 8; ++j) { u32x4 w; unsigned q[4];
#pragma unroll
        for (int e = 0; e < 4; ++e) q[e] = (unsigned)scr[(8 * j + 2 * e) * 66 + lane] | ((unsigned)scr[(8 * j + 2 * e + 1) * 66 + lane] << 16);
        w.x = q[0]; w.y = q[1]; w.z = q[2]; w.w = q[3]; *(u32x4*)(orow + 8 * j) = w; }
    asm volatile("s_waitcnt lgkmcnt(0)" ::: "memory");
}
__device__ __forceinline__ void cg_fix_item(int idx, bf16_t* ACT, const bf16_t* GB, const float* cw, const float* cb) {
    const int col = (idx % 704) * 8, rs = idx / 704, side = rs & 1, grp = rs >> 1, row = grp * 64 + (side ? 63 : 0), t = row & 4095;
    const bf16_t* gb = GB + (size_t)grp * 4 * 5632 + col;
    u32x4 gm = (u32x4){0u, 0u, 0u, 0u}, gp = (u32x4){0u, 0u, 0u, 0u}, g0;
    if (side == 0) { g0 = *(const u32x4*)gb; gp = *(const u32x4*)(gb + 5632); if (t > 0) gm = *(const u32x4*)(gb - 5632); }
    else { gm = *(const u32x4*)(gb + 2 * 5632); g0 = *(const u32x4*)(gb + 3 * 5632); if (t < 4095) gp = *(const u32x4*)(gb + 4 * 5632); }
    bf16_t* ap = ACT + (size_t)row * 5632 + col;
    const u32x4 a = *(const u32x4*)ap;
    const f32x4 w0a = *(const f32x4*)(cw + col), w0b = *(const f32x4*)(cw + col + 4), w1a = *(const f32x4*)(cw + 5632 + col), w1b = *(const f32x4*)(cw + 5632 + col + 4);
    const f32x4 w2a = *(const f32x4*)(cw + 11264 + col), w2b = *(const f32x4*)(cw + 11264 + col + 4), ba = *(const f32x4*)(cb + col), bb = *(const f32x4*)(cb + col + 4);
    float w0[8] = {w0a.x, w0a.y, w0a.z, w0a.w, w0b.x, w0b.y, w0b.z, w0b.w}, w1[8] = {w1a.x, w1a.y, w1a.z, w1a.w, w1b.x, w1b.y, w1b.z, w1b.w};
    float w2[8] = {w2a.x, w2a.y, w2a.z, w2a.w, w2b.x, w2b.y, w2b.z, w2b.w}, bs[8] = {ba.x, ba.y, ba.z, ba.w, bb.x, bb.y, bb.z, bb.w};
    u32x4 o;
#pragma unroll
    for (int i = 0; i < 4; ++i) {
        const float xl = bflo(gm[i]) * w0[2 * i] + bflo(g0[i]) * w1[2 * i] + bflo(gp[i]) * w2[2 * i] + bs[2 * i];
        const float xh = bfhi(gm[i]) * w0[2 * i + 1] + bfhi(g0[i]) * w1[2 * i + 1] + bfhi(gp[i]) * w2[2 * i + 1] + bs[2 * i + 1];
        const float sl = xl / (1.0f + __expf(-xl)), shh = xh / (1.0f + __expf(-xh));
        o[i] = pk2(sl * bflo(a[i]), shh * bfhi(a[i]));
    }
    *(u32x4*)ap = o;
}

typedef const __attribute__((address_space(4))) Args* kargs_t;
__global__ void __launch_bounds__(512, 2) mega_fwd(Args args) {
    extern __shared__ __attribute__((aligned(16))) unsigned char lds_raw[];
    LAS unsigned char* lds = (LAS unsigned char*)lds_raw;
    const int G = gridDim.x, bx = blockIdx.x, vcu = (G % 8 == 0) ? (bx % 8) * (G / 8) + bx / 8 : bx, NGW = G * 8;
    const int lo = args.ph_lo, hi = args.ph_hi;
    const int wave_s = __builtin_amdgcn_readfirstlane(threadIdx.x >> 6);
    {
        volatile LAS unsigned* MISC = (volatile LAS unsigned*)(lds + MISC_OFF);
        for (int u = threadIdx.x; u < (LDS_BYTES - MISC_OFF) / 4; u += NTHR) MISC[u] = 0u;
        __syncthreads();
    }
    XcdBarrier bar; bar.bar = (unsigned*)(args.ws + WS_CTL) + CW_BAR; bar.x = 0; bar.st = nullptr;
    if (hi - lo > 1) bar = xcd_barrier_post((unsigned*)(args.ws + WS_CTL) + CW_BAR, (volatile LAS unsigned*)(lds + MISC_OFF) + 8);
#ifndef NOBAR_PASSES
#define NOBAR_PASSES 0
#endif
    int pc = 0;
#define IS_T0() ({ int t0_; asm volatile("v_mbcnt_lo_u32_b32 %0, -1, 0\n\tv_mbcnt_hi_u32_b32 %0, -1, %0" : "=v"(t0_)); (t0_ | wave_s) == 0; })
#define PH_IN (pc >= lo && pc < hi)
#define PH_CTX int ptid; asm volatile("v_mbcnt_lo_u32_b32 %0, -1, 0\n\tv_mbcnt_hi_u32_b32 %0, -1, %0" : "=v"(ptid)); ptid |= (wave_s << 6); const int plane = ptid & 63, pwave = __builtin_amdgcn_readfirstlane(ptid >> 6), pgw = vcu * 8 + pwave; (void)plane; (void)pgw; \
    kargs_t ap = (kargs_t)__builtin_amdgcn_kernarg_segment_ptr(); asm volatile("" : "+s"(ap)); unsigned char* const pws = ap->ws; (void)pws; int pl = l, pch = ch; asm volatile("" : "+s"(pl), "+s"(pch)); (void)pl; (void)pch;
#ifndef DUP_MASK
#define DUP_MASK 0
#endif
#ifndef DUP_REP
#define DUP_REP 2
#endif
#ifndef DUP_BAR
#define DUP_BAR 0
#endif
#define DUP(bit) for (int rep_ = 0; rep_ < (((DUP_MASK) & (bit)) ? (DUP_REP) : 1); (void)(((DUP_BAR) && ((DUP_MASK) & (bit)) && rep_ + 1 < (DUP_REP)) ? (xcd_barrier(bar, IS_T0()), 0) : 0), ++rep_)
#ifndef BAR_REP
#define BAR_REP 1
#endif
#define PH_END do { if (pc >= lo && pc + 1 < hi && pass_ == (NOBAR_PASSES)) { for (int br_ = 0; br_ < (BAR_REP); ++br_) xcd_barrier(bar, IS_T0()); } ++pc; } while (0)
#define WSP(T, off) ((T*)(pws + (off)))
#define XO_PTR (WSP(bf16_t, WS_XB) + (size_t)pch * MROWS * 2048)
#define XIN0_PTR ((pch == 0) ? ap->in[0] : ap->in[1] + (size_t)(pch - 1) * MROWS * 2048)
#define MODB_PTR (WSP(const float, WS_MOD) + ((size_t)pl * 12 + pch * 4) * 12288)
#define HB_CUR (((pl * NCHUNK + pch) & 1) ? WSP(bf16_t, WS_HB2) : WSP(bf16_t, WS_HB))

    for (int pass_ = 0; pass_ <= (NOBAR_PASSES); ++pass_) {
    pc = 0;
    if (pass_ > 0 && pass_ == (NOBAR_PASSES)) xcd_barrier(bar, IS_T0());
    { const int l = 0, ch = 0; if (PH_IN) DUP(512) { PH_CTX prologue_phase(ap, lds, vcu, G, ptid); __syncthreads(); } }
    PH_END;
    for (int l = 0; l < DEPTH_; ++l) {
        { const int ch = 0;
          if (PH_IN) DUP(1024) { PH_CTX int pvcu = vcu; asm volatile("" : "+s"(pvcu)); for (int u = pvcu; u < 512; u += G) filt_hidden_unit(u, ap->in[11] + pl * 33 * 64, ap->in[12] + pl * 64, ap->in[13] + pl * 64, ap->in[14] + pl * 64 * 64, ap->in[15] + pl * 64, ap->in[16] + pl * 64, nullptr, WSP(bf16_t, WS_H2F), (LAS float*)lds, ptid); }
          PH_END;
          if (PH_IN) DUP(2048) { PH_CTX int pvcu = vcu; asm volatile("" : "+s"(pvcu)); for (int c2 = pvcu; c2 < 512; c2 += G) filt_channel_unit2(2 * c2, WSP(const bf16_t, WS_H2F), ap->in[17] + (size_t)pl * 64 * 4096, WSP(unsigned, WS_KF), lds, ptid); }
          PH_END; }
        for (int ch = 0; ch < NCHUNK; ++ch) {
            if (l == 0 && ch == 0) {
                if (PH_IN) { PH_CTX norm_phase<false>(XIN0_PTR, WSP(bf16_t, WS_HB), ap->in[6], MODB_PTR, 0, 2048, pgw, NGW, plane, XO_PTR); }
                PH_END;
            }
            if (PH_IN) DUP(2) {
                { PH_CTX const bf16_t* Win = WSP(const bf16_t, WS_WIN) + (size_t)pl * 11776 * 2048;
                  pg8::Gemm g{Win, HB_CUR, 3584, MROWS, 2048}; pg8::StaticOrder S; S.init(3584, MROWS, G, bx); pg8::EpiG1a<0> E{WSP(bf16_t, WS_UT), WSP(bf16_t, WS_VT)};
                  pg8::gemm_phase<pg8::EpiG1a<0>, pg8::StaticOrder, PG8_ALIGN, true>(lds, g, S, E, ptid); }
                { PH_CTX const bf16_t* Win = WSP(const bf16_t, WS_WIN) + (size_t)pl * 11776 * 2048 + (size_t)3584 * 2048;
                  pg8::Gemm g{Win, HB_CUR, 512, MROWS, 2048}; pg8::StaticOrder S; S.init(512, MROWS, G, (bx + G / 2) % G); pg8::EpiG1a<1> E{WSP(bf16_t, WS_UT), WSP(bf16_t, WS_VT)};
                  pg8::gemm_phase<pg8::EpiG1a<1>, pg8::StaticOrder, PG8_ALIGN, true>(lds, g, S, E, ptid); }
                { PH_CTX const bf16_t* Win = WSP(const bf16_t, WS_WIN) + (size_t)pl * 11776 * 2048 + (size_t)4096 * 2048;
                  pg8::Gemm g{Win, HB_CUR, 512, MROWS, 2048}; pg8::StaticOrder S; S.init(512, MROWS, G, bx); pg8::EpiG1a<2> E{WSP(bf16_t, WS_UT), WSP(bf16_t, WS_VT)};
                  pg8::gemm_phase<pg8::EpiG1a<2>, pg8::StaticOrder, PG8_ALIGN, true>(lds, g, S, E, ptid); }
                { PH_CTX const bf16_t* Win = WSP(const bf16_t, WS_WIN) + (size_t)pl * 11776 * 2048;
                  pg8::Gemm g{HB_CUR, Win + (size_t)NA_ * 2048, MROWS, NB_, 2048}; pg8::StaticOrder S; S.init(MROWS, NB_, G, bx); pg8::EpiG1b E{WSP(bf16_t, WS_QKG), ap->in[8] + pl * 4096};
                  pg8::gemm_phase<pg8::EpiG1b, pg8::StaticOrder, PG8_ALIGN, true>(lds, g, S, E, ptid); }
                if (l * NCHUNK + ch + 1 < DEPTH_ * NCHUNK) {
                    PH_CTX
                    const int itn = pl * NCHUNK + pch + 1, ln = itn / NCHUNK, chn = itn % NCHUNK;
                    const bool split = (G == 256);
                    if (!split || bx >= 128) {
                        const int lw = (split ? bx - 128 : bx) * 8 + pwave, nlw = (split ? 128 : G) * 8;
                        bf16_t* hn = (itn & 1) ? WSP(bf16_t, WS_HB2) : WSP(bf16_t, WS_HB); const float* mb = WSP(const float, WS_MOD) + ((size_t)ln * 12 + chn * 4) * 12288;
                        if (ln == 0) norm_phase<false>((chn == 0) ? ap->in[0] : ap->in[1] + (size_t)(chn - 1) * MROWS * 2048, hn, ap->in[6] + ln * 2048, mb, 0, 2048, lw, nlw, plane, WSP(bf16_t, WS_XB) + (size_t)chn * MROWS * 2048);
                        else norm_phase<true>(WSP(bf16_t, WS_XB) + (size_t)chn * MROWS * 2048, hn, ap->in[6] + ln * 2048, mb, 0, 2048, lw, nlw, plane);
                    }
                }
            }
            PH_END;
            if (PH_IN) {
                DUP(4) { PH_CTX
                  hyena_units(vcu, G, WSP(const bf16_t, WS_UT), WSP(bf16_t, WS_YHT), WSP(const unsigned, WS_KF), ap->in[9] + pl * 3 * 3072, ap->in[10] + pl * 3072, ap->in[18] + pl * 2048, lds, ptid, rep_ < (DUP_REP) - 1 && ((DUP_MASK) & 4));
                  __syncthreads(); }
                DUP(8) { PH_CTX
                  attn_bias_table((LAS float*)(lds + AT_TAB_OFF), ap->in[19], ptid);
                  attn_units(vcu, G, 4 * 24 * 16, WSP(const bf16_t, WS_QKG), WSP(const bf16_t, WS_VT), WSP(bf16_t, WS_OG), WSP(float, WS_LSE), lds, ptid);
                  __syncthreads(); }
            }
            PH_END;
            if (PH_IN) DUP(16) {
                PH_CTX
                for (int tile = pgw; tile < 4096; tile += NGW) transpose_yh_tile(tile, WSP(const bf16_t, WS_YHT), WSP(bf16_t, WS_YH), (LAS bf16_t*)(lds + pwave * 8448), plane);
                for (int it = bx * NTHR + ptid; it < MROWS * 64; it += G * NTHR) attn_combine_item(it, WSP(const bf16_t, WS_OG), WSP(const float, WS_LSE), WSP(bf16_t, WS_YH), 1536, 1024);
                __syncthreads();
            }
            PH_END;
            if (PH_IN) DUP(32) { PH_CTX pg8::Gemm g{WSP(const bf16_t, WS_YH), WSP(const bf16_t, WS_WBH) + (size_t)pl * 2048 * 1536, MROWS, 2048, 1536}; pg8::StaticOrder S; S.init(MROWS, 2048, G, bx);
                pg8::EpiG2M E{WSP(const bf16_t, WS_QKG), WSP(bf16_t, WS_MB)};
                pg8::gemm_phase<pg8::EpiG2M, pg8::StaticOrder, PG8_ALIGN, true>(lds, g, S, E, ptid); }
            PH_END;
            if (PH_IN) { PH_CTX pg8::Gemm g{WSP(const bf16_t, WS_MB), WSP(const bf16_t, WS_WOUT) + (size_t)pl * 2048 * 2048, MROWS, 2048, 2048};
                pg8::PanelOrder S; S.init(MROWS, 2048, G, bx);
                pg8::EpiResN<false> E{nullptr, XO_PTR, XO_PTR, HB_CUR, MODB_PTR, ap->in[23] + pl * 2048, 2 * 2048, WSP(float, WS_PART), (unsigned*)(pws + WS_CTL) + CW_PANEL, 32u * (unsigned)(pl * NCHUNK + pch + 1), (unsigned*)(pws + WS_CTL) + CW_TMO, nullptr};
                pg8::gemm_phase<pg8::EpiResN<false>, pg8::PanelOrder, PG8_ALIGN, true>(lds, g, S, E, ptid); }
            PH_END;
            if (PH_IN) DUP(128) { PH_CTX pg8::Gemm g{HB_CUR, WSP(const bf16_t, WS_WUP) + (size_t)pl * 11264 * 2048, MROWS, 11264, 2048}; pg8::StaticOrder S; S.init(MROWS, 11264, G, bx); pg8::EpiUpCG E{WSP(bf16_t, WS_ACT), WSP(bf16_t, WS_GB), ap->in[25] + (size_t)pl * 3 * 5632, ap->in[26] + pl * 5632};
                pg8::gemm_phase<pg8::EpiUpCG, pg8::StaticOrder, PG8_ALIGN, true>(lds, g, S, E, ptid); }
            PH_END;
            if (PH_IN) { PH_CTX for (int it = bx * NTHR + ptid; it < 256 * 2 * 704; it += G * NTHR) cg_fix_item(it, WSP(bf16_t, WS_ACT), WSP(const bf16_t, WS_GB), ap->in[25] + (size_t)pl * 3 * 5632, ap->in[26] + pl * 5632); }
            PH_END;
            if (PH_IN) {
                if (l == DEPTH_ - 1) {
                    PH_CTX pg8::Gemm g{WSP(const bf16_t, WS_ACT), WSP(const bf16_t, WS_WDN) + (size_t)pl * 2048 * 5632, MROWS, 2048, 5632}; pg8::PanelOrder S; S.init(MROWS, 2048, G, bx);
                    pg8::EpiResN<false, true> E{nullptr, XO_PTR, nullptr, nullptr, MODB_PTR, ap->in[28], 5 * 2048, WSP(float, WS_PART), (unsigned*)(pws + WS_CTL) + CW_PANEL2, 32u * (unsigned)(pch + 1), (unsigned*)(pws + WS_CTL) + CW_TMO, ap->out + (size_t)pch * MROWS * 2048};
                    pg8::gemm_phase<pg8::EpiResN<false, true>, pg8::PanelOrder, PG8_ALIGN, true>(lds, g, S, E, ptid);
                } else {
                    PH_CTX pg8::Gemm g{WSP(const bf16_t, WS_ACT), WSP(const bf16_t, WS_WDN) + (size_t)pl * 2048 * 5632, MROWS, 2048, 5632}; pg8::StaticOrder S; S.init(MROWS, 2048, G, bx);
                    pg8::EpiResB<false> E{nullptr, XO_PTR, XO_PTR, MODB_PTR + 5 * 2048};
                    pg8::gemm_phase<pg8::EpiResB<false>, pg8::StaticOrder, PG8_ALIGN, true>(lds, g, S, E, ptid);
                } }
            if (l == DEPTH_ - 1 && ch == NCHUNK - 1) PH_END;
        }
    }
    }
#undef PH_IN
#undef PH_CTX
#undef PH_END
#undef DUP
}

#ifndef MK_LAUNCH_PER_PHASE
#define MK_LAUNCH_PER_PHASE 0
#endif
extern "C" void kernel_launch(void* const* d_in, const int* in_sizes, int n_in, void* d_out, int out_size, void* d_ws, size_t ws_size, hipStream_t stream) {
    static int grid = 0;
    if (grid == 0) {
        if (n_in != 29 || out_size != NSEQ * SEQ * 2048 || ws_size < WS_END) { fprintf(stderr, "kernel_launch: unexpected sizes n_in %d out %d ws %zu\n", n_in, out_size, ws_size); grid = -1; return; }
        int dev = 0, cus = 0, per_cu = 0;
        if (hipGetDevice(&dev) != hipSuccess || hipDeviceGetAttribute(&cus, hipDeviceAttributeMultiprocessorCount, dev) != hipSuccess) { grid = -1; return; }
        if (hipFuncSetAttribute((const void*)mega_fwd, hipFuncAttributeMaxDynamicSharedMemorySize, LDS_BYTES) != hipSuccess) { fprintf(stderr, "kernel_launch: hipFuncSetAttribute failed\n"); grid = -1; return; }
        if (hipOccupancyMaxActiveBlocksPerMultiprocessor(&per_cu, (const void*)mega_fwd, 512, LDS_BYTES) != hipSuccess || per_cu < 1) fprintf(stderr, "kernel_launch: occupancy query says %d\n", per_cu);
        (void)hipGetLastError();
        grid = cus >= 256 ? 256 : cus >= 128 ? 128 : cus >= 64 ? 64 : -1;
        if (grid < 0) { fprintf(stderr, "kernel_launch: %d CUs\n", cus); return; }
    }
    if (grid < 0) return;
    (void)hipMemsetAsync((char*)d_ws + WS_CTL, 0, CTL_ZERO_BYTES, stream);
    Args a{};
    for (int i = 0; i < 29; ++i) a.in[i] = (const float*)d_in[i];
    a.out = (float*)d_out; a.ws = (unsigned char*)d_ws;
#if MK_LAUNCH_PER_PHASE
    for (int p = 0; p < N_PHASES; ++p) { a.ph_lo = p; a.ph_hi = p + 1; hipLaunchKernelGGL(mega_fwd, dim3(grid), dim3(512), LDS_BYTES, stream, a); }
#else
    a.ph_lo = 0; a.ph_hi = N_PHASES; hipLaunchKernelGGL(mega_fwd, dim3(grid), dim3(512), LDS_BYTES, stream, a);
#endif
}
```

```cpp
#include <hip/hip_runtime.h>
#include <cstdio>
#include <cstdint>
#define DEV __device__ __forceinline__
#define DEVCONST __device__
#define LAS __attribute__((address_space(3)))
#define SYNC() __syncthreads()
#define F2U(x) __float_as_uint(x)
#define U2F(x) __uint_as_float(x)
#define BITCAST(T, v) __builtin_bit_cast(T, v)
#define EXP2(x) __builtin_amdgcn_exp2f(x)
#define LOG2(x) __builtin_amdgcn_logf(x)
#define SINCOSPI(x, s, c) do { const float hx_ = 0.5f * (x); *(s) = __builtin_amdgcn_sinf(hx_); *(c) = __builtin_amdgcn_cosf(hx_); } while (0)
__device__ __forceinline__ float shfl_from(float v, int src_lane) { return __builtin_bit_cast(float, __builtin_amdgcn_ds_bpermute(src_lane << 2, __builtin_bit_cast(int, v))); }
#define SHFL_XOR3(v, m, lane) shfl_from((v), (lane) ^ (m))
template <int N> __device__ __forceinline__ float dpp_ror(float v) { return __builtin_bit_cast(float, __builtin_amdgcn_update_dpp(0, __builtin_bit_cast(int, v), 0x120 + N, 0xf, 0xf, false)); }
#define MFMA32(a, b, c) __builtin_amdgcn_mfma_f32_32x32x16_bf16((a), (b), (c), 0, 0, 0)
#define OPAQUE_I(x) asm volatile("" : "+v"(x))

typedef _Float16 h16x2_t __attribute__((ext_vector_type(2)));
__device__ __forceinline__ unsigned pkh2(float a, float b) { h16x2_t h; h.x = (_Float16)a; h.y = (_Float16)b; return __builtin_bit_cast(unsigned, h); }
__device__ __forceinline__ float hlo(unsigned w) { return (float)__builtin_bit_cast(h16x2_t, w).x; }
__device__ __forceinline__ float hhi(unsigned w) { return (float)__builtin_bit_cast(h16x2_t, w).y; }
constexpr int D_ = 2048, SEQ = 4096, NSEQ = 12, DEPTH_ = 4, CHS = 4  , NCHUNK = 3, MROWS = CHS * SEQ  ;
constexpr int HW_ = 1024, AW_ = 1536, AO_ = 512, DFF_ = 5632, INC_ = 11776, NMOD_ = 6;
constexpr int NA_ = 4608  , NB_ = 7168  ;
constexpr int FFTN = 8192, FPAD = FFTN + FFTN / 16  ;
constexpr int NTHR = 512;

typedef unsigned short bf16_t;
typedef short bf16x8 __attribute__((ext_vector_type(8)));
typedef float f32x4 __attribute__((ext_vector_type(4)));
typedef float f32x16 __attribute__((ext_vector_type(16)));
typedef float cf __attribute__((ext_vector_type(2)));
typedef unsigned u32x4 __attribute__((ext_vector_type(4)));
typedef unsigned u32x2 __attribute__((ext_vector_type(2)));
typedef unsigned short u16x4 __attribute__((ext_vector_type(4)));

DEV unsigned short f2bf(float f) { unsigned u = F2U(f); u += 0x7fffu + ((u >> 16) & 1u); return (unsigned short)(u >> 16); }
DEV float bf2f(unsigned short b) { return U2F(((unsigned)b) << 16); }
DEV unsigned pk2(float lo, float hi) { return (unsigned)f2bf(lo) | ((unsigned)f2bf(hi) << 16); }

DEVCONST constexpr float C8T[9] = {1.0f, 0.980785280403230449f, 0.923879532511286756f, 0.831469612302545237f, 0.707106781186547524f, 0.555570233019602225f, 0.382683432365089772f, 0.195090322016128268f, 0.0f};
DEV constexpr float tw_cos(int m) { m &= 31; return m <= 8 ? C8T[m] : (m <= 16 ? -C8T[16 - m] : (m <= 24 ? -C8T[m - 16] : C8T[32 - m])); }
DEV constexpr float tw_sin(int m) { return tw_cos(m - 8); }
DEVCONST constexpr int BR16[16] = {0, 8, 4, 12, 2, 10, 6, 14, 1, 9, 5, 13, 3, 11, 7, 15};
DEVCONST constexpr int BR32[32] = {0, 16, 8, 24, 4, 20, 12, 28, 2, 18, 10, 26, 6, 22, 14, 30, 1, 17, 9, 25, 5, 21, 13, 29, 3, 19, 11, 27, 7, 23, 15, 31};
#ifdef EMU
DEV cf cmul(cf a, cf b) { return cf{a.x * b.x - a.y * b.y, a.x * b.y + a.y * b.x}; }
DEV cf cmulc(cf a, cf b) { return cf{a.x * b.x + a.y * b.y, a.y * b.x - a.x * b.y}; }
#else
DEV cf cmul(cf a, cf b) { cf r, t;
    asm("v_pk_mul_f32 %1, %2, %3 op_sel:[1,1] op_sel_hi:[1,0] neg_lo:[1,0]\n\tv_pk_fma_f32 %0, %2, %3, %1 op_sel_hi:[0,1,1]" : "=v"(r), "=&v"(t) : "v"(a), "v"(b));
    return r; }
DEV cf cmulc(cf a, cf b) { cf r, t;
    asm("v_pk_mul_f32 %1, %2, %3 op_sel:[1,1] op_sel_hi:[1,0]\n\tv_pk_fma_f32 %0, %2, %3, %1 op_sel_hi:[0,1,1] neg_hi:[1,0,0]" : "=v"(r), "=&v"(t) : "v"(a), "v"(b));
    return r; }
#endif
template <int R, bool INV> DEV void dft_regs(cf (&v)[R]) {
#pragma unroll
    for (int s = R; s >= 2; s >>= 1) {
        const int h = s >> 1;
#pragma unroll
        for (int b = 0; b < R; b += s) {
#pragma unroll
            for (int k = 0; k < h; ++k) {
                const cf a = v[b + k], c = v[b + k + h];
                v[b + k] = a + c;
                const cf d = a - c;
                const int m = k * (32 / s);
                const float wr = tw_cos(m), wi = INV ? tw_sin(m) : -tw_sin(m);
                v[b + k + h] = cf{d.x * wr - d.y * wi, d.x * wi + d.y * wr};
            }
        }
    }
}
DEV int PADI(int i) { return i + (i >> 4); }
DEV int fpos(int k) { return ((k & 15) << 9) | (((k >> 4) & 31) << 4) | (k >> 9); }
DEV int fnat(int p) { return (p >> 9) | (((p >> 4) & 31) << 4) | ((p & 15) << 9); }

DEV void fft_f1(LAS cf* buf, const cf (&z)[8], int tid) {
    OPAQUE_I(tid);
    cf v[16];
#pragma unroll
    for (int q = 0; q < 8; ++q) { v[q] = z[q]; v[q + 8] = cf{0.f, 0.f}; }
    dft_regs<16, false>(v);
    float sn, cs; SINCOSPI(-(float)tid * (2.0f / 8192.0f), &sn, &cs);
    const cf w = cf{cs, sn}; cf wp = cf{1.f, 0.f};
#pragma unroll
    for (int p = 0; p < 16; ++p) { buf[PADI(tid + 512 * p)] = cmul(v[BR16[p]], wp); wp = cmul(wp, w); }
}
DEV void fft_f1x2(LAS cf* buf0, LAS cf* buf1, const cf (&z0)[8], const cf (&z1)[8], int tid) {
    OPAQUE_I(tid);
    cf v[16], u[16];
#pragma unroll
    for (int q = 0; q < 8; ++q) { v[q] = z0[q]; v[q + 8] = cf{0.f, 0.f}; u[q] = z1[q]; u[q + 8] = cf{0.f, 0.f}; }
    dft_regs<16, false>(v); dft_regs<16, false>(u);
    float sn, cs; SINCOSPI(-(float)tid * (2.0f / 8192.0f), &sn, &cs);
    const cf w = cf{cs, sn}; cf wp = cf{1.f, 0.f};
    LAS cf* p0 = buf0 + PADI(tid); LAS cf* p1 = buf1 + PADI(tid);
#pragma unroll
    for (int p = 0; p < 16; ++p) { p0[544 * p] = cmul(v[BR16[p]], wp); p1[544 * p] = cmul(u[BR16[p]], wp); wp = cmul(wp, w); }
}
DEV void fft_i1x2(LAS cf* buf0, LAS cf* buf1, cf (&y0)[8], cf (&y1)[8], int tid) {
    OPAQUE_I(tid);
    float sn, cs; SINCOSPI(-(float)tid * (2.0f / 8192.0f), &sn, &cs);
    const cf w = cf{cs, sn}; cf wp = cf{1.f, 0.f};
    cf v[16], u[16];
    const LAS cf* p0 = buf0 + PADI(tid); const LAS cf* p1 = buf1 + PADI(tid);
#pragma unroll
    for (int p = 0; p < 16; ++p) { v[p] = cmulc(p0[544 * p], wp); u[p] = cmulc(p1[544 * p], wp); wp = cmul(wp, w); }
    dft_regs<16, true>(v); dft_regs<16, true>(u);
#pragma unroll
    for (int q = 0; q < 8; ++q) { y0[q] = v[BR16[q]]; y1[q] = u[BR16[q]]; }
}
DEV void fft_f2(LAS cf* buf, int t8) {
    OPAQUE_I(t8);
    LAS cf* pb = buf + (t8 >> 4) * 544 + (t8 & 15);
    cf v[32];
#pragma unroll
    for (int q = 0; q < 32; ++q) v[q] = pb[17 * q];
    dft_regs<32, false>(v);
    float sn, cs; SINCOSPI(-(float)(t8 & 15) * (2.0f / 512.0f), &sn, &cs);
    const cf w = cf{cs, sn}; cf wp = cf{1.f, 0.f};
#pragma unroll
    for (int p = 0; p < 32; ++p) { pb[17 * p] = cmul(v[BR32[p]], wp); wp = cmul(wp, w); }
}
DEV cf kunpack(unsigned w) { return cf{U2F(w << 16), U2F(w & 0xffff0000u)}; }
template <bool MULK> DEV void fft_mid(LAS cf* buf, const unsigned* Kp, int blk) {
    const int base = 16 * blk;
    cf v[16];
#pragma unroll
    for (int q = 0; q < 16; ++q) v[q] = buf[PADI(base + q)];
    dft_regs<16, false>(v);
    if (MULK) {
        cf w[16];
#pragma unroll
        for (int p = 0; p < 16; ++p) w[p] = cmul(v[BR16[p]], kunpack(Kp[base + p]));
        dft_regs<16, true>(w);
#pragma unroll
        for (int q = 0; q < 16; ++q) buf[PADI(base + q)] = w[BR16[q]];
    } else {
#pragma unroll
        for (int p = 0; p < 16; ++p) buf[PADI(base + p)] = v[BR16[p]];
    }
}
DEV void fft_midx2(LAS cf* buf0, LAS cf* buf1, const unsigned* Kp, int blk) {
    const int base = 16 * blk;
    LAS cf* p0 = buf0 + 17 * blk; LAS cf* p1 = buf1 + 17 * blk;
    cf v[16], u[16];
#pragma unroll
    for (int q = 0; q < 16; ++q) { v[q] = p0[q]; u[q] = p1[q]; }
    dft_regs<16, false>(v); dft_regs<16, false>(u);
    cf w[16], x[16];
    u32x4 kw[4];
#pragma unroll
    for (int j = 0; j < 4; ++j) kw[j] = *(const u32x4*)(Kp + base + 4 * j);
#pragma unroll
    for (int p = 0; p < 16; ++p) { const cf k = kunpack(kw[p >> 2][p & 3]); w[p] = cmul(v[BR16[p]], k); x[p] = cmul(u[BR16[p]], k); }
    dft_regs<16, true>(w); dft_regs<16, true>(x);
#pragma unroll
    for (int q = 0; q < 16; ++q) { p0[q] = w[BR16[q]]; p1[q] = x[BR16[q]]; }
}
DEV void fft_i2(LAS cf* buf, int t8) {
    OPAQUE_I(t8);
    LAS cf* pb = buf + (t8 >> 4) * 544 + (t8 & 15);
    float sn, cs; SINCOSPI(-(float)(t8 & 15) * (2.0f / 512.0f), &sn, &cs);
    const cf w = cf{cs, sn}; cf wp = cf{1.f, 0.f};
    cf v[32];
#pragma unroll
    for (int p = 0; p < 32; ++p) { v[p] = cmulc(pb[17 * p], wp); wp = cmul(wp, w); }
    dft_regs<32, true>(v);
#pragma unroll
    for (int q = 0; q < 32; ++q) pb[17 * q] = v[BR32[q]];
}
DEV void fft_i1(LAS cf* buf, cf (&y)[8], int tid) {
    OPAQUE_I(tid);
    float sn, cs; SINCOSPI(-(float)tid * (2.0f / 8192.0f), &sn, &cs);
    const cf w = cf{cs, sn}; cf wp = cf{1.f, 0.f};
    cf v[16];
#pragma unroll
    for (int p = 0; p < 16; ++p) { v[p] = cmulc(buf[PADI(tid + 512 * p)], wp); wp = cmul(wp, w); }
    dft_regs<16, true>(v);
#pragma unroll
    for (int q = 0; q < 8; ++q) y[q] = v[BR16[q]];
}

DEV void filt_hidden_unit(int unit, const float* w1, const float* b1, const float* fr1, const float* w2, const float* b2, const float* fr2, float* h2out  , bf16_t* h2b  , LAS float* sm, int tid) {
    LAS float* feat = sm;
    LAS float* h1 = sm + 8 * 33;
    const int tl = tid >> 6, j = tid & 63, t = unit * 8 + tl;
    if (tid < 8 * 33) {
        const int tt = tid / 33, f = tid % 33, tp = unit * 8 + tt;
        float val;
        if (f == 0) val = (float)tp * (1.0f / 4095.0f);
        else { const int k = (f - 1) & 15; const float band = 1e-4f + (float)k * ((15.0f - 1e-4f) / 15.0f);
               const float xr = (float)tp * band * (1.0f / 4096.0f), fr = xr - floorf(xr);
               float sn, cs; SINCOSPI(2.0f * fr, &sn, &cs);
               val = (f <= 16) ? cs : -sn; }
        feat[tt * 33 + f] = val;
    }
    SYNC();
    { float a = b1[j];
#pragma unroll 11
      for (int f = 0; f < 33; ++f) a += feat[tl * 33 + f] * w1[f * 64 + j];
      h1[tl * 64 + j] = sinf(fr1[j] * a); }
    SYNC();
    { float a = b2[j];
#pragma unroll 16
      for (int i = 0; i < 64; ++i) a += h1[tl * 64 + i] * w2[i * 64 + j];
      const float hv = sinf(fr2[j] * a); if (h2out) h2out[j * 4096 + t] = hv; h2b[t * 64 + j] = f2bf(hv); }
    SYNC();
}
DEV void filt_channel_unit(int c, const float* h2, const float* w3, unsigned* KF, LAS unsigned char* lds, int tid) {
    LAS cf* buf = (LAS cf*)lds;
    LAS float* sw = (LAS float*)(lds + FPAD * 8);
    LAS float* red = sw + 256;
    if (tid < 256) { const int i = tid >> 2, q = tid & 3; sw[tid] = w3[i * 4096 + q * 1024 + c]; }
    SYNC();
    const float dmin = -3.0701134573253947f, dmax = -15.350567286626973f;
    const float delta = fabsf(dmin + (float)c * ((dmax - dmin) / 1023.0f));
    float s0 = 0.f, s1 = 0.f;
#pragma unroll 1
    for (int i = 0; i < 8; ++i) {
        const int t = tid + 512 * i;
        const float* hc = h2 + t;
        float a0 = 0.f, a1 = 0.f, a2 = 0.f, a3 = 0.f;
        float xv[64];
#pragma unroll
        for (int k = 0; k < 64; ++k) xv[k] = hc[k * 4096];
#pragma unroll
        for (int k = 0; k < 64; ++k) { const f32x4 w = *(const LAS f32x4*)(sw + k * 4); a0 += xv[k] * w.x; a1 += xv[k] * w.y; a2 += xv[k] * w.z; a3 += xv[k] * w.w; }
        const float dec = expf(-((float)t * (1.0f / 4095.0f)) * delta);
        a0 *= dec; a1 *= dec; a2 *= dec; a3 *= dec;
        s0 += fabsf(a0); s1 += fabsf(a1);
        buf[PADI(t)] = cf{a0, a1};
        if (t > 0) { s0 += fabsf(a2); s1 += fabsf(a3); buf[PADI(8192 - t)] = cf{a2, a3}; }
        else buf[PADI(4096)] = cf{a2 * 0.f, a3 * 0.f};
    }
#pragma unroll
    for (int o = 1; o < 64; o <<= 1) { s0 += SHFL_XOR3(s0, o, tid & 63); s1 += SHFL_XOR3(s1, o, tid & 63); }
    if ((tid & 63) == 0) { red[(tid >> 6) * 2] = s0; red[(tid >> 6) * 2 + 1] = s1; }
    SYNC();
    float t0 = 0.f, t1 = 0.f;
#pragma unroll
    for (int w = 0; w < 8; ++w) { t0 += red[w * 2]; t1 += red[w * 2 + 1]; }
    const cf inrm = cf{1.0f / t0, 1.0f / t1};
    {
        OPAQUE_I(tid);
        cf v[16];
#pragma unroll
        for (int q = 0; q < 16; ++q) v[q] = buf[PADI(tid + 512 * q)] * inrm;
        dft_regs<16, false>(v);
        float sn, cs; SINCOSPI(-(float)tid * (2.0f / 8192.0f), &sn, &cs);
        const cf w = cf{cs, sn}; cf wp = cf{1.f, 0.f};
#pragma unroll
        for (int p = 0; p < 16; ++p) { buf[PADI(tid + 512 * p)] = cmul(v[BR16[p]], wp); wp = cmul(wp, w); }
    }
    SYNC();
    if (tid < 256) fft_f2(buf, tid);
    SYNC();
    fft_mid<false>(buf, nullptr, tid);
    SYNC();
    const float sc = 0.5f / 8192.0f;
#pragma unroll
    for (int i = 0; i < 16; ++i) {
        const int p = tid + 512 * i, k = fnat(p), p2 = fpos((8192 - k) & 8191);
        const cf a = buf[PADI(p)], b = buf[PADI(p2)];
        KF[((size_t)c * 2 + 0) * 8192 + p] = pk2((a.x + b.x) * sc, (a.y - b.y) * sc);
        KF[((size_t)c * 2 + 1) * 8192 + p] = pk2((a.y + b.y) * sc, (b.x - a.x) * sc);
    }
    SYNC();
}

DEV void filt_channel_unit2(int c, const bf16_t* h2b, const float* w3, unsigned* KF, LAS unsigned char* lds, int tid) {
    LAS cf* buf0 = (LAS cf*)lds; LAS cf* buf1 = buf0 + FPAD;
    int swo = 2 * FPAD * 8 + 1024; OPAQUE_I(swo);
    LAS float* sw = (LAS float*)(lds + swo);
    LAS float* red = sw + 512;
    { const int i = tid >> 3, q = tid & 7; sw[tid] = w3[i * 4096 + (q & 3) * 1024 + c + (q >> 2)]; }
    SYNC();
    const float dmin = -3.0701134573253947f, dmax = -15.350567286626973f;
    const int lane = tid & 63, wave = tid >> 6, n = lane & 31, hl = lane >> 5;
    const float delta = fabsf(dmin + (float)(c + hl) * ((dmax - dmin) / 1023.0f));
    bf16x8 wa[4];
#pragma unroll
    for (int ks = 0; ks < 4; ++ks) { float wv[8];
#pragma unroll
        for (int j = 0; j < 8; ++j) { const float x = sw[(16 * ks + 8 * hl + j) * 8 + (n & 7)]; wv[j] = (n < 8) ? x : 0.f; }
        u32x4 w; w.x = pk2(wv[0], wv[1]); w.y = pk2(wv[2], wv[3]); w.z = pk2(wv[4], wv[5]); w.w = pk2(wv[6], wv[7]); wa[ks] = BITCAST(bf16x8, w); }
    LAS cf* bufc = hl ? buf1 : buf0;
    float s[2] = {0.f, 0.f};
#pragma unroll 1
    for (int g = 0; g < 4; ++g) {
        bf16x8 hb[4][4];
#pragma unroll
        for (int i = 0; i < 4; ++i) { const int t = 32 * (wave * 16 + 4 * g + i) + n;
#pragma unroll
            for (int ks = 0; ks < 4; ++ks) hb[i][ks] = *(const bf16x8*)(h2b + t * 64 + 16 * ks + 8 * hl); }
#pragma unroll
        for (int i = 0; i < 4; ++i) { const int t = 32 * (wave * 16 + 4 * g + i) + n;
            f32x16 acc;
#pragma unroll
            for (int r = 0; r < 16; ++r) acc[r] = 0.f;
#pragma unroll
            for (int ks = 0; ks < 4; ++ks) acc = MFMA32(wa[ks], hb[i][ks], acc);
            const float dec = expf(-(float)t * (1.0f / 4095.0f) * delta);
            const float a0 = acc[0] * dec, a1 = acc[1] * dec, a2 = acc[2] * dec, a3 = acc[3] * dec;
            s[0] += fabsf(a0); s[1] += fabsf(a1);
            bufc[PADI(t)] = cf{a0, a1};
            if (t > 0) { s[0] += fabsf(a2); s[1] += fabsf(a3); bufc[PADI(8192 - t)] = cf{a2, a3}; }
            else bufc[PADI(4096)] = cf{a2 * 0.f, a3 * 0.f};
        }
    }
#pragma unroll
    for (int o = 1; o < 32; o <<= 1) { s[0] += SHFL_XOR3(s[0], o, lane); s[1] += SHFL_XOR3(s[1], o, lane); }
    if (n == 0) { red[wave * 4 + 2 * hl] = s[0]; red[wave * 4 + 2 * hl + 1] = s[1]; }
    SYNC();
    float tt[4] = {0.f, 0.f, 0.f, 0.f};
#pragma unroll
    for (int w = 0; w < 8; ++w)
#pragma unroll
        for (int q = 0; q < 4; ++q) tt[q] += red[w * 4 + q];
    const cf in0 = cf{1.0f / tt[0], 1.0f / tt[1]}, in1 = cf{1.0f / tt[2], 1.0f / tt[3]};
    {
        OPAQUE_I(tid);
        cf v[16], u[16];
#pragma unroll
        for (int q = 0; q < 16; ++q) { v[q] = buf0[PADI(tid + 512 * q)] * in0; u[q] = buf1[PADI(tid + 512 * q)] * in1; }
        dft_regs<16, false>(v); dft_regs<16, false>(u);
        float sn, cs; SINCOSPI(-(float)tid * (2.0f / 8192.0f), &sn, &cs);
        const cf w = cf{cs, sn}; cf wp = cf{1.f, 0.f};
#pragma unroll
        for (int p = 0; p < 16; ++p) { buf0[PADI(tid + 512 * p)] = cmul(v[BR16[p]], wp); buf1[PADI(tid + 512 * p)] = cmul(u[BR16[p]], wp); wp = cmul(wp, w); }
    }
    SYNC();
    fft_f2((tid >> 8) ? buf1 : buf0, tid & 255);
    SYNC();
    fft_mid<false>(buf0, nullptr, tid); fft_mid<false>(buf1, nullptr, tid);
    SYNC();
    const float sc = 0.5f / 8192.0f;
#pragma unroll
    for (int i = 0; i < 16; ++i) {
        const int p = tid + 512 * i, k = fnat(p), p2 = fpos((8192 - k) & 8191);
        const cf a0 = buf0[PADI(p)], b0 = buf0[PADI(p2)], a1 = buf1[PADI(p)], b1 = buf1[PADI(p2)];
        KF[((size_t)c * 2 + 0) * 8192 + p] = pk2((a0.x + b0.x) * sc, (a0.y - b0.y) * sc);
        KF[((size_t)c * 2 + 1) * 8192 + p] = pk2((a0.y + b0.y) * sc, (b0.x - a0.x) * sc);
        KF[((size_t)c * 2 + 2) * 8192 + p] = pk2((a1.x + b1.x) * sc, (a1.y - b1.y) * sc);
        KF[((size_t)c * 2 + 3) * 8192 + p] = pk2((a1.y + b1.y) * sc, (b1.x - a1.x) * sc);
    }
    SYNC();
}

DEV float ldsbf(const LAS bf16_t* p) { return bf2f(*p); }
DEV void hyena_issue_rows(const bf16_t* UT, int s, int c, u32x4 (&r)[4], int tid) {
#pragma unroll
    for (int b = 0; b < 4; ++b) r[b] = *(const u32x4*)(UT + ((size_t)(b * 3072 + s * 1024 + c)) * 4096 + tid * 8);
}
DEV void hyena_commit_rows(LAS unsigned char* lds, const u32x4 (&r)[4], int tid) {
#pragma unroll
    for (int b = 0; b < 4; ++b) *(LAS u32x4*)(lds + b * 8192 + tid * 16) = r[b];
}
template <int MODE> DEV void hyena_conv_rows(const LAS unsigned char* lds, int slot0, float w0, float w1, float w2, float bs, cf (&z)[2][8], const cf (&y)[2][8], float hb, int tid) {
#pragma unroll
    for (int b = 0; b < 4; ++b) {
        const LAS bf16_t* row = (const LAS bf16_t*)(lds + (slot0 + b) * 8192);
#pragma unroll
        for (int i = 0; i < 8; ++i) {
            const int t = tid + 512 * i, par = tid & 1, d0 = (tid >> 1) + par;
            const LAS unsigned* rw = (const LAS unsigned*)row + d0;
            const unsigned dw0 = (i == 0) ? rw[d0 > 0 ? -1 : 0] : rw[256 * i - 1], dw1 = rw[256 * i];
            float um = par ? U2F(dw0 << 16) : U2F(dw0 & 0xffff0000u);
            const float u0 = par ? U2F(dw0 & 0xffff0000u) : U2F(dw1 << 16);
            float up = par ? U2F(dw1 << 16) : U2F(dw1 & 0xffff0000u);
            um = (t > 0) ? um : 0.f; up = (t < 4095) ? up : 0.f;
            const float r = um * w0 + u0 * w1 + up * w2 + bs;
            if (MODE == 0) { if (b & 1) z[b >> 1][i].y = r; else z[b >> 1][i].x = r; }
            else { if (b & 1) z[b >> 1][i].y = r * (y[b >> 1][i].y + hb * z[b >> 1][i].y); else z[b >> 1][i].x = r * (y[b >> 1][i].x + hb * z[b >> 1][i].x); }
        }
    }
}
#ifndef HY_ABL
#define HY_ABL 0
#endif
DEV void hyena_conv_head(LAS cf* buf0, LAS cf* buf1, const unsigned* Kp, const cf (&z)[2][8], int tid, bool abl) {
    const bool skip_all = abl && HY_ABL == 1, nosync = abl && HY_ABL == 2, nok = abl && HY_ABL == 3, skip1 = (abl && HY_ABL == 4) || skip_all, skip2 = (abl && HY_ABL == 5) || skip_all, skipm = (abl && HY_ABL == 6) || skip_all;
    if (!skip1) fft_f1x2(buf0, buf1, z[0], z[1], tid);
    if (!nosync && !skip_all) SYNC();
    if (!skip2) fft_f2((tid >> 8) ? buf1 : buf0, tid & 255);
    if (!nosync && !skip_all) SYNC();
    if (!skipm) { if (nok) { fft_mid<false>(buf0, Kp, tid); fft_mid<false>(buf1, Kp, tid); } else fft_midx2(buf0, buf1, Kp, tid); }
    if (!nosync && !skip_all) SYNC();
    if (!skip2) fft_i2((tid >> 8) ? buf1 : buf0, tid & 255);
    if (!nosync && !skip_all) SYNC();
}
DEV void hyena_units(int c0, int cstride, const bf16_t* UT, bf16_t* YHT, const unsigned* KF, const float* convw  , const float* convb  , const float* hyb  , LAS unsigned char* lds, int tid, bool abl = false) {
    if (c0 >= 1024) return;
    LAS cf* buf0 = (LAS cf*)lds; LAS cf* buf1 = buf0 + FPAD;
    u32x4 r[4];
    hyena_issue_rows(UT, 0, c0, r, tid);
#pragma unroll 1
    for (int c = c0; c < 1024; c += cstride) {
        OPAQUE_I(tid);
        cf z[2][8], y[2][8];
        hyena_commit_rows(lds, r, tid);
        SYNC();
        hyena_conv_rows<0>(lds, 0, convw[c], convw[3072 + c], convw[6144 + c], convb[c], z, y, 0.f, tid);
        SYNC();
#pragma unroll 1
        for (int o = 0; o < 2; ++o) {
            hyena_conv_head(buf0, buf1, KF + ((size_t)c * 2 + o) * 8192, z, tid, abl);
            hyena_issue_rows(UT, 1 + o, c, r, tid);
            if (abl && (HY_ABL == 1 || HY_ABL == 4)) {
#pragma unroll
                for (int i = 0; i < 8; ++i) { y[0][i] = z[0][i]; y[1][i] = z[1][i]; }
            } else fft_i1x2(buf0, buf1, y[0], y[1], tid);
            SYNC();
            hyena_commit_rows(lds, r, tid);
            if (o == 1 && c + cstride < 1024) hyena_issue_rows(UT, 0, c + cstride, r, tid);
            SYNC();
            const int col = (1 + o) * 1024 + c;
            hyena_conv_rows<1>(lds, 0, convw[col], convw[3072 + col], convw[6144 + col], convb[col], z, y, hyb[o * 1024 + c], tid);
            SYNC();
        }
#pragma unroll
        for (int p = 0; p < 2; ++p)
#pragma unroll
            for (int i = 0; i < 8; ++i) {
                const int t = tid + 512 * i;
                YHT[((size_t)((2 * p) * 1024 + c)) * 4096 + t] = f2bf(z[p][i].x);
                YHT[((size_t)((2 * p + 1) * 1024 + c)) * 4096 + t] = f2bf(z[p][i].y);
            }
    }
}
DEV void hyena_unit(int c, const bf16_t* UT, bf16_t* YHT, const unsigned* KF, const float* convw, const float* convb, const float* hyb, LAS unsigned char* lds, int tid) {
    hyena_units(c, 1024, UT, YHT, KF, convw, convb, hyb, lds, tid);
}

DEV void attn_bias_table(LAS float* tab, const float* rel_bias, int tid) {
    for (int idx = tid; idx < 24 * 129; idx += NTHR) {
        const int gh = idx / 129, jj = idx % 129, g = gh >> 3, dil = 1 << (2 * g);
        const int rel = (jj - 64) * dil, n = rel < 0 ? -rel : rel;
        int bk = (rel > 0) ? 16 : 0;
        if (n < 8) bk += n;
        else bk += 8 + (n >= 15) + (n >= 27) + (n >= 50) + (n >= 91) + (n >= 166) + (n >= 305) + (n >= 559);
        tab[idx] = rel_bias[bk * 24 + gh] * 1.4426950408889634f;
    }
}
DEV void attn_tile(int tile, const bf16_t* QKG, const bf16_t* VT, bf16_t* OG, float* LSE, const LAS float* tab, int lane) {
    const int b = tile / (24 * 64), rem = tile % (24 * 64), gh = rem >> 6, tau = rem & 63, g = gh >> 3, h = gh & 7;
    const int dsh = 2 * g, Mg = 4096 >> dsh, ntm = Mg >> 6, r = tau / ntm, m0 = (tau % ntm) * 64;
    const int n = lane & 31, hl = lane >> 5;
    const size_t rowbase = (size_t)b * 4096;
    const int colq = g * 512 + h * 64;
    const float SC = 0.125f * 1.4426950408889634f;
    bf16x8 qf[2][4];
#pragma unroll
    for (int qb = 0; qb < 2; ++qb) {
        const int t = ((m0 + 32 * qb + n) << dsh) + r;
        const bf16_t* p = QKG + (rowbase + t) * 7168 + colq + 8 * hl;
#pragma unroll
        for (int ks = 0; ks < 4; ++ks) qf[qb][ks] = *(const bf16x8*)(p + 16 * ks);
    }
    f32x16 oacc[2][2];
#pragma unroll
    for (int a = 0; a < 2; ++a)
#pragma unroll
        for (int c2 = 0; c2 < 2; ++c2)
#pragma unroll
            for (int i = 0; i < 16; ++i) oacc[a][c2][i] = 0.f;
    float mrun[2] = {-1e30f, -1e30f}, lrun[2] = {0.f, 0.f};
    for (int kbi = 0; kbi < 3; ++kbi) {
        const int kb = (kbi == 0) ? 1 : (kbi == 1 ? 0 : 2);
        const int mk0 = m0 - 64 + 64 * kb;
        if (mk0 < 0 || mk0 >= Mg) continue;
        f32x16 s[2][2];
#pragma unroll
        for (int sb = 0; sb < 2; ++sb) {
            const int t = ((mk0 + 32 * sb + n) << dsh) + r;
            const bf16_t* p = QKG + (rowbase + t) * 7168 + 1536 + colq + 8 * hl;
            bf16x8 kf[4];
#pragma unroll
            for (int ks = 0; ks < 4; ++ks) kf[ks] = *(const bf16x8*)(p + 16 * ks);
#pragma unroll
            for (int qb = 0; qb < 2; ++qb) {
                f32x16 a;
#pragma unroll
                for (int i = 0; i < 16; ++i) a[i] = 0.f;
#pragma unroll
                for (int ks = 0; ks < 4; ++ks) a = MFMA32(kf[ks], qf[qb][ks], a);
                s[sb][qb] = a;
            }
        }
#pragma unroll
        for (int qb = 0; qb < 2; ++qb) {
            const int qq = 32 * qb + n;
            float mx = -1e30f;
#pragma unroll
            for (int sb = 0; sb < 2; ++sb)
#pragma unroll
                for (int rg = 0; rg < 16; ++rg) {
                    const int kk = 32 * sb + (rg & 3) + 8 * (rg >> 2) + 4 * hl;
                    const int jj = 64 * kb + kk - qq;
                    const bool ok = (unsigned)jj <= 128u;
                    const float bia = tab[gh * 129 + (ok ? jj : 0)];
                    const float v = ok ? s[sb][qb][rg] * SC + bia : -1e30f;
                    s[sb][qb][rg] = v; mx = fmaxf(mx, v);
                }
            mx = fmaxf(mx, SHFL_XOR3(mx, 32, lane));
            const float mnew = fmaxf(mrun[qb], mx);
            const float alpha = EXP2(mrun[qb] - mnew);
            float rs = 0.f;
#pragma unroll
            for (int sb = 0; sb < 2; ++sb)
#pragma unroll
                for (int rg = 0; rg < 16; ++rg) { const float p = EXP2(s[sb][qb][rg] - mnew); s[sb][qb][rg] = p; rs += p; }
            rs += SHFL_XOR3(rs, 32, lane);
            lrun[qb] = lrun[qb] * alpha + rs; mrun[qb] = mnew;
#pragma unroll
            for (int eb = 0; eb < 2; ++eb)
#pragma unroll
                for (int i = 0; i < 16; ++i) oacc[eb][qb][i] *= alpha;
        }
#pragma unroll
        for (int sb = 0; sb < 2; ++sb)
#pragma unroll
            for (int s2 = 0; s2 < 2; ++s2) {
                bf16x8 pf[2];
#pragma unroll
                for (int qb = 0; qb < 2; ++qb) {
                    u32x4 w;
                    w.x = pk2(s[sb][qb][8 * s2 + 0], s[sb][qb][8 * s2 + 1]); w.y = pk2(s[sb][qb][8 * s2 + 2], s[sb][qb][8 * s2 + 3]);
                    w.z = pk2(s[sb][qb][8 * s2 + 4], s[sb][qb][8 * s2 + 5]); w.w = pk2(s[sb][qb][8 * s2 + 6], s[sb][qb][8 * s2 + 7]);
                    pf[qb] = BITCAST(bf16x8, w);
                }
#pragma unroll
                for (int eb = 0; eb < 2; ++eb) {
                    const int e = 32 * eb + n;
                    const bf16_t* vp = VT + ((size_t)(b * 1536 + colq + e)) * 4096 + r * Mg + mk0 + 32 * sb + 16 * s2 + 4 * hl;
                    const u32x2 lo = *(const u32x2*)vp, hi = *(const u32x2*)(vp + 8);
                    u32x4 w; w.x = lo.x; w.y = lo.y; w.z = hi.x; w.w = hi.y;
                    const bf16x8 vf = BITCAST(bf16x8, w);
#pragma unroll
                    for (int qb = 0; qb < 2; ++qb) oacc[eb][qb] = MFMA32(vf, pf[qb], oacc[eb][qb]);
                }
            }
    }
#pragma unroll
    for (int qb = 0; qb < 2; ++qb) {
        const float inv = 1.0f / lrun[qb];
        const int t = ((m0 + 32 * qb + n) << dsh) + r;
        bf16_t* op = OG + (rowbase + t) * 1536 + colq;
#pragma unroll
        for (int eb = 0; eb < 2; ++eb)
#pragma unroll
            for (int gq = 0; gq < 4; ++gq) {
                u32x2 w; w.x = pk2(oacc[eb][qb][4 * gq] * inv, oacc[eb][qb][4 * gq + 1] * inv); w.y = pk2(oacc[eb][qb][4 * gq + 2] * inv, oacc[eb][qb][4 * gq + 3] * inv);
                *(u32x2*)(op + 32 * eb + 8 * gq + 4 * hl) = w;
            }
        if (hl == 0) LSE[(rowbase + t) * 24 + gh] = mrun[qb] + LOG2(lrun[qb]);
    }
}
constexpr int AT_KP = 144, AT_VP = 776;
constexpr int AT_K_OFF = 0, AT_V_OFF = 384 * AT_KP, AT_TAB_OFF = AT_V_OFF + 64 * AT_VP;
struct AttnU { int b, gh, g, dsh, Mg, r, mu0, colq; };
DEV AttnU attn_decode(int unit) {
    AttnU a; a.b = unit / 384; const int rem = unit % 384; a.gh = rem >> 4; const int uu = rem & 15; a.g = a.gh >> 3;
    a.dsh = 2 * a.g; a.Mg = 4096 >> a.dsh; const int upc = a.Mg >> 8; a.r = uu / upc; a.mu0 = (uu % upc) * 256; a.colq = a.g * 512 + (a.gh & 7) * 64;
    return a;
}
DEV void attn_issue(const AttnU& a, const bf16_t* QKG, const bf16_t* VT, u32x4 (&kr)[6], u32x4 (&vr)[6], int tid) {
    const size_t rowbase = (size_t)a.b * 4096;
#pragma unroll
    for (int i = 0; i < 6; ++i) {
        const int idx = tid + 512 * i, row = idx >> 3, ch = idx & 7, m = a.mu0 - 64 + row;
        kr[i] = (u32x4){0u, 0u, 0u, 0u};
        if (m >= 0 && m < a.Mg) kr[i] = *(const u32x4*)(QKG + (rowbase + (size_t)((m << a.dsh) + a.r)) * 7168 + 1536 + a.colq + 8 * ch);
    }
#pragma unroll
    for (int i = 0; i < 6; ++i) {
        const int idx = tid + 512 * i, e = idx / 48, ch = idx % 48, m = a.mu0 - 64 + 8 * ch;
        vr[i] = (u32x4){0u, 0u, 0u, 0u};
        if (m >= 0 && m < a.Mg) vr[i] = *(const u32x4*)(VT + ((size_t)(a.b * 1536 + a.colq + e)) * 4096 + a.r * a.Mg + m);
    }
}
DEV void attn_commit(LAS unsigned char* lds, const u32x4 (&kr)[6], const u32x4 (&vr)[6], int tid) {
#pragma unroll
    for (int i = 0; i < 6; ++i) { const int idx = tid + 512 * i, row = idx >> 3, ch = idx & 7; *(LAS u32x4*)(lds + AT_K_OFF + row * AT_KP + ch * 16) = kr[i]; }
#pragma unroll
    for (int i = 0; i < 6; ++i) { const int idx = tid + 512 * i, e = idx / 48, ch = idx % 48;
        LAS u32x2* d = (LAS u32x2*)(lds + AT_V_OFF + e * AT_VP + ch * 16);
        d[0] = (u32x2){vr[i].x, vr[i].y}; d[1] = (u32x2){vr[i].z, vr[i].w}; }
}
DEV void attn_compute(const AttnU& a, const bf16x8 (&qf)[4], int tq, bf16_t* OG, float* LSE, LAS unsigned char* lds, int tid) {
    const int lane = tid & 63, wave = tid >> 6, n = lane & 31, hl = lane >> 5;
    const size_t rowbase = (size_t)a.b * 4096;
    const LAS float* tab = (const LAS float*)(lds + AT_TAB_OFF) + a.gh * 129;
    const float SC = 0.125f * 1.4426950408889634f;
    f32x16 s[5];
    bool vb[5];
    float mx = -1e30f;
#pragma unroll
    for (int sb = 0; sb < 5; ++sb) {
        const int sbk = wave + sb, mb = a.mu0 - 64 + 32 * sbk;
        vb[sb] = (mb >= 0) && (mb < a.Mg);
        f32x16 acc;
#pragma unroll
        for (int i = 0; i < 16; ++i) acc[i] = 0.f;
        if (vb[sb]) {
            const LAS unsigned char* kp = lds + AT_K_OFF + (32 * sbk + n) * AT_KP + 16 * hl;
#pragma unroll
            for (int ks = 0; ks < 4; ++ks) { const bf16x8 kf = *(const LAS bf16x8*)(kp + 32 * ks); acc = MFMA32(kf, qf[ks], acc); }
        }
#pragma unroll
        for (int rg = 0; rg < 16; ++rg) {
            const int jj = 32 * sb + (rg & 3) + 8 * (rg >> 2) + 4 * hl - n;
            const bool ok = vb[sb] && ((unsigned)jj <= 128u);
            const float bia = tab[ok ? jj : 0];
            const float v = ok ? acc[rg] * SC + bia : -1e30f;
            acc[rg] = v; mx = fmaxf(mx, v);
        }
        s[sb] = acc;
    }
    mx = fmaxf(mx, SHFL_XOR3(mx, 32, lane));
    float rs = 0.f;
#pragma unroll
    for (int sb = 0; sb < 5; ++sb)
#pragma unroll
        for (int rg = 0; rg < 16; ++rg) { const float p = EXP2(s[sb][rg] - mx); s[sb][rg] = p; rs += p; }
    rs += SHFL_XOR3(rs, 32, lane);
    f32x16 oacc[2];
#pragma unroll
    for (int eb = 0; eb < 2; ++eb)
#pragma unroll
        for (int i = 0; i < 16; ++i) oacc[eb][i] = 0.f;
#pragma unroll
    for (int sb = 0; sb < 5; ++sb) {
        if (!vb[sb]) continue;
#pragma unroll
        for (int s2 = 0; s2 < 2; ++s2) {
            u32x4 w;
            w.x = pk2(s[sb][8 * s2 + 0], s[sb][8 * s2 + 1]); w.y = pk2(s[sb][8 * s2 + 2], s[sb][8 * s2 + 3]);
            w.z = pk2(s[sb][8 * s2 + 4], s[sb][8 * s2 + 5]); w.w = pk2(s[sb][8 * s2 + 6], s[sb][8 * s2 + 7]);
            const bf16x8 pf = BITCAST(bf16x8, w);
#pragma unroll
            for (int eb = 0; eb < 2; ++eb) {
                const LAS unsigned char* vp = lds + AT_V_OFF + (32 * eb + n) * AT_VP + (32 * (wave + sb) + 16 * s2 + 4 * hl) * 2;
                const u32x2 lo = *(const LAS u32x2*)vp, hi = *(const LAS u32x2*)(vp + 16);
                u32x4 wv; wv.x = lo.x; wv.y = lo.y; wv.z = hi.x; wv.w = hi.y;
                oacc[eb] = MFMA32(BITCAST(bf16x8, wv), pf, oacc[eb]);
            }
        }
    }
    const float inv = 1.0f / rs;
    bf16_t* op = OG + (rowbase + tq) * 1536 + a.colq;
#pragma unroll
    for (int eb = 0; eb < 2; ++eb)
#pragma unroll
        for (int gq = 0; gq < 4; ++gq) {
            u32x2 w; w.x = pk2(oacc[eb][4 * gq] * inv, oacc[eb][4 * gq + 1] * inv); w.y = pk2(oacc[eb][4 * gq + 2] * inv, oacc[eb][4 * gq + 3] * inv);
            *(u32x2*)(op + 32 * eb + 8 * gq + 4 * hl) = w;
        }
    if (hl == 0) LSE[(rowbase + tq) * 24 + a.gh] = mx + LOG2(rs);
}
DEV void attn_load_q(const AttnU& a, const bf16_t* QKG, bf16x8 (&qf)[4], int tid) {
    const int lane = tid & 63, wave = tid >> 6, n = lane & 31, hl = lane >> 5;
    const int tq = ((a.mu0 + 32 * wave + n) << a.dsh) + a.r;
    const bf16_t* p = QKG + ((size_t)a.b * 4096 + tq) * 7168 + a.colq + 8 * hl;
#pragma unroll
    for (int ks = 0; ks < 4; ++ks) qf[ks] = *(const bf16x8*)(p + 16 * ks);
}
DEV void attn_units(int u0, int ustride, int nunits, const bf16_t* QKG, const bf16_t* VT, bf16_t* OG, float* LSE, LAS unsigned char* lds, int tid) {
    if (u0 >= nunits) return;
    u32x4 kr[6], vr[6]; bf16x8 qn[4];
    { const AttnU a0 = attn_decode(u0); attn_issue(a0, QKG, VT, kr, vr, tid); attn_load_q(a0, QKG, qn, tid); }
#pragma unroll 1
    for (int u = u0; u < nunits; u += ustride) {
        OPAQUE_I(tid);
        const AttnU a = attn_decode(u);
        const int lane = tid & 63, wave = tid >> 6, n = lane & 31;
        SYNC();
        attn_commit(lds, kr, vr, tid);
        bf16x8 qf[4];
#pragma unroll
        for (int ks = 0; ks < 4; ++ks) qf[ks] = qn[ks];
        const int tq = ((a.mu0 + 32 * wave + n) << a.dsh) + a.r;
        SYNC();
        if (u + ustride < nunits) { const AttnU an = attn_decode(u + ustride); attn_issue(an, QKG, VT, kr, vr, tid); attn_load_q(an, QKG, qn, tid); }
        attn_compute(a, qf, tq, OG, LSE, lds, tid);
    }
}
DEV void attn_unit(int unit, const bf16_t* QKG, const bf16_t* VT, bf16_t* OG, float* LSE, LAS unsigned char* lds, int tid) {
    attn_units(unit, 1 << 20, unit + 1, QKG, VT, OG, LSE, lds, tid);
}
DEV void attn_combine_item(int item, const bf16_t* OG, const float* LSE, bf16_t* YA, int pitch = 512, int coloff = 0) {
    const int row = item >> 6, h = (item >> 3) & 7, e8 = item & 7;
    const float l0 = LSE[row * 24 + h], l1 = LSE[row * 24 + 8 + h], l2 = LSE[row * 24 + 16 + h];
    const float mx = fmaxf(l0, fmaxf(l1, l2));
    float w0 = EXP2(l0 - mx), w1 = EXP2(l1 - mx), w2 = EXP2(l2 - mx);
    const float inv = 1.0f / (w0 + w1 + w2); w0 *= inv; w1 *= inv; w2 *= inv;
    const bf16_t* p = OG + (size_t)row * 1536 + h * 64 + e8 * 8;
    const u32x4 a = *(const u32x4*)p, b = *(const u32x4*)(p + 512), c = *(const u32x4*)(p + 1024);
    u32x4 o;
#pragma unroll
    for (int i = 0; i < 4; ++i) {
        const float lo = w0 * U2F(a[i] << 16) + w1 * U2F(b[i] << 16) + w2 * U2F(c[i] << 16);
        const float hi = w0 * U2F(a[i] & 0xffff0000u) + w1 * U2F(b[i] & 0xffff0000u) + w2 * U2F(c[i] & 0xffff0000u);
        o[i] = pk2(lo, hi);
    }
    *(u32x4*)(YA + (size_t)row * pitch + coloff + h * 64 + e8 * 8) = o;
}

namespace pg8 {
#define PG8_LAS __attribute__((address_space(3)))
typedef unsigned short bf16_t;
typedef short bf16x8 __attribute__((ext_vector_type(8)));
typedef float f32x4 __attribute__((ext_vector_type(4)));
typedef unsigned u32x4 __attribute__((ext_vector_type(4)));
constexpr int BM = 256, BK = 64, HALF = 128, HTB = HALF * BK * 2  , STAGE_BYTES = 8 * HTB, NXCD = 8, WGM = 8;

__host__ __device__ __forceinline__ int lds_byte(int r, int c) { const int st = (r >> 4) * 2 + (c >> 5), rr = r & 15, cc = c & 31, ob = rr * 64 + cc * 2; return st * 1024 + (ob ^ (((ob >> 9) & 1) << 5)); }
__host__ __device__ __forceinline__ void stage_rc(int b, int& R, int& C) { const int st = b / 1024, sb = b % 1024, swz = sb ^ (((sb >> 9) & 1) << 5); R = (st >> 1) * 16 + swz / 64; C = (st & 1) * 32 + (swz % 64) / 2; }
__host__ __device__ __forceinline__ int perm32(int rho) { const int n = rho >> 4, i = rho & 15; return 8 * (i >> 2) + 4 * n + (i & 3); }

struct Unit { int pm, pn; };
struct Gemm { const bf16_t* A; const bf16_t* Bt; int M, N, K; };

struct StaticOrder {
    int nM, nN, nwg, G, c;
    __host__ __device__ void init(int M, int N, int G_, int c_) { nM = M / BM; nN = N / BM; nwg = nM * nN; G = G_; c = c_; }
    __host__ __device__ bool next(int i, Unit& u) const {
        const long L = (long)i * G + c; if (L >= nwg) return false;
        int wgid = (int)L; { const int q = nwg / NXCD, r = nwg % NXCD, xcd = wgid % NXCD, off = wgid / NXCD; wgid = (xcd < r ? xcd * (q + 1) : r * (q + 1) + (xcd - r) * q) + off; }
        const int nig = WGM * nN, gid = wgid / nig, fm = gid * WGM, gsz = (nM - fm) < WGM ? (nM - fm) : WGM;
        u.pm = fm + ((wgid % nig) % gsz); u.pn = (wgid % nig) / gsz; return true;
    }
    __device__ __forceinline__ void a_ready(const Unit&) const {}
    __device__ __forceinline__ void done(const Unit&) const {}
};

__device__ __forceinline__ unsigned cvt_pk_bf16(float lo, float hi) { unsigned r; asm volatile("v_cvt_pk_bf16_f32 %0, %1, %2" : "=v"(r) : "v"(lo), "v"(hi)); return r; }
constexpr int EPI_LDS_OFF = 139264 + 1024;
template <int MODE> __device__ __forceinline__ int perm_row(int R) {
    if (MODE == 0) return R;
    if (MODE == 1) return (R & ~31) + perm32(R & 31);
    const int wcp = R >> 5, n = (R >> 4) & 1, fq = (R >> 2) & 3, e = R & 3;
    if (MODE == 2) return fq + 4 * (8 * wcp + 4 * n + e);
    return (4 * wcp + fq) + 16 * (4 * n + e);
}
__device__ __forceinline__ float sigmoid_f(float x) { return __builtin_amdgcn_rcpf(1.0f + __builtin_amdgcn_exp2f(-1.4426950408889634f * x)); }
__device__ __forceinline__ f32x4 exp2_4(f32x4 t) { f32x4 r;
#pragma unroll
    for (int j = 0; j < 4; ++j) r[j] = __builtin_amdgcn_exp2f(fminf(t[j], 60.0f));
    return r; }
__device__ __forceinline__ f32x4 rcp_4(f32x4 t) { f32x4 r;
#pragma unroll
    for (int j = 0; j < 4; ++j) r[j] = __builtin_amdgcn_rcpf(t[j]);
    return r; }
__device__ __forceinline__ float bflo(unsigned w) { return __uint_as_float(w << 16); }
__device__ __forceinline__ float bfhi(unsigned w) { return __uint_as_float(w & 0xffff0000u); }
template <int VM> struct EpiG1a {
    static constexpr bool PERM = true, AFTER_DRAIN = false; static constexpr int PMODE = 1 + VM, KSPLIT = 0; static constexpr bool PREF = false;
    bf16_t* UT; bf16_t* VT;
    __device__ __forceinline__ void operator()(const f32x4 (&acc)[2][2][4][2], const Unit& u, int wr, int wc, int fr, int fq) const {
        const int row0 = u.pm * BM + wr * 64 + fr;
        const int T0 = u.pn * BM, bseq = T0 >> 12, t0 = T0 & 4095;
#pragma unroll
        for (int ai = 0; ai < 2; ++ai)
#pragma unroll
            for (int m = 0; m < 4; ++m) {
                const int nn = row0 + ai * HALF + m * 16;
#pragma unroll
                for (int bj = 0; bj < 2; ++bj) {
                    const f32x4 v0 = acc[ai][bj][m][0], v1 = acc[ai][bj][m][1];
                    u32x4 w; w.x = cvt_pk_bf16(v0[0], v0[1]); w.y = cvt_pk_bf16(v0[2], v0[3]); w.z = cvt_pk_bf16(v1[0], v1[1]); w.w = cvt_pk_bf16(v1[2], v1[3]);
                    const int th = t0 + bj * HALF;
                    if (VM == 0) {
                        const int t = th + wc * 32 + 8 * fq;
                        if (u.pm < 12) *(u32x4*)(UT + ((size_t)(bseq * 3072 + nn)) * 4096 + t) = w;
                        else *(u32x4*)(VT + ((size_t)(bseq * 1536 + (nn - 3072))) * 4096 + t) = w;
                    } else if (VM == 1) {
                        *(u32x4*)(VT + ((size_t)(bseq * 1536 + 512 + nn)) * 4096 + fq * 1024 + (th >> 2) + 8 * wc) = w;
                    } else {
                        *(u32x4*)(VT + ((size_t)(bseq * 1536 + 1024 + nn)) * 4096 + (4 * wc + fq) * 256 + (th >> 4)) = w;
                    }
                }
            }
    }
};
struct EpiG1b {
    static constexpr bool PERM = true, AFTER_DRAIN = false; static constexpr int PMODE = 1, KSPLIT = 0; static constexpr bool PREF = true;
    bf16_t* O; const float* bgate;
    __device__ __forceinline__ void prefetch(const Unit& u, int buf, PG8_LAS unsigned char* lds, int wid, int lane) const {
        if (u.pn >= 12 && wid == 0) __builtin_amdgcn_global_load_lds((const unsigned*)(bgate + (lane >> 5) * 2048 + (u.pn - 12) * 128 + (lane & 31) * 4), (PG8_LAS unsigned*)(lds + EPI_LDS_OFF + buf * 2048), 16, 0, 0);
    }
    __device__ __forceinline__ void run(const f32x4 (&acc)[2][2][4][2], const Unit& u, int wr, int wc, int fr, int fq, PG8_LAS unsigned char* lds, int buf) const {
        const int row0 = u.pm * BM + wr * 64 + fr, col0 = u.pn * BM + wc * 32 + 8 * fq; const bool gate = u.pn >= 12;
        const PG8_LAS float* bl = (const PG8_LAS float*)(lds + EPI_LDS_OFF + buf * 2048) + wc * 32 + 8 * fq;
        f32x4 bv[2][2];
#pragma unroll
        for (int bj = 0; bj < 2; ++bj)
#pragma unroll
            for (int n = 0; n < 2; ++n) bv[bj][n] = gate ? *(const PG8_LAS f32x4*)(bl + bj * HALF + 4 * n) : (f32x4){0.f, 0.f, 0.f, 0.f};
#pragma unroll
        for (int ai = 0; ai < 2; ++ai)
#pragma unroll
            for (int m = 0; m < 4; ++m) { bf16_t* rowp = O + (size_t)(row0 + ai * HALF + m * 16) * 7168 + col0;
                {
                    f32x4 h0 = acc[ai][0][m][0] + bv[0][0], h1 = acc[ai][0][m][1] + bv[0][1], a0 = acc[ai][1][m][0] + bv[1][0], a1 = acc[ai][1][m][1] + bv[1][1];
                    if (gate) {
                        const float nl2e = -1.4426950408889634f;
                        const f32x4 pa0 = exp2_4(a0 * nl2e) + 1.0f, pa1 = exp2_4(a1 * nl2e) + 1.0f, ph0 = exp2_4(h0 * nl2e) + 1.0f, ph1 = exp2_4(h1 * nl2e) + 1.0f;
                        const f32x4 r0 = rcp_4(pa0 * ph0), r1 = rcp_4(pa1 * ph1);
                        h0 = r0 * pa0 * pa0; h1 = r1 * pa1 * pa1; a0 = r0 * ph0; a1 = r1 * ph1; }
                    u32x4 w; w.x = cvt_pk_bf16(h0[0], h0[1]); w.y = cvt_pk_bf16(h0[2], h0[3]); w.z = cvt_pk_bf16(h1[0], h1[1]); w.w = cvt_pk_bf16(h1[2], h1[3]);
                    *(u32x4*)(rowp) = w;
                    w.x = cvt_pk_bf16(a0[0], a0[1]); w.y = cvt_pk_bf16(a0[2], a0[3]); w.z = cvt_pk_bf16(a1[0], a1[1]); w.w = cvt_pk_bf16(a1[2], a1[3]);
                    *(u32x4*)(rowp + HALF) = w; } }
    }
};
template <bool ADD> struct EpiG2 {
    static constexpr bool PERM = true, AFTER_DRAIN = false; static constexpr int PMODE = 1, KSPLIT = 0; static constexpr bool PREF = false;
    const bf16_t* QKG; bf16_t* MB; int goff;
    __device__ __forceinline__ void operator()(const f32x4 (&acc)[2][2][4][2], const Unit& u, int wr, int wc, int fr, int fq) const {
        const int row0 = u.pm * BM + wr * 64 + fr, col0 = u.pn * BM + wc * 32 + 8 * fq;
#pragma unroll
        for (int ai = 0; ai < 2; ++ai) {
            u32x4 gtv[4][2], mbv[4][2];
#pragma unroll
            for (int m = 0; m < 4; ++m) { const size_t row = (size_t)(row0 + ai * HALF + m * 16);
#pragma unroll
                for (int bj = 0; bj < 2; ++bj) { const int col = col0 + bj * HALF;
                    gtv[m][bj] = *(const u32x4*)(QKG + row * 7168 + goff + col);
                    if (ADD) mbv[m][bj] = *(const u32x4*)(MB + row * 2048 + col); } }
#pragma unroll
            for (int m = 0; m < 4; ++m) { const size_t row = (size_t)(row0 + ai * HALF + m * 16);
#pragma unroll
                for (int bj = 0; bj < 2; ++bj) { const int col = col0 + bj * HALF;
                    const u32x4 gt = gtv[m][bj];
                    f32x4 v0 = acc[ai][bj][m][0], v1 = acc[ai][bj][m][1];
                    v0[0] *= bflo(gt.x); v0[1] *= bfhi(gt.x); v0[2] *= bflo(gt.y); v0[3] *= bfhi(gt.y); v1[0] *= bflo(gt.z); v1[1] *= bfhi(gt.z); v1[2] *= bflo(gt.w); v1[3] *= bfhi(gt.w);
                    if (ADD) { const u32x4 mb = mbv[m][bj];
                        v0[0] += bflo(mb.x); v0[1] += bfhi(mb.x); v0[2] += bflo(mb.y); v0[3] += bfhi(mb.y); v1[0] += bflo(mb.z); v1[1] += bfhi(mb.z); v1[2] += bflo(mb.w); v1[3] += bfhi(mb.w); }
                    u32x4 w; w.x = cvt_pk_bf16(v0[0], v0[1]); w.y = cvt_pk_bf16(v0[2], v0[3]); w.z = cvt_pk_bf16(v1[0], v1[1]); w.w = cvt_pk_bf16(v1[2], v1[3]);
                    *(u32x4*)(MB + row * 2048 + col) = w; } }
        }
    }
};
struct EpiRes {
    static constexpr bool PERM = false, AFTER_DRAIN = false; static constexpr int PMODE = 0, KSPLIT = 0; static constexpr bool PREF = false;
    const float* xold; float* xnew; const float* gate;
    __device__ __forceinline__ void operator()(const f32x4 (&acc)[2][2][4][2], const Unit& u, int wr, int wc, int fr, int fq) const {
        const int row0 = u.pm * BM + wr * 64 + fr, col0 = u.pn * BM + wc * 32 + 4 * fq;
        const float* gp = gate + (size_t)(u.pm >> 4) * 12288 + col0;
        f32x4 gv[2][2];
#pragma unroll
        for (int bj = 0; bj < 2; ++bj)
#pragma unroll
            for (int n = 0; n < 2; ++n) gv[bj][n] = *(const f32x4*)(gp + bj * HALF + n * 16);
#pragma unroll
        for (int ai = 0; ai < 2; ++ai) {
            f32x4 xo[4][2][2];
#pragma unroll
            for (int m = 0; m < 4; ++m) { const size_t off = (size_t)(row0 + ai * HALF + m * 16) * 2048 + col0;
#pragma unroll
                for (int bj = 0; bj < 2; ++bj)
#pragma unroll
                    for (int n = 0; n < 2; ++n) xo[m][bj][n] = *(const f32x4*)(xold + off + bj * HALF + n * 16); }
#pragma unroll
            for (int m = 0; m < 4; ++m) { const size_t off = (size_t)(row0 + ai * HALF + m * 16) * 2048 + col0;
#pragma unroll
                for (int bj = 0; bj < 2; ++bj)
#pragma unroll
                    for (int n = 0; n < 2; ++n) *(f32x4*)(xnew + off + bj * HALF + n * 16) = xo[m][bj][n] + gv[bj][n] * acc[ai][bj][m][n]; }
        }
    }
};
template <bool F32IN> struct EpiResB {
    static constexpr bool PERM = true, AFTER_DRAIN = false; static constexpr int PMODE = 1, KSPLIT = 0; static constexpr bool PREF = false;
    const float* xin; const bf16_t* xold; bf16_t* xnew; const float* gate;
    __device__ __forceinline__ void operator()(const f32x4 (&acc)[2][2][4][2], const Unit& u, int wr, int wc, int fr, int fq) const {
        const int row0 = u.pm * BM + wr * 64 + fr, col0 = u.pn * BM + wc * 32 + 8 * fq;
        const float* gp = gate + (size_t)(u.pm >> 4) * 12288 + col0;
        f32x4 gv[2][2];
#pragma unroll
        for (int bj = 0; bj < 2; ++bj)
#pragma unroll
            for (int n = 0; n < 2; ++n) gv[bj][n] = *(const f32x4*)(gp + bj * HALF + n * 4);
        if constexpr (F32IN) {
#pragma unroll
            for (int ai = 0; ai < 2; ++ai) {
                f32x4 xo[4][2][2];
#pragma unroll
                for (int m = 0; m < 4; ++m) { const size_t off = (size_t)(row0 + ai * HALF + m * 16) * 2048 + col0;
#pragma unroll
                    for (int bj = 0; bj < 2; ++bj)
#pragma unroll
                        for (int n = 0; n < 2; ++n) xo[m][bj][n] = *(const f32x4*)(xin + off + bj * HALF + n * 4); }
#pragma unroll
                for (int m = 0; m < 4; ++m) { const size_t off = (size_t)(row0 + ai * HALF + m * 16) * 2048 + col0;
#pragma unroll
                    for (int bj = 0; bj < 2; ++bj) { const f32x4 v0 = xo[m][bj][0] + gv[bj][0] * acc[ai][bj][m][0], v1 = xo[m][bj][1] + gv[bj][1] * acc[ai][bj][m][1];
                        u32x4 w; w.x = pkh2(v0[0], v0[1]); w.y = pkh2(v0[2], v0[3]); w.z = pkh2(v1[0], v1[1]); w.w = pkh2(v1[2], v1[3]);
                        *(u32x4*)(xnew + off + bj * HALF) = w; } }
            }
        } else {
            u32x4 xo[2][4][2];
#pragma unroll
            for (int ai = 0; ai < 2; ++ai)
#pragma unroll
                for (int m = 0; m < 4; ++m) { const size_t off = (size_t)(row0 + ai * HALF + m * 16) * 2048 + col0;
#pragma unroll
                    for (int bj = 0; bj < 2; ++bj) xo[ai][m][bj] = *(const u32x4*)(xold + off + bj * HALF); }
#pragma unroll
            for (int ai = 0; ai < 2; ++ai)
#pragma unroll
                for (int m = 0; m < 4; ++m) { const size_t off = (size_t)(row0 + ai * HALF + m * 16) * 2048 + col0;
#pragma unroll
                    for (int bj = 0; bj < 2; ++bj) { const u32x4 o = xo[ai][m][bj]; const f32x4 a0 = acc[ai][bj][m][0], a1 = acc[ai][bj][m][1], g0 = gv[bj][0], g1 = gv[bj][1];
                        u32x4 w;
                        w.x = pkh2(hlo(o.x) + g0[0] * a0[0], hhi(o.x) + g0[1] * a0[1]); w.y = pkh2(hlo(o.y) + g0[2] * a0[2], hhi(o.y) + g0[3] * a0[3]);
                        w.z = pkh2(hlo(o.z) + g1[0] * a1[0], hhi(o.z) + g1[1] * a1[1]); w.w = pkh2(hlo(o.w) + g1[2] * a1[2], hhi(o.w) + g1[3] * a1[3]);
                        *(u32x4*)(xnew + off + bj * HALF) = w; } }
        }
    }
};
struct PanelOrder {
    int nwg, G, c;
    __host__ __device__ void init(int M, int N, int G_, int c_) { nwg = (M / BM) * (N / BM); G = G_; c = c_; }
    __host__ __device__ __attribute__((always_inline)) bool next(int i, Unit& u) const {
        const int L = i * G + c; if (L >= nwg) return false;
        const int x = c & 7, r = c >> 3, ppx = G >> 6;
        u.pm = ((i * G) >> 3) + x * ppx + (r % ppx); u.pn = r / ppx; return true;
    }
    __device__ __forceinline__ void a_ready(const Unit&) const {}
    __device__ __forceinline__ void done(const Unit&) const {}
};
template <bool F32IN> struct EpiResN {
    static constexpr bool PERM = true, AFTER_DRAIN = false; static constexpr int PMODE = 1, KSPLIT = 0; static constexpr bool PREF = true;
    const float* xin; const bf16_t* xold; bf16_t* xnew; bf16_t* hout; const float* modb; const float* gn; int goff; float* part; unsigned* cnt; unsigned want; unsigned* tmo;
    __device__ __forceinline__ void prefetch(const Unit& u, int buf, PG8_LAS unsigned char* lds, int wid, int lane) const {
        if (wid < 4) { asm volatile("v_mbcnt_lo_u32_b32 %0, -1, 0\n\tv_mbcnt_hi_u32_b32 %0, -1, %0" : "=v"(lane));
            const float* base = wid == 1 ? gn + u.pn * BM : modb + (size_t)(u.pm >> 4) * 12288 + u.pn * BM + (wid == 0 ? goff : wid == 2 ? 4 * 2048 : 3 * 2048);
            __builtin_amdgcn_global_load_lds((const unsigned*)(base + lane * 4), (PG8_LAS unsigned*)(lds + EPI_LDS_OFF + buf * 4096 + wid * 1024), 16, 0, 0); }
    }
    __device__ __forceinline__ void run(f32x4 (&acc)[2][2][4][2], const Unit& u, int wr, int wc, int fr, int fq, PG8_LAS unsigned char* lds, int buf) const {
        { int l_; asm volatile("v_mbcnt_lo_u32_b32 %0, -1, 0\n\tv_mbcnt_hi_u32_b32 %0, -1, %0" : "=v"(l_)); fr = l_ & 15; fq = l_ >> 4; }
        const int wid = wr * 4 + wc;
        PG8_LAS float* P = (PG8_LAS float*)(lds + EPI_LDS_OFF + 8192);
        PG8_LAS float* S = (PG8_LAS float*)(lds + EPI_LDS_OFF + 12288);
        PG8_LAS unsigned* flag = (PG8_LAS unsigned*)(lds + EPI_LDS_OFF + 13312);
        { const int row0 = u.pm * BM + wr * 64 + fr, col0 = u.pn * BM + wc * 32 + 8 * fq;
        const PG8_LAS float* vb = (const PG8_LAS float*)(lds + EPI_LDS_OFF + buf * 4096) + wc * 32 + 8 * fq;
        f32x4 gv[2][2];
#pragma unroll
        for (int bj = 0; bj < 2; ++bj)
#pragma unroll
            for (int n = 0; n < 2; ++n) gv[bj][n] = *(const PG8_LAS f32x4*)(vb + bj * HALF + 4 * n);
        if constexpr (F32IN) {
#pragma unroll
            for (int ai = 0; ai < 2; ++ai)
#pragma unroll
                for (int mh = 0; mh < 2; ++mh) {
                    f32x4 xo[2][2][2];
#pragma unroll
                    for (int mm = 0; mm < 2; ++mm) { const unsigned off = (unsigned)(row0 + ai * HALF + (2 * mh + mm) * 16) * 2048u + (unsigned)col0;
#pragma unroll
                        for (int bj = 0; bj < 2; ++bj)
#pragma unroll
                            for (int n = 0; n < 2; ++n) xo[mm][bj][n] = *(const f32x4*)(xin + off + bj * HALF + n * 4); }
#pragma unroll
                    for (int mm = 0; mm < 2; ++mm)
#pragma unroll
                        for (int bj = 0; bj < 2; ++bj)
#pragma unroll
                            for (int n = 0; n < 2; ++n) acc[ai][bj][2 * mh + mm][n] = xo[mm][bj][n] + gv[bj][n] * acc[ai][bj][2 * mh + mm][n];
                    asm volatile("" ::: "memory");
                }
        } else {
            u32x4 xo[2][4][2];
#pragma unroll
            for (int ai = 0; ai < 2; ++ai)
#pragma unroll
                for (int m = 0; m < 4; ++m) { const unsigned off = (unsigned)(row0 + ai * HALF + m * 16) * 2048u + (unsigned)col0;
#pragma unroll
                    for (int bj = 0; bj < 2; ++bj) xo[ai][m][bj] = *(const u32x4*)(xold + off + bj * HALF); }
#pragma unroll
            for (int ai = 0; ai < 2; ++ai)
#pragma unroll
                for (int m = 0; m < 4; ++m)
#pragma unroll
                    for (int bj = 0; bj < 2; ++bj) { const u32x4 o = xo[ai][m][bj];
                        const f32x4 x0 = (f32x4){hlo(o.x), hhi(o.x), hlo(o.y), hhi(o.y)}, x1 = (f32x4){hlo(o.z), hhi(o.z), hlo(o.w), hhi(o.w)};
                        acc[ai][bj][m][0] = x0 + gv[bj][0] * acc[ai][bj][m][0]; acc[ai][bj][m][1] = x1 + gv[bj][1] * acc[ai][bj][m][1]; }
        }
        }
        __builtin_amdgcn_sched_barrier(0);
        asm volatile("" : "+v"(fr), "+v"(fq));
        const int lane = fq * 16 + fr;
#pragma unroll
        for (int ai = 0; ai < 2; ++ai)
#pragma unroll
            for (int m = 0; m < 4; ++m) { float q = 0.f;
#pragma unroll
                for (int bj = 0; bj < 2; ++bj)
#pragma unroll
                    for (int n = 0; n < 2; ++n) { const f32x4 x = acc[ai][bj][m][n]; q += (x[0] * x[0] + x[1] * x[1]) + (x[2] * x[2] + x[3] * x[3]); }
                q += shfl_from(q, lane ^ 16); q += shfl_from(q, lane ^ 32);
                if (fq == 0) P[(ai * HALF + wr * 64 + m * 16 + fr) * 4 + wc] = q; }
        asm volatile("s_waitcnt lgkmcnt(0)" ::: "memory"); __builtin_amdgcn_s_barrier(); asm volatile("" ::: "memory");
        const int t = wid * 64 + lane;
        if (wid < 4) { const f32x4 p = *(const PG8_LAS f32x4*)(P + t * 4);
            __hip_atomic_store((unsigned*)part + ((size_t)u.pm * BM + t) * 8 + u.pn, __float_as_uint((p[0] + p[1]) + (p[2] + p[3])), __ATOMIC_RELAXED, __HIP_MEMORY_SCOPE_AGENT);
            asm volatile("s_waitcnt vmcnt(0)" ::: "memory");
            if (lane == 0) __hip_atomic_fetch_add(cnt + 64 * u.pm, 1u, __ATOMIC_RELAXED, __HIP_MEMORY_SCOPE_AGENT); }
        if (wid == 0) {
            unsigned got, it_; unsigned tmpv; const unsigned* cp = cnt + 64 * u.pm;
            asm volatile("s_mov_b32 %2, 0\n.Lpw%=: global_load_dword %0, %3, off sc1\n\ts_waitcnt vmcnt(0)\n\tv_readfirstlane_b32 %1, %0\n\ts_cmp_ge_u32 %1, %4\n\ts_cbranch_scc1 .Lpd%=\n\ts_sleep 2\n\ts_add_u32 %2, %2, 1\n\ts_cmp_lt_u32 %2, 0x40000\n\ts_cbranch_scc1 .Lpw%=\n.Lpd%=:"
                         : "=&v"(tmpv), "=&s"(got), "=&s"(it_) : "v"(cp), "s"(want) : "scc", "memory");
            const bool dead = got < want;
            if (dead && lane == 0) __hip_atomic_store(tmo, 1u, __ATOMIC_RELAXED, __HIP_MEMORY_SCOPE_AGENT);
            __builtin_amdgcn_fence(__ATOMIC_ACQUIRE, "agent");
            if (lane == 0) flag[0] = dead ? 1u : 0u; }
        asm volatile("s_waitcnt vmcnt(0) lgkmcnt(0)" ::: "memory"); __builtin_amdgcn_s_barrier(); asm volatile("" ::: "memory");
        const bool bad = flag[0] != 0u;
        if (wid < 4) { const unsigned long long* sl = (const unsigned long long*)((const unsigned*)part + ((size_t)u.pm * BM + t) * 8); float q = 0.f;
#pragma unroll
            for (int k = 0; k < 4; ++k) { const unsigned long long w = __hip_atomic_load(sl + k, __ATOMIC_RELAXED, __HIP_MEMORY_SCOPE_AGENT); q += __uint_as_float((unsigned)w) + __uint_as_float((unsigned)(w >> 32)); }
            S[t] = 1.0f / sqrtf(q * (1.0f / 2048.0f) + 1e-6f); }
        asm volatile("s_waitcnt vmcnt(0) lgkmcnt(0)" ::: "memory"); __builtin_amdgcn_s_barrier(); asm volatile("" ::: "memory");
        __builtin_amdgcn_sched_barrier(0);
        asm volatile("" : "+v"(fr), "+v"(fq));
        const int row0 = u.pm * BM + wr * 64 + fr, col0 = u.pn * BM + wc * 32 + 8 * fq;
        const PG8_LAS float* vb = (const PG8_LAS float*)(lds + EPI_LDS_OFF + buf * 4096) + wc * 32 + 8 * fq;
        f32x4 gs[2][2], sh[2][2];
#pragma unroll
        for (int bj = 0; bj < 2; ++bj)
#pragma unroll
            for (int n = 0; n < 2; ++n) { gs[bj][n] = *(const PG8_LAS f32x4*)(vb + 256 + bj * HALF + 4 * n) * (*(const PG8_LAS f32x4*)(vb + 512 + bj * HALF + 4 * n) + 1.0f); sh[bj][n] = *(const PG8_LAS f32x4*)(vb + 768 + bj * HALF + 4 * n); }
        const float qnan = __builtin_nanf("");
#pragma unroll
        for (int ai = 0; ai < 2; ++ai)
#pragma unroll
            for (int m = 0; m < 4; ++m) { const float rstd = bad ? qnan : S[ai * HALF + wr * 64 + m * 16 + fr]; const unsigned off = (unsigned)(row0 + ai * HALF + m * 16) * 2048u + (unsigned)col0;
#pragma unroll
                for (int bj = 0; bj < 2; ++bj) { const f32x4 x0 = acc[ai][bj][m][0], x1 = acc[ai][bj][m][1];
                    u32x4 w; w.x = pkh2(x0[0], x0[1]); w.y = pkh2(x0[2], x0[3]); w.z = pkh2(x1[0], x1[1]); w.w = pkh2(x1[2], x1[3]);
                    *(u32x4*)(xnew + off + bj * HALF) = w;
                    const f32x4 h0 = x0 * rstd * gs[bj][0] + sh[bj][0], h1 = x1 * rstd * gs[bj][1] + sh[bj][1];
                    w.x = cvt_pk_bf16(h0[0], h0[1]); w.y = cvt_pk_bf16(h0[2], h0[3]); w.z = cvt_pk_bf16(h1[0], h1[1]); w.w = cvt_pk_bf16(h1[2], h1[3]);
                    *(u32x4*)(hout + off + bj * HALF) = w; } }
    }
};
struct EpiPlain {
    static constexpr bool PERM = true, AFTER_DRAIN = false; static constexpr int PMODE = 1, KSPLIT = 0; static constexpr bool PREF = false;
    bf16_t* O; int ldc;
    __device__ __forceinline__ void operator()(const f32x4 (&acc)[2][2][4][2], const Unit& u, int wr, int wc, int fr, int fq) const {
        const int row0 = u.pm * BM + wr * 64 + fr, col0 = u.pn * BM + wc * 32 + 8 * fq;
#pragma unroll
        for (int ai = 0; ai < 2; ++ai)
#pragma unroll
            for (int m = 0; m < 4; ++m) { bf16_t* rowp = O + (size_t)(row0 + ai * HALF + m * 16) * ldc + col0;
#pragma unroll
                for (int bj = 0; bj < 2; ++bj) { const f32x4 v0 = acc[ai][bj][m][0], v1 = acc[ai][bj][m][1];
                    u32x4 w; w.x = cvt_pk_bf16(v0[0], v0[1]); w.y = cvt_pk_bf16(v0[2], v0[3]); w.z = cvt_pk_bf16(v1[0], v1[1]); w.w = cvt_pk_bf16(v1[2], v1[3]);
                    *(u32x4*)(rowp + bj * HALF) = w; } }
    }
};

struct EpiUpCG {
    static constexpr bool PERM = true, AFTER_DRAIN = false; static constexpr int PMODE = 1, KSPLIT = 0; static constexpr bool PREF = true;
    bf16_t* ACT; bf16_t* GB; const float* cw; const float* cb;
    __device__ __forceinline__ void prefetch(const Unit& u, int buf, PG8_LAS unsigned char* lds, int wid, int lane) const {
        if (wid < 2) { const int v = 2 * wid + (lane >> 5);
            const float* src = (v < 3 ? cw + v * 5632 : cb) + u.pn * 128 + (lane & 31) * 4;
            __builtin_amdgcn_global_load_lds((const unsigned*)src, (PG8_LAS unsigned*)(lds + EPI_LDS_OFF + buf * 2048 + wid * 1024), 16, 0, 0); }
    }
    __device__ __forceinline__ void run(const f32x4 (&acc)[2][2][4][2], const Unit& u, int wr, int wc, int fr, int fq, PG8_LAS unsigned char* lds, int buf) const {
        const int row0 = u.pm * BM + wr * 64 + fr, ch0 = u.pn * 128 + wc * 32 + 8 * fq;
        const PG8_LAS float* vl = (const PG8_LAS float*)(lds + EPI_LDS_OFF + buf * 2048) + wc * 32 + 8 * fq;
        const int lane = fq * 16 + fr, lup = (lane & 48) | ((lane - 1) & 15), ldn = (lane & 48) | ((lane + 1) & 15);
        f32x4 w0[2], w1[2], w2[2], bb[2];
#pragma unroll
        for (int n = 0; n < 2; ++n) { w0[n] = *(const PG8_LAS f32x4*)(vl + 4 * n); w1[n] = *(const PG8_LAS f32x4*)(vl + 128 + 4 * n); w2[n] = *(const PG8_LAS f32x4*)(vl + 256 + 4 * n); bb[n] = *(const PG8_LAS f32x4*)(vl + 384 + 4 * n); }
#pragma unroll
        for (int ai = 0; ai < 2; ++ai) {
            unsigned op[4][2][2];
#pragma unroll
            for (int n = 0; n < 2; ++n)
#pragma unroll
                for (int ep = 0; ep < 2; ++ep) {
                    float ov[4][2], xv[4][2];
#pragma unroll
                    for (int eh = 0; eh < 2; ++eh) { const int e = 2 * ep + eh;
                        float R[4], L[4];
#pragma unroll
                        for (int m = 0; m < 4; ++m) { R[m] = dpp_ror<1>(acc[ai][1][m][n][e]); L[m] = dpp_ror<15>(acc[ai][1][m][n][e]); }
#pragma unroll
                        for (int m = 0; m < 4; ++m) {
                            const float up = (fr == 0) ? R[m > 0 ? m - 1 : 0] : R[m];
                            const float dn = (fr == 15) ? L[m < 3 ? m + 1 : 3] : L[m];
                            xv[m][eh] = up * w0[n][e] + acc[ai][1][m][n][e] * w1[n][e] + dn * w2[n][e] + bb[n][e];
                        } }
#pragma unroll
                    for (int m = 0; m < 4; ++m) {
                        const float p0 = __builtin_amdgcn_exp2f(fminf(-1.4426950408889634f * xv[m][0], 60.0f)) + 1.0f, p1 = __builtin_amdgcn_exp2f(fminf(-1.4426950408889634f * xv[m][1], 60.0f)) + 1.0f;
                        const float r = __builtin_amdgcn_rcpf(p0 * p1);
                        const bool edge = (m == 0 && fr == 0) || (m == 3 && fr == 15);
                        ov[m][0] = edge ? acc[ai][0][m][n][2 * ep] : xv[m][0] * (r * p1) * acc[ai][0][m][n][2 * ep];
                        ov[m][1] = edge ? acc[ai][0][m][n][2 * ep + 1] : xv[m][1] * (r * p0) * acc[ai][0][m][n][2 * ep + 1];
                    }
#pragma unroll
                    for (int m = 0; m < 4; ++m) op[m][n][ep] = cvt_pk_bf16(ov[m][0], ov[m][1]);
                    __builtin_amdgcn_sched_barrier(0);
                }
#pragma unroll
            for (int m = 0; m < 4; ++m) {
                u32x4 w; w.x = op[m][0][0]; w.y = op[m][0][1]; w.z = op[m][1][0]; w.w = op[m][1][1];
                *(u32x4*)(ACT + (size_t)(row0 + ai * HALF + m * 16) * 5632 + ch0) = w;
            }
            const int grp = u.pm * 4 + ai * 2 + wr;
            if (fr <= 1) { const f32x4 g0 = acc[ai][1][0][0], g1 = acc[ai][1][0][1];
                u32x4 w; w.x = cvt_pk_bf16(g0[0], g0[1]); w.y = cvt_pk_bf16(g0[2], g0[3]); w.z = cvt_pk_bf16(g1[0], g1[1]); w.w = cvt_pk_bf16(g1[2], g1[3]);
                *(u32x4*)(GB + ((size_t)(grp * 4 + fr)) * 5632 + ch0) = w; }
            if (fr >= 14) { const f32x4 g0 = acc[ai][1][3][0], g1 = acc[ai][1][3][1];
                u32x4 w; w.x = cvt_pk_bf16(g0[0], g0[1]); w.y = cvt_pk_bf16(g0[2], g0[3]); w.z = cvt_pk_bf16(g1[0], g1[1]); w.w = cvt_pk_bf16(g1[2], g1[3]);
                *(u32x4*)(GB + ((size_t)(grp * 4 + fr - 12)) * 5632 + ch0) = w; }
        }
    }
};

struct EpiG2M {
    static constexpr bool PERM = true, AFTER_DRAIN = false; static constexpr int PMODE = 1, KSPLIT = 1024; static constexpr bool PREF = false;
    const bf16_t* QKG; bf16_t* MB;
    __device__ __forceinline__ void midk(f32x4 (&acc)[2][2][4][2], const Unit& u, int wr, int wc, int fr, int fq) const {
        asm volatile("" : "+v"(fr), "+v"(fq));
        scale<0>(acc, u, wr, wc, fr, fq);
    }
    template <int WHICH> __device__ __forceinline__ void scale(f32x4 (&acc)[2][2][4][2], const Unit& u, int wr, int wc, int fr, int fq) const {
        const int row0 = u.pm * BM + wr * 64 + fr, gcol = 3072 + u.pn * 512 + WHICH * 128 + wc * 32 + 8 * fq;
        u32x4 g[2][4][2];
#pragma unroll
        for (int ai = 0; ai < 2; ++ai)
#pragma unroll
            for (int m = 0; m < 4; ++m)
#pragma unroll
                for (int bj = 0; bj < 2; ++bj) g[ai][m][bj] = *(const u32x4*)(QKG + (size_t)(row0 + ai * HALF + m * 16) * 7168 + gcol + bj * 256);
#pragma unroll
        for (int ai = 0; ai < 2; ++ai)
#pragma unroll
            for (int m = 0; m < 4; ++m)
#pragma unroll
                for (int bj = 0; bj < 2; ++bj) {
                    const unsigned gw[4] = {g[ai][m][bj].x, g[ai][m][bj].y, g[ai][m][bj].z, g[ai][m][bj].w};
#pragma unroll
                    for (int j = 0; j < 4; ++j) { acc[ai][bj][m][j >> 1][(2 * j) & 3] *= bflo(gw[j]); acc[ai][bj][m][j >> 1][(2 * j + 1) & 3] *= bfhi(gw[j]); }
                }
    }
    __device__ __forceinline__ void operator()(f32x4 (&acc)[2][2][4][2], const Unit& u, int wr, int wc, int fr, int fq) const {
        scale<1>(acc, u, wr, wc, fr, fq);
        const int row0 = u.pm * BM + wr * 64 + fr, col0 = u.pn * BM + wc * 32 + 8 * fq;
#pragma unroll
        for (int ai = 0; ai < 2; ++ai)
#pragma unroll
            for (int m = 0; m < 4; ++m)
#pragma unroll
                for (int bj = 0; bj < 2; ++bj) { const f32x4 v0 = acc[ai][bj][m][0], v1 = acc[ai][bj][m][1];
                    u32x4 w; w.x = cvt_pk_bf16(v0[0], v0[1]); w.y = cvt_pk_bf16(v0[2], v0[3]); w.z = cvt_pk_bf16(v1[0], v1[1]); w.w = cvt_pk_bf16(v1[2], v1[3]);
                    *(u32x4*)(MB + (size_t)(row0 + ai * HALF + m * 16) * 2048 + col0 + bj * HALF) = w; }
    }
};
template <class Epi, class Sched, bool ALIGN_EPI = false, bool SP2 = false>
__device__ __forceinline__ void gemm_phase(PG8_LAS unsigned char* lds, const Gemm g, const Sched& S, const Epi& E, const int tid_in) {
    int tid_l = tid_in; asm volatile("" : "+v"(tid_l));
    const int tid = tid_l, wid = __builtin_amdgcn_readfirstlane(tid >> 6), lane = tid & 63, wr = wid >> 2, wc = wid & 3, fr = lane & 15, fq = lane >> 4;
    const int K = g.K, nt = K / BK;
    unsigned voffA[2], voffB[2];
#pragma unroll
    for (int i = 0; i < 2; ++i) { int R, C; stage_rc(tid * 16 + i * 8192, R, C); const int Rb = perm_row<Epi::PMODE>(R);
        voffA[i] = (unsigned)(R * K + C) * 2u; voffB[i] = (unsigned)(Rb * K + C) * 2u; }
    const size_t kstep = (size_t)(BK * 2);
    const size_t hstep = (size_t)HALF * K * 2;
    const size_t tstep = 2 * hstep;
    const unsigned ldsw = (unsigned)wid * 1024u;
    const int aoff = lds_byte(wr * 64 + fr, fq * 8), boff = lds_byte(wc * 32 + fr, fq * 8);
#define PG8_SA(b, h) (((b) * 2 + (h)) * HTB)
#define PG8_SB(b, h) ((4 + (b) * 2 + (h)) * HTB)
#define PG8_STAGE(bufoff, gbase, voff) do { _Pragma("unroll") for (int _i = 0; _i < 2; ++_i) \
        __builtin_amdgcn_global_load_lds((const unsigned*)((const char*)(gbase) + (voff)[_i]), (PG8_LAS unsigned*)(lds + (bufoff) + ldsw + _i * 8192), 16, 0, 0); } while (0)
#define PG8_LDA(dst, b, h) do { _Pragma("unroll") for (int m = 0; m < 4; ++m) _Pragma("unroll") for (int k = 0; k < 2; ++k) dst[m][k] = *(const PG8_LAS bf16x8*)(lds + PG8_SA(b, h) + aoff + m * 2048 + k * 1024); } while (0)
#define PG8_LDB(dst, b, h) do { _Pragma("unroll") for (int n = 0; n < 2; ++n) _Pragma("unroll") for (int k = 0; k < 2; ++k) dst[n][k] = *(const PG8_LAS bf16x8*)(lds + PG8_SB(b, h) + boff + n * 2048 + k * 1024); } while (0)
#define PG8_MMA(ai, bj, At, Bt) do { __builtin_amdgcn_s_setprio(1); _Pragma("unroll") for (int m = 0; m < 4; ++m) _Pragma("unroll") for (int n = 0; n < 2; ++n) _Pragma("unroll") for (int k = 0; k < 2; ++k) \
        acc[ai][bj][m][n] = __builtin_amdgcn_mfma_f32_16x16x32_bf16(Bt[n][k], At[m][k], acc[ai][bj][m][n], 0, 0, 0); __builtin_amdgcn_s_setprio(0); } while (0)
#define PG8_WAIT_V(n) asm volatile("s_waitcnt vmcnt(" #n ")" ::: "memory")
#define PG8_WAIT_L(n) asm volatile("s_waitcnt lgkmcnt(" #n ")" ::: "memory")
#define PG8_BAR __builtin_amdgcn_s_barrier()
#define PG8_SCHED __builtin_amdgcn_sched_barrier(0)
    Unit cur, nxt; int ui = 0;
    if (!S.next(0, cur)) return;
    f32x4 acc[2][2][4][2];
#pragma unroll
    for (int a = 0; a < 2; ++a)
#pragma unroll
        for (int b = 0; b < 2; ++b)
#pragma unroll
            for (int m = 0; m < 4; ++m)
#pragma unroll
                for (int n = 0; n < 2; ++n) acc[a][b][m][n] = (f32x4){0.f, 0.f, 0.f, 0.f};
    bf16x8 At[4][2], B0[2][2], B1[2][2];
    const char* cA = (const char*)g.A + (size_t)cur.pm * tstep; const char* cB = (const char*)g.Bt + (size_t)cur.pn * tstep;
    S.a_ready(cur);
    if constexpr (Epi::PREF) E.prefetch(cur, 0, lds, wid, lane);
    if constexpr (SP2) {
        PG8_STAGE(PG8_SB(0, 0), cB, voffB); PG8_STAGE(PG8_SB(0, 1), cB + hstep, voffB); PG8_STAGE(PG8_SA(0, 0), cA, voffA); PG8_STAGE(PG8_SA(0, 1), cA + hstep, voffA);
        if (wr == 1) PG8_BAR;
        PG8_WAIT_V(2); PG8_BAR;
        PG8_STAGE(PG8_SB(1, 0), cB + kstep, voffB); PG8_STAGE(PG8_SA(1, 0), cA + kstep, voffA); PG8_STAGE(PG8_SB(1, 1), cB + hstep + kstep, voffB);
        PG8_WAIT_V(6); PG8_BAR;
    } else {
        PG8_STAGE(PG8_SB(0, 0), cB, voffB); PG8_STAGE(PG8_SA(0, 0), cA, voffA); PG8_STAGE(PG8_SB(0, 1), cB + hstep, voffB); PG8_STAGE(PG8_SA(0, 1), cA + hstep, voffA);
        if (wr == 1) PG8_BAR;
        PG8_WAIT_V(4); PG8_BAR;
        PG8_STAGE(PG8_SB(1, 0), cB + kstep, voffB); PG8_STAGE(PG8_SA(1, 0), cA + kstep, voffA); PG8_STAGE(PG8_SB(1, 1), cB + hstep + kstep, voffB);
        PG8_WAIT_V(6); PG8_BAR;
    }
    for (;;) {
        const bool has_next = S.next(ui + 1, nxt);
        const char* nA = has_next ? (const char*)g.A + (size_t)nxt.pm * tstep : cA; const char* nB = has_next ? (const char*)g.Bt + (size_t)nxt.pn * tstep : cB;
        for (int t = 0; t < nt; t += 2) {
            if constexpr (Epi::KSPLIT > 0) { if (t == Epi::KSPLIT / BK) E.midk(acc, cur, wr, wc, fr, fq); }
            const bool last = (t == nt - 2);
            const char* a1 = cA + (size_t)(t + 1) * kstep;
            const char* a2 = last ? nA : cA + (size_t)(t + 2) * kstep; const char* b2 = last ? nB : cB + (size_t)(t + 2) * kstep;
            const char* a3 = a2 + kstep; const char* b3 = b2 + kstep;
            if (last && has_next) S.a_ready(nxt);
            if constexpr (SP2) {
            PG8_LDB(B0, 0, 0); PG8_LDB(B1, 0, 1); PG8_SCHED; PG8_LDA(At, 0, 0); PG8_STAGE(PG8_SA(1, 1), a1 + hstep, voffA);
            PG8_WAIT_V(8); PG8_WAIT_L(0); PG8_BAR; PG8_MMA(0, 0, At, B0); PG8_MMA(0, 1, At, B1); PG8_BAR; PG8_SCHED;
            PG8_LDA(At, 0, 1); PG8_STAGE(PG8_SB(0, 0), b2, voffB); PG8_STAGE(PG8_SB(0, 1), b2 + hstep, voffB); PG8_STAGE(PG8_SA(0, 0), a2, voffA);
            PG8_WAIT_V(8); PG8_WAIT_L(0); PG8_BAR; PG8_MMA(1, 0, At, B0); PG8_MMA(1, 1, At, B1); PG8_BAR; PG8_SCHED;
            PG8_LDB(B0, 1, 0); PG8_LDB(B1, 1, 1); PG8_SCHED; PG8_LDA(At, 1, 0); PG8_STAGE(PG8_SA(0, 1), a2 + hstep, voffA);
            PG8_WAIT_V(8); PG8_WAIT_L(0); PG8_BAR; PG8_MMA(0, 0, At, B0); PG8_MMA(0, 1, At, B1); PG8_BAR; PG8_SCHED;
            PG8_LDA(At, 1, 1); PG8_STAGE(PG8_SB(1, 0), b3, voffB); PG8_STAGE(PG8_SB(1, 1), b3 + hstep, voffB); PG8_STAGE(PG8_SA(1, 0), a3, voffA);
            PG8_WAIT_V(8); PG8_WAIT_L(0); PG8_BAR; PG8_MMA(1, 0, At, B0); PG8_MMA(1, 1, At, B1); PG8_BAR; PG8_SCHED;
            } else {
            PG8_LDB(B0, 0, 0); PG8_SCHED; PG8_LDA(At, 0, 0); PG8_STAGE(PG8_SA(1, 1), a1 + hstep, voffA);
            PG8_WAIT_L(8); PG8_BAR; PG8_WAIT_L(0); PG8_MMA(0, 0, At, B0); PG8_BAR; PG8_SCHED;
            PG8_LDB(B1, 0, 1); PG8_STAGE(PG8_SB(0, 0), b2, voffB);
            PG8_BAR; PG8_WAIT_L(0); PG8_MMA(0, 1, At, B1); PG8_BAR;
            PG8_LDA(At, 0, 1); PG8_STAGE(PG8_SA(0, 0), a2, voffA);
            PG8_BAR; PG8_WAIT_L(0); PG8_MMA(1, 0, At, B0); PG8_BAR; PG8_SCHED;
            PG8_STAGE(PG8_SB(0, 1), b2 + hstep, voffB);
            PG8_WAIT_V(6); PG8_BAR; PG8_MMA(1, 1, At, B1); PG8_BAR;
            PG8_LDB(B0, 1, 0); PG8_SCHED; PG8_LDA(At, 1, 0); PG8_STAGE(PG8_SA(0, 1), a2 + hstep, voffA);
            PG8_WAIT_L(8); PG8_BAR; PG8_WAIT_L(0); PG8_MMA(0, 0, At, B0); PG8_BAR; PG8_SCHED;
            PG8_LDB(B1, 1, 1); PG8_STAGE(PG8_SB(1, 0), b3, voffB);
            PG8_BAR; PG8_WAIT_L(0); PG8_MMA(0, 1, At, B1); PG8_BAR;
            PG8_LDA(At, 1, 1); PG8_STAGE(PG8_SA(1, 0), a3, voffA);
            PG8_BAR; PG8_WAIT_L(0); PG8_MMA(1, 0, At, B0); PG8_BAR; PG8_SCHED;
            PG8_STAGE(PG8_SB(1, 1), b3 + hstep, voffB);
            PG8_WAIT_V(6); PG8_BAR; PG8_MMA(1, 1, At, B1); PG8_BAR;
            }
        }
        if constexpr (ALIGN_EPI) { if (wr == 0) PG8_BAR; }
        if constexpr (Epi::PREF) { if (has_next) E.prefetch(nxt, (ui + 1) & 1, lds, wid, lane); E.run(acc, cur, wr, wc, fr, fq, lds, ui & 1); S.done(cur); }
        else if constexpr (!Epi::AFTER_DRAIN) { E(acc, cur, wr, wc, fr, fq); S.done(cur); }
        if (!has_next) break;
#pragma unroll
        for (int a = 0; a < 2; ++a)
#pragma unroll
            for (int b = 0; b < 2; ++b)
#pragma unroll
                for (int m = 0; m < 4; ++m)
#pragma unroll
                    for (int n = 0; n < 2; ++n) acc[a][b][m][n] = (f32x4){0.f, 0.f, 0.f, 0.f};
        cur = nxt; cA = nA; cB = nB; ++ui;
        if constexpr (ALIGN_EPI) { if (wr == 1) PG8_BAR; }
    }
    PG8_WAIT_V(0);
    if constexpr (!ALIGN_EPI) { if (wr == 0) PG8_BAR; }
    PG8_BAR;
    if constexpr (Epi::AFTER_DRAIN) { E.fused(acc, cur, wr, wc, fr, fq, lds, wid, lane); S.done(cur); }
#undef PG8_SA
#undef PG8_SB
#undef PG8_STAGE
#undef PG8_LDA
#undef PG8_LDB
#undef PG8_MMA
#undef PG8_WAIT_V
#undef PG8_WAIT_L
#undef PG8_BAR
#undef PG8_SCHED
}
}

#define XB_TMO      128
#define XB_XCNT(j)  (256  + 64 * (j))
#define XB_XSUB(j)  (1280 + 64 * (j))
#define XB_XGEN(j)  (2304 + 64 * (j))
#define XB_TOP      3328
#define XB_TOPGEN   3392
#define XCD_BAR_WORDS 3456
#define XB_SPIN_CAP (1u << 18)

__device__ __forceinline__ unsigned xb_ld(unsigned* p)              { return __hip_atomic_load(p, __ATOMIC_RELAXED, __HIP_MEMORY_SCOPE_AGENT); }
__device__ __forceinline__ unsigned xb_add(unsigned* p, unsigned v) { return __hip_atomic_fetch_add(p, v, __ATOMIC_RELAXED, __HIP_MEMORY_SCOPE_AGENT); }
__device__ __forceinline__ unsigned xb_xcc_id() { return (unsigned)__builtin_amdgcn_s_getreg((3 << 11) | 20) & 0xFu; }
#define XB_SPIN(cond, bar) do { unsigned _sp = 0; while (cond) { __builtin_amdgcn_s_sleep(1); \
    if ((++_sp & 255u) == 0u) { if (xb_ld(&(bar)[XB_TMO])) break; if (_sp > XB_SPIN_CAP) { atomicAdd(&(bar)[XB_TMO], 1u); break; } } } } while (0)

struct XcdBarrier {
    unsigned* bar; unsigned x;
    volatile LAS unsigned* st;
};

__device__ __forceinline__ XcdBarrier xcd_barrier_post(unsigned* bar, volatile LAS unsigned* st) {
    XcdBarrier b; b.bar = bar; b.x = xb_xcc_id(); b.st = st;
    if (threadIdx.x == 0) (void)xb_add(&bar[XB_XCNT(b.x)], 1u);
    return b;
}
__device__ __forceinline__ void xcd_barrier_complete(unsigned* bar, unsigned x, unsigned& nloc, unsigned& nx) {
    const unsigned G = gridDim.x * gridDim.y * gridDim.z;
    unsigned sum, cnt, mine, sp = 0u;
    for (;;) {
        sum = 0u; cnt = 0u; mine = 0u;
#pragma unroll
        for (unsigned j = 0; j < 16; ++j) { const unsigned c = xb_ld(&bar[XB_XCNT(j)]); sum += c; cnt += (c > 0u) ? 1u : 0u; mine = (j == x) ? c : mine; }
        if (sum == G) break;
        __builtin_amdgcn_s_sleep(1);
        if ((++sp & 255u) == 0u) { if (xb_ld(&bar[XB_TMO])) break; if (sp > XB_SPIN_CAP) { atomicAdd(&bar[XB_TMO], 1u); break; } }
    }
    nloc = mine > 0u ? mine : 1u; nx = cnt > 0u ? cnt : 1u;
}

__device__ __forceinline__ void xcd_barrier(const XcdBarrier& b, const bool leader) {
    asm volatile("s_waitcnt vmcnt(0)" ::: "memory");
    __syncthreads();
    if (leader) {
        unsigned* bar = b.bar;
        __builtin_amdgcn_s_waitcnt(0);
        unsigned nloc = b.st[0], nx = b.st[1];
        if (nloc == 0u) { xcd_barrier_complete(bar, b.x, nloc, nx); b.st[0] = nloc; b.st[1] = nx; }
        const unsigned old = xb_add(&bar[XB_XSUB(b.x)], 1u);
        const unsigned gen = old / nloc;
        if (old + 1u == (gen + 1u) * nloc) {
            __builtin_amdgcn_fence(__ATOMIC_RELEASE, "agent");
            asm volatile("s_waitcnt vmcnt(0)" ::: "memory");
            const unsigned og = xb_add(&bar[XB_TOP], 1u);
            const unsigned tg = og / nx;
            if (og + 1u == (tg + 1u) * nx) xb_add(&bar[XB_TOPGEN], 1u);
            else XB_SPIN(xb_ld(&bar[XB_TOPGEN]) == tg, bar);
            __builtin_amdgcn_fence(__ATOMIC_ACQUIRE, "agent");
            xb_add(&bar[XB_XGEN(b.x)], 1u);
            asm volatile("s_waitcnt vmcnt(0)" ::: "memory");
        } else {
            XB_SPIN(xb_ld(&bar[XB_XGEN(b.x)]) == gen, bar);
            __builtin_amdgcn_fence(__ATOMIC_ACQUIRE, "agent");
            asm volatile("s_waitcnt vmcnt(0)" ::: "memory");
        }
    }
    __syncthreads();
}


constexpr size_t MiB = 1u << 20;
constexpr size_t WS_CTL = 0, CTL_ZERO_BYTES = 1 * MiB;
constexpr size_t WS_MOD = 1 * MiB;
constexpr size_t WS_H2F = 4 * MiB;
constexpr size_t WS_KF = 8 * MiB;
constexpr size_t WS_WIN = 136 * MiB;
constexpr size_t WS_WUP = 320 * MiB;
constexpr size_t WS_WDN = 496 * MiB;
constexpr size_t WS_WOUT = 584 * MiB;
constexpr size_t WS_WBH = 616 * MiB;
constexpr size_t WS_HB = 640 * MiB;
constexpr size_t WS_YHT = 704 * MiB;
constexpr size_t WS_YH = 736 * MiB;
constexpr size_t WS_MB = 784 * MiB;
constexpr size_t WS_ACT = 1522 * MiB;
constexpr size_t WS_UT = 848 * MiB;
constexpr size_t WS_VT = 944 * MiB;
constexpr size_t WS_QKG = 992 * MiB;
constexpr size_t WS_OG = 1216 * MiB;
constexpr size_t WS_LSE = 1264 * MiB;
constexpr size_t WS_GB = 848 * MiB;
constexpr size_t WS_HB2 = 1266 * MiB;
constexpr size_t WS_XB = 1330 * MiB;
constexpr size_t WS_PART = 1698 * MiB;
constexpr size_t WS_END = 1699 * MiB;
constexpr int CW_BAR = 4096, CW_PANEL = 131072  , CW_TMO = CW_PANEL + 64 * 64;
constexpr int LDS_BYTES = 155648, MISC_OFF = 139264; static_assert(pg8::EPI_LDS_OFF == MISC_OFF + 1024 && pg8::EPI_LDS_OFF + 13312 + 64 <= LDS_BYTES, "epilogue vector buffers + row-sum exchange tables");
constexpr int N_PHASES = 1 + DEPTH_ * 2 + 1 + DEPTH_ * NCHUNK * 7 + 1 + 1;

#ifndef PG8_ALIGN
#define PG8_ALIGN true
#endif
struct Args { const float* in[29]; float* out; unsigned char* ws; int ph_lo, ph_hi; };

using pg8::bflo; using pg8::bfhi;
__device__ __forceinline__ float wave_sum(float v, int lane) {
#pragma unroll
    for (int o = 1; o < 64; o <<= 1) v += shfl_from(v, lane ^ o);
    return v;
}
__device__ __forceinline__ void transpose_item(const float* W, int K, int N, bf16_t* WT, int k0, int n0, int drow0, LAS float* scr, int lane) {
#pragma unroll 8
    for (int i = 0; i < 32; ++i) { const int kk = 2 * i + (lane >> 5); scr[kk * 33 + (lane & 31)] = W[(size_t)(k0 + kk) * N + n0 + (lane & 31)]; }
    asm volatile("s_waitcnt lgkmcnt(0)" ::: "memory");
    const int c = lane & 7;
#pragma unroll
    for (int j = 0; j < 4; ++j) { const int n = (lane >> 3) + 8 * j; const LAS float* s = scr + (8 * c) * 33 + n;
        u32x4 o; o.x = pk2(s[0 * 33], s[1 * 33]); o.y = pk2(s[2 * 33], s[3 * 33]); o.z = pk2(s[4 * 33], s[5 * 33]); o.w = pk2(s[6 * 33], s[7 * 33]);
        *(u32x4*)(WT + (size_t)(drow0 + n) * K + k0 + 8 * c) = o; }
    asm volatile("s_waitcnt lgkmcnt(0)" ::: "memory");
}
__device__ __forceinline__ int win_dest_row(int n0) {
    if (n0 < 3072) return n0;
    if (n0 < 4608) return n0 + 1536;
    if (n0 < 6144) return n0 + 1536;
    if (n0 < 7680) return n0 - 3072;
    const int g = n0 - 7680, c = g & 2047;
    return 7680 + (c >> 7) * 256 + (g >> 11) * 128 + (c & 127);
}
__device__ __forceinline__ int wup_dest_row(int n0) {
    const int j = (n0 < 5632) ? n0 : n0 - 5632; return (j >> 7) * 256 + ((n0 < 5632) ? 0 : 128) + (j & 127);
}
__device__ __forceinline__ void prologue_phase(const __attribute__((address_space(4))) Args* Ap, LAS unsigned char* lds, int vcu, int G, int tid) {
    const int lane = tid & 63, wave = tid >> 6;
    unsigned char* ws = Ap->ws;
    {
        LAS float* scr = (LAS float*)(lds + wave * 16384);
        const int gw = vcu * 8 + wave, NGW = G * 8;
        constexpr int I_IN = 32 * 368, I_UP = 32 * 352, I_DN = 88 * 64, I_OUT = 32 * 64, I_BH = 16 * 64, I_BA = 8 * 64, I_L = I_IN + I_UP + I_DN + I_OUT + I_BH + I_BA;
        for (int it = gw; it < DEPTH_ * I_L; it += NGW) {
            const int l = it / I_L; int r = it % I_L;
            if (r < I_IN) { const int kb = r / 368, nb = r % 368; transpose_item(Ap->in[7] + (size_t)l * 2048 * 11776, 2048, 11776, (bf16_t*)(ws + WS_WIN) + (size_t)l * 11776 * 2048, 64 * kb, 32 * nb, win_dest_row(32 * nb), scr, lane); continue; } r -= I_IN;
            if (r < I_UP) { const int kb = r / 352, nb = r % 352; transpose_item(Ap->in[24] + (size_t)l * 2048 * 11264, 2048, 11264, (bf16_t*)(ws + WS_WUP) + (size_t)l * 11264 * 2048, 64 * kb, 32 * nb, wup_dest_row(32 * nb), scr, lane); continue; } r -= I_UP;
            if (r < I_DN) { const int kb = r / 64, nb = r % 64; transpose_item(Ap->in[27] + (size_t)l * 5632 * 2048, 5632, 2048, (bf16_t*)(ws + WS_WDN) + (size_t)l * 2048 * 5632, 64 * kb, 32 * nb, 32 * nb, scr, lane); continue; } r -= I_DN;
            if (r < I_OUT) { const int kb = r / 64, nb = r % 64; transpose_item(Ap->in[22] + (size_t)l * 2048 * 2048, 2048, 2048, (bf16_t*)(ws + WS_WOUT) + (size_t)l * 2048 * 2048, 64 * kb, 32 * nb, 32 * nb, scr, lane); continue; } r -= I_OUT;
            if (r < I_BH) { const int kb = r / 64, nb = r % 64; transpose_item(Ap->in[20] + (size_t)l * 1024 * 2048, 1536, 2048, (bf16_t*)(ws + WS_WBH) + (size_t)l * 2048 * 1536, 64 * kb, 32 * nb, 32 * nb, scr, lane); continue; } r -= I_BH;
            { const int kb = r / 64, nb = r % 64; transpose_item(Ap->in[21] + (size_t)l * 512 * 2048, 1536, 2048, (bf16_t*)(ws + WS_WBH) + (size_t)l * 2048 * 1536 + 1024, 64 * kb, 32 * nb, 32 * nb, scr, lane); }
        }
    }
    __syncthreads();
    {
        LAS float* cs = (LAS float*)lds;
        LAS float* red = (LAS float*)(lds + 98304);
        bool loaded = false;
        for (int unit = vcu; unit < DEPTH_ * 192; unit += G) {
            if (!loaded) {
                for (int i = tid; i < 12 * 2048; i += NTHR) { const int b = i >> 11, k = i & 2047; const float c = (b < 4) ? Ap->in[2][b * 2048 + k] : Ap->in[3][(b - 4) * 2048 + k]; cs[i] = c / (1.0f + __expf(-c)); }
                loaded = true; __syncthreads();
            }
            const int l = unit / 192, j = (unit % 192) * 64 + lane;
            const float* wp = Ap->in[4] + ((size_t)l * 2048 + wave * 256) * 12288 + j;
            float acc[12];
#pragma unroll
            for (int b = 0; b < 12; ++b) acc[b] = 0.f;
#pragma unroll 4
            for (int k = 0; k < 256; ++k) { const float w = wp[(size_t)k * 12288];
#pragma unroll
                for (int b = 0; b < 12; ++b) acc[b] += w * cs[b * 2048 + wave * 256 + k]; }
#pragma unroll
            for (int b = 0; b < 12; ++b) red[(wave * 12 + b) * 64 + lane] = acc[b];
            __syncthreads();
            for (int i = tid; i < 12 * 64; i += NTHR) { const int b = i >> 6, jj = i & 63; float s = 0.f;
#pragma unroll
                for (int w = 0; w < 8; ++w) s += red[(w * 12 + b) * 64 + jj];
                const int col = (unit % 192) * 64 + jj;
                ((float*)(ws + WS_MOD))[((size_t)l * 12 + b) * 12288 + col] = s + Ap->in[5][l * 12288 + col]; }
            __syncthreads();
        }
    }
}
template <bool XBF> __device__ __forceinline__ void norm_phase(const void* xv, bf16_t* hout, const float* gn, const float* modb  , int sh_off, int sc_off, int gw, int NGW, int lane, bf16_t* xcopy = nullptr  ) {
    int curb = -1; f32x4 gs[8], sh[8];
    for (int row = gw; row < MROWS; row += NGW) {
        const int b = row >> 12;
        if (b != curb) { curb = b;
#pragma unroll
            for (int j = 0; j < 8; ++j) { const int col = 4 * lane + 256 * j; const f32x4 g = *(const f32x4*)(gn + col), sc = *(const f32x4*)(modb + (size_t)b * 12288 + sc_off + col);
                gs[j] = g * (sc + 1.0f); sh[j] = *(const f32x4*)(modb + (size_t)b * 12288 + sh_off + col); } }
        f32x4 v[8]; float ss = 0.f;
        if constexpr (XBF) {
            const u32x2* xr = (const u32x2*)((const bf16_t*)xv + (size_t)row * 2048) + lane; u32x2 r[8];
#pragma unroll
            for (int j = 0; j < 8; ++j) r[j] = xr[64 * j];
#pragma unroll
            for (int j = 0; j < 8; ++j) { v[j].x = hlo(r[j].x); v[j].y = hhi(r[j].x); v[j].z = hlo(r[j].y); v[j].w = hhi(r[j].y); }
        } else {
            const f32x4* xr = (const f32x4*)((const float*)xv + (size_t)row * 2048) + lane;
#pragma unroll
            for (int j = 0; j < 8; ++j) v[j] = xr[64 * j];
            if (xcopy) { u32x2* c8 = (u32x2*)(xcopy + (size_t)row * 2048) + lane;
#pragma unroll
                for (int j = 0; j < 8; ++j) { u32x2 w; w.x = pkh2(v[j].x, v[j].y); w.y = pkh2(v[j].z, v[j].w); c8[64 * j] = w; } }
        }
#pragma unroll
        for (int j = 0; j < 8; ++j) ss += (v[j].x * v[j].x + v[j].y * v[j].y) + (v[j].z * v[j].z + v[j].w * v[j].w);
        const float rstd = 1.0f / sqrtf(wave_sum(ss, lane) * (1.0f / 2048.0f) + 1e-6f);
        u32x2* o8 = (u32x2*)(hout + (size_t)row * 2048) + lane;
#pragma unroll
        for (int j = 0; j < 8; ++j) { const f32x4 y = v[j] * rstd * gs[j] + sh[j]; u32x2 w; w.x = pk2(y.x, y.y); w.y = pk2(y.z, y.w); o8[64 * j] = w; }
    }
}
__device__ __forceinline__ void final_norm_phase(const bf16_t* xb, float* out, const float* gn, int gw, int NGW, int lane) {
    f32x4 gs[8];
#pragma unroll
    for (int j = 0; j < 8; ++j) gs[j] = *(const f32x4*)(gn + 4 * lane + 256 * j);
    for (int row = gw; row < NSEQ * SEQ; row += NGW) {
        const u32x2* xr = (const u32x2*)(xb + (size_t)row * 2048) + lane; u32x2 r[8];
#pragma unroll
        for (int j = 0; j < 8; ++j) r[j] = xr[64 * j];
        f32x4 v[8]; float ss = 0.f;
#pragma unroll
        for (int j = 0; j < 8; ++j) { v[j].x = hlo(r[j].x); v[j].y = hhi(r[j].x); v[j].z = hlo(r[j].y); v[j].w = hhi(r[j].y);
            ss += (v[j].x * v[j].x + v[j].y * v[j].y) + (v[j].z * v[j].z + v[j].w * v[j].w); }
        const float rstd = 1.0f / sqrtf(wave_sum(ss, lane) * (1.0f / 2048.0f) + 1e-6f);
        f32x4* o = (f32x4*)(out + (size_t)row * 2048) + lane;
#pragma unroll
        for (int j = 0; j < 8; ++j) o[64 * j] = v[j] * rstd * gs[j];
    }
}
__device__ __forceinline__ void transpose_yh_tile(int tile, const bf16_t* YHT, bf16_t* YH, LAS bf16_t* scr, int lane) {
    const int b = tile >> 10, ct = (tile >> 6) & 15, tt = tile & 63, c0 = ct * 64, t0 = tt * 64;
#pragma unroll
    for (int i = 0; i < 8; ++i) { const int row = (lane >> 3) + 8 * i, ch = lane & 7;
        const u32x4 v = *(const u32x4*)(YHT + ((size_t)(b * 1024 + c0 + row)) * 4096 + t0 + 8 * ch);
        LAS bf16_t* d = scr + row * 66 + 8 * ch;
        d[0] = (bf16_t)(v.x & 0xffffu); d[1] = (bf16_t)(v.x >> 16); d[2] = (bf16_t)(v.y & 0xffffu); d[3] = (bf16_t)(v.y >> 16);
        d[4] = (bf16_t)(v.z & 0xffffu); d[5] = (bf16_t)(v.z >> 16); d[6] = (bf16_t)(v.w & 0xffffu); d[7] = (bf16_t)(v.w >> 16); }
    asm volatile("s_waitcnt lgkmcnt(0)" ::: "memory");
#pragma unroll
    for (int i = 0; i < 8; ++i) { const int r = (lane >> 3) + 8 * i, ch = lane & 7; u32x4 w; unsigned q[4];
#pragma unroll
        for (int e = 0; e < 4; ++e) q[e] = (unsigned)scr[(8 * ch + 2 * e) * 66 + r] | ((unsigned)scr[(8 * ch + 2 * e + 1) * 66 + r] << 16);
        w.x = q[0]; w.y = q[1]; w.z = q[2]; w.w = q[3]; *(u32x4*)(YH + ((size_t)(b * 4096 + t0 + r)) * 1536 + c0 + 8 * ch) = w; }
    asm volatile("s_waitcnt lgkmcnt(0)" ::: "memory");
}
__device__ __forceinline__ void cg_fix_item(int idx, bf16_t* ACT, const bf16_t* GB, const float* cw, const float* cb) {
    const int col = (idx % 704) * 8, rs = idx / 704, side = rs & 1, grp = rs >> 1, row = grp * 64 + (side ? 63 : 0), t = row & 4095;
    const bf16_t* gb = GB + (size_t)grp * 4 * 5632 + col;
    u32x4 gm = (u32x4){0u, 0u, 0u, 0u}, gp = (u32x4){0u, 0u, 0u, 0u}, g0;
    if (side == 0) { g0 = *(const u32x4*)gb; gp = *(const u32x4*)(gb + 5632); if (t > 0) gm = *(const u32x4*)(gb - 5632); }
    else { gm = *(const u32x4*)(gb + 2 * 5632); g0 = *(const u32x4*)(gb + 3 * 5632); if (t < 4095) gp = *(const u32x4*)(gb + 4 * 5632); }
    bf16_t* ap = ACT + (size_t)row * 5632 + col;
    const u32x4 a = *(const u32x4*)ap;
    const f32x4 w0a = *(const f32x4*)(cw + col), w0b = *(const f32x4*)(cw + col + 4), w1a = *(const f32x4*)(cw + 5632 + col), w1b = *(const f32x4*)(cw + 5632 + col + 4);
    const f32x4 w2a = *(const f32x4*)(cw + 11264 + col), w2b = *(const f32x4*)(cw + 11264 + col + 4), ba = *(const f32x4*)(cb + col), bb = *(const f32x4*)(cb + col + 4);
    float w0[8] = {w0a.x, w0a.y, w0a.z, w0a.w, w0b.x, w0b.y, w0b.z, w0b.w}, w1[8] = {w1a.x, w1a.y, w1a.z, w1a.w, w1b.x, w1b.y, w1b.z, w1b.w};
    float w2[8] = {w2a.x, w2a.y, w2a.z, w2a.w, w2b.x, w2b.y, w2b.z, w2b.w}, bs[8] = {ba.x, ba.y, ba.z, ba.w, bb.x, bb.y, bb.z, bb.w};
    u32x4 o;
#pragma unroll
    for (int i = 0; i < 4; ++i) {
        const float xl = bflo(gm[i]) * w0[2 * i] + bflo(g0[i]) * w1[2 * i] + bflo(gp[i]) * w2[2 * i] + bs[2 * i];
        const float xh = bfhi(gm[i]) * w0[2 * i + 1] + bfhi(g0[i]) * w1[2 * i + 1] + bfhi(gp[i]) * w2[2 * i + 1] + bs[2 * i + 1];
        const float sl = xl / (1.0f + __expf(-xl)), shh = xh / (1.0f + __expf(-xh));
        o[i] = pk2(sl * bflo(a[i]), shh * bfhi(a[i]));
    }
    *(u32x4*)ap = o;
}

typedef const __attribute__((address_space(4))) Args* kargs_t;
__global__ void __launch_bounds__(512, 2) mega_fwd(Args args) {
    extern __shared__ __attribute__((aligned(16))) unsigned char lds_raw[];
    LAS unsigned char* lds = (LAS unsigned char*)lds_raw;
    const int G = gridDim.x, bx = blockIdx.x, vcu = (G % 8 == 0) ? (bx % 8) * (G / 8) + bx / 8 : bx, NGW = G * 8;
    const int lo = args.ph_lo, hi = args.ph_hi;
    const int wave_s = __builtin_amdgcn_readfirstlane(threadIdx.x >> 6);
    {
        volatile LAS unsigned* MISC = (volatile LAS unsigned*)(lds + MISC_OFF);
        for (int u = threadIdx.x; u < (LDS_BYTES - MISC_OFF) / 4; u += NTHR) MISC[u] = 0u;
        __syncthreads();
    }
    XcdBarrier bar; bar.bar = (unsigned*)(args.ws + WS_CTL) + CW_BAR; bar.x = 0; bar.st = nullptr;
    if (hi - lo > 1) bar = xcd_barrier_post((unsigned*)(args.ws + WS_CTL) + CW_BAR, (volatile LAS unsigned*)(lds + MISC_OFF) + 8);
#ifndef NOBAR_PASSES
#define NOBAR_PASSES 0
#endif
    int pc = 0;
#define IS_T0() ({ int t0_; asm volatile("v_mbcnt_lo_u32_b32 %0, -1, 0\n\tv_mbcnt_hi_u32_b32 %0, -1, %0" : "=v"(t0_)); (t0_ | wave_s) == 0; })
#define PH_IN (pc >= lo && pc < hi)
#define PH_CTX int ptid; asm volatile("v_mbcnt_lo_u32_b32 %0, -1, 0\n\tv_mbcnt_hi_u32_b32 %0, -1, %0" : "=v"(ptid)); ptid |= (wave_s << 6); const int plane = ptid & 63, pwave = __builtin_amdgcn_readfirstlane(ptid >> 6), pgw = vcu * 8 + pwave; (void)plane; (void)pgw; \
    kargs_t ap = (kargs_t)__builtin_amdgcn_kernarg_segment_ptr(); asm volatile("" : "+s"(ap)); unsigned char* const pws = ap->ws; (void)pws; int pl = l, pch = ch; asm volatile("" : "+s"(pl), "+s"(pch)); (void)pl; (void)pch;
#ifndef DUP_MASK
#define DUP_MASK 0
#endif
#ifndef DUP_REP
#define DUP_REP 2
#endif
#ifndef DUP_BAR
#define DUP_BAR 0
#endif
#define DUP(bit) for (int rep_ = 0; rep_ < (((DUP_MASK) & (bit)) ? (DUP_REP) : 1); (void)(((DUP_BAR) && ((DUP_MASK) & (bit)) && rep_ + 1 < (DUP_REP)) ? (xcd_barrier(bar, IS_T0()), 0) : 0), ++rep_)
#ifndef BAR_REP
#define BAR_REP 1
#endif
#define PH_END do { if (pc >= lo && pc + 1 < hi && pass_ == (NOBAR_PASSES)) { for (int br_ = 0; br_ < (BAR_REP); ++br_) xcd_barrier(bar, IS_T0()); } ++pc; } while (0)
#define WSP(T, off) ((T*)(pws + (off)))
#define XO_PTR (WSP(bf16_t, WS_XB) + (size_t)pch * MROWS * 2048)
#define XIN0_PTR ((pch == 0) ? ap->in[0] : ap->in[1] + (size_t)(pch - 1) * MROWS * 2048)
#define MODB_PTR (WSP(const float, WS_MOD) + ((size_t)pl * 12 + pch * 4) * 12288)
#define HB_CUR (((pl * NCHUNK + pch) & 1) ? WSP(bf16_t, WS_HB2) : WSP(bf16_t, WS_HB))

    for (int pass_ = 0; pass_ <= (NOBAR_PASSES); ++pass_) {
    pc = 0;
    if (pass_ > 0 && pass_ == (NOBAR_PASSES)) xcd_barrier(bar, IS_T0());
    { const int l = 0, ch = 0; if (PH_IN) DUP(512) { PH_CTX prologue_phase(ap, lds, vcu, G, ptid); __syncthreads(); } }
    PH_END;
    for (int l = 0; l < DEPTH_; ++l) {
        { const int ch = 0;
          if (PH_IN) DUP(1024) { PH_CTX int pvcu = vcu; asm volatile("" : "+s"(pvcu)); for (int u = pvcu; u < 512; u += G) filt_hidden_unit(u, ap->in[11] + pl * 33 * 64, ap->in[12] + pl * 64, ap->in[13] + pl * 64, ap->in[14] + pl * 64 * 64, ap->in[15] + pl * 64, ap->in[16] + pl * 64, nullptr, WSP(bf16_t, WS_H2F), (LAS float*)lds, ptid); }
          PH_END;
          if (PH_IN) DUP(2048) { PH_CTX int pvcu = vcu; asm volatile("" : "+s"(pvcu)); for (int c2 = pvcu; c2 < 512; c2 += G) filt_channel_unit2(2 * c2, WSP(const bf16_t, WS_H2F), ap->in[17] + (size_t)pl * 64 * 4096, WSP(unsigned, WS_KF), lds, ptid); }
          PH_END; }
        for (int ch = 0; ch < NCHUNK; ++ch) {
            if (l == 0 && ch == 0) {
                if (PH_IN) { PH_CTX norm_phase<false>(XIN0_PTR, WSP(bf16_t, WS_HB), ap->in[6], MODB_PTR, 0, 2048, pgw, NGW, plane, XO_PTR); }
                PH_END;
            }
            if (PH_IN) DUP(2) {
                { PH_CTX const bf16_t* Win = WSP(const bf16_t, WS_WIN) + (size_t)pl * 11776 * 2048;
                  pg8::Gemm g{Win, HB_CUR, 3584, MROWS, 2048}; pg8::StaticOrder S; S.init(3584, MROWS, G, bx); pg8::EpiG1a<0> E{WSP(bf16_t, WS_UT), WSP(bf16_t, WS_VT)};
                  pg8::gemm_phase<pg8::EpiG1a<0>, pg8::StaticOrder, PG8_ALIGN, true>(lds, g, S, E, ptid); }
                { PH_CTX const bf16_t* Win = WSP(const bf16_t, WS_WIN) + (size_t)pl * 11776 * 2048 + (size_t)3584 * 2048;
                  pg8::Gemm g{Win, HB_CUR, 512, MROWS, 2048}; pg8::StaticOrder S; S.init(512, MROWS, G, (bx + G / 2) % G); pg8::EpiG1a<1> E{WSP(bf16_t, WS_UT), WSP(bf16_t, WS_VT)};
                  pg8::gemm_phase<pg8::EpiG1a<1>, pg8::StaticOrder, PG8_ALIGN, true>(lds, g, S, E, ptid); }
                { PH_CTX const bf16_t* Win = WSP(const bf16_t, WS_WIN) + (size_t)pl * 11776 * 2048 + (size_t)4096 * 2048;
                  pg8::Gemm g{Win, HB_CUR, 512, MROWS, 2048}; pg8::StaticOrder S; S.init(512, MROWS, G, bx); pg8::EpiG1a<2> E{WSP(bf16_t, WS_UT), WSP(bf16_t, WS_VT)};
                  pg8::gemm_phase<pg8::EpiG1a<2>, pg8::StaticOrder, PG8_ALIGN, true>(lds, g, S, E, ptid); }
                { PH_CTX const bf16_t* Win = WSP(const bf16_t, WS_WIN) + (size_t)pl * 11776 * 2048;
                  pg8::Gemm g{HB_CUR, Win + (size_t)NA_ * 2048, MROWS, NB_, 2048}; pg8::StaticOrder S; S.init(MROWS, NB_, G, bx); pg8::EpiG1b E{WSP(bf16_t, WS_QKG), ap->in[8] + pl * 4096};
                  pg8::gemm_phase<pg8::EpiG1b, pg8::StaticOrder, PG8_ALIGN, true>(lds, g, S, E, ptid); }
                if (l * NCHUNK + ch + 1 < DEPTH_ * NCHUNK) {
                    PH_CTX
                    const int itn = pl * NCHUNK + pch + 1, ln = itn / NCHUNK, chn = itn % NCHUNK;
                    const bool split = (G == 256);
                    if (!split || bx >= 128) {
                        const int lw = (split ? bx - 128 : bx) * 8 + pwave, nlw = (split ? 128 : G) * 8;
                        bf16_t* hn = (itn & 1) ? WSP(bf16_t, WS_HB2) : WSP(bf16_t, WS_HB); const float* mb = WSP(const float, WS_MOD) + ((size_t)ln * 12 + chn * 4) * 12288;
                        if (ln == 0) norm_phase<false>((chn == 0) ? ap->in[0] : ap->in[1] + (size_t)(chn - 1) * MROWS * 2048, hn, ap->in[6] + ln * 2048, mb, 0, 2048, lw, nlw, plane, WSP(bf16_t, WS_XB) + (size_t)chn * MROWS * 2048);
                        else norm_phase<true>(WSP(bf16_t, WS_XB) + (size_t)chn * MROWS * 2048, hn, ap->in[6] + ln * 2048, mb, 0, 2048, lw, nlw, plane);
                    }
                }
            }
            PH_END;
            if (PH_IN) {
                DUP(4) { PH_CTX
                  hyena_units(vcu, G, WSP(const bf16_t, WS_UT), WSP(bf16_t, WS_YHT), WSP(const unsigned, WS_KF), ap->in[9] + pl * 3 * 3072, ap->in[10] + pl * 3072, ap->in[18] + pl * 2048, lds, ptid, rep_ < (DUP_REP) - 1 && ((DUP_MASK) & 4));
                  __syncthreads(); }
                DUP(8) { PH_CTX
                  attn_bias_table((LAS float*)(lds + AT_TAB_OFF), ap->in[19], ptid);
                  attn_units(vcu, G, 4 * 24 * 16, WSP(const bf16_t, WS_QKG), WSP(const bf16_t, WS_VT), WSP(bf16_t, WS_OG), WSP(float, WS_LSE), lds, ptid);
                  __syncthreads(); }
            }
            PH_END;
            if (PH_IN) DUP(16) {
                PH_CTX
                for (int tile = pgw; tile < 4096; tile += NGW) transpose_yh_tile(tile, WSP(const bf16_t, WS_YHT), WSP(bf16_t, WS_YH), (LAS bf16_t*)(lds + pwave * 8448), plane);
                for (int it = bx * NTHR + ptid; it < MROWS * 64; it += G * NTHR) attn_combine_item(it, WSP(const bf16_t, WS_OG), WSP(const float, WS_LSE), WSP(bf16_t, WS_YH), 1536, 1024);
                __syncthreads();
            }
            PH_END;
            if (PH_IN) DUP(32) { PH_CTX pg8::Gemm g{WSP(const bf16_t, WS_YH), WSP(const bf16_t, WS_WBH) + (size_t)pl * 2048 * 1536, MROWS, 2048, 1536}; pg8::StaticOrder S; S.init(MROWS, 2048, G, bx);
                pg8::EpiG2M E{WSP(const bf16_t, WS_QKG), WSP(bf16_t, WS_MB)};
                pg8::gemm_phase<pg8::EpiG2M, pg8::StaticOrder, PG8_ALIGN, true>(lds, g, S, E, ptid); }
            PH_END;
            if (PH_IN) { PH_CTX pg8::Gemm g{WSP(const bf16_t, WS_MB), WSP(const bf16_t, WS_WOUT) + (size_t)pl * 2048 * 2048, MROWS, 2048, 2048};
                pg8::PanelOrder S; S.init(MROWS, 2048, G, bx);
                pg8::EpiResN<false> E{nullptr, XO_PTR, XO_PTR, HB_CUR, MODB_PTR, ap->in[23] + pl * 2048, 2 * 2048, WSP(float, WS_PART), (unsigned*)(pws + WS_CTL) + CW_PANEL, 32u * (unsigned)(pl * NCHUNK + pch + 1), (unsigned*)(pws + WS_CTL) + CW_TMO};
                pg8::gemm_phase<pg8::EpiResN<false>, pg8::PanelOrder, PG8_ALIGN, true>(lds, g, S, E, ptid); }
            PH_END;
            if (PH_IN) DUP(128) { PH_CTX pg8::Gemm g{HB_CUR, WSP(const bf16_t, WS_WUP) + (size_t)pl * 11264 * 2048, MROWS, 11264, 2048}; pg8::StaticOrder S; S.init(MROWS, 11264, G, bx); pg8::EpiUpCG E{WSP(bf16_t, WS_ACT), WSP(bf16_t, WS_GB), ap->in[25] + (size_t)pl * 3 * 5632, ap->in[26] + pl * 5632};
                pg8::gemm_phase<pg8::EpiUpCG, pg8::StaticOrder, PG8_ALIGN, true>(lds, g, S, E, ptid); }
            PH_END;
            if (PH_IN) { PH_CTX for (int it = bx * NTHR + ptid; it < 256 * 2 * 704; it += G * NTHR) cg_fix_item(it, WSP(bf16_t, WS_ACT), WSP(const bf16_t, WS_GB), ap->in[25] + (size_t)pl * 3 * 5632, ap->in[26] + pl * 5632); }
            PH_END;
            if (PH_IN) DUP(8192) { PH_CTX pg8::Gemm g{WSP(const bf16_t, WS_ACT), WSP(const bf16_t, WS_WDN) + (size_t)pl * 2048 * 5632, MROWS, 2048, 5632}; pg8::StaticOrder S; S.init(MROWS, 2048, G, bx);
                pg8::EpiResB<false> E{nullptr, XO_PTR, (((DUP_MASK) & 8192) && rep_ < (DUP_REP) - 1) ? WSP(bf16_t, WS_YHT) : XO_PTR, MODB_PTR + 5 * 2048};
                pg8::gemm_phase<pg8::EpiResB<false>, pg8::StaticOrder, PG8_ALIGN, true>(lds, g, S, E, ptid); }
            if (l == DEPTH_ - 1 && ch == NCHUNK - 1) PH_END;
        }
    }
    { const int l = 0, ch = 0; if (PH_IN) { PH_CTX final_norm_phase(WSP(const bf16_t, WS_XB), ap->out, ap->in[28], pgw, NGW, plane); } }
    PH_END;
    }
#undef PH_IN
#undef PH_CTX
#undef PH_END
#undef DUP
}

#ifndef MK_LAUNCH_PER_PHASE
#define MK_LAUNCH_PER_PHASE 0
#endif
extern "C" void kernel_launch(void* const* d_in, const int* in_sizes, int n_in, void* d_out, int out_size, void* d_ws, size_t ws_size, hipStream_t stream) {
    static int grid = 0;
    if (grid == 0) {
        if (n_in != 29 || out_size != NSEQ * SEQ * 2048 || ws_size < WS_END) { fprintf(stderr, "kernel_launch: unexpected sizes n_in %d out %d ws %zu\n", n_in, out_size, ws_size); grid = -1; return; }
        int dev = 0, cus = 0, per_cu = 0;
        if (hipGetDevice(&dev) != hipSuccess || hipDeviceGetAttribute(&cus, hipDeviceAttributeMultiprocessorCount, dev) != hipSuccess) { grid = -1; return; }
        if (hipFuncSetAttribute((const void*)mega_fwd, hipFuncAttributeMaxDynamicSharedMemorySize, LDS_BYTES) != hipSuccess) { fprintf(stderr, "kernel_launch: hipFuncSetAttribute failed\n"); grid = -1; return; }
        if (hipOccupancyMaxActiveBlocksPerMultiprocessor(&per_cu, (const void*)mega_fwd, 512, LDS_BYTES) != hipSuccess || per_cu < 1) fprintf(stderr, "kernel_launch: occupancy query says %d\n", per_cu);
        (void)hipGetLastError();
        grid = cus >= 256 ? 256 : cus >= 128 ? 128 : cus >= 64 ? 64 : -1;
        if (grid < 0) { fprintf(stderr, "kernel_launch: %d CUs\n", cus); return; }
    }
    if (grid < 0) return;
    (void)hipMemsetAsync((char*)d_ws + WS_CTL, 0, CTL_ZERO_BYTES, stream);
    Args a{};
    for (int i = 0; i < 29; ++i) a.in[i] = (const float*)d_in[i];
    a.out = (float*)d_out; a.ws = (unsigned char*)d_ws;
#if MK_LAUNCH_PER_PHASE
    for (int p = 0; p < N_PHASES; ++p) { a.ph_lo = p; a.ph_hi = p + 1; hipLaunchKernelGGL(mega_fwd, dim3(grid), dim3(512), LDS_BYTES, stream, a); }
#else
    a.ph_lo = 0; a.ph_hi = N_PHASES; hipLaunchKernelGGL(mega_fwd, dim3(grid), dim3(512), LDS_BYTES, stream, a);
#endif
}
```

```cpp
#include <hip/hip_runtime.h>
#include <cstdio>
#include <cstdint>
#define DEV __device__ __forceinline__
#define DEVCONST __device__
#define LAS __attribute__((address_space(3)))
#define SYNC() __syncthreads()
#define F2U(x) __float_as_uint(x)
#define U2F(x) __uint_as_float(x)
#define BITCAST(T, v) __builtin_bit_cast(T, v)
#define EXP2(x) __builtin_amdgcn_exp2f(x)
#define LOG2(x) __builtin_amdgcn_logf(x)
#define SINCOSPI(x, s, c) do { const float hx_ = 0.5f * (x); *(s) = __builtin_amdgcn_sinf(hx_); *(c) = __builtin_amdgcn_cosf(hx_); } while (0)
__device__ __forceinline__ float shfl_from(float v, int src_lane) { return __builtin_bit_cast(float, __builtin_amdgcn_ds_bpermute(src_lane << 2, __builtin_bit_cast(int, v))); }
#define SHFL_XOR3(v, m, lane) shfl_from((v), (lane) ^ (m))
template <int N> __device__ __forceinline__ float dpp_ror(float v) { return __builtin_bit_cast(float, __builtin_amdgcn_update_dpp(0, __builtin_bit_cast(int, v), 0x120 + N, 0xf, 0xf, false)); }
#define LANE_SWAP1(v) __builtin_bit_cast(float, __builtin_amdgcn_update_dpp(0, __builtin_bit_cast(int, (float)(v)), 0xB1, 0xf, 0xf, false))
#define MFMA32(a, b, c) __builtin_amdgcn_mfma_f32_32x32x16_bf16((a), (b), (c), 0, 0, 0)
#define OPAQUE_I(x) asm volatile("" : "+v"(x))

typedef _Float16 h16x2_t __attribute__((ext_vector_type(2)));
__device__ __forceinline__ unsigned pkh2(float a, float b) { h16x2_t h; h.x = (_Float16)a; h.y = (_Float16)b; return __builtin_bit_cast(unsigned, h); }
__device__ __forceinline__ float hlo(unsigned w) { return (float)__builtin_bit_cast(h16x2_t, w).x; }
__device__ __forceinline__ float hhi(unsigned w) { return (float)__builtin_bit_cast(h16x2_t, w).y; }
constexpr int D_ = 2048, SEQ = 4096, NSEQ = 12, DEPTH_ = 4, CHS = 4  , NCHUNK = 3, MROWS = CHS * SEQ  ;
constexpr int HW_ = 1024, AW_ = 1536, AO_ = 512, DFF_ = 5632, INC_ = 11776, NMOD_ = 6;
constexpr int NA_ = 4608  , NB_ = 7168  ;
constexpr int FFTN = 8192, FPAD = FFTN + FFTN / 16  ;
constexpr int NTHR = 512;

typedef unsigned short bf16_t;
typedef short bf16x8 __attribute__((ext_vector_type(8)));
typedef float f32x4 __attribute__((ext_vector_type(4)));
typedef float f32x16 __attribute__((ext_vector_type(16)));
typedef float cf __attribute__((ext_vector_type(2)));
typedef unsigned u32x4 __attribute__((ext_vector_type(4)));
typedef unsigned u32x2 __attribute__((ext_vector_type(2)));
typedef unsigned short u16x4 __attribute__((ext_vector_type(4)));

DEV unsigned short f2bf(float f) { unsigned u = F2U(f); u += 0x7fffu + ((u >> 16) & 1u); return (unsigned short)(u >> 16); }
DEV float bf2f(unsigned short b) { return U2F(((unsigned)b) << 16); }
DEV unsigned pk2(float lo, float hi) { return (unsigned)f2bf(lo) | ((unsigned)f2bf(hi) << 16); }

DEVCONST constexpr float C8T[9] = {1.0f, 0.980785280403230449f, 0.923879532511286756f, 0.831469612302545237f, 0.707106781186547524f, 0.555570233019602225f, 0.382683432365089772f, 0.195090322016128268f, 0.0f};
DEV constexpr float tw_cos(int m) { m &= 31; return m <= 8 ? C8T[m] : (m <= 16 ? -C8T[16 - m] : (m <= 24 ? -C8T[m - 16] : C8T[32 - m])); }
DEV constexpr float tw_sin(int m) { return tw_cos(m - 8); }
DEVCONST constexpr int BR16[16] = {0, 8, 4, 12, 2, 10, 6, 14, 1, 9, 5, 13, 3, 11, 7, 15};
DEVCONST constexpr int BR32[32] = {0, 16, 8, 24, 4, 20, 12, 28, 2, 18, 10, 26, 6, 22, 14, 30, 1, 17, 9, 25, 5, 21, 13, 29, 3, 19, 11, 27, 7, 23, 15, 31};
#ifdef EMU
DEV cf cmul(cf a, cf b) { return cf{a.x * b.x - a.y * b.y, a.x * b.y + a.y * b.x}; }
DEV cf cmulc(cf a, cf b) { return cf{a.x * b.x + a.y * b.y, a.y * b.x - a.x * b.y}; }
#else
DEV cf cmul(cf a, cf b) { cf r, t;
    asm("v_pk_mul_f32 %1, %2, %3 op_sel:[1,1] op_sel_hi:[1,0] neg_lo:[1,0]\n\tv_pk_fma_f32 %0, %2, %3, %1 op_sel_hi:[0,1,1]" : "=v"(r), "=&v"(t) : "v"(a), "v"(b));
    return r; }
DEV cf cmulc(cf a, cf b) { cf r, t;
    asm("v_pk_mul_f32 %1, %2, %3 op_sel:[1,1] op_sel_hi:[1,0]\n\tv_pk_fma_f32 %0, %2, %3, %1 op_sel_hi:[0,1,1] neg_hi:[1,0,0]" : "=v"(r), "=&v"(t) : "v"(a), "v"(b));
    return r; }
#endif
template <int R, bool INV> DEV void dft_regs(cf (&v)[R]) {
#pragma unroll
    for (int s = R; s >= 2; s >>= 1) {
        const int h = s >> 1;
#pragma unroll
        for (int b = 0; b < R; b += s) {
#pragma unroll
            for (int k = 0; k < h; ++k) {
                const cf a = v[b + k], c = v[b + k + h];
                v[b + k] = a + c;
                const cf d = a - c;
                const int m = k * (32 / s);
                const float wr = tw_cos(m), wi = INV ? tw_sin(m) : -tw_sin(m);
                v[b + k + h] = cf{d.x * wr - d.y * wi, d.x * wi + d.y * wr};
            }
        }
    }
}
DEV int PADI(int i) { return i + (i >> 4); }
DEV int fpos(int k) { return ((k & 15) << 9) | (((k >> 4) & 31) << 4) | (k >> 9); }
DEV int fnat(int p) { return (p >> 9) | (((p >> 4) & 31) << 4) | ((p & 15) << 9); }

DEV void fft_f1(LAS cf* buf, const cf (&z)[8], int tid) {
    OPAQUE_I(tid);
    cf v[16];
#pragma unroll
    for (int q = 0; q < 8; ++q) { v[q] = z[q]; v[q + 8] = cf{0.f, 0.f}; }
    dft_regs<16, false>(v);
    float sn, cs; SINCOSPI(-(float)tid * (2.0f / 8192.0f), &sn, &cs);
    const cf w = cf{cs, sn}; cf wp = cf{1.f, 0.f};
#pragma unroll
    for (int p = 0; p < 16; ++p) { buf[PADI(tid + 512 * p)] = cmul(v[BR16[p]], wp); wp = cmul(wp, w); }
}
DEV void fft_f1x2(LAS cf* buf0, LAS cf* buf1, const cf (&z0)[8], const cf (&z1)[8], int tid) {
    OPAQUE_I(tid);
    cf v[16], u[16];
#pragma unroll
    for (int q = 0; q < 8; ++q) { v[q] = z0[q]; v[q + 8] = cf{0.f, 0.f}; u[q] = z1[q]; u[q + 8] = cf{0.f, 0.f}; }
    dft_regs<16, false>(v); dft_regs<16, false>(u);
    float sn, cs; SINCOSPI(-(float)tid * (2.0f / 8192.0f), &sn, &cs);
    const cf w = cf{cs, sn}; cf wp = cf{1.f, 0.f};
    LAS cf* p0 = buf0 + PADI(tid); LAS cf* p1 = buf1 + PADI(tid);
#pragma unroll
    for (int p = 0; p < 16; ++p) { p0[544 * p] = cmul(v[BR16[p]], wp); p1[544 * p] = cmul(u[BR16[p]], wp); wp = cmul(wp, w); }
}
DEV void fft_i1x2(LAS cf* buf0, LAS cf* buf1, cf (&y0)[8], cf (&y1)[8], int tid) {
    OPAQUE_I(tid);
    float sn, cs; SINCOSPI(-(float)tid * (2.0f / 8192.0f), &sn, &cs);
    const cf w = cf{cs, sn}; cf wp = cf{1.f, 0.f};
    cf v[16], u[16];
    const LAS cf* p0 = buf0 + PADI(tid); const LAS cf* p1 = buf1 + PADI(tid);
#pragma unroll
    for (int p = 0; p < 16; ++p) { v[p] = cmulc(p0[544 * p], wp); u[p] = cmulc(p1[544 * p], wp); wp = cmul(wp, w); }
    dft_regs<16, true>(v); dft_regs<16, true>(u);
#pragma unroll
    for (int q = 0; q < 8; ++q) { y0[q] = v[BR16[q]]; y1[q] = u[BR16[q]]; }
}
DEV void fft_f2(LAS cf* buf, int t8) {
    OPAQUE_I(t8);
    LAS cf* pb = buf + (t8 >> 4) * 544 + (t8 & 15);
    cf v[32];
#pragma unroll
    for (int q = 0; q < 32; ++q) v[q] = pb[17 * q];
    dft_regs<32, false>(v);
    float sn, cs; SINCOSPI(-(float)(t8 & 15) * (2.0f / 512.0f), &sn, &cs);
    const cf w = cf{cs, sn}; cf wp = cf{1.f, 0.f};
#pragma unroll
    for (int p = 0; p < 32; ++p) { pb[17 * p] = cmul(v[BR32[p]], wp); wp = cmul(wp, w); }
}
DEV cf kunpack(unsigned w) { return cf{U2F(w << 16), U2F(w & 0xffff0000u)}; }
template <bool MULK> DEV void fft_mid(LAS cf* buf, const unsigned* Kp, int blk) {
    const int base = 16 * blk;
    cf v[16];
#pragma unroll
    for (int q = 0; q < 16; ++q) v[q] = buf[PADI(base + q)];
    dft_regs<16, false>(v);
    if (MULK) {
        cf w[16];
#pragma unroll
        for (int p = 0; p < 16; ++p) w[p] = cmul(v[BR16[p]], kunpack(Kp[base + p]));
        dft_regs<16, true>(w);
#pragma unroll
        for (int q = 0; q < 16; ++q) buf[PADI(base + q)] = w[BR16[q]];
    } else {
#pragma unroll
        for (int p = 0; p < 16; ++p) buf[PADI(base + p)] = v[BR16[p]];
    }
}
DEV void fft_midx2(LAS cf* buf0, LAS cf* buf1, const unsigned* Kp, int blk) {
    const int base = 16 * blk;
    LAS cf* p0 = buf0 + 17 * blk; LAS cf* p1 = buf1 + 17 * blk;
    cf v[16], u[16];
#pragma unroll
    for (int q = 0; q < 16; ++q) { v[q] = p0[q]; u[q] = p1[q]; }
    dft_regs<16, false>(v); dft_regs<16, false>(u);
    cf w[16], x[16];
    u32x4 kw[4];
#pragma unroll
    for (int j = 0; j < 4; ++j) kw[j] = *(const u32x4*)(Kp + base + 4 * j);
#pragma unroll
    for (int p = 0; p < 16; ++p) { const cf k = kunpack(kw[p >> 2][p & 3]); w[p] = cmul(v[BR16[p]], k); x[p] = cmul(u[BR16[p]], k); }
    dft_regs<16, true>(w); dft_regs<16, true>(x);
#pragma unroll
    for (int q = 0; q < 16; ++q) { p0[q] = w[BR16[q]]; p1[q] = x[BR16[q]]; }
}
DEV void fft_i2(LAS cf* buf, int t8) {
    OPAQUE_I(t8);
    LAS cf* pb = buf + (t8 >> 4) * 544 + (t8 & 15);
    float sn, cs; SINCOSPI(-(float)(t8 & 15) * (2.0f / 512.0f), &sn, &cs);
    const cf w = cf{cs, sn}; cf wp = cf{1.f, 0.f};
    cf v[32];
#pragma unroll
    for (int p = 0; p < 32; ++p) { v[p] = cmulc(pb[17 * p], wp); wp = cmul(wp, w); }
    dft_regs<32, true>(v);
#pragma unroll
    for (int q = 0; q < 32; ++q) pb[17 * q] = v[BR32[q]];
}
DEV void fft_i1(LAS cf* buf, cf (&y)[8], int tid) {
    OPAQUE_I(tid);
    float sn, cs; SINCOSPI(-(float)tid * (2.0f / 8192.0f), &sn, &cs);
    const cf w = cf{cs, sn}; cf wp = cf{1.f, 0.f};
    cf v[16];
#pragma unroll
    for (int p = 0; p < 16; ++p) { v[p] = cmulc(buf[PADI(tid + 512 * p)], wp); wp = cmul(wp, w); }
    dft_regs<16, true>(v);
#pragma unroll
    for (int q = 0; q < 8; ++q) y[q] = v[BR16[q]];
}

DEV void filt_hidden_unit(int unit, const float* w1, const float* b1, const float* fr1, const float* w2, const float* b2, const float* fr2, float* h2out  , bf16_t* h2b  , LAS float* sm, int tid) {
    LAS float* feat = sm;
    LAS float* h1 = sm + 8 * 33;
    const int tl = tid >> 6, j = tid & 63, t = unit * 8 + tl;
    if (tid < 8 * 33) {
        const int tt = tid / 33, f = tid % 33, tp = unit * 8 + tt;
        float val;
        if (f == 0) val = (float)tp * (1.0f / 4095.0f);
        else { const int k = (f - 1) & 15; const float band = 1e-4f + (float)k * ((15.0f - 1e-4f) / 15.0f);
               const float xr = (float)tp * band * (1.0f / 4096.0f), fr = xr - floorf(xr);
               float sn, cs; SINCOSPI(2.0f * fr, &sn, &cs);
               val = (f <= 16) ? cs : -sn; }
        feat[tt * 33 + f] = val;
    }
    SYNC();
    { float a = b1[j];
#pragma unroll 11
      for (int f = 0; f < 33; ++f) a += feat[tl * 33 + f] * w1[f * 64 + j];
      h1[tl * 64 + j] = sinf(fr1[j] * a); }
    SYNC();
    { float a = b2[j];
#pragma unroll 16
      for (int i = 0; i < 64; ++i) a += h1[tl * 64 + i] * w2[i * 64 + j];
      const float hv = sinf(fr2[j] * a); if (h2out) h2out[j * 4096 + t] = hv; h2b[t * 64 + j] = f2bf(hv); }
    SYNC();
}
DEV void filt_channel_unit(int c, const float* h2, const float* w3, unsigned* KF, LAS unsigned char* lds, int tid) {
    LAS cf* buf = (LAS cf*)lds;
    LAS float* sw = (LAS float*)(lds + FPAD * 8);
    LAS float* red = sw + 256;
    if (tid < 256) { const int i = tid >> 2, q = tid & 3; sw[tid] = w3[i * 4096 + q * 1024 + c]; }
    SYNC();
    const float dmin = -3.0701134573253947f, dmax = -15.350567286626973f;
    const float delta = fabsf(dmin + (float)c * ((dmax - dmin) / 1023.0f));
    float s0 = 0.f, s1 = 0.f;
#pragma unroll 1
    for (int i = 0; i < 8; ++i) {
        const int t = tid + 512 * i;
        const float* hc = h2 + t;
        float a0 = 0.f, a1 = 0.f, a2 = 0.f, a3 = 0.f;
        float xv[64];
#pragma unroll
        for (int k = 0; k < 64; ++k) xv[k] = hc[k * 4096];
#pragma unroll
        for (int k = 0; k < 64; ++k) { const f32x4 w = *(const LAS f32x4*)(sw + k * 4); a0 += xv[k] * w.x; a1 += xv[k] * w.y; a2 += xv[k] * w.z; a3 += xv[k] * w.w; }
        const float dec = expf(-((float)t * (1.0f / 4095.0f)) * delta);
        a0 *= dec; a1 *= dec; a2 *= dec; a3 *= dec;
        s0 += fabsf(a0); s1 += fabsf(a1);
        buf[PADI(t)] = cf{a0, a1};
        if (t > 0) { s0 += fabsf(a2); s1 += fabsf(a3); buf[PADI(8192 - t)] = cf{a2, a3}; }
        else buf[PADI(4096)] = cf{a2 * 0.f, a3 * 0.f};
    }
#pragma unroll
    for (int o = 1; o < 64; o <<= 1) { s0 += SHFL_XOR3(s0, o, tid & 63); s1 += SHFL_XOR3(s1, o, tid & 63); }
    if ((tid & 63) == 0) { red[(tid >> 6) * 2] = s0; red[(tid >> 6) * 2 + 1] = s1; }
    SYNC();
    float t0 = 0.f, t1 = 0.f;
#pragma unroll
    for (int w = 0; w < 8; ++w) { t0 += red[w * 2]; t1 += red[w * 2 + 1]; }
    const cf inrm = cf{1.0f / t0, 1.0f / t1};
    {
        OPAQUE_I(tid);
        cf v[16];
#pragma unroll
        for (int q = 0; q < 16; ++q) v[q] = buf[PADI(tid + 512 * q)] * inrm;
        dft_regs<16, false>(v);
        float sn, cs; SINCOSPI(-(float)tid * (2.0f / 8192.0f), &sn, &cs);
        const cf w = cf{cs, sn}; cf wp = cf{1.f, 0.f};
#pragma unroll
        for (int p = 0; p < 16; ++p) { buf[PADI(tid + 512 * p)] = cmul(v[BR16[p]], wp); wp = cmul(wp, w); }
    }
    SYNC();
    if (tid < 256) fft_f2(buf, tid);
    SYNC();
    fft_mid<false>(buf, nullptr, tid);
    SYNC();
    const float sc = 0.5f / 8192.0f;
#pragma unroll
    for (int i = 0; i < 16; ++i) {
        const int p = tid + 512 * i, k = fnat(p), p2 = fpos((8192 - k) & 8191);
        const cf a = buf[PADI(p)], b = buf[PADI(p2)];
        KF[((size_t)c * 2 + 0) * 8192 + p] = pk2((a.x + b.x) * sc, (a.y - b.y) * sc);
        KF[((size_t)c * 2 + 1) * 8192 + p] = pk2((a.y + b.y) * sc, (b.x - a.x) * sc);
    }
    SYNC();
}

DEV void filt_channel_unit2(int c, const bf16_t* h2b, const float* w3, unsigned* KF, LAS unsigned char* lds, int tid) {
    LAS cf* buf0 = (LAS cf*)lds; LAS cf* buf1 = buf0 + FPAD;
    int swo = 2 * FPAD * 8 + 1024; OPAQUE_I(swo);
    LAS float* sw = (LAS float*)(lds + swo);
    LAS float* red = sw + 512;
    { const int i = tid >> 3, q = tid & 7; sw[tid] = w3[i * 4096 + (q & 3) * 1024 + c + (q >> 2)]; }
    SYNC();
    const float dmin = -3.0701134573253947f, dmax = -15.350567286626973f;
    const int lane = tid & 63, wave = tid >> 6, n = lane & 31, hl = lane >> 5;
    const float delta = fabsf(dmin + (float)(c + hl) * ((dmax - dmin) / 1023.0f));
    bf16x8 wa[4];
#pragma unroll
    for (int ks = 0; ks < 4; ++ks) { float wv[8];
#pragma unroll
        for (int j = 0; j < 8; ++j) { const float x = sw[(16 * ks + 8 * hl + j) * 8 + (n & 7)]; wv[j] = (n < 8) ? x : 0.f; }
        u32x4 w; w.x = pk2(wv[0], wv[1]); w.y = pk2(wv[2], wv[3]); w.z = pk2(wv[4], wv[5]); w.w = pk2(wv[6], wv[7]); wa[ks] = BITCAST(bf16x8, w); }
    LAS cf* bufc = hl ? buf1 : buf0;
    float s[2] = {0.f, 0.f};
#pragma unroll 1
    for (int g = 0; g < 4; ++g) {
        bf16x8 hb[4][4];
#pragma unroll
        for (int i = 0; i < 4; ++i) { const int t = 32 * (wave * 16 + 4 * g + i) + n;
#pragma unroll
            for (int ks = 0; ks < 4; ++ks) hb[i][ks] = *(const bf16x8*)(h2b + t * 64 + 16 * ks + 8 * hl); }
#pragma unroll
        for (int i = 0; i < 4; ++i) { const int t = 32 * (wave * 16 + 4 * g + i) + n;
            f32x16 acc;
#pragma unroll
            for (int r = 0; r < 16; ++r) acc[r] = 0.f;
#pragma unroll
            for (int ks = 0; ks < 4; ++ks) acc = MFMA32(wa[ks], hb[i][ks], acc);
            const float dec = expf(-(float)t * (1.0f / 4095.0f) * delta);
            const float a0 = acc[0] * dec, a1 = acc[1] * dec, a2 = acc[2] * dec, a3 = acc[3] * dec;
            s[0] += fabsf(a0); s[1] += fabsf(a1);
            bufc[PADI(t)] = cf{a0, a1};
            if (t > 0) { s[0] += fabsf(a2); s[1] += fabsf(a3); bufc[PADI(8192 - t)] = cf{a2, a3}; }
            else bufc[PADI(4096)] = cf{a2 * 0.f, a3 * 0.f};
        }
    }
#pragma unroll
    for (int o = 1; o < 32; o <<= 1) { s[0] += SHFL_XOR3(s[0], o, lane); s[1] += SHFL_XOR3(s[1], o, lane); }
    if (n == 0) { red[wave * 4 + 2 * hl] = s[0]; red[wave * 4 + 2 * hl + 1] = s[1]; }
    SYNC();
    float tt[4] = {0.f, 0.f, 0.f, 0.f};
#pragma unroll
    for (int w = 0; w < 8; ++w)
#pragma unroll
        for (int q = 0; q < 4; ++q) tt[q] += red[w * 4 + q];
    const cf in0 = cf{1.0f / tt[0], 1.0f / tt[1]}, in1 = cf{1.0f / tt[2], 1.0f / tt[3]};
    {
        OPAQUE_I(tid);
        cf v[16], u[16];
#pragma unroll
        for (int q = 0; q < 16; ++q) { v[q] = buf0[PADI(tid + 512 * q)] * in0; u[q] = buf1[PADI(tid + 512 * q)] * in1; }
        dft_regs<16, false>(v); dft_regs<16, false>(u);
        float sn, cs; SINCOSPI(-(float)tid * (2.0f / 8192.0f), &sn, &cs);
        const cf w = cf{cs, sn}; cf wp = cf{1.f, 0.f};
#pragma unroll
        for (int p = 0; p < 16; ++p) { buf0[PADI(tid + 512 * p)] = cmul(v[BR16[p]], wp); buf1[PADI(tid + 512 * p)] = cmul(u[BR16[p]], wp); wp = cmul(wp, w); }
    }
    SYNC();
    fft_f2((tid >> 8) ? buf1 : buf0, tid & 255);
    SYNC();
    fft_mid<false>(buf0, nullptr, tid); fft_mid<false>(buf1, nullptr, tid);
    SYNC();
    const float sc = 0.5f / 8192.0f;
#pragma unroll
    for (int i = 0; i < 16; ++i) {
        const int p = tid + 512 * i, k = fnat(p), p2 = fpos((8192 - k) & 8191);
        const cf a0 = buf0[PADI(p)], b0 = buf0[PADI(p2)], a1 = buf1[PADI(p)], b1 = buf1[PADI(p2)];
        KF[((size_t)c * 2 + 0) * 8192 + p] = pk2((a0.x + b0.x) * sc, (a0.y - b0.y) * sc);
        KF[((size_t)c * 2 + 1) * 8192 + p] = pk2((a0.y + b0.y) * sc, (b0.x - a0.x) * sc);
        KF[((size_t)c * 2 + 2) * 8192 + p] = pk2((a1.x + b1.x) * sc, (a1.y - b1.y) * sc);
        KF[((size_t)c * 2 + 3) * 8192 + p] = pk2((a1.y + b1.y) * sc, (b1.x - a1.x) * sc);
    }
    SYNC();
}

DEV float ldsbf(const LAS bf16_t* p) { return bf2f(*p); }
DEV void hyena_issue_rows(const bf16_t* UT, int s, int c, u32x4 (&r)[4], int tid) {
#pragma unroll
    for (int b = 0; b < 4; ++b) r[b] = *(const u32x4*)(UT + ((size_t)(b * 3072 + s * 1024 + c)) * 4096 + tid * 8);
}
DEV void hyena_commit_rows(LAS unsigned char* lds, const u32x4 (&r)[4], int tid) {
#pragma unroll
    for (int b = 0; b < 4; ++b) *(LAS u32x4*)(lds + b * 8192 + tid * 16) = r[b];
}
template <int MODE> DEV void hyena_conv_rows(const LAS unsigned char* lds, int slot0, float w0, float w1, float w2, float bs, cf (&z)[2][8], const cf (&y)[2][8], float hb, int tid) {
#pragma unroll
    for (int b = 0; b < 4; ++b) {
        const LAS bf16_t* row = (const LAS bf16_t*)(lds + (slot0 + b) * 8192);
#pragma unroll
        for (int i = 0; i < 8; ++i) {
            const int t = tid + 512 * i, par = tid & 1, d0 = (tid >> 1) + par;
            const LAS unsigned* rw = (const LAS unsigned*)row + d0;
            const unsigned dw0 = (i == 0) ? rw[d0 > 0 ? -1 : 0] : rw[256 * i - 1], dw1 = rw[256 * i];
            float um = par ? U2F(dw0 << 16) : U2F(dw0 & 0xffff0000u);
            const float u0 = par ? U2F(dw0 & 0xffff0000u) : U2F(dw1 << 16);
            float up = par ? U2F(dw1 << 16) : U2F(dw1 & 0xffff0000u);
            um = (t > 0) ? um : 0.f; up = (t < 4095) ? up : 0.f;
            const float r = um * w0 + u0 * w1 + up * w2 + bs;
            if (MODE == 0) { if (b & 1) z[b >> 1][i].y = r; else z[b >> 1][i].x = r; }
            else { if (b & 1) z[b >> 1][i].y = r * (y[b >> 1][i].y + hb * z[b >> 1][i].y); else z[b >> 1][i].x = r * (y[b >> 1][i].x + hb * z[b >> 1][i].x); }
        }
    }
}
#ifndef HY_ABL
#define HY_ABL 0
#endif
DEV void hyena_conv_head(LAS cf* buf0, LAS cf* buf1, const unsigned* Kp, const cf (&z)[2][8], int tid, bool abl) {
    const bool skip_all = abl && HY_ABL == 1, nosync = abl && HY_ABL == 2, nok = abl && HY_ABL == 3, skip1 = (abl && HY_ABL == 4) || skip_all, skip2 = (abl && HY_ABL == 5) || skip_all, skipm = (abl && HY_ABL == 6) || skip_all;
    if (!skip1) fft_f1x2(buf0, buf1, z[0], z[1], tid);
    if (!nosync && !skip_all) SYNC();
    if (!skip2) fft_f2((tid >> 8) ? buf1 : buf0, tid & 255);
    if (!nosync && !skip_all) SYNC();
    if (!skipm) { if (nok) { fft_mid<false>(buf0, Kp, tid); fft_mid<false>(buf1, Kp, tid); } else fft_midx2(buf0, buf1, Kp, tid); }
    if (!nosync && !skip_all) SYNC();
    if (!skip2) fft_i2((tid >> 8) ? buf1 : buf0, tid & 255);
    if (!nosync && !skip_all) SYNC();
}
DEV void hyena_units(int c0, int cstride, const bf16_t* UT, bf16_t* YHT, const unsigned* KF, const float* convw  , const float* convb  , const float* hyb  , LAS unsigned char* lds, int tid, bool abl = false) {
    if (c0 >= 1024) return;
    LAS cf* buf0 = (LAS cf*)lds; LAS cf* buf1 = buf0 + FPAD;
    u32x4 r[4];
    hyena_issue_rows(UT, 0, c0, r, tid);
#pragma unroll 1
    for (int c = c0; c < 1024; c += cstride) {
        OPAQUE_I(tid);
        cf z[2][8], y[2][8];
        hyena_commit_rows(lds, r, tid);
        SYNC();
        hyena_conv_rows<0>(lds, 0, convw[c], convw[3072 + c], convw[6144 + c], convb[c], z, y, 0.f, tid);
        SYNC();
#pragma unroll 1
        for (int o = 0; o < 2; ++o) {
            hyena_conv_head(buf0, buf1, KF + ((size_t)c * 2 + o) * 8192, z, tid, abl);
            hyena_issue_rows(UT, 1 + o, c, r, tid);
            if (abl && (HY_ABL == 1 || HY_ABL == 4)) {
#pragma unroll
                for (int i = 0; i < 8; ++i) { y[0][i] = z[0][i]; y[1][i] = z[1][i]; }
            } else fft_i1x2(buf0, buf1, y[0], y[1], tid);
            SYNC();
            hyena_commit_rows(lds, r, tid);
            if (o == 1 && c + cstride < 1024) hyena_issue_rows(UT, 0, c + cstride, r, tid);
            SYNC();
            const int col = (1 + o) * 1024 + c;
            hyena_conv_rows<1>(lds, 0, convw[col], convw[3072 + col], convw[6144 + col], convb[col], z, y, hyb[o * 1024 + c], tid);
            SYNC();
        }
#pragma unroll
        for (int p = 0; p < 2; ++p)
#pragma unroll
            for (int i = 0; i < 8; ++i) {
                const int t = tid + 512 * i, odd = tid & 1;
                const float xn = LANE_SWAP1(z[p][i].x), yn = LANE_SWAP1(z[p][i].y);
                const unsigned w = odd ? pk2(yn, z[p][i].y) : pk2(z[p][i].x, xn);
                *(unsigned*)(YHT + ((size_t)((2 * p + odd) * 1024 + c)) * 4096 + (t & ~1)) = w;
            }
    }
}
DEV void hyena_unit(int c, const bf16_t* UT, bf16_t* YHT, const unsigned* KF, const float* convw, const float* convb, const float* hyb, LAS unsigned char* lds, int tid) {
    hyena_units(c, 1024, UT, YHT, KF, convw, convb, hyb, lds, tid);
}

DEV void attn_bias_table(LAS float* tab, const float* rel_bias, int tid) {
    for (int idx = tid; idx < 24 * 129; idx += NTHR) {
        const int gh = idx / 129, jj = idx % 129, g = gh >> 3, dil = 1 << (2 * g);
        const int rel = (jj - 64) * dil, n = rel < 0 ? -rel : rel;
        int bk = (rel > 0) ? 16 : 0;
        if (n < 8) bk += n;
        else bk += 8 + (n >= 15) + (n >= 27) + (n >= 50) + (n >= 91) + (n >= 166) + (n >= 305) + (n >= 559);
        tab[idx] = rel_bias[bk * 24 + gh] * 1.4426950408889634f;
    }
}
DEV void attn_tile(int tile, const bf16_t* QKG, const bf16_t* VT, bf16_t* OG, float* LSE, const LAS float* tab, int lane) {
    const int b = tile / (24 * 64), rem = tile % (24 * 64), gh = rem >> 6, tau = rem & 63, g = gh >> 3, h = gh & 7;
    const int dsh = 2 * g, Mg = 4096 >> dsh, ntm = Mg >> 6, r = tau / ntm, m0 = (tau % ntm) * 64;
    const int n = lane & 31, hl = lane >> 5;
    const size_t rowbase = (size_t)b * 4096;
    const int colq = g * 512 + h * 64;
    const float SC = 0.125f * 1.4426950408889634f;
    bf16x8 qf[2][4];
#pragma unroll
    for (int qb = 0; qb < 2; ++qb) {
        const int t = ((m0 + 32 * qb + n) << dsh) + r;
        const bf16_t* p = QKG + (rowbase + t) * 7168 + colq + 8 * hl;
#pragma unroll
        for (int ks = 0; ks < 4; ++ks) qf[qb][ks] = *(const bf16x8*)(p + 16 * ks);
    }
    f32x16 oacc[2][2];
#pragma unroll
    for (int a = 0; a < 2; ++a)
#pragma unroll
        for (int c2 = 0; c2 < 2; ++c2)
#pragma unroll
            for (int i = 0; i < 16; ++i) oacc[a][c2][i] = 0.f;
    float mrun[2] = {-1e30f, -1e30f}, lrun[2] = {0.f, 0.f};
    for (int kbi = 0; kbi < 3; ++kbi) {
        const int kb = (kbi == 0) ? 1 : (kbi == 1 ? 0 : 2);
        const int mk0 = m0 - 64 + 64 * kb;
        if (mk0 < 0 || mk0 >= Mg) continue;
        f32x16 s[2][2];
#pragma unroll
        for (int sb = 0; sb < 2; ++sb) {
            const int t = ((mk0 + 32 * sb + n) << dsh) + r;
            const bf16_t* p = QKG + (rowbase + t) * 7168 + 1536 + colq + 8 * hl;
            bf16x8 kf[4];
#pragma unroll
            for (int ks = 0; ks < 4; ++ks) kf[ks] = *(const bf16x8*)(p + 16 * ks);
#pragma unroll
            for (int qb = 0; qb < 2; ++qb) {
                f32x16 a;
#pragma unroll
                for (int i = 0; i < 16; ++i) a[i] = 0.f;
#pragma unroll
                for (int ks = 0; ks < 4; ++ks) a = MFMA32(kf[ks], qf[qb][ks], a);
                s[sb][qb] = a;
            }
        }
#pragma unroll
        for (int qb = 0; qb < 2; ++qb) {
            const int qq = 32 * qb + n;
            float mx = -1e30f;
#pragma unroll
            for (int sb = 0; sb < 2; ++sb)
#pragma unroll
                for (int rg = 0; rg < 16; ++rg) {
                    const int kk = 32 * sb + (rg & 3) + 8 * (rg >> 2) + 4 * hl;
                    const int jj = 64 * kb + kk - qq;
                    const bool ok = (unsigned)jj <= 128u;
                    const float bia = tab[gh * 129 + (ok ? jj : 0)];
                    const float v = ok ? s[sb][qb][rg] * SC + bia : -1e30f;
                    s[sb][qb][rg] = v; mx = fmaxf(mx, v);
                }
            mx = fmaxf(mx, SHFL_XOR3(mx, 32, lane));
            const float mnew = fmaxf(mrun[qb], mx);
            const float alpha = EXP2(mrun[qb] - mnew);
            float rs = 0.f;
#pragma unroll
            for (int sb = 0; sb < 2; ++sb)
#pragma unroll
                for (int rg = 0; rg < 16; ++rg) { const float p = EXP2(s[sb][qb][rg] - mnew); s[sb][qb][rg] = p; rs += p; }
            rs += SHFL_XOR3(rs, 32, lane);
            lrun[qb] = lrun[qb] * alpha + rs; mrun[qb] = mnew;
#pragma unroll
            for (int eb = 0; eb < 2; ++eb)
#pragma unroll
                for (int i = 0; i < 16; ++i) oacc[eb][qb][i] *= alpha;
        }
#pragma unroll
        for (int sb = 0; sb < 2; ++sb)
#pragma unroll
            for (int s2 = 0; s2 < 2; ++s2) {
                bf16x8 pf[2];
#pragma unroll
                for (int qb = 0; qb < 2; ++qb) {
                    u32x4 w;
                    w.x = pk2(s[sb][qb][8 * s2 + 0], s[sb][qb][8 * s2 + 1]); w.y = pk2(s[sb][qb][8 * s2 + 2], s[sb][qb][8 * s2 + 3]);
                    w.z = pk2(s[sb][qb][8 * s2 + 4], s[sb][qb][8 * s2 + 5]); w.w = pk2(s[sb][qb][8 * s2 + 6], s[sb][qb][8 * s2 + 7]);
                    pf[qb] = BITCAST(bf16x8, w);
                }
#pragma unroll
                for (int eb = 0; eb < 2; ++eb) {
                    const int e = 32 * eb + n;
                    const bf16_t* vp = VT + ((size_t)(b * 1536 + colq + e)) * 4096 + r * Mg + mk0 + 32 * sb + 16 * s2 + 4 * hl;
                    const u32x2 lo = *(const u32x2*)vp, hi = *(const u32x2*)(vp + 8);
                    u32x4 w; w.x = lo.x; w.y = lo.y; w.z = hi.x; w.w = hi.y;
                    const bf16x8 vf = BITCAST(bf16x8, w);
#pragma unroll
                    for (int qb = 0; qb < 2; ++qb) oacc[eb][qb] = MFMA32(vf, pf[qb], oacc[eb][qb]);
                }
            }
    }
#pragma unroll
    for (int qb = 0; qb < 2; ++qb) {
        const float inv = 1.0f / lrun[qb];
        const int t = ((m0 + 32 * qb + n) << dsh) + r;
        bf16_t* op = OG + (rowbase + t) * 1536 + colq;
#pragma unroll
        for (int eb = 0; eb < 2; ++eb)
#pragma unroll
            for (int gq = 0; gq < 4; ++gq) {
                u32x2 w; w.x = pk2(oacc[eb][qb][4 * gq] * inv, oacc[eb][qb][4 * gq + 1] * inv); w.y = pk2(oacc[eb][qb][4 * gq + 2] * inv, oacc[eb][qb][4 * gq + 3] * inv);
                *(u32x2*)(op + 32 * eb + 8 * gq + 4 * hl) = w;
            }
        if (hl == 0) LSE[(rowbase + t) * 24 + gh] = mrun[qb] + LOG2(lrun[qb]);
    }
}
constexpr int AT_KP = 144, AT_VP = 776;
constexpr int AT_K_OFF = 0, AT_V_OFF = 384 * AT_KP, AT_TAB_OFF = AT_V_OFF + 64 * AT_VP;
struct AttnU { int b, gh, g, dsh, Mg, r, mu0, colq; };
DEV AttnU attn_decode(int unit) {
    AttnU a; a.b = unit / 384; const int rem = unit % 384; a.gh = rem >> 4; const int uu = rem & 15; a.g = a.gh >> 3;
    a.dsh = 2 * a.g; a.Mg = 4096 >> a.dsh; const int upc = a.Mg >> 8; a.r = uu / upc; a.mu0 = (uu % upc) * 256; a.colq = a.g * 512 + (a.gh & 7) * 64;
    return a;
}
DEV void attn_issue(const AttnU& a, const bf16_t* QKG, const bf16_t* VT, u32x4 (&kr)[6], u32x4 (&vr)[6], int tid) {
    const size_t rowbase = (size_t)a.b * 4096;
#pragma unroll
    for (int i = 0; i < 6; ++i) {
        const int idx = tid + 512 * i, row = idx >> 3, ch = idx & 7, m = a.mu0 - 64 + row;
        kr[i] = (u32x4){0u, 0u, 0u, 0u};
        if (m >= 0 && m < a.Mg) kr[i] = *(const u32x4*)(QKG + (rowbase + (size_t)((m << a.dsh) + a.r)) * 7168 + 1536 + a.colq + 8 * ch);
    }
#pragma unroll
    for (int i = 0; i < 6; ++i) {
        const int idx = tid + 512 * i, e = idx / 48, ch = idx % 48, m = a.mu0 - 64 + 8 * ch;
        vr[i] = (u32x4){0u, 0u, 0u, 0u};
        if (m >= 0 && m < a.Mg) vr[i] = *(const u32x4*)(VT + ((size_t)(a.b * 1536 + a.colq + e)) * 4096 + a.r * a.Mg + m);
    }
}
DEV void attn_commit(LAS unsigned char* lds, const u32x4 (&kr)[6], const u32x4 (&vr)[6], int tid) {
#pragma unroll
    for (int i = 0; i < 6; ++i) { const int idx = tid + 512 * i, row = idx >> 3, ch = idx & 7; *(LAS u32x4*)(lds + AT_K_OFF + row * AT_KP + ch * 16) = kr[i]; }
#pragma unroll
    for (int i = 0; i < 6; ++i) { const int idx = tid + 512 * i, e = idx / 48, ch = idx % 48;
        LAS u32x2* d = (LAS u32x2*)(lds + AT_V_OFF + e * AT_VP + ch * 16);
        d[0] = (u32x2){vr[i].x, vr[i].y}; d[1] = (u32x2){vr[i].z, vr[i].w}; }
}
DEV void attn_compute(const AttnU& a, const bf16x8 (&qf)[4], int tq, bf16_t* OG, float* LSE, LAS unsigned char* lds, int tid) {
    const int lane = tid & 63, wave = tid >> 6, n = lane & 31, hl = lane >> 5;
    const size_t rowbase = (size_t)a.b * 4096;
    const LAS float* tab = (const LAS float*)(lds + AT_TAB_OFF) + a.gh * 129;
    const float SC = 0.125f * 1.4426950408889634f;
    f32x16 s[5];
    bool vb[5];
    float mx = -1e30f;
#pragma unroll
    for (int sb = 0; sb < 5; ++sb) {
        const int sbk = wave + sb, mb = a.mu0 - 64 + 32 * sbk;
        vb[sb] = (mb >= 0) && (mb < a.Mg);
        f32x16 acc;
#pragma unroll
        for (int i = 0; i < 16; ++i) acc[i] = 0.f;
        if (vb[sb]) {
            const LAS unsigned char* kp = lds + AT_K_OFF + (32 * sbk + n) * AT_KP + 16 * hl;
#pragma unroll
            for (int ks = 0; ks < 4; ++ks) { const bf16x8 kf = *(const LAS bf16x8*)(kp + 32 * ks); acc = MFMA32(kf, qf[ks], acc); }
        }
#pragma unroll
        for (int rg = 0; rg < 16; ++rg) {
            const int jj = 32 * sb + (rg & 3) + 8 * (rg >> 2) + 4 * hl - n;
            const bool ok = vb[sb] && ((unsigned)jj <= 128u);
            const float bia = tab[ok ? jj : 0];
            const float v = ok ? acc[rg] * SC + bia : -1e30f;
            acc[rg] = v; mx = fmaxf(mx, v);
        }
        s[sb] = acc;
    }
    mx = fmaxf(mx, SHFL_XOR3(mx, 32, lane));
    float rs = 0.f;
#pragma unroll
    for (int sb = 0; sb < 5; ++sb)
#pragma unroll
        for (int rg = 0; rg < 16; ++rg) { const float p = EXP2(s[sb][rg] - mx); s[sb][rg] = p; rs += p; }
    rs += SHFL_XOR3(rs, 32, lane);
    f32x16 oacc[2];
#pragma unroll
    for (int eb = 0; eb < 2; ++eb)
#pragma unroll
        for (int i = 0; i < 16; ++i) oacc[eb][i] = 0.f;
#pragma unroll
    for (int sb = 0; sb < 5; ++sb) {
        if (!vb[sb]) continue;
#pragma unroll
        for (int s2 = 0; s2 < 2; ++s2) {
            u32x4 w;
            w.x = pk2(s[sb][8 * s2 + 0], s[sb][8 * s2 + 1]); w.y = pk2(s[sb][8 * s2 + 2], s[sb][8 * s2 + 3]);
            w.z = pk2(s[sb][8 * s2 + 4], s[sb][8 * s2 + 5]); w.w = pk2(s[sb][8 * s2 + 6], s[sb][8 * s2 + 7]);
            const bf16x8 pf = BITCAST(bf16x8, w);
#pragma unroll
            for (int eb = 0; eb < 2; ++eb) {
                const LAS unsigned char* vp = lds + AT_V_OFF + (32 * eb + n) * AT_VP + (32 * (wave + sb) + 16 * s2 + 4 * hl) * 2;
                const u32x2 lo = *(const LAS u32x2*)vp, hi = *(const LAS u32x2*)(vp + 16);
                u32x4 wv; wv.x = lo.x; wv.y = lo.y; wv.z = hi.x; wv.w = hi.y;
                oacc[eb] = MFMA32(BITCAST(bf16x8, wv), pf, oacc[eb]);
            }
        }
    }
    const float inv = 1.0f / rs;
    bf16_t* op = OG + (rowbase + tq) * 1536 + a.colq;
#pragma unroll
    for (int eb = 0; eb < 2; ++eb)
#pragma unroll
        for (int gq = 0; gq < 4; ++gq) {
            u32x2 w; w.x = pk2(oacc[eb][4 * gq] * inv, oacc[eb][4 * gq + 1] * inv); w.y = pk2(oacc[eb][4 * gq + 2] * inv, oacc[eb][4 * gq + 3] * inv);
            *(u32x2*)(op + 32 * eb + 8 * gq + 4 * hl) = w;
        }
    if (hl == 0) LSE[(rowbase + tq) * 24 + a.gh] = mx + LOG2(rs);
}
DEV void attn_load_q(const AttnU& a, const bf16_t* QKG, bf16x8 (&qf)[4], int tid) {
    const int lane = tid & 63, wave = tid >> 6, n = lane & 31, hl = lane >> 5;
    const int tq = ((a.mu0 + 32 * wave + n) << a.dsh) + a.r;
    const bf16_t* p = QKG + ((size_t)a.b * 4096 + tq) * 7168 + a.colq + 8 * hl;
#pragma unroll
    for (int ks = 0; ks < 4; ++ks) qf[ks] = *(const bf16x8*)(p + 16 * ks);
}
DEV void attn_units(int u0, int ustride, int nunits, const bf16_t* QKG, const bf16_t* VT, bf16_t* OG, float* LSE, LAS unsigned char* lds, int tid) {
    if (u0 >= nunits) return;
    u32x4 kr[6], vr[6]; bf16x8 qn[4];
    { const AttnU a0 = attn_decode(u0); attn_issue(a0, QKG, VT, kr, vr, tid); attn_load_q(a0, QKG, qn, tid); }
#pragma unroll 1
    for (int u = u0; u < nunits; u += ustride) {
        OPAQUE_I(tid);
        const AttnU a = attn_decode(u);
        const int lane = tid & 63, wave = tid >> 6, n = lane & 31;
        SYNC();
        attn_commit(lds, kr, vr, tid);
        bf16x8 qf[4];
#pragma unroll
        for (int ks = 0; ks < 4; ++ks) qf[ks] = qn[ks];
        const int tq = ((a.mu0 + 32 * wave + n) << a.dsh) + a.r;
        SYNC();
        if (u + ustride < nunits) { const AttnU an = attn_decode(u + ustride); attn_issue(an, QKG, VT, kr, vr, tid); attn_load_q(an, QKG, qn, tid); }
        attn_compute(a, qf, tq, OG, LSE, lds, tid);
    }
}
DEV void attn_unit(int unit, const bf16_t* QKG, const bf16_t* VT, bf16_t* OG, float* LSE, LAS unsigned char* lds, int tid) {
    attn_units(unit, 1 << 20, unit + 1, QKG, VT, OG, LSE, lds, tid);
}
DEV void attn_combine_item(int item, const bf16_t* OG, const float* LSE, bf16_t* YA, int pitch = 512, int coloff = 0) {
    const int row = item >> 6, h = (item >> 3) & 7, e8 = item & 7;
    const float l0 = LSE[row * 24 + h], l1 = LSE[row * 24 + 8 + h], l2 = LSE[row * 24 + 16 + h];
    const float mx = fmaxf(l0, fmaxf(l1, l2));
    float w0 = EXP2(l0 - mx), w1 = EXP2(l1 - mx), w2 = EXP2(l2 - mx);
    const float inv = 1.0f / (w0 + w1 + w2); w0 *= inv; w1 *= inv; w2 *= inv;
    const bf16_t* p = OG + (size_t)row * 1536 + h * 64 + e8 * 8;
    const u32x4 a = *(const u32x4*)p, b = *(const u32x4*)(p + 512), c = *(const u32x4*)(p + 1024);
    u32x4 o;
#pragma unroll
    for (int i = 0; i < 4; ++i) {
        const float lo = w0 * U2F(a[i] << 16) + w1 * U2F(b[i] << 16) + w2 * U2F(c[i] << 16);
        const float hi = w0 * U2F(a[i] & 0xffff0000u) + w1 * U2F(b[i] & 0xffff0000u) + w2 * U2F(c[i] & 0xffff0000u);
        o[i] = pk2(lo, hi);
    }
    *(u32x4*)(YA + (size_t)row * pitch + coloff + h * 64 + e8 * 8) = o;
}

namespace pg8 {
#define PG8_LAS __attribute__((address_space(3)))
typedef unsigned short bf16_t;
typedef short bf16x8 __attribute__((ext_vector_type(8)));
typedef float f32x4 __attribute__((ext_vector_type(4)));
typedef unsigned u32x4 __attribute__((ext_vector_type(4)));
constexpr int BM = 256, BK = 64, HALF = 128, HTB = HALF * BK * 2  , STAGE_BYTES = 8 * HTB, NXCD = 8, WGM = 8;

__host__ __device__ __forceinline__ int lds_byte(int r, int c) { const int st = (r >> 4) * 2 + (c >> 5), rr = r & 15, cc = c & 31, ob = rr * 64 + cc * 2; return st * 1024 + (ob ^ (((ob >> 9) & 1) << 5)); }
__host__ __device__ __forceinline__ void stage_rc(int b, int& R, int& C) { const int st = b / 1024, sb = b % 1024, swz = sb ^ (((sb >> 9) & 1) << 5); R = (st >> 1) * 16 + swz / 64; C = (st & 1) * 32 + (swz % 64) / 2; }
__host__ __device__ __forceinline__ int perm32(int rho) { const int n = rho >> 4, i = rho & 15; return 8 * (i >> 2) + 4 * n + (i & 3); }

struct Unit { int pm, pn; };
struct Gemm { const bf16_t* A; const bf16_t* Bt; int M, N, K; };

struct StaticOrder {
    int nM, nN, nwg, G, c;
    __host__ __device__ void init(int M, int N, int G_, int c_) { nM = M / BM; nN = N / BM; nwg = nM * nN; G = G_; c = c_; }
    __host__ __device__ bool next(int i, Unit& u) const {
        const long L = (long)i * G + c; if (L >= nwg) return false;
        int wgid = (int)L; { const int q = nwg / NXCD, r = nwg % NXCD, xcd = wgid % NXCD, off = wgid / NXCD; wgid = (xcd < r ? xcd * (q + 1) : r * (q + 1) + (xcd - r) * q) + off; }
        const int nig = WGM * nN, gid = wgid / nig, fm = gid * WGM, gsz = (nM - fm) < WGM ? (nM - fm) : WGM;
        u.pm = fm + ((wgid % nig) % gsz); u.pn = (wgid % nig) / gsz; return true;
    }
    __device__ __forceinline__ void a_ready(const Unit&) const {}
    __device__ __forceinline__ void done(const Unit&) const {}
};

__device__ __forceinline__ unsigned cvt_pk_bf16(float lo, float hi) { unsigned r; asm volatile("v_cvt_pk_bf16_f32 %0, %1, %2" : "=v"(r) : "v"(lo), "v"(hi)); return r; }
constexpr int EPI_LDS_OFF = 139264 + 1024;
template <int MODE> __device__ __forceinline__ int perm_row(int R) {
    if (MODE == 0) return R;
    if (MODE == 1) return (R & ~31) + perm32(R & 31);
    const int wcp = R >> 5, n = (R >> 4) & 1, fq = (R >> 2) & 3, e = R & 3;
    if (MODE == 2) return fq + 4 * (8 * wcp + 4 * n + e);
    return (4 * wcp + fq) + 16 * (4 * n + e);
}
__device__ __forceinline__ float sigmoid_f(float x) { return __builtin_amdgcn_rcpf(1.0f + __builtin_amdgcn_exp2f(-1.4426950408889634f * x)); }
__device__ __forceinline__ f32x4 exp2_4(f32x4 t) { f32x4 r;
#pragma unroll
    for (int j = 0; j < 4; ++j) r[j] = __builtin_amdgcn_exp2f(fminf(t[j], 60.0f));
    return r; }
__device__ __forceinline__ f32x4 rcp_4(f32x4 t) { f32x4 r;
#pragma unroll
    for (int j = 0; j < 4; ++j) r[j] = __builtin_amdgcn_rcpf(t[j]);
    return r; }
__device__ __forceinline__ float bflo(unsigned w) { return __uint_as_float(w << 16); }
__device__ __forceinline__ float bfhi(unsigned w) { return __uint_as_float(w & 0xffff0000u); }
template <int VM> struct EpiG1a {
    static constexpr bool PERM = true, AFTER_DRAIN = false; static constexpr int PMODE = 1 + VM, KSPLIT = 0; static constexpr bool PREF = false;
    bf16_t* UT; bf16_t* VT;
    __device__ __forceinline__ void operator()(const f32x4 (&acc)[2][2][4][2], const Unit& u, int wr, int wc, int fr, int fq) const {
        const int row0 = u.pm * BM + wr * 64 + fr;
        const int T0 = u.pn * BM, bseq = T0 >> 12, t0 = T0 & 4095;
#pragma unroll
        for (int ai = 0; ai < 2; ++ai)
#pragma unroll
            for (int m = 0; m < 4; ++m) {
                const int nn = row0 + ai * HALF + m * 16;
#pragma unroll
                for (int bj = 0; bj < 2; ++bj) {
                    const f32x4 v0 = acc[ai][bj][m][0], v1 = acc[ai][bj][m][1];
                    u32x4 w; w.x = cvt_pk_bf16(v0[0], v0[1]); w.y = cvt_pk_bf16(v0[2], v0[3]); w.z = cvt_pk_bf16(v1[0], v1[1]); w.w = cvt_pk_bf16(v1[2], v1[3]);
                    const int th = t0 + bj * HALF;
                    if (VM == 0) {
                        const int t = th + wc * 32 + 8 * fq;
                        if (u.pm < 12) *(u32x4*)(UT + ((size_t)(bseq * 3072 + nn)) * 4096 + t) = w;
                        else *(u32x4*)(VT + ((size_t)(bseq * 1536 + (nn - 3072))) * 4096 + t) = w;
                    } else if (VM == 1) {
                        *(u32x4*)(VT + ((size_t)(bseq * 1536 + 512 + nn)) * 4096 + fq * 1024 + (th >> 2) + 8 * wc) = w;
                    } else {
                        *(u32x4*)(VT + ((size_t)(bseq * 1536 + 1024 + nn)) * 4096 + (4 * wc + fq) * 256 + (th >> 4)) = w;
                    }
                }
            }
    }
};
struct EpiG1b {
    static constexpr bool PERM = true, AFTER_DRAIN = false; static constexpr int PMODE = 1, KSPLIT = 0; static constexpr bool PREF = true;
    bf16_t* O; const float* bgate;
    __device__ __forceinline__ void prefetch(const Unit& u, int buf, PG8_LAS unsigned char* lds, int wid, int lane) const {
        if (u.pn >= 12 && wid == 0) __builtin_amdgcn_global_load_lds((const unsigned*)(bgate + (lane >> 5) * 2048 + (u.pn - 12) * 128 + (lane & 31) * 4), (PG8_LAS unsigned*)(lds + EPI_LDS_OFF + buf * 2048), 16, 0, 0);
    }
    __device__ __forceinline__ void run(const f32x4 (&acc)[2][2][4][2], const Unit& u, int wr, int wc, int fr, int fq, PG8_LAS unsigned char* lds, int buf) const {
        const int row0 = u.pm * BM + wr * 64 + fr, col0 = u.pn * BM + wc * 32 + 8 * fq; const bool gate = u.pn >= 12;
        const PG8_LAS float* bl = (const PG8_LAS float*)(lds + EPI_LDS_OFF + buf * 2048) + wc * 32 + 8 * fq;
        f32x4 bv[2][2];
#pragma unroll
        for (int bj = 0; bj < 2; ++bj)
#pragma unroll
            for (int n = 0; n < 2; ++n) bv[bj][n] = gate ? *(const PG8_LAS f32x4*)(bl + bj * HALF + 4 * n) : (f32x4){0.f, 0.f, 0.f, 0.f};
#pragma unroll
        for (int ai = 0; ai < 2; ++ai)
#pragma unroll
            for (int m = 0; m < 4; ++m) { bf16_t* rowp = O + (size_t)(row0 + ai * HALF + m * 16) * 7168 + col0;
                {
                    f32x4 h0 = acc[ai][0][m][0] + bv[0][0], h1 = acc[ai][0][m][1] + bv[0][1], a0 = acc[ai][1][m][0] + bv[1][0], a1 = acc[ai][1][m][1] + bv[1][1];
                    if (gate) {
                        const float nl2e = -1.4426950408889634f;
                        const f32x4 pa0 = exp2_4(a0 * nl2e) + 1.0f, pa1 = exp2_4(a1 * nl2e) + 1.0f, ph0 = exp2_4(h0 * nl2e) + 1.0f, ph1 = exp2_4(h1 * nl2e) + 1.0f;
                        const f32x4 r0 = rcp_4(pa0 * ph0), r1 = rcp_4(pa1 * ph1);
                        h0 = r0 * pa0 * pa0; h1 = r1 * pa1 * pa1; a0 = r0 * ph0; a1 = r1 * ph1; }
                    u32x4 w; w.x = cvt_pk_bf16(h0[0], h0[1]); w.y = cvt_pk_bf16(h0[2], h0[3]); w.z = cvt_pk_bf16(h1[0], h1[1]); w.w = cvt_pk_bf16(h1[2], h1[3]);
                    *(u32x4*)(rowp) = w;
                    w.x = cvt_pk_bf16(a0[0], a0[1]); w.y = cvt_pk_bf16(a0[2], a0[3]); w.z = cvt_pk_bf16(a1[0], a1[1]); w.w = cvt_pk_bf16(a1[2], a1[3]);
                    *(u32x4*)(rowp + HALF) = w; } }
    }
};
template <bool ADD> struct EpiG2 {
    static constexpr bool PERM = true, AFTER_DRAIN = false; static constexpr int PMODE = 1, KSPLIT = 0; static constexpr bool PREF = false;
    const bf16_t* QKG; bf16_t* MB; int goff;
    __device__ __forceinline__ void operator()(const f32x4 (&acc)[2][2][4][2], const Unit& u, int wr, int wc, int fr, int fq) const {
        const int row0 = u.pm * BM + wr * 64 + fr, col0 = u.pn * BM + wc * 32 + 8 * fq;
#pragma unroll
        for (int ai = 0; ai < 2; ++ai) {
            u32x4 gtv[4][2], mbv[4][2];
#pragma unroll
            for (int m = 0; m < 4; ++m) { const size_t row = (size_t)(row0 + ai * HALF + m * 16);
#pragma unroll
                for (int bj = 0; bj < 2; ++bj) { const int col = col0 + bj * HALF;
                    gtv[m][bj] = *(const u32x4*)(QKG + row * 7168 + goff + col);
                    if (ADD) mbv[m][bj] = *(const u32x4*)(MB + row * 2048 + col); } }
#pragma unroll
            for (int m = 0; m < 4; ++m) { const size_t row = (size_t)(row0 + ai * HALF + m * 16);
#pragma unroll
                for (int bj = 0; bj < 2; ++bj) { const int col = col0 + bj * HALF;
                    const u32x4 gt = gtv[m][bj];
                    f32x4 v0 = acc[ai][bj][m][0], v1 = acc[ai][bj][m][1];
                    v0[0] *= bflo(gt.x); v0[1] *= bfhi(gt.x); v0[2] *= bflo(gt.y); v0[3] *= bfhi(gt.y); v1[0] *= bflo(gt.z); v1[1] *= bfhi(gt.z); v1[2] *= bflo(gt.w); v1[3] *= bfhi(gt.w);
                    if (ADD) { const u32x4 mb = mbv[m][bj];
                        v0[0] += bflo(mb.x); v0[1] += bfhi(mb.x); v0[2] += bflo(mb.y); v0[3] += bfhi(mb.y); v1[0] += bflo(mb.z); v1[1] += bfhi(mb.z); v1[2] += bflo(mb.w); v1[3] += bfhi(mb.w); }
                    u32x4 w; w.x = cvt_pk_bf16(v0[0], v0[1]); w.y = cvt_pk_bf16(v0[2], v0[3]); w.z = cvt_pk_bf16(v1[0], v1[1]); w.w = cvt_pk_bf16(v1[2], v1[3]);
                    *(u32x4*)(MB + row * 2048 + col) = w; } }
        }
    }
};
struct EpiRes {
    static constexpr bool PERM = false, AFTER_DRAIN = false; static constexpr int PMODE = 0, KSPLIT = 0; static constexpr bool PREF = false;
    const float* xold; float* xnew; const float* gate;
    __device__ __forceinline__ void operator()(const f32x4 (&acc)[2][2][4][2], const Unit& u, int wr, int wc, int fr, int fq) const {
        const int row0 = u.pm * BM + wr * 64 + fr, col0 = u.pn * BM + wc * 32 + 4 * fq;
        const float* gp = gate + (size_t)(u.pm >> 4) * 12288 + col0;
        f32x4 gv[2][2];
#pragma unroll
        for (int bj = 0; bj < 2; ++bj)
#pragma unroll
            for (int n = 0; n < 2; ++n) gv[bj][n] = *(const f32x4*)(gp + bj * HALF + n * 16);
#pragma unroll
        for (int ai = 0; ai < 2; ++ai) {
            f32x4 xo[4][2][2];
#pragma unroll
            for (int m = 0; m < 4; ++m) { const size_t off = (size_t)(row0 + ai * HALF + m * 16) * 2048 + col0;
#pragma unroll
                for (int bj = 0; bj < 2; ++bj)
#pragma unroll
                    for (int n = 0; n < 2; ++n) xo[m][bj][n] = *(const f32x4*)(xold + off + bj * HALF + n * 16); }
#pragma unroll
            for (int m = 0; m < 4; ++m) { const size_t off = (size_t)(row0 + ai * HALF + m * 16) * 2048 + col0;
#pragma unroll
                for (int bj = 0; bj < 2; ++bj)
#pragma unroll
                    for (int n = 0; n < 2; ++n) *(f32x4*)(xnew + off + bj * HALF + n * 16) = xo[m][bj][n] + gv[bj][n] * acc[ai][bj][m][n]; }
        }
    }
};
template <bool F32IN> struct EpiResB {
    static constexpr bool PERM = true, AFTER_DRAIN = false; static constexpr int PMODE = 1, KSPLIT = 0; static constexpr bool PREF = false;
    const float* xin; const bf16_t* xold; bf16_t* xnew; const float* gate;
    __device__ __forceinline__ void operator()(const f32x4 (&acc)[2][2][4][2], const Unit& u, int wr, int wc, int fr, int fq) const {
        const int row0 = u.pm * BM + wr * 64 + fr, col0 = u.pn * BM + wc * 32 + 8 * fq;
        const float* gp = gate + (size_t)(u.pm >> 4) * 12288 + col0;
        f32x4 gv[2][2];
#pragma unroll
        for (int bj = 0; bj < 2; ++bj)
#pragma unroll
            for (int n = 0; n < 2; ++n) gv[bj][n] = *(const f32x4*)(gp + bj * HALF + n * 4);
        if constexpr (F32IN) {
#pragma unroll
            for (int ai = 0; ai < 2; ++ai) {
                f32x4 xo[4][2][2];
#pragma unroll
                for (int m = 0; m < 4; ++m) { const size_t off = (size_t)(row0 + ai * HALF + m * 16) * 2048 + col0;
#pragma unroll
                    for (int bj = 0; bj < 2; ++bj)
#pragma unroll
                        for (int n = 0; n < 2; ++n) xo[m][bj][n] = *(const f32x4*)(xin + off + bj * HALF + n * 4); }
#pragma unroll
                for (int m = 0; m < 4; ++m) { const size_t off = (size_t)(row0 + ai * HALF + m * 16) * 2048 + col0;
#pragma unroll
                    for (int bj = 0; bj < 2; ++bj) { const f32x4 v0 = xo[m][bj][0] + gv[bj][0] * acc[ai][bj][m][0], v1 = xo[m][bj][1] + gv[bj][1] * acc[ai][bj][m][1];
                        u32x4 w; w.x = pkh2(v0[0], v0[1]); w.y = pkh2(v0[2], v0[3]); w.z = pkh2(v1[0], v1[1]); w.w = pkh2(v1[2], v1[3]);
                        *(u32x4*)(xnew + off + bj * HALF) = w; } }
            }
        } else {
            u32x4 xo[2][4][2];
#pragma unroll
            for (int ai = 0; ai < 2; ++ai)
#pragma unroll
                for (int m = 0; m < 4; ++m) { const size_t off = (size_t)(row0 + ai * HALF + m * 16) * 2048 + col0;
#pragma unroll
                    for (int bj = 0; bj < 2; ++bj) xo[ai][m][bj] = *(const u32x4*)(xold + off + bj * HALF); }
#pragma unroll
            for (int ai = 0; ai < 2; ++ai)
#pragma unroll
                for (int m = 0; m < 4; ++m) { const size_t off = (size_t)(row0 + ai * HALF + m * 16) * 2048 + col0;
#pragma unroll
                    for (int bj = 0; bj < 2; ++bj) { const u32x4 o = xo[ai][m][bj]; const f32x4 a0 = acc[ai][bj][m][0], a1 = acc[ai][bj][m][1], g0 = gv[bj][0], g1 = gv[bj][1];
                        u32x4 w;
                        w.x = pkh2(hlo(o.x) + g0[0] * a0[0], hhi(o.x) + g0[1] * a0[1]); w.y = pkh2(hlo(o.y) + g0[2] * a0[2], hhi(o.y) + g0[3] * a0[3]);
                        w.z = pkh2(hlo(o.z) + g1[0] * a1[0], hhi(o.z) + g1[1] * a1[1]); w.w = pkh2(hlo(o.w) + g1[2] * a1[2], hhi(o.w) + g1[3] * a1[3]);
                        *(u32x4*)(xnew + off + bj * HALF) = w; } }
        }
    }
};
struct PanelOrder {
    int nwg, G, c;
    __host__ __device__ void init(int M, int N, int G_, int c_) { nwg = (M / BM) * (N / BM); G = G_; c = c_; }
    __host__ __device__ __attribute__((always_inline)) bool next(int i, Unit& u) const {
        const int L = i * G + c; if (L >= nwg) return false;
        const int x = c & 7, r = c >> 3, ppx = G >> 6;
        u.pm = ((i * G) >> 3) + x * ppx + (r % ppx); u.pn = r / ppx; return true;
    }
    __device__ __forceinline__ void a_ready(const Unit&) const {}
    __device__ __forceinline__ void done(const Unit&) const {}
};
template <bool F32IN> struct EpiResN {
    static constexpr bool PERM = true, AFTER_DRAIN = false; static constexpr int PMODE = 1, KSPLIT = 0; static constexpr bool PREF = true;
    const float* xin; const bf16_t* xold; bf16_t* xnew; bf16_t* hout; const float* modb; const float* gn; int goff; float* part; unsigned* cnt; unsigned want; unsigned* tmo;
    __device__ __forceinline__ void prefetch(const Unit& u, int buf, PG8_LAS unsigned char* lds, int wid, int lane) const {
        if (wid < 4) { asm volatile("v_mbcnt_lo_u32_b32 %0, -1, 0\n\tv_mbcnt_hi_u32_b32 %0, -1, %0" : "=v"(lane));
            const float* base = wid == 1 ? gn + u.pn * BM : modb + (size_t)(u.pm >> 4) * 12288 + u.pn * BM + (wid == 0 ? goff : wid == 2 ? 4 * 2048 : 3 * 2048);
            __builtin_amdgcn_global_load_lds((const unsigned*)(base + lane * 4), (PG8_LAS unsigned*)(lds + EPI_LDS_OFF + buf * 4096 + wid * 1024), 16, 0, 0); }
    }
    __device__ __forceinline__ void run(f32x4 (&acc)[2][2][4][2], const Unit& u, int wr, int wc, int fr, int fq, PG8_LAS unsigned char* lds, int buf) const {
        { int l_; asm volatile("v_mbcnt_lo_u32_b32 %0, -1, 0\n\tv_mbcnt_hi_u32_b32 %0, -1, %0" : "=v"(l_)); fr = l_ & 15; fq = l_ >> 4; }
        const int wid = wr * 4 + wc;
        PG8_LAS float* P = (PG8_LAS float*)(lds + EPI_LDS_OFF + 8192);
        PG8_LAS float* S = (PG8_LAS float*)(lds + EPI_LDS_OFF + 12288);
        PG8_LAS unsigned* flag = (PG8_LAS unsigned*)(lds + EPI_LDS_OFF + 13312);
        { const int row0 = u.pm * BM + wr * 64 + fr, col0 = u.pn * BM + wc * 32 + 8 * fq;
        const PG8_LAS float* vb = (const PG8_LAS float*)(lds + EPI_LDS_OFF + buf * 4096) + wc * 32 + 8 * fq;
        f32x4 gv[2][2];
#pragma unroll
        for (int bj = 0; bj < 2; ++bj)
#pragma unroll
            for (int n = 0; n < 2; ++n) gv[bj][n] = *(const PG8_LAS f32x4*)(vb + bj * HALF + 4 * n);
        if constexpr (F32IN) {
#pragma unroll
            for (int ai = 0; ai < 2; ++ai)
#pragma unroll
                for (int mh = 0; mh < 2; ++mh) {
                    f32x4 xo[2][2][2];
#pragma unroll
                    for (int mm = 0; mm < 2; ++mm) { const unsigned off = (unsigned)(row0 + ai * HALF + (2 * mh + mm) * 16) * 2048u + (unsigned)col0;
#pragma unroll
                        for (int bj = 0; bj < 2; ++bj)
#pragma unroll
                            for (int n = 0; n < 2; ++n) xo[mm][bj][n] = *(const f32x4*)(xin + off + bj * HALF + n * 4); }
#pragma unroll
                    for (int mm = 0; mm < 2; ++mm)
#pragma unroll
                        for (int bj = 0; bj < 2; ++bj)
#pragma unroll
                            for (int n = 0; n < 2; ++n) acc[ai][bj][2 * mh + mm][n] = xo[mm][bj][n] + gv[bj][n] * acc[ai][bj][2 * mh + mm][n];
                    asm volatile("" ::: "memory");
                }
        } else {
            u32x4 xo[2][4][2];
#pragma unroll
            for (int ai = 0; ai < 2; ++ai)
#pragma unroll
                for (int m = 0; m < 4; ++m) { const unsigned off = (unsigned)(row0 + ai * HALF + m * 16) * 2048u + (unsigned)col0;
#pragma unroll
                    for (int bj = 0; bj < 2; ++bj) xo[ai][m][bj] = *(const u32x4*)(xold + off + bj * HALF); }
#pragma unroll
            for (int ai = 0; ai < 2; ++ai)
#pragma unroll
                for (int m = 0; m < 4; ++m)
#pragma unroll
                    for (int bj = 0; bj < 2; ++bj) { const u32x4 o = xo[ai][m][bj];
                        const f32x4 x0 = (f32x4){hlo(o.x), hhi(o.x), hlo(o.y), hhi(o.y)}, x1 = (f32x4){hlo(o.z), hhi(o.z), hlo(o.w), hhi(o.w)};
                        acc[ai][bj][m][0] = x0 + gv[bj][0] * acc[ai][bj][m][0]; acc[ai][bj][m][1] = x1 + gv[bj][1] * acc[ai][bj][m][1]; }
        }
        }
        __builtin_amdgcn_sched_barrier(0);
        asm volatile("" : "+v"(fr), "+v"(fq));
        const int lane = fq * 16 + fr;
#pragma unroll
        for (int ai = 0; ai < 2; ++ai)
#pragma unroll
            for (int m = 0; m < 4; ++m) { float q = 0.f;
#pragma unroll
                for (int bj = 0; bj < 2; ++bj)
#pragma unroll
                    for (int n = 0; n < 2; ++n) { const f32x4 x = acc[ai][bj][m][n]; q += (x[0] * x[0] + x[1] * x[1]) + (x[2] * x[2] + x[3] * x[3]); }
                q += shfl_from(q, lane ^ 16); q += shfl_from(q, lane ^ 32);
                if (fq == 0) P[(ai * HALF + wr * 64 + m * 16 + fr) * 4 + wc] = q; }
        asm volatile("s_waitcnt lgkmcnt(0)" ::: "memory"); __builtin_amdgcn_s_barrier(); asm volatile("" ::: "memory");
        const int t = wid * 64 + lane;
        if (wid < 4) { const f32x4 p = *(const PG8_LAS f32x4*)(P + t * 4);
            __hip_atomic_store((unsigned*)part + ((size_t)u.pm * BM + t) * 8 + u.pn, __float_as_uint((p[0] + p[1]) + (p[2] + p[3])), __ATOMIC_RELAXED, __HIP_MEMORY_SCOPE_AGENT);
            asm volatile("s_waitcnt vmcnt(0)" ::: "memory");
            if (lane == 0) __hip_atomic_fetch_add(cnt + 64 * u.pm, 1u, __ATOMIC_RELAXED, __HIP_MEMORY_SCOPE_AGENT); }
        if (wid == 0) {
            unsigned got, it_; unsigned tmpv; const unsigned* cp = cnt + 64 * u.pm;
            asm volatile("s_mov_b32 %2, 0\n.Lpw%=: global_load_dword %0, %3, off sc1\n\ts_waitcnt vmcnt(0)\n\tv_readfirstlane_b32 %1, %0\n\ts_cmp_ge_u32 %1, %4\n\ts_cbranch_scc1 .Lpd%=\n\ts_sleep 2\n\ts_add_u32 %2, %2, 1\n\ts_cmp_lt_u32 %2, 0x40000\n\ts_cbranch_scc1 .Lpw%=\n.Lpd%=:"
                         : "=&v"(tmpv), "=&s"(got), "=&s"(it_) : "v"(cp), "s"(want) : "scc", "memory");
            const bool dead = got < want;
            if (dead && lane == 0) __hip_atomic_store(tmo, 1u, __ATOMIC_RELAXED, __HIP_MEMORY_SCOPE_AGENT);
            __builtin_amdgcn_fence(__ATOMIC_ACQUIRE, "agent");
            if (lane == 0) flag[0] = dead ? 1u : 0u; }
        asm volatile("s_waitcnt vmcnt(0) lgkmcnt(0)" ::: "memory"); __builtin_amdgcn_s_barrier(); asm volatile("" ::: "memory");
        const bool bad = flag[0] != 0u;
        if (wid < 4) { const unsigned long long* sl = (const unsigned long long*)((const unsigned*)part + ((size_t)u.pm * BM + t) * 8); float q = 0.f;
#pragma unroll
            for (int k = 0; k < 4; ++k) { const unsigned long long w = __hip_atomic_load(sl + k, __ATOMIC_RELAXED, __HIP_MEMORY_SCOPE_AGENT); q += __uint_as_float((unsigned)w) + __uint_as_float((unsigned)(w >> 32)); }
            S[t] = 1.0f / sqrtf(q * (1.0f / 2048.0f) + 1e-6f); }
        asm volatile("s_waitcnt vmcnt(0) lgkmcnt(0)" ::: "memory"); __builtin_amdgcn_s_barrier(); asm volatile("" ::: "memory");
        __builtin_amdgcn_sched_barrier(0);
        asm volatile("" : "+v"(fr), "+v"(fq));
        const int row0 = u.pm * BM + wr * 64 + fr, col0 = u.pn * BM + wc * 32 + 8 * fq;
        const PG8_LAS float* vb = (const PG8_LAS float*)(lds + EPI_LDS_OFF + buf * 4096) + wc * 32 + 8 * fq;
        f32x4 gs[2][2], sh[2][2];
#pragma unroll
        for (int bj = 0; bj < 2; ++bj)
#pragma unroll
            for (int n = 0; n < 2; ++n) { gs[bj][n] = *(const PG8_LAS f32x4*)(vb + 256 + bj * HALF + 4 * n) * (*(const PG8_LAS f32x4*)(vb + 512 + bj * HALF + 4 * n) + 1.0f); sh[bj][n] = *(const PG8_LAS f32x4*)(vb + 768 + bj * HALF + 4 * n); }
        const float qnan = __builtin_nanf("");
#pragma unroll
        for (int ai = 0; ai < 2; ++ai)
#pragma unroll
            for (int m = 0; m < 4; ++m) { const float rstd = bad ? qnan : S[ai * HALF + wr * 64 + m * 16 + fr]; const unsigned off = (unsigned)(row0 + ai * HALF + m * 16) * 2048u + (unsigned)col0;
#pragma unroll
                for (int bj = 0; bj < 2; ++bj) { const f32x4 x0 = acc[ai][bj][m][0], x1 = acc[ai][bj][m][1];
                    u32x4 w; w.x = pkh2(x0[0], x0[1]); w.y = pkh2(x0[2], x0[3]); w.z = pkh2(x1[0], x1[1]); w.w = pkh2(x1[2], x1[3]);
                    *(u32x4*)(xnew + off + bj * HALF) = w;
                    const f32x4 h0 = x0 * rstd * gs[bj][0] + sh[bj][0], h1 = x1 * rstd * gs[bj][1] + sh[bj][1];
                    w.x = cvt_pk_bf16(h0[0], h0[1]); w.y = cvt_pk_bf16(h0[2], h0[3]); w.z = cvt_pk_bf16(h1[0], h1[1]); w.w = cvt_pk_bf16(h1[2], h1[3]);
                    *(u32x4*)(hout + off + bj * HALF) = w; } }
    }
};
struct EpiPlain {
    static constexpr bool PERM = true, AFTER_DRAIN = false; static constexpr int PMODE = 1, KSPLIT = 0; static constexpr bool PREF = false;
    bf16_t* O; int ldc;
    __device__ __forceinline__ void operator()(const f32x4 (&acc)[2][2][4][2], const Unit& u, int wr, int wc, int fr, int fq) const {
        const int row0 = u.pm * BM + wr * 64 + fr, col0 = u.pn * BM + wc * 32 + 8 * fq;
#pragma unroll
        for (int ai = 0; ai < 2; ++ai)
#pragma unroll
            for (int m = 0; m < 4; ++m) { bf16_t* rowp = O + (size_t)(row0 + ai * HALF + m * 16) * ldc + col0;
#pragma unroll
                for (int bj = 0; bj < 2; ++bj) { const f32x4 v0 = acc[ai][bj][m][0], v1 = acc[ai][bj][m][1];
                    u32x4 w; w.x = cvt_pk_bf16(v0[0], v0[1]); w.y = cvt_pk_bf16(v0[2], v0[3]); w.z = cvt_pk_bf16(v1[0], v1[1]); w.w = cvt_pk_bf16(v1[2], v1[3]);
                    *(u32x4*)(rowp + bj * HALF) = w; } }
    }
};

struct EpiUpCG {
    static constexpr bool PERM = true, AFTER_DRAIN = false; static constexpr int PMODE = 1, KSPLIT = 0; static constexpr bool PREF = true;
    bf16_t* ACT; bf16_t* GB; const float* cw; const float* cb;
    __device__ __forceinline__ void prefetch(const Unit& u, int buf, PG8_LAS unsigned char* lds, int wid, int lane) const {
        if (wid < 2) { const int v = 2 * wid + (lane >> 5);
            const float* src = (v < 3 ? cw + v * 5632 : cb) + u.pn * 128 + (lane & 31) * 4;
            __builtin_amdgcn_global_load_lds((const unsigned*)src, (PG8_LAS unsigned*)(lds + EPI_LDS_OFF + buf * 2048 + wid * 1024), 16, 0, 0); }
    }
    __device__ __forceinline__ void run(const f32x4 (&acc)[2][2][4][2], const Unit& u, int wr, int wc, int fr, int fq, PG8_LAS unsigned char* lds, int buf) const {
        const int row0 = u.pm * BM + wr * 64 + fr, ch0 = u.pn * 128 + wc * 32 + 8 * fq;
        const PG8_LAS float* vl = (const PG8_LAS float*)(lds + EPI_LDS_OFF + buf * 2048) + wc * 32 + 8 * fq;
        const int lane = fq * 16 + fr, lup = (lane & 48) | ((lane - 1) & 15), ldn = (lane & 48) | ((lane + 1) & 15);
        f32x4 w0[2], w1[2], w2[2], bb[2];
#pragma unroll
        for (int n = 0; n < 2; ++n) { w0[n] = *(const PG8_LAS f32x4*)(vl + 4 * n); w1[n] = *(const PG8_LAS f32x4*)(vl + 128 + 4 * n); w2[n] = *(const PG8_LAS f32x4*)(vl + 256 + 4 * n); bb[n] = *(const PG8_LAS f32x4*)(vl + 384 + 4 * n); }
#pragma unroll
        for (int ai = 0; ai < 2; ++ai) {
            unsigned op[4][2][2];
#pragma unroll
            for (int n = 0; n < 2; ++n)
#pragma unroll
                for (int ep = 0; ep < 2; ++ep) {
                    float ov[4][2], xv[4][2];
#pragma unroll
                    for (int eh = 0; eh < 2; ++eh) { const int e = 2 * ep + eh;
                        float R[4], L[4];
#pragma unroll
                        for (int m = 0; m < 4; ++m) { R[m] = dpp_ror<1>(acc[ai][1][m][n][e]); L[m] = dpp_ror<15>(acc[ai][1][m][n][e]); }
#pragma unroll
                        for (int m = 0; m < 4; ++m) {
                            const float up = (fr == 0) ? R[m > 0 ? m - 1 : 0] : R[m];
                            const float dn = (fr == 15) ? L[m < 3 ? m + 1 : 3] : L[m];
                            xv[m][eh] = up * w0[n][e] + acc[ai][1][m][n][e] * w1[n][e] + dn * w2[n][e] + bb[n][e];
                        } }
#pragma unroll
                    for (int m = 0; m < 4; ++m) {
                        const float p0 = __builtin_amdgcn_exp2f(fminf(-1.4426950408889634f * xv[m][0], 60.0f)) + 1.0f, p1 = __builtin_amdgcn_exp2f(fminf(-1.4426950408889634f * xv[m][1], 60.0f)) + 1.0f;
                        const float r = __builtin_amdgcn_rcpf(p0 * p1);
                        const bool edge = (m == 0 && fr == 0) || (m == 3 && fr == 15);
                        ov[m][0] = edge ? acc[ai][0][m][n][2 * ep] : xv[m][0] * (r * p1) * acc[ai][0][m][n][2 * ep];
                        ov[m][1] = edge ? acc[ai][0][m][n][2 * ep + 1] : xv[m][1] * (r * p0) * acc[ai][0][m][n][2 * ep + 1];
                    }
#pragma unroll
                    for (int m = 0; m < 4; ++m) op[m][n][ep] = cvt_pk_bf16(ov[m][0], ov[m][1]);
                    __builtin_amdgcn_sched_barrier(0);
                }
#pragma unroll
            for (int m = 0; m < 4; ++m) {
                u32x4 w; w.x = op[m][0][0]; w.y = op[m][0][1]; w.z = op[m][1][0]; w.w = op[m][1][1];
                *(u32x4*)(ACT + (size_t)(row0 + ai * HALF + m * 16) * 5632 + ch0) = w;
            }
            const int grp = u.pm * 4 + ai * 2 + wr;
            if (fr <= 1) { const f32x4 g0 = acc[ai][1][0][0], g1 = acc[ai][1][0][1];
                u32x4 w; w.x = cvt_pk_bf16(g0[0], g0[1]); w.y = cvt_pk_bf16(g0[2], g0[3]); w.z = cvt_pk_bf16(g1[0], g1[1]); w.w = cvt_pk_bf16(g1[2], g1[3]);
                *(u32x4*)(GB + ((size_t)(grp * 4 + fr)) * 5632 + ch0) = w; }
            if (fr >= 14) { const f32x4 g0 = acc[ai][1][3][0], g1 = acc[ai][1][3][1];
                u32x4 w; w.x = cvt_pk_bf16(g0[0], g0[1]); w.y = cvt_pk_bf16(g0[2], g0[3]); w.z = cvt_pk_bf16(g1[0], g1[1]); w.w = cvt_pk_bf16(g1[2], g1[3]);
                *(u32x4*)(GB + ((size_t)(grp * 4 + fr - 12)) * 5632 + ch0) = w; }
        }
    }
};

struct EpiG2M {
    static constexpr bool PERM = true, AFTER_DRAIN = false; static constexpr int PMODE = 1, KSPLIT = 1024; static constexpr bool PREF = false;
    const bf16_t* QKG; bf16_t* MB;
    __device__ __forceinline__ void midk(f32x4 (&acc)[2][2][4][2], const Unit& u, int wr, int wc, int fr, int fq) const {
        asm volatile("" : "+v"(fr), "+v"(fq));
        scale<0>(acc, u, wr, wc, fr, fq);
    }
    template <int WHICH> __device__ __forceinline__ void scale(f32x4 (&acc)[2][2][4][2], const Unit& u, int wr, int wc, int fr, int fq) const {
        const int row0 = u.pm * BM + wr * 64 + fr, gcol = 3072 + u.pn * 512 + WHICH * 128 + wc * 32 + 8 * fq;
        u32x4 g[2][4][2];
#pragma unroll
        for (int ai = 0; ai < 2; ++ai)
#pragma unroll
            for (int m = 0; m < 4; ++m)
#pragma unroll
                for (int bj = 0; bj < 2; ++bj) g[ai][m][bj] = *(const u32x4*)(QKG + (size_t)(row0 + ai * HALF + m * 16) * 7168 + gcol + bj * 256);
#pragma unroll
        for (int ai = 0; ai < 2; ++ai)
#pragma unroll
            for (int m = 0; m < 4; ++m)
#pragma unroll
                for (int bj = 0; bj < 2; ++bj) {
                    const unsigned gw[4] = {g[ai][m][bj].x, g[ai][m][bj].y, g[ai][m][bj].z, g[ai][m][bj].w};
#pragma unroll
                    for (int j = 0; j < 4; ++j) { acc[ai][bj][m][j >> 1][(2 * j) & 3] *= bflo(gw[j]); acc[ai][bj][m][j >> 1][(2 * j + 1) & 3] *= bfhi(gw[j]); }
                }
    }
    __device__ __forceinline__ void operator()(f32x4 (&acc)[2][2][4][2], const Unit& u, int wr, int wc, int fr, int fq) const {
        scale<1>(acc, u, wr, wc, fr, fq);
        const int row0 = u.pm * BM + wr * 64 + fr, col0 = u.pn * BM + wc * 32 + 8 * fq;
#pragma unroll
        for (int ai = 0; ai < 2; ++ai)
#pragma unroll
            for (int m = 0; m < 4; ++m)
#pragma unroll
                for (int bj = 0; bj < 2; ++bj) { const f32x4 v0 = acc[ai][bj][m][0], v1 = acc[ai][bj][m][1];
                    u32x4 w; w.x = cvt_pk_bf16(v0[0], v0[1]); w.y = cvt_pk_bf16(v0[2], v0[3]); w.z = cvt_pk_bf16(v1[0], v1[1]); w.w = cvt_pk_bf16(v1[2], v1[3]);
                    *(u32x4*)(MB + (size_t)(row0 + ai * HALF + m * 16) * 2048 + col0 + bj * HALF) = w; }
    }
};
template <class Epi, class Sched, bool ALIGN_EPI = false, bool SP2 = false>
__device__ __forceinline__ void gemm_phase(PG8_LAS unsigned char* lds, const Gemm g, const Sched& S, const Epi& E, const int tid_in) {
    int tid_l = tid_in; asm volatile("" : "+v"(tid_l));
    const int tid = tid_l, wid = __builtin_amdgcn_readfirstlane(tid >> 6), lane = tid & 63, wr = wid >> 2, wc = wid & 3, fr = lane & 15, fq = lane >> 4;
    const int K = g.K, nt = K / BK;
    unsigned voffA[2], voffB[2];
#pragma unroll
    for (int i = 0; i < 2; ++i) { int R, C; stage_rc(tid * 16 + i * 8192, R, C); const int Rb = perm_row<Epi::PMODE>(R);
        voffA[i] = (unsigned)(R * K + C) * 2u; voffB[i] = (unsigned)(Rb * K + C) * 2u; }
    const size_t kstep = (size_t)(BK * 2);
    const size_t hstep = (size_t)HALF * K * 2;
    const size_t tstep = 2 * hstep;
    const unsigned ldsw = (unsigned)wid * 1024u;
    const int aoff = lds_byte(wr * 64 + fr, fq * 8), boff = lds_byte(wc * 32 + fr, fq * 8);
#define PG8_SA(b, h) (((b) * 2 + (h)) * HTB)
#define PG8_SB(b, h) ((4 + (b) * 2 + (h)) * HTB)
#define PG8_STAGE(bufoff, gbase, voff) do { _Pragma("unroll") for (int _i = 0; _i < 2; ++_i) \
        __builtin_amdgcn_global_load_lds((const unsigned*)((const char*)(gbase) + (voff)[_i]), (PG8_LAS unsigned*)(lds + (bufoff) + ldsw + _i * 8192), 16, 0, 0); } while (0)
#define PG8_LDA(dst, b, h) do { _Pragma("unroll") for (int m = 0; m < 4; ++m) _Pragma("unroll") for (int k = 0; k < 2; ++k) dst[m][k] = *(const PG8_LAS bf16x8*)(lds + PG8_SA(b, h) + aoff + m * 2048 + k * 1024); } while (0)
#define PG8_LDB(dst, b, h) do { _Pragma("unroll") for (int n = 0; n < 2; ++n) _Pragma("unroll") for (int k = 0; k < 2; ++k) dst[n][k] = *(const PG8_LAS bf16x8*)(lds + PG8_SB(b, h) + boff + n * 2048 + k * 1024); } while (0)
#define PG8_MMA(ai, bj, At, Bt) do { __builtin_amdgcn_s_setprio(1); _Pragma("unroll") for (int m = 0; m < 4; ++m) _Pragma("unroll") for (int n = 0; n < 2; ++n) _Pragma("unroll") for (int k = 0; k < 2; ++k) \
        acc[ai][bj][m][n] = __builtin_amdgcn_mfma_f32_16x16x32_bf16(Bt[n][k], At[m][k], acc[ai][bj][m][n], 0, 0, 0); __builtin_amdgcn_s_setprio(0); } while (0)
#define PG8_WAIT_V(n) asm volatile("s_waitcnt vmcnt(" #n ")" ::: "memory")
#define PG8_WAIT_L(n) asm volatile("s_waitcnt lgkmcnt(" #n ")" ::: "memory")
#define PG8_BAR __builtin_amdgcn_s_barrier()
#define PG8_SCHED __builtin_amdgcn_sched_barrier(0)
    Unit cur, nxt; int ui = 0;
    if (!S.next(0, cur)) return;
    f32x4 acc[2][2][4][2];
#pragma unroll
    for (int a = 0; a < 2; ++a)
#pragma unroll
        for (int b = 0; b < 2; ++b)
#pragma unroll
            for (int m = 0; m < 4; ++m)
#pragma unroll
                for (int n = 0; n < 2; ++n) acc[a][b][m][n] = (f32x4){0.f, 0.f, 0.f, 0.f};
    bf16x8 At[4][2], B0[2][2], B1[2][2];
    const char* cA = (const char*)g.A + (size_t)cur.pm * tstep; const char* cB = (const char*)g.Bt + (size_t)cur.pn * tstep;
    S.a_ready(cur);
    if constexpr (Epi::PREF) E.prefetch(cur, 0, lds, wid, lane);
    if constexpr (SP2) {
        PG8_STAGE(PG8_SB(0, 0), cB, voffB); PG8_STAGE(PG8_SB(0, 1), cB + hstep, voffB); PG8_STAGE(PG8_SA(0, 0), cA, voffA); PG8_STAGE(PG8_SA(0, 1), cA + hstep, voffA);
        if (wr == 1) PG8_BAR;
        PG8_WAIT_V(2); PG8_BAR;
        PG8_STAGE(PG8_SB(1, 0), cB + kstep, voffB); PG8_STAGE(PG8_SA(1, 0), cA + kstep, voffA); PG8_STAGE(PG8_SB(1, 1), cB + hstep + kstep, voffB);
        PG8_WAIT_V(6); PG8_BAR;
    } else {
        PG8_STAGE(PG8_SB(0, 0), cB, voffB); PG8_STAGE(PG8_SA(0, 0), cA, voffA); PG8_STAGE(PG8_SB(0, 1), cB + hstep, voffB); PG8_STAGE(PG8_SA(0, 1), cA + hstep, voffA);
        if (wr == 1) PG8_BAR;
        PG8_WAIT_V(4); PG8_BAR;
        PG8_STAGE(PG8_SB(1, 0), cB + kstep, voffB); PG8_STAGE(PG8_SA(1, 0), cA + kstep, voffA); PG8_STAGE(PG8_SB(1, 1), cB + hstep + kstep, voffB);
        PG8_WAIT_V(6); PG8_BAR;
    }
    for (;;) {
        const bool has_next = S.next(ui + 1, nxt);
        const char* nA = has_next ? (const char*)g.A + (size_t)nxt.pm * tstep : cA; const char* nB = has_next ? (const char*)g.Bt + (size_t)nxt.pn * tstep : cB;
        for (int t = 0; t < nt; t += 2) {
            if constexpr (Epi::KSPLIT > 0) { if (t == Epi::KSPLIT / BK) E.midk(acc, cur, wr, wc, fr, fq); }
            const bool last = (t == nt - 2);
            const char* a1 = cA + (size_t)(t + 1) * kstep;
            const char* a2 = last ? nA : cA + (size_t)(t + 2) * kstep; const char* b2 = last ? nB : cB + (size_t)(t + 2) * kstep;
            const char* a3 = a2 + kstep; const char* b3 = b2 + kstep;
            if (last && has_next) S.a_ready(nxt);
            if constexpr (SP2) {
            PG8_LDB(B0, 0, 0); PG8_LDB(B1, 0, 1); PG8_SCHED; PG8_LDA(At, 0, 0); PG8_STAGE(PG8_SA(1, 1), a1 + hstep, voffA);
            PG8_WAIT_V(8); PG8_WAIT_L(0); PG8_BAR; PG8_MMA(0, 0, At, B0); PG8_MMA(0, 1, At, B1); PG8_BAR; PG8_SCHED;
            PG8_LDA(At, 0, 1); PG8_STAGE(PG8_SB(0, 0), b2, voffB); PG8_STAGE(PG8_SB(0, 1), b2 + hstep, voffB); PG8_STAGE(PG8_SA(0, 0), a2, voffA);
            PG8_WAIT_V(8); PG8_WAIT_L(0); PG8_BAR; PG8_MMA(1, 0, At, B0); PG8_MMA(1, 1, At, B1); PG8_BAR; PG8_SCHED;
            PG8_LDB(B0, 1, 0); PG8_LDB(B1, 1, 1); PG8_SCHED; PG8_LDA(At, 1, 0); PG8_STAGE(PG8_SA(0, 1), a2 + hstep, voffA);
            PG8_WAIT_V(8); PG8_WAIT_L(0); PG8_BAR; PG8_MMA(0, 0, At, B0); PG8_MMA(0, 1, At, B1); PG8_BAR; PG8_SCHED;
            PG8_LDA(At, 1, 1); PG8_STAGE(PG8_SB(1, 0), b3, voffB); PG8_STAGE(PG8_SB(1, 1), b3 + hstep, voffB); PG8_STAGE(PG8_SA(1, 0), a3, voffA);
            PG8_WAIT_V(8); PG8_WAIT_L(0); PG8_BAR; PG8_MMA(1, 0, At, B0); PG8_MMA(1, 1, At, B1); PG8_BAR; PG8_SCHED;
            } else {
            PG8_LDB(B0, 0, 0); PG8_SCHED; PG8_LDA(At, 0, 0); PG8_STAGE(PG8_SA(1, 1), a1 + hstep, voffA);
            PG8_WAIT_L(8); PG8_BAR; PG8_WAIT_L(0); PG8_MMA(0, 0, At, B0); PG8_BAR; PG8_SCHED;
            PG8_LDB(B1, 0, 1); PG8_STAGE(PG8_SB(0, 0), b2, voffB);
            PG8_BAR; PG8_WAIT_L(0); PG8_MMA(0, 1, At, B1); PG8_BAR;
            PG8_LDA(At, 0, 1); PG8_STAGE(PG8_SA(0, 0), a2, voffA);
            PG8_BAR; PG8_WAIT_L(0); PG8_MMA(1, 0, At, B0); PG8_BAR; PG8_SCHED;
            PG8_STAGE(PG8_SB(0, 1), b2 + hstep, voffB);
            PG8_WAIT_V(6); PG8_BAR; PG8_MMA(1, 1, At, B1); PG8_BAR;
            PG8_LDB(B0, 1, 0); PG8_SCHED; PG8_LDA(At, 1, 0); PG8_STAGE(PG8_SA(0, 1), a2 + hstep, voffA);
            PG8_WAIT_L(8); PG8_BAR; PG8_WAIT_L(0); PG8_MMA(0, 0, At, B0); PG8_BAR; PG8_SCHED;
            PG8_LDB(B1, 1, 1); PG8_STAGE(PG8_SB(1, 0), b3, voffB);
            PG8_BAR; PG8_WAIT_L(0); PG8_MMA(0, 1, At, B1); PG8_BAR;
            PG8_LDA(At, 1, 1); PG8_STAGE(PG8_SA(1, 0), a3, voffA);
            PG8_BAR; PG8_WAIT_L(0); PG8_MMA(1, 0, At, B0); PG8_BAR; PG8_SCHED;
            PG8_STAGE(PG8_SB(1, 1), b3 + hstep, voffB);
            PG8_WAIT_V(6); PG8_BAR; PG8_MMA(1, 1, At, B1); PG8_BAR;
            }
        }
        if constexpr (ALIGN_EPI) { if (wr == 0) PG8_BAR; }
        if constexpr (Epi::PREF) { if (has_next) E.prefetch(nxt, (ui + 1) & 1, lds, wid, lane); E.run(acc, cur, wr, wc, fr, fq, lds, ui & 1); S.done(cur); }
        else if constexpr (!Epi::AFTER_DRAIN) { E(acc, cur, wr, wc, fr, fq); S.done(cur); }
        if (!has_next) break;
#pragma unroll
        for (int a = 0; a < 2; ++a)
#pragma unroll
            for (int b = 0; b < 2; ++b)
#pragma unroll
                for (int m = 0; m < 4; ++m)
#pragma unroll
                    for (int n = 0; n < 2; ++n) acc[a][b][m][n] = (f32x4){0.f, 0.f, 0.f, 0.f};
        cur = nxt; cA = nA; cB = nB; ++ui;
        if constexpr (ALIGN_EPI) { if (wr == 1) PG8_BAR; }
    }
    PG8_WAIT_V(0);
    if constexpr (!ALIGN_EPI) { if (wr == 0) PG8_BAR; }
    PG8_BAR;
    if constexpr (Epi::AFTER_DRAIN) { E.fused(acc, cur, wr, wc, fr, fq, lds, wid, lane); S.done(cur); }
#undef PG8_SA
#undef PG8_SB
#undef PG8_STAGE
#undef PG8_LDA
#undef PG8_LDB
#undef PG8_MMA
#undef PG8_WAIT_V
#undef PG8_WAIT_L
#undef PG8_BAR
#undef PG8_SCHED
}
}

#define XB_TMO      128
#define XB_XCNT(j)  (256  + 64 * (j))
#define XB_XSUB(j)  (1280 + 64 * (j))
#define XB_XGEN(j)  (2304 + 64 * (j))
#define XB_TOP      3328
#define XB_TOPGEN   3392
#define XCD_BAR_WORDS 3456
#define XB_SPIN_CAP (1u << 18)

__device__ __forceinline__ unsigned xb_ld(unsigned* p)              { return __hip_atomic_load(p, __ATOMIC_RELAXED, __HIP_MEMORY_SCOPE_AGENT); }
__device__ __forceinline__ unsigned xb_add(unsigned* p, unsigned v) { return __hip_atomic_fetch_add(p, v, __ATOMIC_RELAXED, __HIP_MEMORY_SCOPE_AGENT); }
__device__ __forceinline__ unsigned xb_xcc_id() { return (unsigned)__builtin_amdgcn_s_getreg((3 << 11) | 20) & 0xFu; }
#define XB_SPIN(cond, bar) do { unsigned _sp = 0; while (cond) { __builtin_amdgcn_s_sleep(1); \
    if ((++_sp & 255u) == 0u) { if (xb_ld(&(bar)[XB_TMO])) break; if (_sp > XB_SPIN_CAP) { atomicAdd(&(bar)[XB_TMO], 1u); break; } } } } while (0)

struct XcdBarrier {
    unsigned* bar; unsigned x;
    volatile LAS unsigned* st;
};

__device__ __forceinline__ XcdBarrier xcd_barrier_post(unsigned* bar, volatile LAS unsigned* st) {
    XcdBarrier b; b.bar = bar; b.x = xb_xcc_id(); b.st = st;
    if (threadIdx.x == 0) (void)xb_add(&bar[XB_XCNT(b.x)], 1u);
    return b;
}
__device__ __forceinline__ void xcd_barrier_complete(unsigned* bar, unsigned x, unsigned& nloc, unsigned& nx) {
    const unsigned G = gridDim.x * gridDim.y * gridDim.z;
    unsigned sum, cnt, mine, sp = 0u;
    for (;;) {
        sum = 0u; cnt = 0u; mine = 0u;
#pragma unroll
        for (unsigned j = 0; j < 16; ++j) { const unsigned c = xb_ld(&bar[XB_XCNT(j)]); sum += c; cnt += (c > 0u) ? 1u : 0u; mine = (j == x) ? c : mine; }
        if (sum == G) break;
        __builtin_amdgcn_s_sleep(1);
        if ((++sp & 255u) == 0u) { if (xb_ld(&bar[XB_TMO])) break; if (sp > XB_SPIN_CAP) { atomicAdd(&bar[XB_TMO], 1u); break; } }
    }
    nloc = mine > 0u ? mine : 1u; nx = cnt > 0u ? cnt : 1u;
}

__device__ __forceinline__ void xcd_barrier(const XcdBarrier& b, const bool leader) {
    asm volatile("s_waitcnt vmcnt(0)" ::: "memory");
    __syncthreads();
    if (leader) {
        unsigned* bar = b.bar;
        __builtin_amdgcn_s_waitcnt(0);
        unsigned nloc = b.st[0], nx = b.st[1];
        if (nloc == 0u) { xcd_barrier_complete(bar, b.x, nloc, nx); b.st[0] = nloc; b.st[1] = nx; }
        const unsigned old = xb_add(&bar[XB_XSUB(b.x)], 1u);
        const unsigned gen = old / nloc;
        if (old + 1u == (gen + 1u) * nloc) {
            __builtin_amdgcn_fence(__ATOMIC_RELEASE, "agent");
            asm volatile("s_waitcnt vmcnt(0)" ::: "memory");
            const unsigned og = xb_add(&bar[XB_TOP], 1u);
            const unsigned tg = og / nx;
            if (og + 1u == (tg + 1u) * nx) xb_add(&bar[XB_TOPGEN], 1u);
            else XB_SPIN(xb_ld(&bar[XB_TOPGEN]) == tg, bar);
            __builtin_amdgcn_fence(__ATOMIC_ACQUIRE, "agent");
            xb_add(&bar[XB_XGEN(b.x)], 1u);
            asm volatile("s_waitcnt vmcnt(0)" ::: "memory");
        } else {
            XB_SPIN(xb_ld(&bar[XB_XGEN(b.x)]) == gen, bar);
            __builtin_amdgcn_fence(__ATOMIC_ACQUIRE, "agent");
            asm volatile("s_waitcnt vmcnt(0)" ::: "memory");
        }
    }
    __syncthreads();
}


constexpr size_t MiB = 1u << 20;
constexpr size_t WS_CTL = 0, CTL_ZERO_BYTES = 1 * MiB;
constexpr size_t WS_MOD = 1 * MiB;
constexpr size_t WS_H2F = 4 * MiB;
constexpr size_t WS_KF = 8 * MiB;
constexpr size_t WS_WIN = 136 * MiB;
constexpr size_t WS_WUP = 320 * MiB;
constexpr size_t WS_WDN = 496 * MiB;
constexpr size_t WS_WOUT = 584 * MiB;
constexpr size_t WS_WBH = 616 * MiB;
constexpr size_t WS_HB = 640 * MiB;
constexpr size_t WS_YHT = 704 * MiB;
constexpr size_t WS_YH = 736 * MiB;
constexpr size_t WS_MB = 784 * MiB;
constexpr size_t WS_ACT = 1522 * MiB;
constexpr size_t WS_UT = 848 * MiB;
constexpr size_t WS_VT = 944 * MiB;
constexpr size_t WS_QKG = 992 * MiB;
constexpr size_t WS_OG = 1216 * MiB;
constexpr size_t WS_LSE = 1264 * MiB;
constexpr size_t WS_GB = 848 * MiB;
constexpr size_t WS_HB2 = 1266 * MiB;
constexpr size_t WS_XB = 1330 * MiB;
constexpr size_t WS_PART = 1698 * MiB;
constexpr size_t WS_END = 1699 * MiB;
constexpr int CW_BAR = 4096, CW_PANEL = 131072  , CW_TMO = CW_PANEL + 64 * 64;
constexpr int LDS_BYTES = 155648, MISC_OFF = 139264; static_assert(pg8::EPI_LDS_OFF == MISC_OFF + 1024 && pg8::EPI_LDS_OFF + 13312 + 64 <= LDS_BYTES, "epilogue vector buffers + row-sum exchange tables");
constexpr int N_PHASES = 1 + DEPTH_ * 2 + 1 + DEPTH_ * NCHUNK * 7 + 1 + 1;

#ifndef PG8_ALIGN
#define PG8_ALIGN true
#endif
struct Args { const float* in[29]; float* out; unsigned char* ws; int ph_lo, ph_hi; };

using pg8::bflo; using pg8::bfhi;
__device__ __forceinline__ float wave_sum(float v, int lane) {
#pragma unroll
    for (int o = 1; o < 64; o <<= 1) v += shfl_from(v, lane ^ o);
    return v;
}
__device__ __forceinline__ void transpose_item(const float* W, int K, int N, bf16_t* WT, int k0, int n0, int drow0, LAS float* scr, int lane) {
#pragma unroll 8
    for (int i = 0; i < 32; ++i) { const int kk = 2 * i + (lane >> 5); scr[kk * 33 + (lane & 31)] = W[(size_t)(k0 + kk) * N + n0 + (lane & 31)]; }
    asm volatile("s_waitcnt lgkmcnt(0)" ::: "memory");
    const int c = lane & 7;
#pragma unroll
    for (int j = 0; j < 4; ++j) { const int n = (lane >> 3) + 8 * j; const LAS float* s = scr + (8 * c) * 33 + n;
        u32x4 o; o.x = pk2(s[0 * 33], s[1 * 33]); o.y = pk2(s[2 * 33], s[3 * 33]); o.z = pk2(s[4 * 33], s[5 * 33]); o.w = pk2(s[6 * 33], s[7 * 33]);
        *(u32x4*)(WT + (size_t)(drow0 + n) * K + k0 + 8 * c) = o; }
    asm volatile("s_waitcnt lgkmcnt(0)" ::: "memory");
}
__device__ __forceinline__ int win_dest_row(int n0) {
    if (n0 < 3072) return n0;
    if (n0 < 4608) return n0 + 1536;
    if (n0 < 6144) return n0 + 1536;
    if (n0 < 7680) return n0 - 3072;
    const int g = n0 - 7680, c = g & 2047;
    return 7680 + (c >> 7) * 256 + (g >> 11) * 128 + (c & 127);
}
__device__ __forceinline__ int wup_dest_row(int n0) {
    const int j = (n0 < 5632) ? n0 : n0 - 5632; return (j >> 7) * 256 + ((n0 < 5632) ? 0 : 128) + (j & 127);
}
__device__ __forceinline__ void prologue_phase(const __attribute__((address_space(4))) Args* Ap, LAS unsigned char* lds, int vcu, int G, int tid) {
    const int lane = tid & 63, wave = tid >> 6;
    unsigned char* ws = Ap->ws;
    {
        LAS float* scr = (LAS float*)(lds + wave * 16384);
        const int gw = vcu * 8 + wave, NGW = G * 8;
        constexpr int I_IN = 32 * 368, I_UP = 32 * 352, I_DN = 88 * 64, I_OUT = 32 * 64, I_BH = 16 * 64, I_BA = 8 * 64, I_L = I_IN + I_UP + I_DN + I_OUT + I_BH + I_BA;
        for (int it = gw; it < DEPTH_ * I_L; it += NGW) {
            const int l = it / I_L; int r = it % I_L;
            if (r < I_IN) { const int kb = r / 368, nb = r % 368; transpose_item(Ap->in[7] + (size_t)l * 2048 * 11776, 2048, 11776, (bf16_t*)(ws + WS_WIN) + (size_t)l * 11776 * 2048, 64 * kb, 32 * nb, win_dest_row(32 * nb), scr, lane); continue; } r -= I_IN;
            if (r < I_UP) { const int kb = r / 352, nb = r % 352; transpose_item(Ap->in[24] + (size_t)l * 2048 * 11264, 2048, 11264, (bf16_t*)(ws + WS_WUP) + (size_t)l * 11264 * 2048, 64 * kb, 32 * nb, wup_dest_row(32 * nb), scr, lane); continue; } r -= I_UP;
            if (r < I_DN) { const int kb = r / 64, nb = r % 64; transpose_item(Ap->in[27] + (size_t)l * 5632 * 2048, 5632, 2048, (bf16_t*)(ws + WS_WDN) + (size_t)l * 2048 * 5632, 64 * kb, 32 * nb, 32 * nb, scr, lane); continue; } r -= I_DN;
            if (r < I_OUT) { const int kb = r / 64, nb = r % 64; transpose_item(Ap->in[22] + (size_t)l * 2048 * 2048, 2048, 2048, (bf16_t*)(ws + WS_WOUT) + (size_t)l * 2048 * 2048, 64 * kb, 32 * nb, 32 * nb, scr, lane); continue; } r -= I_OUT;
            if (r < I_BH) { const int kb = r / 64, nb = r % 64; transpose_item(Ap->in[20] + (size_t)l * 1024 * 2048, 1536, 2048, (bf16_t*)(ws + WS_WBH) + (size_t)l * 2048 * 1536, 64 * kb, 32 * nb, 32 * nb, scr, lane); continue; } r -= I_BH;
            { const int kb = r / 64, nb = r % 64; transpose_item(Ap->in[21] + (size_t)l * 512 * 2048, 1536, 2048, (bf16_t*)(ws + WS_WBH) + (size_t)l * 2048 * 1536 + 1024, 64 * kb, 32 * nb, 32 * nb, scr, lane); }
        }
    }
    __syncthreads();
    {
        LAS float* cs = (LAS float*)lds;
        LAS float* red = (LAS float*)(lds + 98304);
        bool loaded = false;
        for (int unit = vcu; unit < DEPTH_ * 192; unit += G) {
            if (!loaded) {
                for (int i = tid; i < 12 * 2048; i += NTHR) { const int b = i >> 11, k = i & 2047; const float c = (b < 4) ? Ap->in[2][b * 2048 + k] : Ap->in[3][(b - 4) * 2048 + k]; cs[i] = c / (1.0f + __expf(-c)); }
                loaded = true; __syncthreads();
            }
            const int l = unit / 192, j = (unit % 192) * 64 + lane;
            const float* wp = Ap->in[4] + ((size_t)l * 2048 + wave * 256) * 12288 + j;
            float acc[12];
#pragma unroll
            for (int b = 0; b < 12; ++b) acc[b] = 0.f;
#pragma unroll 4
            for (int k = 0; k < 256; ++k) { const float w = wp[(size_t)k * 12288];
#pragma unroll
                for (int b = 0; b < 12; ++b) acc[b] += w * cs[b * 2048 + wave * 256 + k]; }
#pragma unroll
            for (int b = 0; b < 12; ++b) red[(wave * 12 + b) * 64 + lane] = acc[b];
            __syncthreads();
            for (int i = tid; i < 12 * 64; i += NTHR) { const int b = i >> 6, jj = i & 63; float s = 0.f;
#pragma unroll
                for (int w = 0; w < 8; ++w) s += red[(w * 12 + b) * 64 + jj];
                const int col = (unit % 192) * 64 + jj;
                ((float*)(ws + WS_MOD))[((size_t)l * 12 + b) * 12288 + col] = s + Ap->in[5][l * 12288 + col]; }
            __syncthreads();
        }
    }
}
template <bool XBF> __device__ __forceinline__ void norm_phase(const void* xv, bf16_t* hout, const float* gn, const float* modb  , int sh_off, int sc_off, int gw, int NGW, int lane, bf16_t* xcopy = nullptr  ) {
    int curb = -1; f32x4 gs[8], sh[8];
    for (int row = gw; row < MROWS; row += NGW) {
        const int b = row >> 12;
        if (b != curb) { curb = b;
#pragma unroll
            for (int j = 0; j < 8; ++j) { const int col = 4 * lane + 256 * j; const f32x4 g = *(const f32x4*)(gn + col), sc = *(const f32x4*)(modb + (size_t)b * 12288 + sc_off + col);
                gs[j] = g * (sc + 1.0f); sh[j] = *(const f32x4*)(modb + (size_t)b * 12288 + sh_off + col); } }
        f32x4 v[8]; float ss = 0.f;
        if constexpr (XBF) {
            const u32x2* xr = (const u32x2*)((const bf16_t*)xv + (size_t)row * 2048) + lane; u32x2 r[8];
#pragma unroll
            for (int j = 0; j < 8; ++j) r[j] = xr[64 * j];
#pragma unroll
            for (int j = 0; j < 8; ++j) { v[j].x = hlo(r[j].x); v[j].y = hhi(r[j].x); v[j].z = hlo(r[j].y); v[j].w = hhi(r[j].y); }
        } else {
            const f32x4* xr = (const f32x4*)((const float*)xv + (size_t)row * 2048) + lane;
#pragma unroll
            for (int j = 0; j < 8; ++j) v[j] = xr[64 * j];
            if (xcopy) { u32x2* c8 = (u32x2*)(xcopy + (size_t)row * 2048) + lane;
#pragma unroll
                for (int j = 0; j < 8; ++j) { u32x2 w; w.x = pkh2(v[j].x, v[j].y); w.y = pkh2(v[j].z, v[j].w); c8[64 * j] = w; } }
        }
#pragma unroll
        for (int j = 0; j < 8; ++j) ss += (v[j].x * v[j].x + v[j].y * v[j].y) + (v[j].z * v[j].z + v[j].w * v[j].w);
        const float rstd = 1.0f / sqrtf(wave_sum(ss, lane) * (1.0f / 2048.0f) + 1e-6f);
        u32x2* o8 = (u32x2*)(hout + (size_t)row * 2048) + lane;
#pragma unroll
        for (int j = 0; j < 8; ++j) { const f32x4 y = v[j] * rstd * gs[j] + sh[j]; u32x2 w; w.x = pk2(y.x, y.y); w.y = pk2(y.z, y.w); o8[64 * j] = w; }
    }
}
__device__ __forceinline__ void final_norm_phase(const bf16_t* xb, float* out, const float* gn, int gw, int NGW, int lane) {
    f32x4 gs[8];
#pragma unroll
    for (int j = 0; j < 8; ++j) gs[j] = *(const f32x4*)(gn + 4 * lane + 256 * j);
    for (int row = gw; row < NSEQ * SEQ; row += NGW) {
        const u32x2* xr = (const u32x2*)(xb + (size_t)row * 2048) + lane; u32x2 r[8];
#pragma unroll
        for (int j = 0; j < 8; ++j) r[j] = xr[64 * j];
        f32x4 v[8]; float ss = 0.f;
#pragma unroll
        for (int j = 0; j < 8; ++j) { v[j].x = hlo(r[j].x); v[j].y = hhi(r[j].x); v[j].z = hlo(r[j].y); v[j].w = hhi(r[j].y);
            ss += (v[j].x * v[j].x + v[j].y * v[j].y) + (v[j].z * v[j].z + v[j].w * v[j].w); }
        const float rstd = 1.0f / sqrtf(wave_sum(ss, lane) * (1.0f / 2048.0f) + 1e-6f);
        f32x4* o = (f32x4*)(out + (size_t)row * 2048) + lane;
#pragma unroll
        for (int j = 0; j < 8; ++j) o[64 * j] = v[j] * rstd * gs[j];
    }
}
__device__ __forceinline__ void transpose_yh_tile(int tile, const bf16_t* YHT, bf16_t* YH, LAS bf16_t* scr, int lane) {
    const int b = tile >> 10, ct = (tile >> 6) & 15, tt = tile & 63, c0 = ct * 64, t0 = tt * 64;
#pragma unroll
    for (int i = 0; i < 8; ++i) { const int row = (lane >> 3) + 8 * i, ch = lane & 7;
        const u32x4 v = *(const u32x4*)(YHT + ((size_t)(b * 1024 + c0 + row)) * 4096 + t0 + 8 * ch);
        LAS bf16_t* d = scr + row * 66 + 8 * ch;
        d[0] = (bf16_t)(v.x & 0xffffu); d[1] = (bf16_t)(v.x >> 16); d[2] = (bf16_t)(v.y & 0xffffu); d[3] = (bf16_t)(v.y >> 16);
        d[4] = (bf16_t)(v.z & 0xffffu); d[5] = (bf16_t)(v.z >> 16); d[6] = (bf16_t)(v.w & 0xffffu); d[7] = (bf16_t)(v.w >> 16); }
    asm volatile("s_waitcnt lgkmcnt(0)" ::: "memory");
#pragma unroll
    for (int i = 0; i < 8; ++i) { const int r = (lane >> 3) + 8 * i, ch = lane & 7; u32x4 w; unsigned q[4];
#pragma unroll
        for (int e = 0; e < 4; ++e) q[e] = (unsigned)scr[(8 * ch + 2 * e) * 66 + r] | ((unsigned)scr[(8 * ch + 2 * e + 1) * 66 + r] << 16);
        w.x = q[0]; w.y = q[1]; w.z = q[2]; w.w = q[3]; *(u32x4*)(YH + ((size_t)(b * 4096 + t0 + r)) * 1536 + c0 + 8 * ch) = w; }
    asm volatile("s_waitcnt lgkmcnt(0)" ::: "memory");
}
__device__ __forceinline__ void cg_fix_item(int idx, bf16_t* ACT, const bf16_t* GB, const float* cw, const float* cb) {
    const int col = (idx % 704) * 8, rs = idx / 704, side = rs & 1, grp = rs >> 1, row = grp * 64 + (side ? 63 : 0), t = row & 4095;
    const bf16_t* gb = GB + (size_t)grp * 4 * 5632 + col;
    u32x4 gm = (u32x4){0u, 0u, 0u, 0u}, gp = (u32x4){0u, 0u, 0u, 0u}, g0;
    if (side == 0) { g0 = *(const u32x4*)gb; gp = *(const u32x4*)(gb + 5632); if (t > 0) gm = *(const u32x4*)(gb - 5632); }
    else { gm = *(const u32x4*)(gb + 2 * 5632); g0 = *(const u32x4*)(gb + 3 * 5632); if (t < 4095) gp = *(const u32x4*)(gb + 4 * 5632); }
    bf16_t* ap = ACT + (size_t)row * 5632 + col;
    const u32x4 a = *(const u32x4*)ap;
    const f32x4 w0a = *(const f32x4*)(cw + col), w0b = *(const f32x4*)(cw + col + 4), w1a = *(const f32x4*)(cw + 5632 + col), w1b = *(const f32x4*)(cw + 5632 + col + 4);
    const f32x4 w2a = *(const f32x4*)(cw + 11264 + col), w2b = *(const f32x4*)(cw + 11264 + col + 4), ba = *(const f32x4*)(cb + col), bb = *(const f32x4*)(cb + col + 4);
    float w0[8] = {w0a.x, w0a.y, w0a.z, w0a.w, w0b.x, w0b.y, w0b.z, w0b.w}, w1[8] = {w1a.x, w1a.y, w1a.z, w1a.w, w1b.x, w1b.y, w1b.z, w1b.w};
    float w2[8] = {w2a.x, w2a.y, w2a.z, w2a.w, w2b.x, w2b.y, w2b.z, w2b.w}, bs[8] = {ba.x, ba.y, ba.z, ba.w, bb.x, bb.y, bb.z, bb.w};
    u32x4 o;
#pragma unroll
    for (int i = 0; i < 4; ++i) {
        const float xl = bflo(gm[i]) * w0[2 * i] + bflo(g0[i]) * w1[2 * i] + bflo(gp[i]) * w2[2 * i] + bs[2 * i];
        const float xh = bfhi(gm[i]) * w0[2 * i + 1] + bfhi(g0[i]) * w1[2 * i + 1] + bfhi(gp[i]) * w2[2 * i + 1] + bs[2 * i + 1];
        const float sl = xl / (1.0f + __expf(-xl)), shh = xh / (1.0f + __expf(-xh));
        o[i] = pk2(sl * bflo(a[i]), shh * bfhi(a[i]));
    }
    *(u32x4*)ap = o;
}

typedef const __attribute__((address_space(4))) Args* kargs_t;
__global__ void __launch_bounds__(512, 2) mega_fwd(Args args) {
    extern __shared__ __attribute__((aligned(16))) unsigned char lds_raw[];
    LAS unsigned char* lds = (LAS unsigned char*)lds_raw;
    const int G = gridDim.x, bx = blockIdx.x, vcu = (G % 8 == 0) ? (bx % 8) * (G / 8) + bx / 8 : bx, NGW = G * 8;
    const int lo = args.ph_lo, hi = args.ph_hi;
    const int wave_s = __builtin_amdgcn_readfirstlane(threadIdx.x >> 6);
    {
        volatile LAS unsigned* MISC = (volatile LAS unsigned*)(lds + MISC_OFF);
        for (int u = threadIdx.x; u < (LDS_BYTES - MISC_OFF) / 4; u += NTHR) MISC[u] = 0u;
        __syncthreads();
    }
    XcdBarrier bar; bar.bar = (unsigned*)(args.ws + WS_CTL) + CW_BAR; bar.x = 0; bar.st = nullptr;
    if (hi - lo > 1) bar = xcd_barrier_post((unsigned*)(args.ws + WS_CTL) + CW_BAR, (volatile LAS unsigned*)(lds + MISC_OFF) + 8);
#ifndef NOBAR_PASSES
#define NOBAR_PASSES 0
#endif
    int pc = 0;
#define IS_T0() ({ int t0_; asm volatile("v_mbcnt_lo_u32_b32 %0, -1, 0\n\tv_mbcnt_hi_u32_b32 %0, -1, %0" : "=v"(t0_)); (t0_ | wave_s) == 0; })
#define PH_IN (pc >= lo && pc < hi)
#define PH_CTX int ptid; asm volatile("v_mbcnt_lo_u32_b32 %0, -1, 0\n\tv_mbcnt_hi_u32_b32 %0, -1, %0" : "=v"(ptid)); ptid |= (wave_s << 6); const int plane = ptid & 63, pwave = __builtin_amdgcn_readfirstlane(ptid >> 6), pgw = vcu * 8 + pwave; (void)plane; (void)pgw; \
    kargs_t ap = (kargs_t)__builtin_amdgcn_kernarg_segment_ptr(); asm volatile("" : "+s"(ap)); unsigned char* const pws = ap->ws; (void)pws; int pl = l, pch = ch; asm volatile("" : "+s"(pl), "+s"(pch)); (void)pl; (void)pch;
#ifndef DUP_MASK
#define DUP_MASK 0
#endif
#ifndef DUP_REP
#define DUP_REP 2
#endif
#ifndef DUP_BAR
#define DUP_BAR 0
#endif
#define DUP(bit) for (int rep_ = 0; rep_ < (((DUP_MASK) & (bit)) ? (DUP_REP) : 1); (void)(((DUP_BAR) && ((DUP_MASK) & (bit)) && rep_ + 1 < (DUP_REP)) ? (xcd_barrier(bar, IS_T0()), 0) : 0), ++rep_)
#ifndef BAR_REP
#define BAR_REP 1
#endif
#define PH_END do { if (pc >= lo && pc + 1 < hi && pass_ == (NOBAR_PASSES)) { for (int br_ = 0; br_ < (BAR_REP); ++br_) xcd_barrier(bar, IS_T0()); } ++pc; } while (0)
#define WSP(T, off) ((T*)(pws + (off)))
#define XO_PTR (WSP(bf16_t, WS_XB) + (size_t)pch * MROWS * 2048)
#define XIN0_PTR ((pch == 0) ? ap->in[0] : ap->in[1] + (size_t)(pch - 1) * MROWS * 2048)
#define MODB_PTR (WSP(const float, WS_MOD) + ((size_t)pl * 12 + pch * 4) * 12288)
#define HB_CUR (((pl * NCHUNK + pch) & 1) ? WSP(bf16_t, WS_HB2) : WSP(bf16_t, WS_HB))

    for (int pass_ = 0; pass_ <= (NOBAR_PASSES); ++pass_) {
    pc = 0;
    if (pass_ > 0 && pass_ == (NOBAR_PASSES)) xcd_barrier(bar, IS_T0());
    { const int l = 0, ch = 0; if (PH_IN) DUP(512) { PH_CTX prologue_phase(ap, lds, vcu, G, ptid); __syncthreads(); } }
    PH_END;
    for (int l = 0; l < DEPTH_; ++l) {
        { const int ch = 0;
          if (PH_IN) DUP(1024) { PH_CTX int pvcu = vcu; asm volatile("" : "+s"(pvcu)); for (int u = pvcu; u < 512; u += G) filt_hidden_unit(u, ap->in[11] + pl * 33 * 64, ap->in[12] + pl * 64, ap->in[13] + pl * 64, ap->in[14] + pl * 64 * 64, ap->in[15] + pl * 64, ap->in[16] + pl * 64, nullptr, WSP(bf16_t, WS_H2F), (LAS float*)lds, ptid); }
          PH_END;
          if (PH_IN) DUP(2048) { PH_CTX int pvcu = vcu; asm volatile("" : "+s"(pvcu)); for (int c2 = pvcu; c2 < 512; c2 += G) filt_channel_unit2(2 * c2, WSP(const bf16_t, WS_H2F), ap->in[17] + (size_t)pl * 64 * 4096, WSP(unsigned, WS_KF), lds, ptid); }
          PH_END; }
        for (int ch = 0; ch < NCHUNK; ++ch) {
            if (l == 0 && ch == 0) {
                if (PH_IN) { PH_CTX norm_phase<false>(XIN0_PTR, WSP(bf16_t, WS_HB), ap->in[6], MODB_PTR, 0, 2048, pgw, NGW, plane, XO_PTR); }
                PH_END;
            }
            if (PH_IN) DUP(2) {
                { PH_CTX const bf16_t* Win = WSP(const bf16_t, WS_WIN) + (size_t)pl * 11776 * 2048;
                  pg8::Gemm g{Win, HB_CUR, 3584, MROWS, 2048}; pg8::StaticOrder S; S.init(3584, MROWS, G, bx); pg8::EpiG1a<0> E{WSP(bf16_t, WS_UT), WSP(bf16_t, WS_VT)};
                  pg8::gemm_phase<pg8::EpiG1a<0>, pg8::StaticOrder, PG8_ALIGN, true>(lds, g, S, E, ptid); }
                { PH_CTX const bf16_t* Win = WSP(const bf16_t, WS_WIN) + (size_t)pl * 11776 * 2048 + (size_t)3584 * 2048;
                  pg8::Gemm g{Win, HB_CUR, 512, MROWS, 2048}; pg8::StaticOrder S; S.init(512, MROWS, G, (bx + G / 2) % G); pg8::EpiG1a<1> E{WSP(bf16_t, WS_UT), WSP(bf16_t, WS_VT)};
                  pg8::gemm_phase<pg8::EpiG1a<1>, pg8::StaticOrder, PG8_ALIGN, true>(lds, g, S, E, ptid); }
                { PH_CTX const bf16_t* Win = WSP(const bf16_t, WS_WIN) + (size_t)pl * 11776 * 2048 + (size_t)4096 * 2048;
                  pg8::Gemm g{Win, HB_CUR, 512, MROWS, 2048}; pg8::StaticOrder S; S.init(512, MROWS, G, bx); pg8::EpiG1a<2> E{WSP(bf16_t, WS_UT), WSP(bf16_t, WS_VT)};
                  pg8::gemm_phase<pg8::EpiG1a<2>, pg8::StaticOrder, PG8_ALIGN, true>(lds, g, S, E, ptid); }
                { PH_CTX const bf16_t* Win = WSP(const bf16_t, WS_WIN) + (size_t)pl * 11776 * 2048;
                  pg8::Gemm g{HB_CUR, Win + (size_t)NA_ * 2048, MROWS, NB_, 2048}; pg8::StaticOrder S; S.init(MROWS, NB_, G, bx); pg8::EpiG1b E{WSP(bf16_t, WS_QKG), ap->in[8] + pl * 4096};
                  pg8::gemm_phase<pg8::EpiG1b, pg8::StaticOrder, PG8_ALIGN, true>(lds, g, S, E, ptid); }
                if (l * NCHUNK + ch + 1 < DEPTH_ * NCHUNK) {
                    PH_CTX
                    const int itn = pl * NCHUNK + pch + 1, ln = itn / NCHUNK, chn = itn % NCHUNK;
                    const bool split = (G == 256);
                    if (!split || bx >= 128) {
                        const int lw = (split ? bx - 128 : bx) * 8 + pwave, nlw = (split ? 128 : G) * 8;
                        bf16_t* hn = (itn & 1) ? WSP(bf16_t, WS_HB2) : WSP(bf16_t, WS_HB); const float* mb = WSP(const float, WS_MOD) + ((size_t)ln * 12 + chn * 4) * 12288;
                        if (ln == 0) norm_phase<false>((chn == 0) ? ap->in[0] : ap->in[1] + (size_t)(chn - 1) * MROWS * 2048, hn, ap->in[6] + ln * 2048, mb, 0, 2048, lw, nlw, plane, WSP(bf16_t, WS_XB) + (size_t)chn * MROWS * 2048);
                        else norm_phase<true>(WSP(bf16_t, WS_XB) + (size_t)chn * MROWS * 2048, hn, ap->in[6] + ln * 2048, mb, 0, 2048, lw, nlw, plane);
                    }
                }
            }
            PH_END;
            if (PH_IN) {
                DUP(4) { PH_CTX
                  hyena_units(vcu, G, WSP(const bf16_t, WS_UT), WSP(bf16_t, WS_YHT), WSP(const unsigned, WS_KF), ap->in[9] + pl * 3 * 3072, ap->in[10] + pl * 3072, ap->in[18] + pl * 2048, lds, ptid, rep_ < (DUP_REP) - 1 && ((DUP_MASK) & 4));
                  __syncthreads(); }
                DUP(8) { PH_CTX
                  attn_bias_table((LAS float*)(lds + AT_TAB_OFF), ap->in[19], ptid);
                  attn_units(vcu, G, 4 * 24 * 16, WSP(const bf16_t, WS_QKG), WSP(const bf16_t, WS_VT), WSP(bf16_t, WS_OG), WSP(float, WS_LSE), lds, ptid);
                  __syncthreads(); }
            }
            PH_END;
            if (PH_IN) DUP(16) {
                PH_CTX
                for (int tile = pgw; tile < 4096; tile += NGW) transpose_yh_tile(tile, WSP(const bf16_t, WS_YHT), WSP(bf16_t, WS_YH), (LAS bf16_t*)(lds + pwave * 8448), plane);
                for (int it = bx * NTHR + ptid; it < MROWS * 64; it += G * NTHR) attn_combine_item(it, WSP(const bf16_t, WS_OG), WSP(const float, WS_LSE), WSP(bf16_t, WS_YH), 1536, 1024);
                __syncthreads();
            }
            PH_END;
            if (PH_IN) DUP(32) { PH_CTX pg8::Gemm g{WSP(const bf16_t, WS_YH), WSP(const bf16_t, WS_WBH) + (size_t)pl * 2048 * 1536, MROWS, 2048, 1536}; pg8::StaticOrder S; S.init(MROWS, 2048, G, bx);
                pg8::EpiG2M E{WSP(const bf16_t, WS_QKG), WSP(bf16_t, WS_MB)};
                pg8::gemm_phase<pg8::EpiG2M, pg8::StaticOrder, PG8_ALIGN, true>(lds, g, S, E, ptid); }
            PH_END;
            if (PH_IN) { PH_CTX pg8::Gemm g{WSP(const bf16_t, WS_MB), WSP(const bf16_t, WS_WOUT) + (size_t)pl * 2048 * 2048, MROWS, 2048, 2048};
                pg8::PanelOrder S; S.init(MROWS, 2048, G, bx);
                pg8::EpiResN<false> E{nullptr, XO_PTR, XO_PTR, HB_CUR, MODB_PTR, ap->in[23] + pl * 2048, 2 * 2048, WSP(float, WS_PART), (unsigned*)(pws + WS_CTL) + CW_PANEL, 32u * (unsigned)(pl * NCHUNK + pch + 1), (unsigned*)(pws + WS_CTL) + CW_TMO};
                pg8::gemm_phase<pg8::EpiResN<false>, pg8::PanelOrder, PG8_ALIGN, true>(lds, g, S, E, ptid); }
            PH_END;
            if (PH_IN) DUP(128) { PH_CTX pg8::Gemm g{HB_CUR, WSP(const bf16_t, WS_WUP) + (size_t)pl * 11264 * 2048, MROWS, 11264, 2048}; pg8::StaticOrder S; S.init(MROWS, 11264, G, bx); pg8::EpiUpCG E{WSP(bf16_t, WS_ACT), WSP(bf16_t, WS_GB), ap->in[25] + (size_t)pl * 3 * 5632, ap->in[26] + pl * 5632};
                pg8::gemm_phase<pg8::EpiUpCG, pg8::StaticOrder, PG8_ALIGN, true>(lds, g, S, E, ptid); }
            PH_END;
            if (PH_IN) { PH_CTX for (int it = bx * NTHR + ptid; it < 256 * 2 * 704; it += G * NTHR) cg_fix_item(it, WSP(bf16_t, WS_ACT), WSP(const bf16_t, WS_GB), ap->in[25] + (size_t)pl * 3 * 5632, ap->in[26] + pl * 5632); }
            PH_END;
            if (PH_IN) DUP(8192) { PH_CTX pg8::Gemm g{WSP(const bf16_t, WS_ACT), WSP(const bf16_t, WS_WDN) + (size_t)pl * 2048 * 5632, MROWS, 2048, 5632}; pg8::StaticOrder S; S.init(MROWS, 2048, G, bx);
                pg8::EpiResB<false> E{nullptr, XO_PTR, (((DUP_MASK) & 8192) && rep_ < (DUP_REP) - 1) ? WSP(bf16_t, WS_YHT) : XO_PTR, MODB_PTR + 5 * 2048};
                pg8::gemm_phase<pg8::EpiResB<false>, pg8::StaticOrder, PG8_ALIGN, true>(lds, g, S, E, ptid); }
            if (l == DEPTH_ - 1 && ch == NCHUNK - 1) PH_END;
        }
    }
    { const int l = 0, ch = 0; if (PH_IN) { PH_CTX final_norm_phase(WSP(const bf16_t, WS_XB), ap->out, ap->in[28], pgw, NGW, plane); } }
    PH_END;
    }
#undef PH_IN
#undef PH_CTX
#undef PH_END
#undef DUP
}

#ifndef MK_LAUNCH_PER_PHASE
#define MK_LAUNCH_PER_PHASE 0
#endif
extern "C" void kernel_launch(void* const* d_in, const int* in_sizes, int n_in, void* d_out, int out_size, void* d_ws, size_t ws_size, hipStream_t stream) {
    static int grid = 0;
    if (grid == 0) {
        if (n_in != 29 || out_size != NSEQ * SEQ * 2048 || ws_size < WS_END) { fprintf(stderr, "kernel_launch: unexpected sizes n_in %d out %d ws %zu\n", n_in, out_size, ws_size); grid = -1; return; }
        int dev = 0, cus = 0, per_cu = 0;
        if (hipGetDevice(&dev) != hipSuccess || hipDeviceGetAttribute(&cus, hipDeviceAttributeMultiprocessorCount, dev) != hipSuccess) { grid = -1; return; }
        if (hipFuncSetAttribute((const void*)mega_fwd, hipFuncAttributeMaxDynamicSharedMemorySize, LDS_BYTES) != hipSuccess) { fprintf(stderr, "kernel_launch: hipFuncSetAttribute failed\n"); grid = -1; return; }
        if (hipOccupancyMaxActiveBlocksPerMultiprocessor(&per_cu, (const void*)mega_fwd, 512, LDS_BYTES) != hipSuccess || per_cu < 1) fprintf(stderr, "kernel_launch: occupancy query says %d\n", per_cu);
        (void)hipGetLastError();
        grid = cus >= 256 ? 256 : cus >= 128 ? 128 : cus >= 64 ? 64 : -1;
        if (grid < 0) { fprintf(stderr, "kernel_launch: %d CUs\n", cus); return; }
    }
    if (grid < 0) return;
    (void)hipMemsetAsync((char*)d_ws + WS_CTL, 0, CTL_ZERO_BYTES, stream);
    Args a{};
    for (int i = 0; i < 29; ++i) a.in[i] = (const float*)d_in[i];
    a.out = (float*)d_out; a.ws = (unsigned char*)d_ws;
#if MK_LAUNCH_PER_PHASE
    for (int p = 0; p < N_PHASES; ++p) { a.ph_lo = p; a.ph_hi = p + 1; hipLaunchKernelGGL(mega_fwd, dim3(grid), dim3(512), LDS_BYTES, stream, a); }
#else
    a.ph_lo = 0; a.ph_hi = N_PHASES; hipLaunchKernelGGL(mega_fwd, dim3(grid), dim3(512), LDS_BYTES, stream, a);
#endif
}
```
